# Optimizing an MI355X kernel written in HIP

```python
import jax, jax.numpy as jnp
from jax import lax
import numpy as np

D_MODEL = 1024
BATCH = 2
SEQ = 8192
DEPTH = 1

GRID_W = 64
CTX_LEN = 256
N_HEADS = 6
QK_NOPE_DIM = 128
QK_ROPE_DIM = 64
V_HEAD_DIM = 128
Q_LORA_RANK = 384
KV_LORA_RANK = 256
MLA_WIDTH = N_HEADS * V_HEAD_DIM
FOURIER_GROUPS = 4
FOURIER_GROUP_DIM = 64
FOURIER_WIDTH = FOURIER_GROUPS * FOURIER_GROUP_DIM
MIX_WIDTH = MLA_WIDTH + FOURIER_WIDTH
IN_PROJ_WIDTH = FOURIER_WIDTH + Q_LORA_RANK + KV_LORA_RANK + QK_ROPE_DIM
ROPE_BASE = 10000.0
Q_BLOCK = 128
N_EXPERTS = 32
TOP_K = 4
D_FF = 1024
SWIGLU_LIMIT = 7.0
SWIGLU_ALPHA = 1.702
EXPERT_BLOCK = 128
RMS_EPS = 1e-6
N_MOD = 6

kernel_name = "hybrid_mla_fnet_moe_dit_block"


def rms_norm(x, g):
    xf = x.astype(jnp.float32)
    y = xf * lax.rsqrt(jnp.mean(xf * xf, axis=-1, keepdims=True) + RMS_EPS)
    return (y * g.astype(jnp.float32)).astype(x.dtype)


def modulate(x, g, shift, scale):
    return rms_norm(x, g) * (1 + scale) + shift


def axial_rope_tables(n_tokens):
    rows = n_tokens // GRID_W
    row = jnp.repeat(jnp.arange(rows, dtype=jnp.float32), GRID_W)
    col = jnp.tile(jnp.arange(GRID_W, dtype=jnp.float32), rows)
    half = QK_ROPE_DIM // 2
    inv = 1.0 / (ROPE_BASE ** (jnp.arange(0, half, 2, dtype=jnp.float32) / half))
    ang = jnp.concatenate([row[:, None] * inv, col[:, None] * inv], axis=-1)
    return jnp.cos(ang), jnp.sin(ang)


def rotate(x, cos, sin):
    xf = x.astype(jnp.float32)
    xe, xo = xf[..., 0::2], xf[..., 1::2]
    out = jnp.stack([xe * cos - xo * sin, xe * sin + xo * cos], axis=-1)
    return out.reshape(x.shape).astype(x.dtype)


def mla_project(p, norm_q, norm_kv, w_q_up, w_kv_up, rope):
    B, N, _ = p.shape
    q_lat, kv_lat, k_rope = jnp.split(p, [Q_LORA_RANK, Q_LORA_RANK + KV_LORA_RANK], axis=-1)
    q = (rms_norm(q_lat, norm_q) @ w_q_up).reshape(B, N, N_HEADS, QK_NOPE_DIM + QK_ROPE_DIM)
    kv = (rms_norm(kv_lat, norm_kv) @ w_kv_up).reshape(B, N, N_HEADS, QK_NOPE_DIM + V_HEAD_DIM)
    q_nope, q_rope = jnp.split(q, [QK_NOPE_DIM], axis=-1)
    k_nope, v = jnp.split(kv, [QK_NOPE_DIM], axis=-1)
    if rope is not None:
        cos, sin = rope
        q_rope = rotate(q_rope, cos[:, None, :], sin[:, None, :])
        k_rope = rotate(k_rope, cos, sin)
    k_rope = jnp.broadcast_to(k_rope[:, :, None, :], (B, N, N_HEADS, QK_ROPE_DIM))
    q = jnp.concatenate([q_nope, q_rope], axis=-1)
    k = jnp.concatenate([k_nope, k_rope], axis=-1)
    return q, k, v


def attend(q, k, v):
    B, N, H, Dq = q.shape
    nb = N // Q_BLOCK
    scale = Dq ** -0.5
    qb = jnp.moveaxis(q.reshape(B, nb, Q_BLOCK, H, Dq), 1, 0)

    def one_block(q_blk):
        s = jnp.einsum('bqhd,bkhd->bhqk', q_blk, k, preferred_element_type=jnp.float32) * scale
        pr = jax.nn.softmax(s, axis=-1).astype(v.dtype)
        return jnp.einsum('bhqk,bkhd->bqhd', pr, v)

    o = lax.map(one_block, qb)
    return jnp.moveaxis(o, 0, 1).reshape(B, N, H * V_HEAD_DIM)


def fourier_mix(u, w):
    B, N, _ = u.shape
    ug = u.reshape(B, N, FOURIER_GROUPS, FOURIER_GROUP_DIM).astype(jnp.float32)
    f = jnp.fft.fft2(ug, axes=(1, 3), norm='ortho').real.astype(u.dtype)
    return jnp.einsum('bngc,gcd->bngd', f, w).reshape(B, N, FOURIER_WIDTH)


def moe(h, w_router, b_router, w_gate, b_gate, w_up, b_up, w_down, b_down):
    T, D = h.shape
    logits = jnp.dot(h, w_router, preferred_element_type=jnp.float32) + b_router.astype(jnp.float32)
    top_logit, top_idx = lax.top_k(logits, TOP_K)
    gates = jax.nn.softmax(top_logit, axis=-1)
    n_pairs = T * TOP_K
    flat_e = top_idx.reshape(n_pairs)
    order = jnp.argsort(flat_e)
    sorted_e = flat_e[order]
    pair_tok = order // TOP_K
    pair_gate = gates.reshape(n_pairs)[order].astype(h.dtype)
    counts = jnp.bincount(flat_e, length=N_EXPERTS)
    padded = (counts + EXPERT_BLOCK - 1) // EXPERT_BLOCK * EXPERT_BLOCK
    pad_end = jnp.cumsum(padded)
    pad_start = pad_end - padded
    start = jnp.cumsum(counts) - counts
    dest = pad_start[sorted_e] + jnp.arange(n_pairs) - start[sorted_e]
    n_blocks = -(-n_pairs // EXPERT_BLOCK) + N_EXPERTS
    slot_tok = jnp.zeros((n_blocks * EXPERT_BLOCK,), jnp.int32).at[dest].set(pair_tok.astype(jnp.int32))
    block_e = jnp.minimum(
        jnp.searchsorted(pad_end, jnp.arange(n_blocks) * EXPERT_BLOCK, side='right'), N_EXPERTS - 1)
    xs = h[slot_tok].reshape(n_blocks, EXPERT_BLOCK, D)

    def expert_block(args):
        xb, e = args
        g = jnp.minimum(xb @ w_gate[e] + b_gate[e], SWIGLU_LIMIT)
        u = jnp.clip(xb @ w_up[e] + b_up[e], -SWIGLU_LIMIT, SWIGLU_LIMIT)
        act = g * jax.nn.sigmoid(SWIGLU_ALPHA * g) * (u + 1)
        return act @ w_down[e] + b_down[e]

    ys = lax.map(expert_block, (xs, block_e)).reshape(n_blocks * EXPERT_BLOCK, D)
    y_pairs = ys[dest] * pair_gate[:, None]
    return jnp.zeros_like(h).at[pair_tok].add(y_pairs)


def setup_inputs(seed: int = 0) -> dict:
    key = jax.random.key(seed)
    ks = jax.random.split(key, 32)
    f32 = jnp.float32
    L, D = DEPTH, D_MODEL

    def nrm(k, shape, scale):
        return jax.random.normal(k, shape, f32) * scale

    def gain(k, shape):
        return 1.0 + 0.05 * jax.random.normal(k, shape, f32)

    return {
        'x': nrm(ks[0], (BATCH, SEQ, D), 1.0),
        'c': nrm(ks[1], (BATCH, D), 1.0),
        'ctx': nrm(ks[2], (BATCH, CTX_LEN, D), 1.0),
        'c_ctx': nrm(ks[3], (D,), 1.0),
        'w_mod': nrm(ks[4], (L, D, N_MOD * D), 0.5 * D ** -0.5),
        'b_mod': nrm(ks[5], (L, N_MOD * D), 0.01),
        'norm_attn_pre': gain(ks[6], (L, D)),
        'norm_attn_post': gain(ks[7], (L, D)),
        'norm_ffn_pre': gain(ks[8], (L, D)),
        'norm_ffn_post': gain(ks[9], (L, D)),
        'w_in': nrm(ks[10], (L, D, IN_PROJ_WIDTH), D ** -0.5),
        'norm_q_lat': gain(ks[11], (L, Q_LORA_RANK)),
        'norm_kv_lat': gain(ks[12], (L, KV_LORA_RANK)),
        'w_q_up': nrm(ks[13], (L, Q_LORA_RANK, N_HEADS * (QK_NOPE_DIM + QK_ROPE_DIM)), Q_LORA_RANK ** -0.5),
        'w_kv_up': nrm(ks[14], (L, KV_LORA_RANK, N_HEADS * (QK_NOPE_DIM + V_HEAD_DIM)), KV_LORA_RANK ** -0.5),
        'w_fourier': nrm(ks[15], (L, FOURIER_GROUPS, FOURIER_GROUP_DIM, FOURIER_GROUP_DIM), FOURIER_GROUP_DIM ** -0.5),
        'w_out': nrm(ks[16], (L, MIX_WIDTH, D), MIX_WIDTH ** -0.5),
        'w_router': nrm(ks[17], (L, D, N_EXPERTS), D ** -0.5),
        'b_router': nrm(ks[18], (L, N_EXPERTS), 0.01),
        'w_gate': nrm(ks[19], (L, N_EXPERTS, D, D_FF), D ** -0.5),
        'b_gate': nrm(ks[20], (L, N_EXPERTS, D_FF), 0.01),
        'w_up': nrm(ks[21], (L, N_EXPERTS, D, D_FF), D ** -0.5),
        'b_up': nrm(ks[22], (L, N_EXPERTS, D_FF), 0.01),
        'w_down': nrm(ks[23], (L, N_EXPERTS, D_FF, D), D_FF ** -0.5),
        'b_down': nrm(ks[24], (L, N_EXPERTS, D), 0.01),
    }


def reference(x, c, ctx, c_ctx, w_mod, b_mod, norm_attn_pre, norm_attn_post, norm_ffn_pre,
              norm_ffn_post, w_in, norm_q_lat, norm_kv_lat, w_q_up, w_kv_up, w_fourier, w_out,
              w_router, b_router, w_gate, b_gate, w_up, b_up, w_down, b_down):
    B, N, D = x.shape
    rope = axial_rope_tables(N)
    for l in range(DEPTH):
        last = l == DEPTH - 1
        m = jax.nn.silu(c) @ w_mod[l] + b_mod[l]
        sh1, sc1, g1, sh2, sc2, g2 = jnp.split(m[:, None, :], N_MOD, axis=-1)
        mc = jax.nn.silu(c_ctx) @ w_mod[l] + b_mod[l]
        csh1, csc1, cg1, csh2, csc2, cg2 = jnp.split(mc, N_MOD, axis=-1)

        hx = modulate(x, norm_attn_pre[l], sh1, sc1)
        hc = modulate(ctx, norm_attn_pre[l], csh1, csc1)
        px = hx @ w_in[l]
        pc = hc @ w_in[l]
        qx, kx, vx = mla_project(px[..., FOURIER_WIDTH:], norm_q_lat[l], norm_kv_lat[l],
                                 w_q_up[l], w_kv_up[l], rope)
        qc, kc, vc = mla_project(pc[..., FOURIER_WIDTH:], norm_q_lat[l], norm_kv_lat[l],
                                 w_q_up[l], w_kv_up[l], None)
        k_all = jnp.concatenate([kx, kc], axis=1)
        v_all = jnp.concatenate([vx, vc], axis=1)
        att_x = attend(qx, k_all, v_all)
        four_x = fourier_mix(px[..., :FOURIER_WIDTH], w_fourier[l])
        mix_x = jnp.concatenate([att_x, four_x], axis=-1) @ w_out[l]
        x = x + g1 * rms_norm(mix_x, norm_attn_post[l])
        if not last:
            att_c = attend(qc, kc, vc)
            four_c = fourier_mix(pc[..., :FOURIER_WIDTH], w_fourier[l])
            mix_c = jnp.concatenate([att_c, four_c], axis=-1) @ w_out[l]
            ctx = ctx + cg1 * rms_norm(mix_c, norm_attn_post[l])

        hx2 = modulate(x, norm_ffn_pre[l], sh2, sc2)
        yx = moe(hx2.reshape(B * N, D), w_router[l], b_router[l], w_gate[l], b_gate[l],
                 w_up[l], b_up[l], w_down[l], b_down[l]).reshape(B, N, D)
        x = x + g2 * rms_norm(yx, norm_ffn_post[l])
        if not last:
            hc2 = modulate(ctx, norm_ffn_pre[l], csh2, csc2)
            yc = moe(hc2.reshape(-1, D), w_router[l], b_router[l], w_gate[l], b_gate[l],
                     w_up[l], b_up[l], w_down[l], b_down[l]).reshape(ctx.shape)
            ctx = ctx + cg2 * rms_norm(yc, norm_ffn_post[l])
    return x
```

```cpp
#include <hip/hip_runtime.h>
#include <cstdint>
#include <cstdio>

#define GAS __attribute__((address_space(1)))
#define LAS __attribute__((address_space(3)))
typedef unsigned short bf16_t;
typedef short bf16x8 __attribute__((ext_vector_type(8)));
typedef float f32x4 __attribute__((ext_vector_type(4)));
typedef float f32x16 __attribute__((ext_vector_type(16)));
typedef unsigned u32x4 __attribute__((ext_vector_type(4)));
typedef unsigned u32x2 __attribute__((ext_vector_type(2)));

constexpr int D = 1024, SEQ = 8192, CTXL = 256, NH = 6, DQK = 192, DNOPE = 128, DROPE = 64, DV = 128;
constexpr int QL = 384, KVL = 256;
constexpr int ML = 2 * SEQ, MC = 2 * CTXL, MA = ML + MC;
constexpr int TK = SEQ + CTXL;
constexpr int PXW = 1280;
constexpr int NE = 32, DFF = 1024;
constexpr int MAXTILES = 288, SLOTS = MAXTILES * 256;
constexpr float RMS_EPS = 1e-6f;
constexpr int NWG = 256, NTHR = 512;
#ifndef MOE_FP8_ON
#define MOE_FP8_ON 1
#endif
constexpr bool MOE_FP8 = MOE_FP8_ON;
constexpr float WSCALE = 32.f;

constexpr size_t KiB = 1024, MiB = 1024 * 1024;
constexpr size_t WS_CTL = 0, CTL_BYTES = 64 * KiB;
constexpr size_t WS_MOD = 1 * MiB;
constexpr size_t WS_ROPE = WS_MOD + 96 * KiB;
constexpr size_t WS_RSTAT = WS_ROPE + 16 * KiB;
constexpr size_t WS_TOPI = 1 * MiB + 256 * KiB;
constexpr size_t WS_GATE = WS_TOPI + 256 * KiB;
constexpr size_t WS_TOKSLOT = WS_GATE + 256 * KiB;
constexpr size_t WS_SLOTTOK = 2 * MiB;
constexpr size_t WS_CHCNT = WS_SLOTTOK + 320 * KiB;
constexpr size_t WS_TILEE = WS_CHCNT + 32 * KiB;
constexpr size_t WS_FTAB = WS_TILEE + 32 * KiB;
constexpr size_t WS_WRT = WS_FTAB + 64 * KiB;
constexpr size_t WS_GA = WS_WRT + 128 * KiB;
constexpr size_t WS_GB = WS_GA + 128 * KiB;
constexpr size_t WS_WIN = 4 * MiB;
constexpr size_t WS_WQ = 7 * MiB;
constexpr size_t WS_WKV = 8 * MiB;
constexpr size_t WS_WOUT = 9 * MiB;
constexpr size_t WS_WD = 16 * MiB;
constexpr size_t WS_WGU = 80 * MiB;
constexpr size_t WS_HX = 208 * MiB;
constexpr size_t WS_Y = 80 * MiB;
constexpr size_t WS_MIX = 242 * MiB;
constexpr size_t WS_ACT = 274 * MiB;
constexpr size_t WS_PX = 274 * MiB;
constexpr size_t WS_Q = 316 * MiB;
constexpr size_t WS_KN = 352 * MiB;
constexpr size_t WS_V = 377 * MiB;
constexpr size_t WS_KR = 402 * MiB;
constexpr size_t WS_FT = 405 * MiB;
constexpr size_t WS_MIXA = 421 * MiB;
constexpr size_t WS_OPART = 208 * MiB;
constexpr size_t WS_OML = 304 * MiB;
constexpr size_t WS_END = 453 * MiB;

constexpr int LDS_BYTES = 163840;
constexpr int LDS_CTL = 139264;

struct P { const float* in[25]; float* out; unsigned char* ws; int ph_lo, ph_hi; };

__device__ __forceinline__ unsigned f2bf(float f) { unsigned u = __float_as_uint(f); return (u + 0x7fffu + ((u >> 16) & 1u)) >> 16; }
__device__ __forceinline__ float bflo(unsigned w) { return __uint_as_float(w << 16); }
__device__ __forceinline__ float bfhi(unsigned w) { return __uint_as_float(w & 0xffff0000u); }
typedef __bf16 bf16x2c __attribute__((ext_vector_type(2)));
typedef float f32x2c __attribute__((ext_vector_type(2)));
__device__ __forceinline__ unsigned pk2(float lo, float hi) { const f32x2c v = {lo, hi}; return __builtin_bit_cast(unsigned, __builtin_convertvector(v, bf16x2c)); }
template <int CTRL, int RMASK, bool BC> __device__ __forceinline__ float dpp_mov(float v) { return __builtin_bit_cast(float, __builtin_amdgcn_update_dpp(0, __builtin_bit_cast(int, v), CTRL, RMASK, 0xf, BC)); }
__device__ __forceinline__ float wave_sum(float v) {
    v += dpp_mov<0x111, 0xf, true>(v); v += dpp_mov<0x112, 0xf, true>(v); v += dpp_mov<0x114, 0xf, true>(v); v += dpp_mov<0x118, 0xf, true>(v);
    v += dpp_mov<0x142, 0xa, false>(v); v += dpp_mov<0x143, 0xc, false>(v);
    return __builtin_bit_cast(float, __builtin_amdgcn_readlane(__builtin_bit_cast(int, v), 63));
}
__device__ __forceinline__ float wave_max(float v) {
#pragma unroll
    for (int o = 1; o < 64; o <<= 1) v = fmaxf(v, __shfl_xor(v, o));
    return v;
}
__device__ __forceinline__ int fresh_tid(int wv) { int t = (wv << 6) | (int)__builtin_amdgcn_mbcnt_hi(~0u, __builtin_amdgcn_mbcnt_lo(~0u, 0u)); asm volatile("" : "+v"(t)); return t; }
__device__ __forceinline__ unsigned pg8_pk4_fp8(f32x4 v) { int p = __builtin_amdgcn_cvt_pk_fp8_f32(v.x, v.y, 0, false); p = __builtin_amdgcn_cvt_pk_fp8_f32(v.z, v.w, p, true); return (unsigned)p; }
__device__ __forceinline__ f32x4 fp8x4(unsigned w) { const auto lo = __builtin_amdgcn_cvt_pk_f32_fp8((int)w, false), hi = __builtin_amdgcn_cvt_pk_f32_fp8((int)w, true); return (f32x4){lo[0], lo[1], hi[0], hi[1]}; }
__device__ __forceinline__ float dot4(f32x4 a, f32x4 b) { return (a.x * b.x + a.y * b.y) + (a.z * b.z + a.w * b.w); }

__device__ __forceinline__ void p0_mod_item(const P& p, int it, int tid, LAS float* scr) {
    LAS float* sl = scr;
    LAS float* part = scr + 3072;
    const float* c = p.in[1]; const float* cc = p.in[3]; const float* wm = p.in[4]; const float* bm = p.in[5];
    for (int i = tid; i < 3072; i += NTHR) { const int r = i >> 10, k = i & 1023; const float v = r < 2 ? c[r * 1024 + k] : cc[k]; sl[i] = v / (1.f + __expf(-v)); }
    __syncthreads();
    const int ks = tid >> 5, cidx = tid & 31, n0 = it * 24;
    if (cidx < 24) {
        float a0 = 0.f, a1 = 0.f, a2 = 0.f;
#pragma unroll 1
        for (int kq = 0; kq < 2; ++kq) { float wv[32];
#pragma unroll
            for (int k = 0; k < 32; ++k) wv[k] = __builtin_nontemporal_load(wm + (size_t)(ks * 64 + kq * 32 + k) * 6144 + n0 + cidx);
#pragma unroll
            for (int k = 0; k < 32; ++k) { const float w = wv[k]; const int kk = ks * 64 + kq * 32 + k; a0 += sl[kk] * w; a1 += sl[1024 + kk] * w; a2 += sl[2048 + kk] * w; } }
        part[(ks * 3 + 0) * 24 + cidx] = a0; part[(ks * 3 + 1) * 24 + cidx] = a1; part[(ks * 3 + 2) * 24 + cidx] = a2;
    }
    __syncthreads();
    if (tid < 72) { const int r = tid / 24, cx = tid % 24; float s = bm[n0 + cx];
        for (int k = 0; k < 16; ++k) s += part[(k * 3 + r) * 24 + cx];
        ((float*)(p.ws + WS_MOD))[r * 6144 + n0 + cx] = s; }
    __syncthreads();
}
__device__ __forceinline__ void p0_misc_item(const P& p, int r, int tid) {
    const double TWO_PI = 6.283185307179586476925;
    if (r == 0) {
        float* ct = (float*)(p.ws + WS_ROPE); float* st = ct + 2048;
        for (int i = tid; i < 2048; i += NTHR) { const int pos = i >> 4, j = i & 15; const double inv = pow(10000.0, -(2.0 * j) / 32.0); const double a = (double)pos * inv; ct[i] = (float)cos(a); st[i] = (float)sin(a); }
        const float* wr = p.in[17]; bf16_t* wrh = (bf16_t*)(p.ws + WS_WRT); bf16_t* wrl = wrh + 32768;
        for (int i = tid; i < 32768; i += NTHR) { const int k = i >> 5, e = i & 31; const float w = wr[i]; const unsigned hb = f2bf(w); wrh[e * 1024 + k] = (bf16_t)hb; wrl[e * 1024 + k] = (bf16_t)f2bf(w - __uint_as_float(hb << 16)); }
    } else if (r == 1) {
        for (int i = tid; i < 8192; i += NTHR) { const double a = TWO_PI * i / 8192.0; ((float2*)(p.ws + WS_FTAB))[i] = make_float2((float)cos(a), (float)sin(a)); }
    } else if (r < 6) {
        bf16_t* GA = (bf16_t*)(p.ws + WS_GA);
        for (int i = tid; i < 64 * 256; i += NTHR) { const int row = (r - 2) * 64 + (i >> 8), kk = i & 255, c = row >> 7, k1 = row & 127, n1 = kk & 127, isq = kk >> 7;
            const double a = TWO_PI * ((n1 * k1) & 127) / 128.0; const double cs = cos(a), sn = sin(a);
            const double v = c == 0 ? (isq ? -sn : cs) : (isq ? -cs : -sn); GA[row * 256 + kk] = (bf16_t)f2bf((float)v); }
    } else {
        bf16_t* GB = (bf16_t*)(p.ws + WS_GB);
        for (int i = tid; i < 64 * 128; i += NTHR) { const int k2 = i >> 7, kk = i & 127, n2 = kk >> 1, c = kk & 1; const double a = TWO_PI * ((k2 * n2) & 63) / 64.0;
            GB[i] = (bf16_t)f2bf((float)(c ? sin(a) : cos(a))); }
    }
}
template <class CM>
__device__ __forceinline__ void p0_xpose_item(const CM& cm, int ldn, const float* gain, int k0, bf16_t* dst, int Kd, int nd0, int tid, LAS float* scr) {
    f32x4 v[8];
#pragma unroll
    for (int i = 0; i < 8; ++i) { const int q = tid + NTHR * i, k = q >> 6, n = (q & 63) * 4; const float* sp = cm(nd0 + n);
        v[i] = sp ? *(const f32x4*)(sp + (size_t)(k0 + k) * ldn) : (f32x4){0.f, 0.f, 0.f, 0.f}; }
#pragma unroll
    for (int i = 0; i < 8; ++i) { const int q = tid + NTHR * i, k = q >> 6, n = (q & 63) * 4; const float g = gain ? gain[k0 + k] : 1.f;
        LAS float* d = scr + k * 257 + n; d[0] = v[i].x * g; d[1] = v[i].y * g; d[2] = v[i].z * g; d[3] = v[i].w * g; }
    __syncthreads();
#pragma unroll
    for (int i = 0; i < 4; ++i) { const int q = tid + NTHR * i, n = q >> 3, kc = q & 7; const LAS float* s = scr + (kc * 8) * 257 + n;
        u32x4 o; o.x = pk2(s[0], s[257]); o.y = pk2(s[2 * 257], s[3 * 257]); o.z = pk2(s[4 * 257], s[5 * 257]); o.w = pk2(s[6 * 257], s[7 * 257]);
        *(u32x4*)(dst + (size_t)(nd0 + n) * Kd + k0 + kc * 8) = o; }
    __syncthreads();
}
struct CmWin { const float* w; __device__ const float* operator()(int n) const { return n < 384 ? w + 256 + n : (n < 448 ? w + 896 + (n - 384) : (n < 512 ? nullptr : w + 640 + (n - 512))); } };
struct CmPlain { const float* w; int nmax; __device__ const float* operator()(int n) const { return n < nmax ? w + n : nullptr; } };
struct CmGU { const float* g; const float* u; int pn; __device__ const float* operator()(int n) const { const int j = n & 255; return j < 128 ? g + 128 * pn + j : u + 128 * pn + (j - 128); } };
__device__ __forceinline__ void p0_fold_item(const P& p, int g, int kb, int tid, LAS float* scr) {
    LAS float* Mg = scr;
    LAS float* wb = scr + 8192;
    LAS float* cs = scr + 8192 + 4160;
    const float* wf = p.in[15] + g * 4096; const float* win = p.in[10];
    if (tid < 64) { const double a = 6.283185307179586476925 * tid / 64.0; cs[tid] = (float)cos(a); cs[64 + tid] = (float)sin(a); }
    __syncthreads();
    const float sinv = 1.0f / 724.0773439350246f;
    for (int i = 0; i < 16; ++i) { const int e = tid + NTHR * i, c = e >> 7, jj = e & 127, j = jj & 63, isq = jj >> 6; float s = 0.f;
        for (int m = 0; m < 64; ++m) s += cs[isq * 64 + ((m * c) & 63)] * wf[m * 64 + j];
        Mg[c * 128 + jj] = s * sinv; }
    for (int i = 0; i < 8; ++i) { const int e = tid + NTHR * i, k = e >> 6, c = e & 63; wb[k * 65 + c] = win[(size_t)(kb * 64 + k) * 960 + g * 64 + c]; }
    __syncthreads();
    const int jj = tid >> 2, kq = tid & 3; float acc[16];
#pragma unroll
    for (int i = 0; i < 16; ++i) acc[i] = 0.f;
    for (int c = 0; c < 64; ++c) { const float mv = Mg[c * 128 + jj];
#pragma unroll
        for (int i = 0; i < 16; ++i) acc[i] += wb[(kq * 16 + i) * 65 + c] * mv; }
    bf16_t* dst = (bf16_t*)(p.ws + WS_WIN) + (size_t)(768 + g * 128 + jj) * 1024 + kb * 64 + kq * 16;
    u32x4 o0, o1; o0.x = pk2(acc[0], acc[1]); o0.y = pk2(acc[2], acc[3]); o0.z = pk2(acc[4], acc[5]); o0.w = pk2(acc[6], acc[7]);
    o1.x = pk2(acc[8], acc[9]); o1.y = pk2(acc[10], acc[11]); o1.z = pk2(acc[12], acc[13]); o1.w = pk2(acc[14], acc[15]);
    *(u32x4*)dst = o0; *(u32x4*)(dst + 8) = o1;
    __syncthreads();
}
constexpr int I_WGU = 32 * 8 * 2 * 8, I_WD = 32 * 8 * 8, NEI = I_WGU + I_WD;
constexpr int FILL_IN = 182 * 4, FILL_Q = 128 + 12 + 232 + 81, NEI_PREP = NEI - FILL_IN - FILL_Q;
__device__ __forceinline__ void p0_expert_items(const P& p, int first, int step, int end, int tid, LAS float* scr) {
        constexpr int XS = 129;
        f32x4 v[8];
#define P0_ISSUE(r_) do { const int r = (r_); const float* s0; int k0; \
            if (r < I_WGU) { const int e = r >> 7, t = (r >> 3) & 15, pn = t >> 1, hf = t & 1; k0 = (r & 7) * 128; s0 = (hf ? p.in[21] : p.in[19]) + (size_t)e * 1048576 + 128 * pn; } \
            else { const int q = r - I_WGU, e = q >> 6, nb = (q >> 3) & 7; k0 = (q & 7) * 128; s0 = p.in[23] + (size_t)e * 1048576 + nb * 128; } \
            _Pragma("unroll") for (int i = 0; i < 8; ++i) { const int q = tid + NTHR * i, k = q >> 5, n = (q & 31) * 4; v[i] = __builtin_nontemporal_load((const f32x4*)(s0 + (size_t)(k0 + k) * 1024 + n)); } } while (0)
        int it = first; LAS float* const scr0 = scr; int par = 0;
        if (it < end) P0_ISSUE(it);
        for (; it < end; it += step, par ^= 1) {
            scr = scr0 + par * (128 * XS);
#pragma unroll
            for (int i = 0; i < 8; ++i) { const int q = tid + NTHR * i, k = q >> 5, n = (q & 31) * 4; LAS float* d = scr + k * XS + ((n + 8 * (k >> 4)) & 127); d[0] = v[i].x; d[1] = v[i].y; d[2] = v[i].z; d[3] = v[i].w; }
            __syncthreads();
            if (it + step < end) P0_ISSUE(it + step);
            size_t drow; int k0;
            if (it < I_WGU) { const int e = it >> 7, t = (it >> 3) & 15, pn = t >> 1, hf = t & 1; k0 = (it & 7) * 128; drow = (size_t)e * 2048 + pn * 256 + hf * 128; }
            else { const int q = it - I_WGU, e = q >> 6, nb = (q >> 3) & 7; k0 = (q & 7) * 128; drow = (size_t)e * 1024 + nb * 128; }
            if constexpr (MOE_FP8) {
                unsigned char* dst = (unsigned char*)(p.ws + (it < I_WGU ? WS_WGU : WS_WD)) + drow * 1024 + k0;
#pragma unroll
                for (int i = 0; i < 2; ++i) { const int q = tid + NTHR * i, n = q >> 3, kc = q & 7; const LAS float* s = scr + (kc * 16) * XS + ((n + 8 * kc) & 127); u32x4 o;
                    o.x = pg8_pk4_fp8((f32x4){s[0], s[XS], s[2 * XS], s[3 * XS]} * WSCALE); o.y = pg8_pk4_fp8((f32x4){s[4 * XS], s[5 * XS], s[6 * XS], s[7 * XS]} * WSCALE);
                    o.z = pg8_pk4_fp8((f32x4){s[8 * XS], s[9 * XS], s[10 * XS], s[11 * XS]} * WSCALE); o.w = pg8_pk4_fp8((f32x4){s[12 * XS], s[13 * XS], s[14 * XS], s[15 * XS]} * WSCALE);
                    __builtin_nontemporal_store(o, (u32x4*)(dst + (size_t)n * 1024 + kc * 16)); }
            } else {
                bf16_t* dst = (bf16_t*)(p.ws + (it < I_WGU ? WS_WGU : WS_WD)) + drow * 1024 + k0;
#pragma unroll
                for (int i = 0; i < 4; ++i) { const int q = tid + NTHR * i, n = q >> 4, kc = q & 15; const LAS float* s = scr + (kc * 8) * XS + ((n + 8 * (kc >> 1)) & 127);
                    u32x4 o; o.x = pk2(s[0], s[XS]); o.y = pk2(s[2 * XS], s[3 * XS]); o.z = pk2(s[4 * XS], s[5 * XS]); o.w = pk2(s[6 * XS], s[7 * XS]);
                    *(u32x4*)(dst + (size_t)n * 1024 + kc * 8) = o; }
            }
        }
        __syncthreads();
#undef P0_ISSUE
}
__device__ __forceinline__ void ph_prologue(const P& p, int wg, int nwg, int tid, LAS unsigned char* lds) {
    LAS float* scr = (LAS float*)lds;
    constexpr int I_MOD = 256, I_MISC = 7, I_FOLD = 64, I_WIN = 3 * 16, I_WQ = 5 * 6, I_WKV = 6 * 4, I_WOUT = 4 * 16;
    constexpr int NIT = I_MOD + I_MISC + I_FOLD + I_WIN + I_WQ + I_WKV + I_WOUT;
    for (int it = wg; it < NIT; it += nwg) {
        int r = it;
        if (r < I_MOD) { p0_mod_item(p, r, tid, scr); continue; } r -= I_MOD;
        if (r < I_MISC) { p0_misc_item(p, r, tid); continue; } r -= I_MISC;
        if (r < I_FOLD) { p0_fold_item(p, r >> 4, r & 15, tid, scr); continue; } r -= I_FOLD;
        if (r < I_WIN) { CmWin cm{p.in[10]}; p0_xpose_item(cm, 960, nullptr, (r & 15) * 64, (bf16_t*)(p.ws + WS_WIN), 1024, (r >> 4) * 256, tid, scr); continue; } r -= I_WIN;
        if (r < I_WQ) { CmPlain cm{p.in[13], 1152}; p0_xpose_item(cm, 1152, p.in[11], (r % 6) * 64, (bf16_t*)(p.ws + WS_WQ), 384, (r / 6) * 256, tid, scr); continue; } r -= I_WQ;
        if (r < I_WKV) { CmPlain cm{p.in[14], 1536}; p0_xpose_item(cm, 1536, p.in[12], (r & 3) * 64, (bf16_t*)(p.ws + WS_WKV), 256, (r >> 2) * 256, tid, scr); continue; } r -= I_WKV;
        if (r < I_WOUT) { CmPlain cm{p.in[16], 1024}; p0_xpose_item(cm, 1024, nullptr, (r & 15) * 64, (bf16_t*)(p.ws + WS_WOUT), 1024, (r >> 4) * 256, tid, scr); continue; } r -= I_WOUT;
    }
    p0_expert_items(p, wg, nwg, nwg == NWG ? NEI_PREP : NEI, tid, scr);
}

template <int NR> __device__ __forceinline__ void modul_rows(const float* const (&rows)[NR], bf16_t* const (&outs)[NR], const f32x4 (&a)[4], const f32x4 (&sh)[4], int lane) {
    f32x4 v[NR][4];
#pragma unroll
    for (int r = 0; r < NR; ++r)
#pragma unroll
        for (int j = 0; j < 4; ++j) v[r][j] = __builtin_nontemporal_load((const f32x4*)(rows[r] + 4 * lane + 256 * j));
#pragma unroll
    for (int r = 0; r < NR; ++r) { float ss = 0.f;
#pragma unroll
        for (int j = 0; j < 4; ++j) ss += dot4(v[r][j], v[r][j]);
        const float rinv = rsqrtf(wave_sum(ss) * (1.f / D) + RMS_EPS);
#pragma unroll
        for (int j = 0; j < 4; ++j) { const f32x4 o = v[r][j] * rinv * a[j] + sh[j]; u32x2 w; w.x = pk2(o.x, o.y); w.y = pk2(o.z, o.w); *(u32x2*)(outs[r] + 4 * lane + 256 * j) = w; } }
}
__device__ __forceinline__ void ph_modulate(const P& p, int wg, int nwg, int tid) {
    const int lane = tid & 63, wave = tid >> 6;
    const float* x = p.in[0]; const float* ctx = p.in[2]; const float* gain = p.in[6];
    const float* MOD = (const float*)(p.ws + WS_MOD); bf16_t* HX = (bf16_t*)(p.ws + WS_HX);
    for (int ch = wg; ch < 256; ch += nwg) {
        f32x4 a[4], sh[4];
        { const int r = ch >> 7;
#pragma unroll
          for (int j = 0; j < 4; ++j) { const int c = 4 * lane + 256 * j; sh[j] = *(const f32x4*)(MOD + r * 6144 + c); a[j] = *(const f32x4*)(gain + c) * (*(const f32x4*)(MOD + r * 6144 + 1024 + c) + 1.f); } }
#pragma unroll
        for (int q = 0; q < 2; ++q) { const int m0 = ch * 64 + wave * 8 + q * 4;
            const float* const rows[4] = {x + (size_t)m0 * D, x + (size_t)(m0 + 1) * D, x + (size_t)(m0 + 2) * D, x + (size_t)(m0 + 3) * D};
            bf16_t* const outs[4] = {HX + (size_t)m0 * D, HX + (size_t)(m0 + 1) * D, HX + (size_t)(m0 + 2) * D, HX + (size_t)(m0 + 3) * D};
            modul_rows<4>(rows, outs, a, sh, lane); }
        if (wave == 7) {
#pragma unroll
            for (int j = 0; j < 4; ++j) { const int c = 4 * lane + 256 * j; sh[j] = *(const f32x4*)(MOD + 2 * 6144 + c); a[j] = *(const f32x4*)(gain + c) * (*(const f32x4*)(MOD + 2 * 6144 + 1024 + c) + 1.f); }
            const int c0 = ch * 2;
            const float* const rows[2] = {ctx + (size_t)c0 * D, ctx + (size_t)(c0 + 1) * D};
            bf16_t* const outs[2] = {HX + (size_t)(ML + c0) * D, HX + (size_t)(ML + c0 + 1) * D};
            modul_rows<2>(rows, outs, a, sh, lane); }
    }
}

template <int NR> __device__ __forceinline__ void row1_rows(const P& p, const int (&ms)[NR], int lane) {
    const bf16_t* PX = (const bf16_t*)(p.ws + WS_PX); float* RS = (float*)(p.ws + WS_RSTAT); bf16_t* KR = (bf16_t*)(p.ws + WS_KR);
    const float* ct = (const float*)(p.ws + WS_ROPE); const float* st = ct + 2048;
    u32x4 c0[NR], c1[NR];
#pragma unroll
    for (int r = 0; r < NR; ++r) { const bf16_t* pr = PX + (size_t)ms[r] * PXW; c0[r] = *(const u32x4*)(pr + 8 * lane); c1[r] = *(const u32x4*)(pr + 512 + 8 * (lane & 31)); }
#pragma unroll
    for (int r = 0; r < NR; ++r) { const int m = ms[r];
        float v[8]; v[0] = bflo(c0[r].x); v[1] = bfhi(c0[r].x); v[2] = bflo(c0[r].y); v[3] = bfhi(c0[r].y); v[4] = bflo(c0[r].z); v[5] = bfhi(c0[r].z); v[6] = bflo(c0[r].w); v[7] = bfhi(c0[r].w);
        float sq = 0.f; if (lane < 48) { for (int j = 0; j < 8; ++j) sq += v[j] * v[j]; }
        float skv = 0.f; if (lane < 32) { const float t0 = bflo(c1[r].x), t1 = bfhi(c1[r].x), t2 = bflo(c1[r].y), t3 = bfhi(c1[r].y), t4 = bflo(c1[r].z), t5 = bfhi(c1[r].z), t6 = bflo(c1[r].w), t7 = bfhi(c1[r].w);
            skv = (t0 * t0 + t1 * t1) + (t2 * t2 + t3 * t3) + (t4 * t4 + t5 * t5) + (t6 * t6 + t7 * t7); }
        const float rq = rsqrtf(wave_sum(sq) * (1.f / QL) + RMS_EPS), rkv = rsqrtf(wave_sum(skv) * (1.f / KVL) + RMS_EPS);
        if (lane == 0) { RS[2 * m] = rq; RS[2 * m + 1] = rkv; }
        if (lane >= 48 && lane < 56) {
            const int d0 = (lane - 48) * 8; int b, tt;
            if (m < ML) { b = m >> 13; tt = m & 8191; const int prow = tt >> 6, pcol = tt & 63;
#pragma unroll
                for (int q = 0; q < 4; ++q) { const int pi = (d0 >> 1) + q; const int pos = pi < 16 ? prow : pcol, j = pi & 15; const float c = ct[pos * 16 + j], s = st[pos * 16 + j];
                    const float e = v[2 * q], o = v[2 * q + 1]; v[2 * q] = e * c - o * s; v[2 * q + 1] = e * s + o * c; } }
            else { b = (m - ML) >> 8; tt = SEQ + ((m - ML) & 255); }
            u32x4 o; o.x = pk2(v[0], v[1]); o.y = pk2(v[2], v[3]); o.z = pk2(v[4], v[5]); o.w = pk2(v[6], v[7]);
            *(u32x4*)(KR + ((size_t)b * TK + tt) * DROPE + d0) = o;
        }
    }
}
__device__ __forceinline__ void ph_row1(const P& p, int wg, int nwg, int tid) {
    const int lane = tid & 63, wave = tid >> 6;
    for (int ch = wg; ch < 256; ch += nwg) {
        { const int m0 = ch * 64 + wave * 8; const int ms[8] = {m0, m0 + 1, m0 + 2, m0 + 3, m0 + 4, m0 + 5, m0 + 6, m0 + 7}; row1_rows<8>(p, ms, lane); }
        if (wave == 7) { const int ms[2] = {ML + ch * 2, ML + ch * 2 + 1}; row1_rows<2>(p, ms, lane); }
    }
}

__device__ __forceinline__ float half_max32(float v, int lane) {
    v = fmaxf(v, __builtin_bit_cast(float, __builtin_amdgcn_update_dpp(__builtin_bit_cast(int, v), __builtin_bit_cast(int, v), 0x111, 0xf, 0xf, false)));
    v = fmaxf(v, __builtin_bit_cast(float, __builtin_amdgcn_update_dpp(__builtin_bit_cast(int, v), __builtin_bit_cast(int, v), 0x112, 0xf, 0xf, false)));
    v = fmaxf(v, __builtin_bit_cast(float, __builtin_amdgcn_update_dpp(__builtin_bit_cast(int, v), __builtin_bit_cast(int, v), 0x114, 0xf, 0xf, false)));
    v = fmaxf(v, __builtin_bit_cast(float, __builtin_amdgcn_update_dpp(__builtin_bit_cast(int, v), __builtin_bit_cast(int, v), 0x118, 0xf, 0xf, false)));
    v = fmaxf(v, __builtin_bit_cast(float, __builtin_amdgcn_update_dpp(__builtin_bit_cast(int, v), __builtin_bit_cast(int, v), 0x142, 0xa, 0xf, false)));
    const float m0 = __builtin_bit_cast(float, __builtin_amdgcn_readlane(__builtin_bit_cast(int, v), 31)), m1 = __builtin_bit_cast(float, __builtin_amdgcn_readlane(__builtin_bit_cast(int, v), 63));
    return lane < 32 ? m0 : m1;
}
__device__ __forceinline__ void ph_row2(const P& p, int wg, int nwg, int tid, LAS unsigned char* lds) {
    const int lane = tid & 63, wave = tid >> 6;
    constexpr int HSTR = 2064;
    LAS unsigned char* Hhi = lds; LAS unsigned char* Hlo = lds + 32 * HSTR;
    LAS float* PL = (LAS float*)(lds + LDS_CTL + 4096);
    LAS int* hist = (LAS int*)(lds + LDS_CTL + 1024);
    const bf16_t* WRH = (const bf16_t*)(p.ws + WS_WRT); const bf16_t* WRL = WRH + 32768;
    const float* x = p.in[0]; const float* MOD = (const float*)(p.ws + WS_MOD); const float* npost = p.in[7]; const float* npre = p.in[8]; const float* br = p.in[18];
    const bf16_t* MIX = (const bf16_t*)(p.ws + WS_MIX); bf16_t* HX2 = (bf16_t*)(p.ws + WS_HX);
    int* TOPI = (int*)(p.ws + WS_TOPI); float* GATE = (float*)(p.ws + WS_GATE); int* CHCNT = (int*)(p.ws + WS_CHCNT);
    for (int ch = wg; ch < 256; ch += nwg) {
        if (tid < 32) hist[tid] = 0;
        const int b = (ch * 64) >> 13;
        f32x4 a1[4], a2[4], s2[4];
#pragma unroll
        for (int j = 0; j < 4; ++j) { const int c = 4 * lane + 256 * j;
            a1[j] = *(const f32x4*)(npost + c) * *(const f32x4*)(MOD + b * 6144 + 2048 + c);
            a2[j] = *(const f32x4*)(npre + c) * (*(const f32x4*)(MOD + b * 6144 + 4096 + c) + 1.f);
            s2[j] = *(const f32x4*)(MOD + b * 6144 + 3072 + c); }
        for (int batch = 0; batch < 2; ++batch) {
            u32x2 mw[4][4]; f32x4 xv[4][4];
#pragma unroll
            for (int i = 0; i < 4; ++i) { const int m = ch * 64 + batch * 32 + wave * 4 + i;
#pragma unroll
                for (int j = 0; j < 4; ++j) { mw[i][j] = *(const u32x2*)(MIX + (size_t)m * D + 4 * lane + 256 * j); xv[i][j] = __builtin_nontemporal_load((const f32x4*)(x + (size_t)m * D + 4 * lane + 256 * j)); } }
            const int fr = lane & 15, fq = lane >> 4, rb = (wave & 1) * 16, kq = wave >> 1;
            const bf16_t* bh = WRH + fr * 1024 + kq * 256 + fq * 8; const bf16_t* bl = WRL + fr * 1024 + kq * 256 + fq * 8;
#pragma unroll
            for (int i = 0; i < 4; ++i) {
                const int rl = wave * 4 + i, m = ch * 64 + batch * 32 + rl;
                f32x4 mx[4], h[4]; float ss = 0.f;
#pragma unroll
                for (int j = 0; j < 4; ++j) { const u32x2 w = mw[i][j]; mx[j] = (f32x4){bflo(w.x), bfhi(w.x), bflo(w.y), bfhi(w.y)}; ss += dot4(mx[j], mx[j]); }
                const float r1 = rsqrtf(wave_sum(ss) * (1.f / D) + RMS_EPS); float s2s = 0.f;
#pragma unroll
                for (int j = 0; j < 4; ++j) { h[j] = xv[i][j] + a1[j] * (mx[j] * r1); s2s += dot4(h[j], h[j]); }
                const float r2 = rsqrtf(wave_sum(s2s) * (1.f / D) + RMS_EPS);
#pragma unroll
                for (int j = 0; j < 4; ++j) { h[j] = h[j] * r2 * a2[j] + s2[j];
                    const unsigned h0 = f2bf(h[j].x), h1 = f2bf(h[j].y), h2 = f2bf(h[j].z), h3 = f2bf(h[j].w);
                    u32x2 wh; wh.x = h0 | (h1 << 16); wh.y = h2 | (h3 << 16);
                    u32x2 wl; wl.x = pk2(h[j].x - __uint_as_float(h0 << 16), h[j].y - __uint_as_float(h1 << 16)); wl.y = pk2(h[j].z - __uint_as_float(h2 << 16), h[j].w - __uint_as_float(h3 << 16));
                    if constexpr (MOE_FP8) *(unsigned*)((unsigned char*)HX2 + (size_t)m * D + 4 * lane + 256 * j) = pg8_pk4_fp8(h[j]);
                    else *(u32x2*)(HX2 + (size_t)m * D + 4 * lane + 256 * j) = wh;
                    *(LAS u32x2*)(Hhi + rl * HSTR + (4 * lane + 256 * j) * 2) = wh; *(LAS u32x2*)(Hlo + rl * HSTR + (4 * lane + 256 * j) * 2) = wl; }
            }
            bf16x8 Bh0[8], Bl0[8];
#pragma unroll
            for (int ks = 0; ks < 8; ++ks) { Bh0[ks] = *(const bf16x8*)(bh + ks * 32); Bl0[ks] = *(const bf16x8*)(bl + ks * 32); }
            __syncthreads();
            { f32x4 acc0 = {0.f, 0.f, 0.f, 0.f}, acc1 = {0.f, 0.f, 0.f, 0.f};
              bf16x8 Bh1[8], Bl1[8];
#pragma unroll
              for (int ks = 0; ks < 8; ++ks) { Bh1[ks] = *(const bf16x8*)(bh + 16 * 1024 + ks * 32); Bl1[ks] = *(const bf16x8*)(bl + 16 * 1024 + ks * 32); }
              const LAS unsigned char* ah = Hhi + (rb + fr) * HSTR + kq * 512 + fq * 16; const LAS unsigned char* al = Hlo + (rb + fr) * HSTR + kq * 512 + fq * 16;
#pragma unroll
              for (int ks = 0; ks < 8; ++ks) {
                  const bf16x8 Ah = *(const LAS bf16x8*)(ah + ks * 64), Al = *(const LAS bf16x8*)(al + ks * 64);
                  acc0 = __builtin_amdgcn_mfma_f32_16x16x32_bf16(Ah, Bh0[ks], acc0, 0, 0, 0); acc0 = __builtin_amdgcn_mfma_f32_16x16x32_bf16(Ah, Bl0[ks], acc0, 0, 0, 0); acc0 = __builtin_amdgcn_mfma_f32_16x16x32_bf16(Al, Bh0[ks], acc0, 0, 0, 0); }
#pragma unroll
              for (int ks = 0; ks < 8; ++ks) {
                  const bf16x8 Ah = *(const LAS bf16x8*)(ah + ks * 64), Al = *(const LAS bf16x8*)(al + ks * 64);
                  acc1 = __builtin_amdgcn_mfma_f32_16x16x32_bf16(Ah, Bh1[ks], acc1, 0, 0, 0); acc1 = __builtin_amdgcn_mfma_f32_16x16x32_bf16(Ah, Bl1[ks], acc1, 0, 0, 0); acc1 = __builtin_amdgcn_mfma_f32_16x16x32_bf16(Al, Bh1[ks], acc1, 0, 0, 0); }
#pragma unroll
              for (int r = 0; r < 4; ++r) { PL[(kq * 32 + rb + fq * 4 + r) * 32 + fr] = acc0[r]; PL[(kq * 32 + rb + fq * 4 + r) * 32 + 16 + fr] = acc1[r]; } }
            __syncthreads();
#pragma unroll
            for (int ps = 0; ps < 2; ++ps) {
                const int rl = wave * 4 + ps * 2 + (lane >> 5), e = lane & 31, m = ch * 64 + batch * 32 + rl;
                float v = ((PL[rl * 32 + e] + PL[(32 + rl) * 32 + e]) + (PL[(64 + rl) * 32 + e] + PL[(96 + rl) * 32 + e])) + br[e];
                int ti[4]; float tv[4];
#pragma unroll
                for (int k = 0; k < 4; ++k) { const float mx = half_max32(v, lane); const unsigned long long bal = __ballot(v == mx);
                    const unsigned hm = lane < 32 ? (unsigned)bal : (unsigned)(bal >> 32); const int idx = __ffs((int)hm) - 1;
                    ti[k] = idx; tv[k] = mx; if (e == idx) v = -3.0e38f; }
                const float e1 = __expf(tv[1] - tv[0]), e2 = __expf(tv[2] - tv[0]), e3 = __expf(tv[3] - tv[0]), inv = 1.f / (1.f + e1 + e2 + e3);
                if (e == 0) { *(int4*)(TOPI + 4 * m) = make_int4(ti[0], ti[1], ti[2], ti[3]); *(f32x4*)(GATE + 4 * m) = (f32x4){inv, e1 * inv, e2 * inv, e3 * inv};
                    atomicAdd((int*)&hist[ti[0]], 1); atomicAdd((int*)&hist[ti[1]], 1); atomicAdd((int*)&hist[ti[2]], 1); atomicAdd((int*)&hist[ti[3]], 1); }
            }
            __syncthreads();
        }
        if (tid < 32) CHCNT[ch * 32 + tid] = hist[tid];
        __syncthreads();
    }
}

__device__ __forceinline__ void ph_lists(const P& p, int wg, int nwg, int tid, LAS unsigned char* lds) {
    LAS int* ct = (LAS int*)lds;
    LAS int* part = ct + 8192;
    LAS int* tot = part + 512; LAS int* base = tot + 32; LAS int* off = base + 64; LAS int* tp = off + 32;
    const int* CHCNT = (const int*)(p.ws + WS_CHCNT); const int* TOPI = (const int*)(p.ws + WS_TOPI);
    int* TOKSLOT = (int*)(p.ws + WS_TOKSLOT); int* SLOTTOK = (int*)(p.ws + WS_SLOTTOK); int* TILEE = (int*)(p.ws + WS_TILEE);
    for (int i = tid; i < 8192; i += NTHR) ct[i] = CHCNT[i];
    __syncthreads();
    { const int e = tid & 31, pt = tid >> 5; int s = 0; for (int c = pt * 16; c < pt * 16 + 16; ++c) s += ct[c * 32 + e]; part[pt * 32 + e] = s; }
    __syncthreads();
    if (tid < 32) { int s = 0; for (int k = 0; k < 16; ++k) s += part[k * 32 + tid]; tot[tid] = s; }
    __syncthreads();
    if (tid == 0) { int run = 0; for (int e = 0; e < 32; ++e) { base[e] = run; run += ((tot[e] + 255) >> 8) << 8; } base[32] = run; }
    __syncthreads();
    for (int ch = wg; ch < 256; ch += nwg) {
        { const int e = tid & 31, pt = tid >> 5; int s = 0; for (int c = pt * 16; c < pt * 16 + 16 && c < ch; ++c) s += ct[c * 32 + e]; part[pt * 32 + e] = s; }
        if (tid < 256) tp[tid] = TOPI[ch * 256 + tid];
        __syncthreads();
        if (tid < 32) { int s = base[tid]; for (int k = 0; k < 16; ++k) s += part[k * 32 + tid]; off[tid] = s; }
        __syncthreads();
        if (tid < 256) { const int e = tp[tid]; int rank = 0; for (int q = 0; q < tid; ++q) rank += (tp[q] == e) ? 1 : 0;
            const int s = off[e] + rank; TOKSLOT[ch * 256 + tid] = s; SLOTTOK[s] = ch * 64 + (tid >> 2); }
        __syncthreads();
    }
    if (wg == 0) {
        if (tid < 32) { const int e = tid; for (int s = base[e] + tot[e]; s < base[e] + (((tot[e] + 255) >> 8) << 8); ++s) SLOTTOK[s] = 0;
            for (int t = base[e] >> 8; t < (base[e] >> 8) + ((tot[e] + 255) >> 8); ++t) TILEE[t] = e; }
        const int nt = base[32] >> 8;
        for (int t = nt + tid; t < MAXTILES; t += NTHR) TILEE[t] = -1;
        if (tid == 0) TILEE[400] = nt;
    }
}

__device__ __forceinline__ void ph_final(const P& p, int wg, int nwg, int tid) {
    const int lane = tid & 63, wave = tid >> 6;
    const float* x = p.in[0]; const float* MOD = (const float*)(p.ws + WS_MOD); const float* npost = p.in[7]; const float* nfpost = p.in[9];
    const bf16_t* MIX = (const bf16_t*)(p.ws + WS_MIX); const unsigned char* Y = (const unsigned char*)(p.ws + WS_Y);
    const int* TOKSLOT = (const int*)(p.ws + WS_TOKSLOT); const float* GATE = (const float*)(p.ws + WS_GATE);
    for (int ch = wg; ch < 256; ch += nwg) {
        const int b = (ch * 64) >> 13;
        f32x4 a1[4], a3[4];
#pragma unroll
        for (int j = 0; j < 4; ++j) { const int c = 4 * lane + 256 * j;
            a1[j] = *(const f32x4*)(npost + c) * *(const f32x4*)(MOD + b * 6144 + 2048 + c);
            a3[j] = *(const f32x4*)(nfpost + c) * *(const f32x4*)(MOD + b * 6144 + 5120 + c); }
        int4 sln[2]; f32x4 gtn[2];
#pragma unroll
        for (int q = 0; q < 2; ++q) { const int m = ch * 64 + wave * 8 + q; sln[q] = *(const int4*)(TOKSLOT + 4 * m); gtn[q] = *(const f32x4*)(GATE + 4 * m); }
#pragma unroll 1
        for (int i2 = 0; i2 < 8; i2 += 2) {
            const int4 sl[2] = {sln[0], sln[1]}; const f32x4 gt[2] = {gtn[0], gtn[1]};
            u32x2 mw[2][4]; unsigned yw[2][4][4]; f32x4 xv[2][4];
#pragma unroll
            for (int q = 0; q < 2; ++q) { const int m = ch * 64 + wave * 8 + i2 + q;
#pragma unroll
                for (int j = 0; j < 4; ++j) { const int c = 4 * lane + 256 * j;
                    mw[q][j] = __builtin_nontemporal_load((const u32x2*)(MIX + (size_t)m * D + c)); xv[q][j] = __builtin_nontemporal_load((const f32x4*)(x + (size_t)m * D + c));
                    yw[q][j][0] = __builtin_nontemporal_load((const unsigned*)(Y + (size_t)sl[q].x * D + c)); yw[q][j][1] = __builtin_nontemporal_load((const unsigned*)(Y + (size_t)sl[q].y * D + c));
                    yw[q][j][2] = __builtin_nontemporal_load((const unsigned*)(Y + (size_t)sl[q].z * D + c)); yw[q][j][3] = __builtin_nontemporal_load((const unsigned*)(Y + (size_t)sl[q].w * D + c)); } }
            if (i2 + 2 < 8) {
#pragma unroll
                for (int q = 0; q < 2; ++q) { const int m = ch * 64 + wave * 8 + i2 + 2 + q; sln[q] = *(const int4*)(TOKSLOT + 4 * m); gtn[q] = *(const f32x4*)(GATE + 4 * m); } }
#pragma unroll
            for (int q = 0; q < 2; ++q) { const int m = ch * 64 + wave * 8 + i2 + q; const f32x4 g = gt[q];
                f32x4 mx[4], y[4]; float ss = 0.f, sy = 0.f;
#pragma unroll
                for (int j = 0; j < 4; ++j) { const u32x2 w = mw[q][j]; mx[j] = (f32x4){bflo(w.x), bfhi(w.x), bflo(w.y), bfhi(w.y)}; ss += dot4(mx[j], mx[j]);
                    f32x4 t = fp8x4(yw[q][j][0]) * g.x; t += fp8x4(yw[q][j][1]) * g.y; t += fp8x4(yw[q][j][2]) * g.z; t += fp8x4(yw[q][j][3]) * g.w;
                    y[j] = t; sy += dot4(t, t); }
                const float r1 = rsqrtf(wave_sum(ss) * (1.f / D) + RMS_EPS), r3 = rsqrtf(wave_sum(sy) * (1.f / D) + RMS_EPS);
#pragma unroll
                for (int j = 0; j < 4; ++j) { const int c = 4 * lane + 256 * j;
                    const f32x4 x1 = xv[q][j] + a1[j] * (mx[j] * r1); __builtin_nontemporal_store(x1 + a3[j] * (y[j] * r3), (f32x4*)(p.out + (size_t)m * D + c)); } }
        }
    }
}

__device__ __forceinline__ f32x4 act4(f32x4 g, f32x4 u) {
    f32x4 r;
#pragma unroll
    for (int i = 0; i < 4; ++i) { const float gg = fminf(g[i], 7.f), uu = fminf(fmaxf(u[i], -7.f), 7.f); r[i] = gg * __builtin_amdgcn_rcpf(1.f + __builtin_amdgcn_exp2f(-2.4554669595930156f * gg)) * (uu + 1.f); }
    return r;
}

namespace pg8 {
constexpr int BM = 256, BK = 64, HALF = 128, HTB = HALF * BK * 2, STAGE_BYTES = 8 * HTB, NXCD = 8, WGM = 8;
__device__ __forceinline__ int lds_byte(int r, int c) { const int st = (r >> 4) * 2 + (c >> 5), rr = r & 15, cc = c & 31, ob = rr * 64 + cc * 2; return st * 1024 + (ob ^ (((ob >> 9) & 1) << 5)); }
__device__ __forceinline__ void stage_rc(int b, int& R, int& C) { const int st = b / 1024, sb = b % 1024, swz = sb ^ (((sb >> 9) & 1) << 5); R = (st >> 1) * 16 + swz / 64; C = (st & 1) * 32 + (swz % 64) / 2; }
__device__ __forceinline__ int perm32(int rho) { const int n = rho >> 4, i = rho & 15; return 8 * (i >> 2) + 4 * n + (i & 3); }
struct GUnit { const char* B; int pm, pn, e, arow, li; };
typedef int i32x4v __attribute__((ext_vector_type(4)));
typedef int i32x8v __attribute__((ext_vector_type(8)));
template <class Epi, class Sched, bool FP8 = false>
__device__ __forceinline__ void gemm_phase(LAS unsigned char* lds, const int tid, const char* Abase, const int K, const Sched& S, const Epi& E) {
    const int wid = __builtin_amdgcn_readfirstlane(tid >> 6), lane = tid & 63, wr = wid >> 2, wc = wid & 3, fr = lane & 15, fq = lane >> 4;
    const int Kb = FP8 ? K : K * 2, nt = Kb / (BK * 2);
    unsigned voffB[2];
#pragma unroll
    for (int i = 0; i < 2; ++i) { int R, C; stage_rc(tid * 16 + i * 8192, R, C); const int Rb = (R & ~31) + perm32(R & 31); voffB[i] = (unsigned)(Rb * Kb + C * 2); }
    const size_t kstep = (size_t)(BK * 2);
    const size_t hstep = (size_t)HALF * Kb;
    const unsigned ldsw = (unsigned)wid * 1024u;
    constexpr int FC = FP8 ? 16 : 8, PSTR = FP8 ? 16 : 1024;
    const int aoff = lds_byte(wr * 64 + fr, fq * FC), boff = lds_byte(wc * 32 + fr, fq * FC);
#define PG8_SA(b, h) (((b) * 2 + (h)) * HTB)
#define PG8_SB(b, h) ((4 + (b) * 2 + (h)) * HTB)
#define PG8_STAGE_B(bufoff, gbase) do { _Pragma("unroll") for (int _i = 0; _i < 2; ++_i) \
        __builtin_amdgcn_global_load_lds((const unsigned*)((const char*)(gbase) + voffB[_i]), (LAS unsigned*)(lds + (bufoff) + ldsw + _i * 8192), 16, 0, 0); } while (0)
#define PG8_STAGE_A(bufoff, vo, koff) do { _Pragma("unroll") for (int _i = 0; _i < 2; ++_i) \
        __builtin_amdgcn_global_load_lds((const unsigned*)(Abase + (size_t)(vo)[_i] + (koff)), (LAS unsigned*)(lds + (bufoff) + ldsw + _i * 8192), 16, 0, 0); } while (0)
#define PG8_LDA(dst, b, h) do { _Pragma("unroll") for (int m = 0; m < 4; ++m) _Pragma("unroll") for (int k = 0; k < 2; ++k) dst[m][k] = *(const LAS bf16x8*)(lds + PG8_SA(b, h) + aoff + m * 2048 + k * PSTR); } while (0)
#define PG8_LDB(dst, b, h) do { _Pragma("unroll") for (int n = 0; n < 2; ++n) _Pragma("unroll") for (int k = 0; k < 2; ++k) dst[n][k] = *(const LAS bf16x8*)(lds + PG8_SB(b, h) + boff + n * 2048 + k * PSTR); } while (0)
#define PG8_CAT(x) __builtin_shufflevector(__builtin_bit_cast(i32x4v, (x)[0]), __builtin_bit_cast(i32x4v, (x)[1]), 0, 1, 2, 3, 4, 5, 6, 7)
#define PG8_MMA(ai, bj, At, Bt) do { __builtin_amdgcn_s_setprio(1); \
        if constexpr (FP8) { _Pragma("unroll") for (int m = 0; m < 4; ++m) _Pragma("unroll") for (int n = 0; n < 2; ++n) \
            acc[ai][bj][m][n] = __builtin_amdgcn_mfma_scale_f32_16x16x128_f8f6f4(PG8_CAT(Bt[n]), PG8_CAT(At[m]), acc[ai][bj][m][n], 0, 0, 0, 0x7F7F7F7F, 0, 0x7F7F7F7F); \
            _Pragma("unroll") for (int m = 0; m < 4; ++m) _Pragma("unroll") for (int n = 0; n < 2; ++n) asm volatile("" : "+v"(acc[ai][bj][m][n])); }   \
        else { _Pragma("unroll") for (int m = 0; m < 4; ++m) _Pragma("unroll") for (int n = 0; n < 2; ++n) _Pragma("unroll") for (int k = 0; k < 2; ++k) \
            acc[ai][bj][m][n] = __builtin_amdgcn_mfma_f32_16x16x32_bf16(Bt[n][k], At[m][k], acc[ai][bj][m][n], 0, 0, 0); } \
        __builtin_amdgcn_s_setprio(0); } while (0)
#define PG8_WAIT_V(n) asm volatile("s_waitcnt vmcnt(" #n ")" ::: "memory")
#define PG8_WAIT_L(n) asm volatile("s_waitcnt lgkmcnt(" #n ")" ::: "memory")
#define PG8_BAR __builtin_amdgcn_s_barrier()
#define PG8_SCHED __builtin_amdgcn_sched_barrier(0)
    GUnit cur, nxt; int ui = 0;
    if (!S.next(0, cur)) return;
    f32x4 acc[2][2][4][2];
#pragma unroll
    for (int a = 0; a < 2; ++a)
#pragma unroll
        for (int b = 0; b < 2; ++b)
#pragma unroll
            for (int m = 0; m < 4; ++m)
#pragma unroll
                for (int n = 0; n < 2; ++n) acc[a][b][m][n] = (f32x4){0.f, 0.f, 0.f, 0.f};
    bf16x8 At[4][2], B0[2][2], B1[2][2];
    unsigned cvo[2][2];
    S.aoffs(cur, tid, cvo);
    const char* cB = cur.B;
    PG8_STAGE_B(PG8_SB(0, 0), cB); PG8_STAGE_B(PG8_SB(0, 1), cB + hstep); PG8_STAGE_A(PG8_SA(0, 0), cvo[0], 0); PG8_STAGE_A(PG8_SA(0, 1), cvo[1], 0);
    if (wr == 1) PG8_BAR;
    PG8_WAIT_V(2); PG8_BAR;
    PG8_STAGE_B(PG8_SB(1, 0), cB + kstep); PG8_STAGE_A(PG8_SA(1, 0), cvo[0], kstep); PG8_STAGE_B(PG8_SB(1, 1), cB + hstep + kstep);
    PG8_WAIT_V(6); PG8_BAR;
    for (;;) {
        const bool has_next = S.next(ui + 1, nxt);
        const char* nB = has_next ? nxt.B : cB;
#pragma nounroll
        for (int t = 0; t < nt; t += 2) {
            const bool last = (t == nt - 2);
            const size_t k1 = (size_t)(t + 1) * kstep, k2 = last ? 0 : (size_t)(t + 2) * kstep, k3 = k2 + kstep;
            const char* b2 = last ? nB : cB + (size_t)(t + 2) * kstep; const char* b3 = b2 + kstep;
            PG8_LDB(B0, 0, 0); PG8_LDB(B1, 0, 1); PG8_SCHED; PG8_LDA(At, 0, 0); PG8_STAGE_A(PG8_SA(1, 1), cvo[1], k1);
            PG8_WAIT_V(8); PG8_WAIT_L(0); PG8_BAR; PG8_MMA(0, 0, At, B0); PG8_MMA(0, 1, At, B1); PG8_BAR; PG8_SCHED;
            if (last && has_next) S.aoffs(nxt, tid, cvo);
            PG8_LDA(At, 0, 1); PG8_STAGE_B(PG8_SB(0, 0), b2); PG8_STAGE_B(PG8_SB(0, 1), b2 + hstep); PG8_STAGE_A(PG8_SA(0, 0), cvo[0], k2);
            PG8_WAIT_V(8); PG8_WAIT_L(0); PG8_BAR; PG8_MMA(1, 0, At, B0); PG8_MMA(1, 1, At, B1); PG8_BAR; PG8_SCHED;
            PG8_LDB(B0, 1, 0); PG8_LDB(B1, 1, 1); PG8_SCHED; PG8_LDA(At, 1, 0); PG8_STAGE_A(PG8_SA(0, 1), cvo[1], k2);
            PG8_WAIT_V(8); PG8_WAIT_L(0); PG8_BAR; PG8_MMA(0, 0, At, B0); PG8_MMA(0, 1, At, B1); PG8_BAR; PG8_SCHED;
            PG8_LDA(At, 1, 1); PG8_STAGE_B(PG8_SB(1, 0), b3); PG8_STAGE_B(PG8_SB(1, 1), b3 + hstep); PG8_STAGE_A(PG8_SA(1, 0), cvo[0], k3);
            PG8_WAIT_V(8); PG8_WAIT_L(0); PG8_BAR; PG8_MMA(1, 0, At, B0); PG8_MMA(1, 1, At, B1); PG8_BAR; PG8_SCHED;
        }
        if (wr == 0) PG8_BAR;
        E(acc, cur, wr, wc, fr, fq);
        if (!has_next) break;
#pragma unroll
        for (int a = 0; a < 2; ++a)
#pragma unroll
            for (int b = 0; b < 2; ++b)
#pragma unroll
                for (int m = 0; m < 4; ++m)
#pragma unroll
                    for (int n = 0; n < 2; ++n) acc[a][b][m][n] = (f32x4){0.f, 0.f, 0.f, 0.f};
        cur = nxt; cB = nB; ++ui;
        if (wr == 1) PG8_BAR;
    }
    PG8_WAIT_V(0);
    PG8_BAR;
#undef PG8_SA
#undef PG8_SB
#undef PG8_STAGE_A
#undef PG8_STAGE_B
#undef PG8_LDA
#undef PG8_LDB
#undef PG8_MMA
#undef PG8_CAT
#undef PG8_WAIT_V
#undef PG8_WAIT_L
#undef PG8_BAR
#undef PG8_SCHED
}
struct DenseSched {
    int nM, nN, G, c, K, lda, acol0; const char* Bt;
    __device__ __forceinline__ bool next(int i, GUnit& u) const {
        const int nwg = nM * nN; const long L = (long)i * G + c; if (L >= nwg) return false;
        int wgid = (int)L; { const int q = nwg / NXCD, r = nwg % NXCD, xcd = wgid % NXCD, off = wgid / NXCD; wgid = (xcd < r ? xcd * (q + 1) : r * (q + 1) + (xcd - r) * q) + off; }
        const int nig = WGM * nN, gid = wgid / nig, fm = gid * WGM, gsz = (nM - fm) < WGM ? (nM - fm) : WGM;
        u.pm = fm + ((wgid % nig) % gsz); u.pn = (wgid % nig) / gsz; u.e = 0; u.arow = u.pm * BM; u.li = i; u.B = Bt + (size_t)u.pn * BM * K * 2; return true;
    }
    __device__ __forceinline__ void aoffs(const GUnit& u, int tid, unsigned (&vo)[2][2]) const {
#pragma unroll
        for (int i = 0; i < 2; ++i) { int R, C; stage_rc(tid * 16 + i * 8192, R, C);
#pragma unroll
            for (int h = 0; h < 2; ++h) vo[h][i] = (unsigned)((u.arow + R + 128 * h) * lda + acol0 + C) * 2u; }
    }
};
template <int NT, bool GATHER, bool FP8 = false> struct MoeSched {
    int G, c; const LAS int* tile; const LAS unsigned* lst; const char* W; int wrows;
    __device__ __forceinline__ bool next(int i, GUnit& u) const {
        constexpr int RPG = 32 / NT; const int L = i * G + c, x = L & 7, j = L >> 3, grp = j >> 5, jj = j & 31;
        const int rt = (grp * 8 + x) * RPG + (jj % RPG), pn = jj / RPG; if (rt >= tile[300]) return false;
        const int e = tile[rt]; u.pm = rt; u.pn = pn; u.e = e; u.arow = rt * BM; u.li = i; u.B = W + ((size_t)e * wrows + pn * BM) * (FP8 ? 1024 : 2048); return true;
    }
    __device__ __forceinline__ void aoffs(const GUnit& u, int tid, unsigned (&vo)[2][2]) const {
#pragma unroll
        for (int i = 0; i < 2; ++i) { int R, C; stage_rc(tid * 16 + i * 8192, R, C);
#pragma unroll
            for (int h = 0; h < 2; ++h) vo[h][i] = GATHER ? lst[u.li * 256 + R + 128 * h] + (unsigned)C * 2u : (unsigned)((u.arow + R + 128 * h) * (FP8 ? 1024 : 2048) + C * 2); }
    }
};
__device__ __forceinline__ u32x4 pack8(f32x4 a, f32x4 b) { u32x4 w; w.x = pk2(a.x, a.y); w.y = pk2(a.z, a.w); w.z = pk2(b.x, b.y); w.w = pk2(b.z, b.w); return w; }
#define PG8_EPI_LOOP _Pragma("unroll") for (int ai = 0; ai < 2; ++ai) _Pragma("unroll") for (int m = 0; m < 4; ++m)
struct EpiRowMajor { bf16_t* O; int ldo;
    __device__ __forceinline__ void operator()(const f32x4 (&acc)[2][2][4][2], const GUnit& u, int wr, int wc, int fr, int fq) const {
        PG8_EPI_LOOP { bf16_t* rp = O + (size_t)(u.arow + 128 * ai + 64 * wr + 16 * m + fr) * ldo + u.pn * BM + 32 * wc + 8 * fq;
#pragma unroll
            for (int bj = 0; bj < 2; ++bj) *(u32x4*)(rp + 128 * bj) = pack8(acc[ai][bj][m][0], acc[ai][bj][m][1]); }
    }
};
constexpr float QPRESCALE = 0.07216878364870322f * 1.4426950408889634f;
struct EpiQ { unsigned char* ws;
    __device__ __forceinline__ void operator()(const f32x4 (&acc)[2][2][4][2], const GUnit& u, int wr, int wc, int fr, int fq) const {
        const float* RS = (const float*)(ws + WS_RSTAT); const float* ct = (const float*)(ws + WS_ROPE); const float* st = ct + 2048; bf16_t* Q = (bf16_t*)(ws + WS_Q);
        PG8_EPI_LOOP { const int row = u.arow + 128 * ai + 64 * wr + 16 * m + fr; const float rinv = RS[2 * row] * QPRESCALE; const int b = row >> 13, t = row & 8191, prow = t >> 6, pcol = t & 63;
#pragma unroll
            for (int bj = 0; bj < 2; ++bj) { const int col = u.pn * BM + 128 * bj + 32 * wc + 8 * fq; if (col >= NH * DQK) continue;
                const int hd = col / DQK, d = col - hd * DQK; f32x4 v0 = acc[ai][bj][m][0] * rinv, v1 = acc[ai][bj][m][1] * rinv;
                if (d >= DNOPE) { const int pi = (d - DNOPE) >> 1, pos = pi < 16 ? prow : pcol, j = pi & 15; const f32x4 cs = *(const f32x4*)(ct + pos * 16 + j), sn = *(const f32x4*)(st + pos * 16 + j);
                    const f32x4 a = v0, c2 = v1; v0.x = a.x * cs.x - a.y * sn.x; v0.y = a.x * sn.x + a.y * cs.x; v0.z = a.z * cs.y - a.w * sn.y; v0.w = a.z * sn.y + a.w * cs.y;
                    v1.x = c2.x * cs.z - c2.y * sn.z; v1.y = c2.x * sn.z + c2.y * cs.z; v1.z = c2.z * cs.w - c2.w * sn.w; v1.w = c2.z * sn.w + c2.w * cs.w; }
                *(u32x4*)(Q + ((size_t)(b * NH + hd) * SEQ + t) * DQK + d) = pack8(v0, v1); }
            asm volatile("" ::: "memory"); }
    }
};
struct EpiKV { unsigned char* ws;
    __device__ __forceinline__ void operator()(const f32x4 (&acc)[2][2][4][2], const GUnit& u, int wr, int wc, int fr, int fq) const {
        const float* RS = (const float*)(ws + WS_RSTAT); bf16_t* KNp = (bf16_t*)(ws + WS_KN); bf16_t* Vp = (bf16_t*)(ws + WS_V);
        PG8_EPI_LOOP { const int row = u.arow + 128 * ai + 64 * wr + 16 * m + fr; const float rinv = RS[2 * row + 1]; int b, tt; if (row < ML) { b = row >> 13; tt = row & 8191; } else { b = (row - ML) >> 8; tt = SEQ + ((row - ML) & 255); }
            const size_t ro = ((size_t)(b * NH + u.pn) * TK + tt) * 128 + 32 * wc + 8 * fq;
            *(u32x4*)(KNp + ro) = pack8(acc[ai][0][m][0] * rinv, acc[ai][0][m][1] * rinv); *(u32x4*)(Vp + ro) = pack8(acc[ai][1][m][0] * rinv, acc[ai][1][m][1] * rinv);
            asm volatile("" ::: "memory"); }
    }
};
struct EpiAct { bf16_t* ACT; const float* bg; const float* bu;
    __device__ __forceinline__ void operator()(const f32x4 (&acc)[2][2][4][2], const GUnit& u, int wr, int wc, int fr, int fq) const {
        const int ac = u.pn * 128 + 32 * wc + 8 * fq; const float* pg = bg + u.e * 1024 + ac; const float* pu = bu + u.e * 1024 + ac;
        const f32x4 g0 = *(const f32x4*)pg, g1 = *(const f32x4*)(pg + 4), u0 = *(const f32x4*)pu, u1 = *(const f32x4*)(pu + 4);
        PG8_EPI_LOOP { const int slot = u.arow + 128 * ai + 64 * wr + 16 * m + fr;
            *(u32x4*)(ACT + (size_t)slot * 1024 + ac) = pack8(act4(acc[ai][0][m][0] + g0, acc[ai][1][m][0] + u0), act4(acc[ai][0][m][1] + g1, acc[ai][1][m][1] + u1)); }
    }
};
__device__ __forceinline__ unsigned pk4_fp8(f32x4 v) { int p = __builtin_amdgcn_cvt_pk_fp8_f32(v.x, v.y, 0, false); p = __builtin_amdgcn_cvt_pk_fp8_f32(v.z, v.w, p, true); return (unsigned)p; }
struct EpiAct8 { unsigned char* ACT; const float* bg; const float* bu; float sc;
    __device__ __forceinline__ void operator()(const f32x4 (&acc)[2][2][4][2], const GUnit& u, int wr, int wc, int fr, int fq) const {
        const int ac = u.pn * 128 + 32 * wc + 8 * fq; const float* pg = bg + u.e * 1024 + ac; const float* pu = bu + u.e * 1024 + ac;
        const f32x4 g0 = *(const f32x4*)pg, g1 = *(const f32x4*)(pg + 4), u0 = *(const f32x4*)pu, u1 = *(const f32x4*)(pu + 4);
        PG8_EPI_LOOP { const int slot = u.arow + 128 * ai + 64 * wr + 16 * m + fr; u32x2 w;
            w.x = pk4_fp8(act4(acc[ai][0][m][0] * sc + g0, acc[ai][1][m][0] * sc + u0)); w.y = pk4_fp8(act4(acc[ai][0][m][1] * sc + g1, acc[ai][1][m][1] * sc + u1));
            *(u32x2*)(ACT + (size_t)slot * 1024 + ac) = w; }
    }
};
struct EpiY { bf16_t* Y; const float* bd; float sc;
    __device__ __forceinline__ void operator()(const f32x4 (&acc)[2][2][4][2], const GUnit& u, int wr, int wc, int fr, int fq) const {
        const int c0 = u.pn * BM + 32 * wc + 8 * fq; const float* pb = bd + u.e * 1024 + c0;
        const f32x4 b00 = *(const f32x4*)pb, b01 = *(const f32x4*)(pb + 4), b10 = *(const f32x4*)(pb + 128), b11 = *(const f32x4*)(pb + 132);
        PG8_EPI_LOOP { const int slot = u.arow + 128 * ai + 64 * wr + 16 * m + fr; bf16_t* rp = Y + (size_t)slot * 1024 + c0;
            *(u32x4*)rp = pack8(acc[ai][0][m][0] * sc + b00, acc[ai][0][m][1] * sc + b01); *(u32x4*)(rp + 128) = pack8(acc[ai][1][m][0] * sc + b10, acc[ai][1][m][1] * sc + b11); }
    }
};
struct EpiY8 { unsigned char* Y; const float* bd; float sc;
    __device__ __forceinline__ void operator()(const f32x4 (&acc)[2][2][4][2], const GUnit& u, int wr, int wc, int fr, int fq) const {
        const int c0 = u.pn * BM + 32 * wc + 8 * fq; const float* pb = bd + u.e * 1024 + c0;
        const f32x4 b00 = *(const f32x4*)pb, b01 = *(const f32x4*)(pb + 4), b10 = *(const f32x4*)(pb + 128), b11 = *(const f32x4*)(pb + 132);
        PG8_EPI_LOOP { const int slot = u.arow + 128 * ai + 64 * wr + 16 * m + fr; unsigned char* rp = Y + (size_t)slot * 1024 + c0; u32x2 w0, w1;
            w0.x = pk4_fp8(acc[ai][0][m][0] * sc + b00); w0.y = pk4_fp8(acc[ai][0][m][1] * sc + b01); w1.x = pk4_fp8(acc[ai][1][m][0] * sc + b10); w1.y = pk4_fp8(acc[ai][1][m][1] * sc + b11);
            *(u32x2*)rp = w0; *(u32x2*)(rp + 128) = w1; }
    }
};
#undef PG8_EPI_LOOP
}


namespace att {
typedef short s16x4 __attribute__((ext_vector_type(4)));
constexpr int NW = 8, QBLK = 32, KVBLK = 64, NTILE = 66, HALFKEYS = NTILE * KVBLK;
constexpr float SCALE = 0.07216878364870322f, THR = 8.f;
constexpr int SHM_V = KVBLK * 128 * 2, SHM_K = KVBLK * 128 * 2, SHM_R = KVBLK * 64 * 2;
__device__ __forceinline__ int crow(int r, int hi) { return (r & 3) + 8 * (r >> 2) + 4 * hi; }
__device__ __forceinline__ unsigned cvtpk(float lo, float hi) { return pk2(lo, hi); }
__device__ __forceinline__ int v_rd_base(int lane) { return ((lane & 3) << 3) | (((lane >> 2) & 3) << 6) | (((lane >> 4) & 1) << 5) | (((lane >> 5) & 1) << 8); }
constexpr int v_rd_off(int d0, int ks, int half) { return d0 * 512 + ks * 4096 + half * 2048; }
constexpr int SLOT_B = SHM_K + SHM_R + SHM_V, SL_K = 0, SL_R = SHM_K, SL_V = SHM_K + SHM_R, DMA_WS = 3 * SLOT_B, ATT_DMA_LDS = DMA_WS + NW * 64 * 4;
#define RSWZ(row, colB) ((row) * 128 + ((colB) ^ ((((row) >> 1) & 7) << 4)))
#define SBAR() __builtin_amdgcn_sched_barrier(0)
__device__ __forceinline__ float max3(float a, float b, float c) { return __builtin_elementwise_maximum(__builtin_elementwise_maximum(a, b), c); }
__device__ __forceinline__ float sm_max(const f32x16& p0, const f32x16& p1) {
  float a = max3(p0[0], p0[1], p0[2]), b = max3(p0[3], p0[4], p0[5]), c = max3(p1[0], p1[1], p1[2]), d = max3(p1[3], p1[4], p1[5]);
  a = max3(a, p0[6], p0[7]); b = max3(b, p0[8], p0[9]); c = max3(c, p1[6], p1[7]); d = max3(d, p1[8], p1[9]);
  a = max3(a, p0[10], p0[11]); b = max3(b, p0[12], p0[13]); c = max3(c, p1[10], p1[11]); d = max3(d, p1[12], p1[13]);
  a = max3(a, p0[14], p0[15]); c = max3(c, p1[14], p1[15]);
  float pmax = max3(a, b, max3(c, d, d));
  auto rr = __builtin_amdgcn_permlane32_swap(__float_as_uint(pmax), __float_as_uint(pmax), false, false);
  return max3(__uint_as_float(rr[0]), __uint_as_float(rr[1]), __uint_as_float(rr[1]));
}
__device__ __forceinline__ int kperm(int i) { const int a = i >> 3, h = (i >> 2) & 1, b = i & 3; return 16 * (a >> 1) + 8 * h + 4 * (a & 1) + b; }
__device__ __forceinline__ s16x4 trv(int a) { return __builtin_amdgcn_ds_read_tr16_b64_v4i16((LAS s16x4*)(uintptr_t)(unsigned)a); }
#define QK_LD(s, slot) do { if ((s) < 4) { f0[slot] = *(const LAS bf16x8*)(uintptr_t)(unsigned)(ka[(s)]); f1[slot] = *(const LAS bf16x8*)(uintptr_t)(unsigned)(ka[(s)] + 8192); } \
    else if ((s) < 8) { f0[slot] = *(const LAS bf16x8*)(uintptr_t)(unsigned)(kha[(s) - 4]); f1[slot] = *(const LAS bf16x8*)(uintptr_t)(unsigned)(kha[(s) - 4] + 8192); } \
    else { f0[slot] = *(const LAS bf16x8*)(uintptr_t)(unsigned)(ra[(s) - 8]); f1[slot] = *(const LAS bf16x8*)(uintptr_t)(unsigned)(ra[(s) - 8] + 4096); } } while (0)
#ifndef PP_KD
#define PP_KD 3
#endif
#ifndef PP_VD
#define PP_VD 6
#endif
constexpr int KD = PP_KD, KR_ = KD + 1, VD = PP_VD, VR_ = 16;
__device__ __forceinline__ void pp_qkt_head(bf16x8 (&f0)[KR_], bf16x8 (&f1)[KR_], const int (&kb)[4], const int (&rb)[4], int khd, int soff) {
  int ka[4], kha[4], ra[4];
#pragma unroll
  for (int i = 0; i < 4; ++i) { ka[i] = kb[i] + soff; kha[i] = ka[i] + khd; ra[i] = rb[i] + soff; }
#pragma unroll
  for (int s = 0; s < KD; ++s) QK_LD(s, s);
}
#define PV_LD(n) do { L[(n) & 15] = trv(vb + v_rd_off((n) & 3, (n) >> 2, 0)); H[(n) & 15] = trv(vb + v_rd_off((n) & 3, (n) >> 2, 1)); } while (0)
#define PV_MFMA(n) do { const bf16x8 pa_ = ((n) >> 2) == 0 ? pa0 : ((n) >> 2) == 1 ? pa1 : ((n) >> 2) == 2 ? pa2 : pa3; const s16x4 l_ = L[(n) & 15], h_ = H[(n) & 15]; \
    o[(n) & 3] = __builtin_amdgcn_mfma_f32_32x32x16_bf16(pa_, (bf16x8){l_[0], l_[1], l_[2], l_[3], h_[0], h_[1], h_[2], h_[3]}, o[(n) & 3], 0, 0, 0); } while (0)
template <bool PV>
__device__ __forceinline__ void pp_mphase(f32x16& p0, f32x16& p1, f32x16* o, bf16x8 (&f0)[KR_], bf16x8 (&f1)[KR_], const int (&kb)[4], int khd, const int (&rb)[4], int soff, int vb, const bf16x8* qr,
                                          bf16x8 pa0, bf16x8 pa1, bf16x8 pa2, bf16x8 pa3, const f32x16& minit) {
  int ka[4], kha[4], ra[4]; s16x4 L[VR_], H[VR_];
#pragma unroll
  for (int i = 0; i < 4; ++i) { ka[i] = kb[i] + soff; kha[i] = ka[i] + khd; ra[i] = rb[i] + soff; }
#pragma unroll
  for (int s = 0; s < 12; ++s) {
    if (s + KD < 12) QK_LD(s + KD, (s + KD) % KR_);
    else if (PV) { if (2 * (s + KD - 12) < VD) PV_LD(2 * (s + KD - 12)); if (2 * (s + KD - 12) + 1 < VD) PV_LD(2 * (s + KD - 12) + 1); }
    SBAR();
    p0 = __builtin_amdgcn_mfma_f32_32x32x16_bf16(f0[s % KR_], qr[s], s == 0 ? minit : p0, 0, 0, 0);
    p1 = __builtin_amdgcn_mfma_f32_32x32x16_bf16(f1[s % KR_], qr[s], s == 0 ? minit : p1, 0, 0, 0);
    SBAR(); }
  if (PV) {
#pragma unroll
    for (int n = 2 * KD; n < VD; ++n) PV_LD(n);
#pragma unroll
    for (int n = 0; n < 16; ++n) { if (n + VD < 16) PV_LD(n + VD); SBAR(); PV_MFMA(n); SBAR(); } }
}
__device__ __forceinline__ void pp_pv(f32x16* o, int vb, bf16x8 pa0, bf16x8 pa1, bf16x8 pa2, bf16x8 pa3) {
  s16x4 L[VR_], H[VR_];
#pragma unroll
  for (int n = 0; n < VD; ++n) PV_LD(n);
#pragma unroll
  for (int n = 0; n < 16; ++n) { if (n + VD < 16) PV_LD(n + VD); SBAR(); PV_MFMA(n); SBAR(); }
}
#undef PV_LD
#undef PV_MFMA
#undef QK_LD
typedef float f32x2p __attribute__((ext_vector_type(2)));
__device__ __forceinline__ bf16x8 pp_pack8(const f32x16& p, int b) {
  u32x4 w = {cvtpk(p[b], p[b + 1]), cvtpk(p[b + 2], p[b + 3]), cvtpk(p[b + 4], p[b + 5]), cvtpk(p[b + 6], p[b + 7])}; return *reinterpret_cast<bf16x8*>(&w); }
__device__ __forceinline__ void pp_expsum(f32x16& p0, f32x16& p1, float& l_reg, bf16x8& pa0, bf16x8& pa1, bf16x8& pa2, bf16x8& pa3) {
  f32x2p s0 = {0.f, 0.f}, s1 = {0.f, 0.f};
#pragma unroll
  for (int r = 0; r < 16; r += 2) { f32x2p v = {__builtin_amdgcn_exp2f(p0[r]), __builtin_amdgcn_exp2f(p0[r + 1])}; s0 += v; p0[r] = v[0]; p0[r + 1] = v[1]; }
#pragma unroll
  for (int r = 0; r < 16; r += 2) { f32x2p v = {__builtin_amdgcn_exp2f(p1[r]), __builtin_amdgcn_exp2f(p1[r + 1])}; s1 += v; p1[r] = v[0]; p1[r + 1] = v[1]; }
  s0 += s1; l_reg += s0[0] + s0[1];
  pa0 = pp_pack8(p0, 0); pa1 = pp_pack8(p0, 8); pa2 = pp_pack8(p1, 0); pa3 = pp_pack8(p1, 8);
}
template <int NTT, bool FULL>
__device__ __forceinline__ void attn_unit_pp(const bf16_t* __restrict__ Qb, const bf16_t* __restrict__ Kh, const bf16_t* __restrict__ Vh, const bf16_t* __restrict__ Rh,
                                             float* __restrict__ Op, float* __restrict__ MLp, LAS unsigned char* lds, const int tid) {
  const int wid = __builtin_amdgcn_readfirstlane(tid >> 6), lane = tid & 63, r32 = lane & 31, hi = lane >> 5;
  const bool grpB = wid >= 4;
  LAS float* wsx = (LAS float*)(lds + DMA_WS) + wid * 64; LAS float* al_l = wsx + 32;
  float l_reg = 0; f32x16 o[4] = {}, minit = {}; bf16x8 qr[12];
  unsigned ko[2], vo[2], ro;
#pragma unroll
  for (int i = 0; i < 2; ++i) { const int pc = 2 * wid + i;
    { const int row = 4 * pc + (lane >> 4), cl = (lane & 15) ^ (row & 15); ko[i] = (unsigned)(row * 128 + cl * 8) * 2u; }
    { const int s = pc * 64 + lane, sub = s >> 5, within = s & 31, kk = (sub >> 2) * 8 + (within >> 2), c = (sub & 3) * 32 + (within & 3) * 8;
      const int k = (kk & ~0xC) | ((kk & 4) << 1) | ((kk & 8) >> 1); vo[i] = (unsigned)(k * 128 + c) * 2u; } }
  { const int row = 8 * wid + (lane >> 3), cl = (lane & 7) ^ ((row >> 1) & 7); ro = (unsigned)(row * 64 + cl * 8) * 2u; }
#define DMA_KR(t, slot) do { const char* kt_ = (const char*)Kh + (size_t)(t) * (KVBLK * 256); const char* rt_ = (const char*)Rh + (size_t)(t) * (KVBLK * 128); const unsigned sb_ = (unsigned)lb + (unsigned)(slot) * SLOT_B; unsigned sv_; \
    asm volatile("s_mov_b32 %0, m0\n\ts_mov_b32 m0, %5\n\ts_nop 0\n\tglobal_load_lds_dwordx4 %1, %4\n\ts_mov_b32 m0, %6\n\ts_nop 0\n\tglobal_load_lds_dwordx4 %2, %4\n\ts_mov_b32 m0, %8\n\ts_nop 0\n\tglobal_load_lds_dwordx4 %3, %7\n\ts_mov_b32 m0, %0" \
                 : "=&s"(sv_) : "v"(ko[0]), "v"(ko[1]), "v"(ro), "s"(kt_), "s"(sb_ + SL_K + (2 * wid) * 1024), "s"(sb_ + SL_K + (2 * wid + 1) * 1024), "s"(rt_), "s"(sb_ + SL_R + wid * 1024) : "memory"); } while (0)
#define DMA_V(t, slot) do { const char* vt_ = (const char*)Vh + (size_t)(t) * (KVBLK * 256); const unsigned sb_ = (unsigned)lb + (unsigned)(slot) * SLOT_B; unsigned sv_; \
    asm volatile("s_mov_b32 %0, m0\n\ts_mov_b32 m0, %4\n\ts_nop 0\n\tglobal_load_lds_dwordx4 %1, %3\n\ts_mov_b32 m0, %5\n\ts_nop 0\n\tglobal_load_lds_dwordx4 %2, %3\n\ts_mov_b32 m0, %0" \
                 : "=&s"(sv_) : "v"(vo[0]), "v"(vo[1]), "s"(vt_), "s"(sb_ + SL_V + (2 * wid) * 1024), "s"(sb_ + SL_V + (2 * wid + 1) * 1024) : "memory"); } while (0)
#define BAR() do { SBAR(); asm volatile("" ::: "memory"); __builtin_amdgcn_s_barrier(); asm volatile("" ::: "memory"); SBAR(); } while (0)
#define MBAR(n) do { SBAR(); asm volatile("s_waitcnt vmcnt(" #n ") lgkmcnt(0)" ::: "memory"); __builtin_amdgcn_s_barrier(); asm volatile("" ::: "memory"); SBAR(); } while (0)
#define RESC(a) do { if (__any((a) < 1.f)) { if (hi == 0) al_l[r32] = (a); asm volatile("s_waitcnt lgkmcnt(0)" ::: "memory"); \
    _Pragma("unroll") for (int d = 0; d < 4; ++d) _Pragma("unroll") for (int r = 0; r < 16; ++r) o[d][r] *= al_l[crow(r, hi)]; } } while (0)
#define VPHASE(FIRST) do { const float rel = sm_max(p0, p1); \
    if ((FIRST) || __any(rel > THR * 1.4426950408889634f)) { const float dl = (FIRST) ? rel : fmaxf(rel, 0.f), al = __builtin_amdgcn_exp2f(-dl); \
      _Pragma("unroll") for (int r = 0; r < 16; ++r) { p0[r] -= dl; p1[r] -= dl; minit[r] -= dl; }     \
      l_reg *= al; RESC(al); } \
    pp_expsum(p0, p1, l_reg, pa0, pa1, pa2, pa3); } while (0)
  constexpr int NT = NTT;
  const int lb = __builtin_amdgcn_readfirstlane((int)(uintptr_t)lds);
  DMA_KR(0, 0); DMA_KR(1, 1); DMA_V(0, 0);
  { const unsigned qo = (unsigned)((wid * QBLK + r32) * DQK + hi * 8) * 2u;
#pragma unroll
    for (int d0 = 0; d0 < 12; ++d0) qr[d0] = *reinterpret_cast<const bf16x8*>((const char*)Qb + qo + d0 * 32); }
  const int vbase = lb + SL_V + v_rd_base(lane);
  int kb[4], rb[4];
#pragma unroll
  for (int i = 0; i < 4; ++i) { const int cb = (i * 16 + hi * 8) * 2, kr = kperm(r32); kb[i] = lb + SL_K + kr * 256 + ((((2 * i + hi) ^ (kr & 7)) + 8 * ((kr >> 3) & 1)) << 4); rb[i] = lb + SL_R + RSWZ(kr, cb); }
  const int khd = ((kperm(r32) >> 3) & 1) ? -128 : 128;
  f32x16 p0, p1; bf16x8 pa0 = {}, pa1 = {}, pa2 = {}, pa3 = {};
  bf16x8 f0[KR_], f1[KR_];
  MBAR(0);
  if (grpB) BAR();
  pp_qkt_head(f0, f1, kb, rb, khd, 0); pp_mphase<false>(p0, p1, o, f0, f1, kb, khd, rb, 0, 0, qr, pa0, pa0, pa0, pa0, minit);
  MBAR(0);
  int sa = 0, sb = 1, sc = 2;
#pragma nounroll
  for (int t = 0; t + 1 < NT; ++t) {
    if (t + 2 < NT) DMA_KR(t + 2, sc);
    DMA_V(t + 1, sb);
    VPHASE(t == 0);
    pp_qkt_head(f0, f1, kb, rb, khd, sb * SLOT_B);
    BAR();
    pp_mphase<true>(p0, p1, o, f0, f1, kb, khd, rb, sb * SLOT_B, vbase + sa * SLOT_B, qr, pa0, pa1, pa2, pa3, minit);
    MBAR(0);
    { const int tmp = sa; sa = sb; sb = sc; sc = tmp; }
  }
  VPHASE(NT == 1);
  BAR();
  pp_pv(o, vbase + sa * SLOT_B, pa0, pa1, pa2, pa3);
  asm volatile("s_waitcnt vmcnt(0)" ::: "memory");
  if (!grpB) BAR();
  { auto rr = __builtin_amdgcn_permlane32_swap(__float_as_uint(l_reg), __float_as_uint(l_reg), false, false); l_reg = __uint_as_float(rr[0]) + __uint_as_float(rr[1]); }
  if constexpr (FULL) {
    if (hi == 0) wsx[r32] = l_reg; asm volatile("s_waitcnt lgkmcnt(0)" ::: "memory");
    const unsigned oo = (unsigned)((wid * QBLK + 4 * hi) * D + r32) * 2u;
#pragma unroll
    for (int r = 0; r < 16; ++r) { const float rl = __builtin_amdgcn_rcpf(wsx[crow(r, hi)]);
#pragma unroll
      for (int d0 = 0; d0 < 4; ++d0) *(bf16_t*)((char*)Op + oo + (unsigned)(((r & 3) + 8 * (r >> 2)) * D + d0 * 32) * 2u) = (bf16_t)f2bf(o[d0][r] * rl); }
  } else {
    if (hi == 0) { *(float2*)((char*)MLp + (unsigned)(wid * QBLK + r32) * 8u) = make_float2(-minit[0], l_reg); }
    const unsigned oo = (unsigned)((wid * QBLK + 4 * hi) * 128 + r32) * 4u;
#pragma unroll
    for (int r = 0; r < 16; ++r)
#pragma unroll
      for (int d0 = 0; d0 < 4; ++d0) *(float*)((char*)Op + oo + (unsigned)(((r & 3) + 8 * (r >> 2)) * 128 + d0 * 32) * 4u) = o[d0][r]; }
#undef DMA_KR
#undef DMA_V
#undef BAR
#undef MBAR
#undef RESC
#undef VPHASE
}
#undef RSWZ
#undef SBAR
}
#ifndef ATTN_UNIT
#define ATTN_UNIT attn_unit_pp
#endif
__device__ __forceinline__ void ph_attn(const P& p, int wg, int nwg, LAS unsigned char* lds, const int wv) {
    unsigned char* ws = p.ws;
    { for (int L = wg; L < 256; L += nwg) { const int bh = L & 7, qb = (L >> 3) & 31, b = bh / NH, h = bh - b * NH;
        const int tid = fresh_tid(wv);
        __syncthreads();
        att::ATTN_UNIT<2 * att::NTILE, true>((const bf16_t*)(ws + WS_Q) + ((size_t)bh * SEQ + qb * 256) * DQK, (const bf16_t*)(ws + WS_KN) + (size_t)bh * TK * 128,
                   (const bf16_t*)(ws + WS_V) + (size_t)bh * TK * 128, (const bf16_t*)(ws + WS_KR) + (size_t)b * TK * 64,
                   (float*)((bf16_t*)(ws + WS_MIXA) + ((size_t)b * SEQ + qb * 256) * D + h * 128), nullptr, lds, tid); } }
    { for (int L = wg; L < 256; L += nwg) { const int x = L & 7, qb = (L >> 3) & 31, bh = 8 + (x >> 1), half = x & 1, b = bh / NH, key0 = half * att::HALFKEYS, pidx = ((bh - 8) * 32 + qb) * 2 + half;
        const int tid = fresh_tid(wv);
        __syncthreads();
        att::ATTN_UNIT<att::NTILE, false>((const bf16_t*)(ws + WS_Q) + ((size_t)bh * SEQ + qb * 256) * DQK, (const bf16_t*)(ws + WS_KN) + ((size_t)bh * TK + key0) * 128,
                   (const bf16_t*)(ws + WS_V) + ((size_t)bh * TK + key0) * 128, (const bf16_t*)(ws + WS_KR) + ((size_t)b * TK + key0) * 64,
                   (float*)(ws + WS_OPART) + (size_t)pidx * 32768, (float*)(ws + WS_OML) + (size_t)pidx * 512, lds, tid); } }
}
__device__ __forceinline__ void ph_acomb(const P& p, int wg, int nwg, int tid) {
    const int lane = tid & 63, gw = wg * 8 + (tid >> 6), ngw = nwg * 8; unsigned char* ws = p.ws;
    const float* OP = (const float*)(ws + WS_OPART); const float* OML = (const float*)(ws + WS_OML); bf16_t* MIXA = (bf16_t*)(ws + WS_MIXA);
    for (int rw = gw; rw < 4 * 32 * 256; rw += ngw) {
        const int pp = rw >> 8, r = rw & 255, bh = 8 + (pp >> 5), qb = pp & 31, b = bh / NH, h = bh - b * NH;
        const float2 ml1 = *(const float2*)(OML + ((size_t)(pp * 2) * 256 + r) * 2), ml2 = *(const float2*)(OML + ((size_t)(pp * 2 + 1) * 256 + r) * 2);
        typedef float f32x2v __attribute__((ext_vector_type(2)));
        const f32x2v o1 = __builtin_nontemporal_load((const f32x2v*)(OP + ((size_t)(pp * 2) * 256 + r) * 128 + 2 * lane)), o2 = __builtin_nontemporal_load((const f32x2v*)(OP + ((size_t)(pp * 2 + 1) * 256 + r) * 128 + 2 * lane));
        const float M = fmaxf(ml1.x, ml2.x), w1 = __builtin_amdgcn_exp2f(ml1.x - M), w2 = __builtin_amdgcn_exp2f(ml2.x - M), inv = 1.f / (ml1.y * w1 + ml2.y * w2);
        *(unsigned*)(MIXA + ((size_t)b * SEQ + qb * 256 + r) * D + h * 128 + 2 * lane) = pk2((o1.x * w1 + o2.x * w2) * inv, (o1.y * w1 + o2.y * w2) * inv);
    }
}

namespace fou {
typedef short s16x4 __attribute__((ext_vector_type(4)));
template <int OFF> __device__ __forceinline__ s16x4 tr_read(int vb) { s16x4 r; asm volatile("ds_read_b64_tr_b16 %0, %1 offset:%2" : "=&v"(r) : "v"(vb), "i"(OFF) : "memory"); return r; }
__device__ __forceinline__ int rd_base(int lane) { return ((lane & 3) << 3) | (((lane >> 2) & 3) << 6) | (((lane >> 4) & 1) << 5) | (((lane >> 5) & 1) << 8); }
__device__ __forceinline__ int img_off(int k, int c) { const int kk = (k & ~0xC) | ((k & 4) << 1) | ((k & 8) >> 1); return ((kk >> 3) * 2 + (c >> 5)) * 512 + ((kk & 7) * 32 + (c & 31)) * 2; }
#define FOU_PK(L, H) (bf16x8){L[0], L[1], L[2], L[3], H[0], H[1], H[2], H[3]}
template <int KS> __device__ __forceinline__ void a_step(f32x16& yr, f32x16& yi, int vb, const bf16x8 (&ar)[16], const bf16x8 (&ai)[16]) {
    const s16x4 l = tr_read<KS * 2048>(vb), h = tr_read<KS * 2048 + 1024>(vb);
    asm volatile("s_waitcnt lgkmcnt(0)" ::: "memory"); __builtin_amdgcn_sched_barrier(0);
    const bf16x8 bb = FOU_PK(l, h);
    yr = __builtin_amdgcn_mfma_f32_32x32x16_bf16(ar[KS], bb, yr, 0, 0, 0); yi = __builtin_amdgcn_mfma_f32_32x32x16_bf16(ai[KS], bb, yi, 0, 0, 0);
}
__device__ __forceinline__ void stage_a(unsigned char* ws, int bg, int n2, LAS unsigned char* lds, int tid) {
    const int b = bg >> 2, g = bg & 3, lane = tid & 63, w = tid >> 6, r32 = lane & 31, hi = lane >> 5;
    const bf16_t* PXb = (const bf16_t*)(ws + WS_PX) + (size_t)b * SEQ * PXW + 768 + g * 128;
#pragma unroll
    for (int i = 0; i < 4; ++i) { const int q = tid + NTHR * i, kk = q >> 3, jc = (q & 7) * 8, n1 = kk & 127, isq = kk >> 7;
        const bf16x8 v = __builtin_nontemporal_load((const bf16x8*)(PXb + (size_t)(64 * n1 + n2) * PXW + isq * 64 + jc)); *(LAS bf16x8*)(lds + img_off(kk, jc)) = v; }
    const int kb = w & 3, d0 = w >> 2;
    bf16x8 ar[16], ai[16];
    { const bf16_t* gar = (const bf16_t*)(ws + WS_GA) + (size_t)(kb * 32 + r32) * 256 + 8 * hi; const bf16_t* gai = gar + 128 * 256;
#pragma unroll
      for (int k = 0; k < 16; ++k) { ar[k] = *(const bf16x8*)(gar + k * 16); ai[k] = *(const bf16x8*)(gai + k * 16); } }
    __syncthreads();
    const int vb = (int)(uintptr_t)lds + rd_base(lane) + d0 * 512;
    f32x16 yr = {0}, yi = {0};
    a_step<0>(yr, yi, vb, ar, ai); a_step<1>(yr, yi, vb, ar, ai); a_step<2>(yr, yi, vb, ar, ai); a_step<3>(yr, yi, vb, ar, ai);
    a_step<4>(yr, yi, vb, ar, ai); a_step<5>(yr, yi, vb, ar, ai); a_step<6>(yr, yi, vb, ar, ai); a_step<7>(yr, yi, vb, ar, ai);
    a_step<8>(yr, yi, vb, ar, ai); a_step<9>(yr, yi, vb, ar, ai); a_step<10>(yr, yi, vb, ar, ai); a_step<11>(yr, yi, vb, ar, ai);
    a_step<12>(yr, yi, vb, ar, ai); a_step<13>(yr, yi, vb, ar, ai); a_step<14>(yr, yi, vb, ar, ai); a_step<15>(yr, yi, vb, ar, ai);
    const float2* tw = (const float2*)(ws + WS_FTAB); bf16_t* FT = (bf16_t*)(ws + WS_FT);
#pragma unroll
    for (int r = 0; r < 16; ++r) { const int k1 = kb * 32 + (r & 3) + 8 * (r >> 2) + 4 * hi; const float2 t = tw[(n2 * k1) & 8191];
        bf16_t* dst = FT + (((size_t)bg * 128 + k1) * 64 + n2) * 128 + d0 * 32 + r32;
        dst[0] = (bf16_t)f2bf(t.x * yr[r] + t.y * yi[r]); dst[64] = (bf16_t)f2bf(t.x * yi[r] - t.y * yr[r]); }
    __syncthreads();
}
template <int KS> __device__ __forceinline__ void b_step(f32x16 (&acc)[2][2], int vb, const bf16x8 (&g0)[8], const bf16x8 (&g1)[8]) {
    const s16x4 l0 = tr_read<KS * 2048>(vb), h0 = tr_read<KS * 2048 + 1024>(vb), l1 = tr_read<KS * 2048 + 512>(vb), h1 = tr_read<KS * 2048 + 1536>(vb);
    asm volatile("s_waitcnt lgkmcnt(0)" ::: "memory"); __builtin_amdgcn_sched_barrier(0);
    const bf16x8 b0 = FOU_PK(l0, h0), b1 = FOU_PK(l1, h1);
    acc[0][0] = __builtin_amdgcn_mfma_f32_32x32x16_bf16(g0[KS], b0, acc[0][0], 0, 0, 0); acc[0][1] = __builtin_amdgcn_mfma_f32_32x32x16_bf16(g0[KS], b1, acc[0][1], 0, 0, 0);
    acc[1][0] = __builtin_amdgcn_mfma_f32_32x32x16_bf16(g1[KS], b0, acc[1][0], 0, 0, 0); acc[1][1] = __builtin_amdgcn_mfma_f32_32x32x16_bf16(g1[KS], b1, acc[1][1], 0, 0, 0);
}
__device__ __forceinline__ void stage_b(unsigned char* ws, int bg, int k1base, LAS unsigned char* lds, int tid) {
    const int b = bg >> 2, g = bg & 3, lane = tid & 63, w = tid >> 6, r32 = lane & 31, hi = lane >> 5, k1 = k1base + w;
    const bf16_t* src = (const bf16_t*)(ws + WS_FT) + ((size_t)bg * 128 + k1) * 64 * 128;
    LAS unsigned char* my = lds + w * 16384;
#pragma unroll
    for (int i = 0; i < 16; ++i) { const int q = lane + 64 * i, kk = q >> 3, jc = (q & 7) * 8; const bf16x8 v = __builtin_nontemporal_load((const bf16x8*)(src + q * 8)); *(LAS bf16x8*)(my + img_off(kk, jc)) = v; }
    bf16x8 g0[8], g1[8];
    { const bf16_t* gb = (const bf16_t*)(ws + WS_GB) + (size_t)r32 * 128 + 8 * hi;
#pragma unroll
      for (int k = 0; k < 8; ++k) { g0[k] = *(const bf16x8*)(gb + k * 16); g1[k] = *(const bf16x8*)(gb + 32 * 128 + k * 16); } }
    asm volatile("s_waitcnt lgkmcnt(0)" ::: "memory"); __builtin_amdgcn_sched_barrier(0);
    const int vb = (int)(uintptr_t)my + rd_base(lane);
    f32x16 acc[2][2] = {};
    b_step<0>(acc, vb, g0, g1); b_step<1>(acc, vb, g0, g1); b_step<2>(acc, vb, g0, g1); b_step<3>(acc, vb, g0, g1); b_step<4>(acc, vb, g0, g1); b_step<5>(acc, vb, g0, g1); b_step<6>(acc, vb, g0, g1); b_step<7>(acc, vb, g0, g1);
    bf16_t* MIXA = (bf16_t*)(ws + WS_MIXA);
#pragma unroll
    for (int rb = 0; rb < 2; ++rb)
#pragma unroll
        for (int r = 0; r < 16; ++r) { const int k2 = rb * 32 + (r & 3) + 8 * (r >> 2) + 4 * hi; bf16_t* dst = MIXA + ((size_t)b * SEQ + k1 + 128 * k2) * D + 768 + g * 64 + r32;
            dst[0] = (bf16_t)f2bf(acc[rb][0][r]); dst[32] = (bf16_t)f2bf(acc[rb][1][r]); }
}
#undef FOU_PK
}


#define XB_TMO      128
#define XB_XCNT(j)  (256  + 64 * (j))
#define XB_XSUB(j)  (1280 + 64 * (j))
#define XB_XGEN(j)  (2304 + 64 * (j))
#define XB_TOP      3328
#define XB_TOPGEN   3392
#define XCD_BAR_WORDS 3456
#define XB_SPIN_CAP (1u << 18)
__device__ __forceinline__ unsigned xb_ld(unsigned* p)              { return __hip_atomic_load(p, __ATOMIC_RELAXED, __HIP_MEMORY_SCOPE_AGENT); }
__device__ __forceinline__ unsigned xb_add(unsigned* p, unsigned v) { return __hip_atomic_fetch_add(p, v, __ATOMIC_RELAXED, __HIP_MEMORY_SCOPE_AGENT); }
__device__ __forceinline__ unsigned xb_xcc_id() { return (unsigned)__builtin_amdgcn_s_getreg((3 << 11) | 20) & 0xFu; }
#define XB_SPIN(cond, bar) do { unsigned _sp = 0; while (cond) { __builtin_amdgcn_s_sleep(1); \
    if ((++_sp & 255u) == 0u) { if (xb_ld(&(bar)[XB_TMO])) break; if (_sp > XB_SPIN_CAP) { atomicAdd(&(bar)[XB_TMO], 1u); break; } } } } while (0)
struct XcdBarrier { unsigned* bar; unsigned x; volatile LAS unsigned* st; };
__device__ __forceinline__ XcdBarrier xcd_barrier_post(unsigned* bar, volatile LAS unsigned* st) {
    XcdBarrier b; b.bar = bar; b.x = xb_xcc_id(); b.st = st;
    if (threadIdx.x == 0) (void)xb_add(&bar[XB_XCNT(b.x)], 1u);
    return b;
}
__device__ __forceinline__ void xcd_barrier_complete(unsigned* bar, unsigned x, unsigned& nloc, unsigned& nx) {
    const unsigned G = gridDim.x * gridDim.y * gridDim.z;
    unsigned sum, cnt, mine, sp = 0u;
    for (;;) {
        sum = 0u; cnt = 0u; mine = 0u;
#pragma unroll
        for (unsigned j = 0; j < 16; ++j) { const unsigned c = xb_ld(&bar[XB_XCNT(j)]); sum += c; cnt += (c > 0u) ? 1u : 0u; mine = (j == x) ? c : mine; }
        if (sum == G) break;
        __builtin_amdgcn_s_sleep(1);
        if ((++sp & 255u) == 0u) { if (xb_ld(&bar[XB_TMO])) break; if (sp > XB_SPIN_CAP) { atomicAdd(&bar[XB_TMO], 1u); break; } }
    }
    nloc = mine > 0u ? mine : 1u; nx = cnt > 0u ? cnt : 1u;
}
__device__ __forceinline__ void xcd_barrier(const XcdBarrier& b) {
    asm volatile("s_waitcnt vmcnt(0)" ::: "memory");
    __syncthreads();
    if (threadIdx.x == 0) {
        unsigned* bar = b.bar;
        __builtin_amdgcn_s_waitcnt(0);
        unsigned nloc = b.st[0], nx = b.st[1];
        if (nloc == 0u) { xcd_barrier_complete(bar, b.x, nloc, nx); b.st[0] = nloc; b.st[1] = nx; }
        const unsigned old = xb_add(&bar[XB_XSUB(b.x)], 1u);
        const unsigned gen = old / nloc;
        if (old + 1u == (gen + 1u) * nloc) {
            __builtin_amdgcn_fence(__ATOMIC_RELEASE, "agent");
            asm volatile("s_waitcnt vmcnt(0)" ::: "memory");
            const unsigned og = xb_add(&bar[XB_TOP], 1u);
            const unsigned tg = og / nx;
            if (og + 1u == (tg + 1u) * nx) xb_add(&bar[XB_TOPGEN], 1u);
            else XB_SPIN(xb_ld(&bar[XB_TOPGEN]) == tg, bar);
            __builtin_amdgcn_fence(__ATOMIC_ACQUIRE, "agent");
            xb_add(&bar[XB_XGEN(b.x)], 1u);
            asm volatile("s_waitcnt vmcnt(0)" ::: "memory");
        } else {
            XB_SPIN(xb_ld(&bar[XB_XGEN(b.x)]) == gen, bar);
            __builtin_amdgcn_fence(__ATOMIC_ACQUIRE, "agent");
            asm volatile("s_waitcnt vmcnt(0)" ::: "memory");
        }
    }
    __syncthreads();
}

enum { PH_PREP = 0, PH_MODUL = 1, PH_INPROJ = 2, PH_ROW1 = 3, PH_QKV = 4, PH_ATTN = 5, PH_ACOMB = 6, PH_OUTPROJ = 7, PH_ROW2 = 8, PH_LIST = 9, PH_MOE1 = 10, PH_MOE2 = 11, PH_FINAL = 12, NPH = 13 };
__global__ void __launch_bounds__(NTHR, 2) mega(P p) {
    extern __shared__ __attribute__((aligned(16))) unsigned char lds_raw[];
    LAS unsigned char* lds = (LAS unsigned char*)lds_raw;
    const int wg = blockIdx.x, nwg = gridDim.x;
    const int lo = p.ph_lo, hi = p.ph_hi;
    int wv = __builtin_amdgcn_readfirstlane((int)(threadIdx.x >> 6)); asm volatile("" : "+s"(wv));
    if (threadIdx.x == 0) { ((volatile LAS unsigned*)(lds + LDS_CTL))[0] = 0u; ((volatile LAS unsigned*)(lds + LDS_CTL))[1] = 0u; }
    __syncthreads();
    XcdBarrier bar; bar.bar = (unsigned*)(p.ws + WS_CTL) + 4096; bar.x = 0; bar.st = (volatile LAS unsigned*)(lds + LDS_CTL);
    if (hi - lo > 1) bar = xcd_barrier_post((unsigned*)(p.ws + WS_CTL) + 4096, (volatile LAS unsigned*)(lds + LDS_CTL));
#define SEAM(k) do { if (lo <= (k) && (k) + 1 < hi) xcd_barrier(bar); } while (0)
#ifndef PHMASK
#define PHMASK 0xFFFF
#endif
#define IN(k) (((PHMASK >> (k)) & 1) && lo <= (k) && (k) < hi)
    unsigned char* ws = p.ws;
#ifndef REPMASK
#define REPMASK 0
#endif
#define PHASE(k, ...) do { if (IN(k)) { _Pragma("unroll") for (int rep_ = 0; rep_ < 1 + ((REPMASK >> (k)) & 1); ++rep_) { if (rep_) xcd_barrier(bar); __VA_ARGS__ } } SEAM(k); } while (0)
    PHASE(PH_PREP, ph_prologue(p, wg, nwg, fresh_tid(wv), lds););
    PHASE(PH_MODUL, ph_modulate(p, wg, nwg, fresh_tid(wv)););
    PHASE(PH_INPROJ, { const pg8::DenseSched S{MA / 256, PXW / 256, nwg, wg, D, D, 0, (const char*)(ws + WS_WIN)}; const pg8::EpiRowMajor E{(bf16_t*)(ws + WS_PX), PXW};
        pg8::gemm_phase(lds, fresh_tid(wv), (const char*)(ws + WS_HX), D, S, E);
        if (nwg == NWG && wg >= 74) p0_expert_items(p, NEI_PREP + (wg - 74), 182, NEI_PREP + FILL_IN, fresh_tid(wv), (LAS float*)lds); });
    PHASE(PH_ROW1, { ph_row1(p, wg, nwg, fresh_tid(wv));
        { const int tid = fresh_tid(wv); __syncthreads(); for (int u = wg; u < 512; u += nwg) fou::stage_a(ws, u >> 6, u & 63, lds, tid); } });
    PHASE(PH_QKV, {
        { const int tid = fresh_tid(wv); for (int u = (wg + nwg / 2) % nwg; u < 128; u += nwg) fou::stage_b(ws, u >> 4, (u & 15) * 8, lds, tid); __syncthreads(); }
        { const pg8::DenseSched S{ML / 256, 5, nwg, wg, QL, PXW, 0, (const char*)(ws + WS_WQ)}; const pg8::EpiQ E{ws}; pg8::gemm_phase(lds, fresh_tid(wv), (const char*)(ws + WS_PX), QL, S, E); }
        { const pg8::DenseSched S{MA / 256, 6, nwg, wg, KVL, PXW, 512, (const char*)(ws + WS_WKV)}; const pg8::EpiKV E{ws}; pg8::gemm_phase(lds, fresh_tid(wv), (const char*)(ws + WS_PX), KVL, S, E); }
        if (nwg == NWG && wg >= 64) { const int tid = fresh_tid(wv); constexpr int QB = NEI_PREP + FILL_IN;
            if (wg < 128) p0_expert_items(p, QB + (wg - 64), 64, QB + 128, tid, (LAS float*)lds);
            else if (wg < 140) p0_expert_items(p, QB + 128 + (wg - 128), 12, QB + 140, tid, (LAS float*)lds);
            else { p0_expert_items(p, QB + 140 + (wg - 140), 116, QB + 372, tid, (LAS float*)lds);
                   if (wg <= 220) p0_expert_items(p, QB + 372 + (wg - 140), 81, QB + 453, tid, (LAS float*)lds); } } });
    static_assert(NEI_PREP + FILL_IN + 453 == NEI, "filler shares");
    PHASE(PH_ATTN, ph_attn(p, wg, nwg, lds, wv););
    PHASE(PH_ACOMB, ph_acomb(p, wg, nwg, fresh_tid(wv)););
    PHASE(PH_OUTPROJ, { const pg8::DenseSched S{ML / 256, D / 256, nwg, wg, D, D, 0, (const char*)(ws + WS_WOUT)}; const pg8::EpiRowMajor E{(bf16_t*)(ws + WS_MIX), D};
        pg8::gemm_phase(lds, fresh_tid(wv), (const char*)(ws + WS_MIXA), D, S, E); });
    PHASE(PH_ROW2, ph_row2(p, wg, nwg, fresh_tid(wv), lds););
    PHASE(PH_LIST, ph_lists(p, wg, nwg, fresh_tid(wv), lds););
    PHASE(PH_MOE1, { const int tid = fresh_tid(wv);
        LAS int* tileL = (LAS int*)(lds + LDS_CTL + 2048); LAS unsigned* lstL = (LAS unsigned*)(lds + LDS_CTL + 4096);
        const int* TILEE = (const int*)(ws + WS_TILEE); const int* SLOTTOK = (const int*)(ws + WS_SLOTTOK);
        for (int i = tid; i < MAXTILES; i += NTHR) tileL[i] = TILEE[i];
        if (tid == 0) tileL[300] = TILEE[400];
        __syncthreads();
        const pg8::MoeSched<8, true, MOE_FP8> S{nwg, wg, tileL, lstL, (const char*)(ws + WS_WGU), 2048};
        { pg8::GUnit u; for (int i = 0; i < 16 && S.next(i, u); ++i) if (tid < 256) lstL[i * 256 + tid] = (unsigned)SLOTTOK[u.arow + tid] * (MOE_FP8 ? 1024u : 2048u); }
        __syncthreads();
        if constexpr (MOE_FP8) { const pg8::EpiAct8 E{ws + WS_ACT, p.in[20], p.in[22], 1.f / WSCALE}; pg8::gemm_phase<pg8::EpiAct8, pg8::MoeSched<8, true, MOE_FP8>, true>(lds, tid, (const char*)(ws + WS_HX), D, S, E); }
        else { const pg8::EpiAct E{(bf16_t*)(ws + WS_ACT), p.in[20], p.in[22]}; pg8::gemm_phase(lds, fresh_tid(wv), (const char*)(ws + WS_HX), D, S, E); } });
    PHASE(PH_MOE2, { const int tid = fresh_tid(wv);
        LAS int* tileL = (LAS int*)(lds + LDS_CTL + 2048); LAS unsigned* lstL = (LAS unsigned*)(lds + LDS_CTL + 4096);
        const int* TILEE = (const int*)(ws + WS_TILEE);
        for (int i = tid; i < MAXTILES; i += NTHR) tileL[i] = TILEE[i];
        if (tid == 0) tileL[300] = TILEE[400];
        __syncthreads();
        const pg8::MoeSched<4, false, MOE_FP8> S{nwg, wg, tileL, lstL, (const char*)(ws + WS_WD), 1024};
        const pg8::EpiY8 E{ws + WS_Y, p.in[24], MOE_FP8 ? 1.f / WSCALE : 1.f};
        pg8::gemm_phase<pg8::EpiY8, pg8::MoeSched<4, false, MOE_FP8>, MOE_FP8>(lds, tid, (const char*)(ws + WS_ACT), D, S, E); });
    PHASE(PH_FINAL, ph_final(p, wg, nwg, fresh_tid(wv)););
#undef PHASE
#undef IN
#undef SEAM
}

extern "C" void kernel_launch(void* const* d_in, const int* in_sizes, int n_in, void* d_out, int out_size, void* d_ws, size_t ws_size, hipStream_t stream) {
    static int ok = 0;
    if (ok == 0) {
        if (n_in != 25 || in_sizes[0] != ML * D || out_size != ML * D || ws_size < WS_END) { fprintf(stderr, "kernel_launch: unexpected shapes (n_in %d, in0 %d, out %d, ws %zu < %zu)\n", n_in, n_in > 0 ? in_sizes[0] : -1, out_size, ws_size, (size_t)WS_END); ok = -1; return; }
        if (hipFuncSetAttribute((const void*)mega, hipFuncAttributeMaxDynamicSharedMemorySize, LDS_BYTES) != hipSuccess) { fprintf(stderr, "kernel_launch: hipFuncSetAttribute failed\n"); ok = -1; return; }
        int dev = 0, cus = 0, per_cu = 0;
        if (hipGetDevice(&dev) != hipSuccess || hipDeviceGetAttribute(&cus, hipDeviceAttributeMultiprocessorCount, dev) != hipSuccess) { fprintf(stderr, "kernel_launch: device query failed\n"); ok = -1; return; }
        if (hipOccupancyMaxActiveBlocksPerMultiprocessor(&per_cu, (const void*)mega, NTHR, LDS_BYTES) != hipSuccess || per_cu < 1) { fprintf(stderr, "kernel_launch: occupancy query says %d blocks per CU\n", per_cu); (void)hipGetLastError(); }
        if (cus != NWG) fprintf(stderr, "kernel_launch: %d CUs (built for %d)\n", cus, NWG);
        ok = cus < NWG ? cus : NWG;
    }
    if (ok < 0) return;
    const int grid = ok;
    (void)hipMemsetAsync((char*)d_ws + WS_CTL, 0, CTL_BYTES, stream);
    P p{}; for (int i = 0; i < 25; ++i) p.in[i] = (const float*)d_in[i]; p.out = (float*)d_out; p.ws = (unsigned char*)d_ws;
#define MEGA(a, b) do { p.ph_lo = (a); p.ph_hi = (b); hipLaunchKernelGGL(mega, dim3(grid), dim3(NTHR), LDS_BYTES, stream, p); } while (0)
#ifdef MULTI_LAUNCH
    for (int ph = 0; ph < NPH; ++ph) MEGA(ph, ph + 1);
#else
    MEGA(0, NPH);
#endif
#undef MEGA
    const hipError_t le = hipPeekAtLastError();
    if (le != hipSuccess) fprintf(stderr, "kernel_launch: launch failed: %s\n", hipGetErrorName(le));
}
```

```cpp
#include <hip/hip_runtime.h>
#include <cstdint>
#include <cstdio>

#define GAS __attribute__((address_space(1)))
#define LAS __attribute__((address_space(3)))
typedef unsigned short bf16_t;
typedef short bf16x8 __attribute__((ext_vector_type(8)));
typedef float f32x4 __attribute__((ext_vector_type(4)));
typedef float f32x16 __attribute__((ext_vector_type(16)));
typedef unsigned u32x4 __attribute__((ext_vector_type(4)));
typedef unsigned u32x2 __attribute__((ext_vector_type(2)));

constexpr int D = 1024, SEQ = 8192, CTXL = 256, NH = 6, DQK = 192, DNOPE = 128, DROPE = 64, DV = 128;
constexpr int QL = 384, KVL = 256;
constexpr int ML = 2 * SEQ, MC = 2 * CTXL, MA = ML + MC;
constexpr int TK = SEQ + CTXL;
constexpr int PXW = 1280;
constexpr int NE = 32, DFF = 1024;
constexpr int MAXTILES = 288, SLOTS = MAXTILES * 256;
constexpr float RMS_EPS = 1e-6f;
constexpr int NWG = 256, NTHR = 512;
#ifndef MOE_FP8_ON
#define MOE_FP8_ON 1
#endif
constexpr bool MOE_FP8 = MOE_FP8_ON;
constexpr float WSCALE = 32.f;

constexpr size_t KiB = 1024, MiB = 1024 * 1024;
constexpr size_t WS_CTL = 0, CTL_BYTES = 64 * KiB;
constexpr size_t WS_MOD = 1 * MiB;
constexpr size_t WS_ROPE = WS_MOD + 96 * KiB;
constexpr size_t WS_RSTAT = WS_ROPE + 16 * KiB;
constexpr size_t WS_TOPI = 1 * MiB + 256 * KiB;
constexpr size_t WS_GATE = WS_TOPI + 256 * KiB;
constexpr size_t WS_TOKSLOT = WS_GATE + 256 * KiB;
constexpr size_t WS_SLOTTOK = 2 * MiB;
constexpr size_t WS_CHCNT = WS_SLOTTOK + 320 * KiB;
constexpr size_t WS_TILEE = WS_CHCNT + 32 * KiB;
constexpr size_t WS_FTAB = WS_TILEE + 32 * KiB;
constexpr size_t WS_WRT = WS_FTAB + 64 * KiB;
constexpr size_t WS_GA = WS_WRT + 128 * KiB;
constexpr size_t WS_GB = WS_GA + 128 * KiB;
constexpr size_t WS_WIN = 4 * MiB;
constexpr size_t WS_WQ = 7 * MiB;
constexpr size_t WS_WKV = 8 * MiB;
constexpr size_t WS_WOUT = 9 * MiB;
constexpr size_t WS_WD = 16 * MiB;
constexpr size_t WS_WGU = 80 * MiB;
constexpr size_t WS_HX = 208 * MiB;
constexpr size_t WS_Y = 80 * MiB;
constexpr size_t WS_MIX = 242 * MiB;
constexpr size_t WS_ACT = 274 * MiB;
constexpr size_t WS_PX = 274 * MiB;
constexpr size_t WS_Q = 316 * MiB;
constexpr size_t WS_KN = 352 * MiB;
constexpr size_t WS_V = 377 * MiB;
constexpr size_t WS_KR = 402 * MiB;
constexpr size_t WS_FT = 405 * MiB;
constexpr size_t WS_MIXA = 421 * MiB;
constexpr size_t WS_OPART = 208 * MiB;
constexpr size_t WS_OML = 304 * MiB;
constexpr size_t WS_END = 453 * MiB;

constexpr int LDS_BYTES = 163840;
constexpr int LDS_CTL = 139264;

struct P { const float* in[25]; float* out; unsigned char* ws; int ph_lo, ph_hi; };

__device__ __forceinline__ unsigned f2bf(float f) { unsigned u = __float_as_uint(f); return (u + 0x7fffu + ((u >> 16) & 1u)) >> 16; }
__device__ __forceinline__ float bflo(unsigned w) { return __uint_as_float(w << 16); }
__device__ __forceinline__ float bfhi(unsigned w) { return __uint_as_float(w & 0xffff0000u); }
typedef __bf16 bf16x2c __attribute__((ext_vector_type(2)));
typedef float f32x2c __attribute__((ext_vector_type(2)));
__device__ __forceinline__ unsigned pk2(float lo, float hi) { const f32x2c v = {lo, hi}; return __builtin_bit_cast(unsigned, __builtin_convertvector(v, bf16x2c)); }
template <int CTRL, int RMASK, bool BC> __device__ __forceinline__ float dpp_mov(float v) { return __builtin_bit_cast(float, __builtin_amdgcn_update_dpp(0, __builtin_bit_cast(int, v), CTRL, RMASK, 0xf, BC)); }
__device__ __forceinline__ float wave_sum(float v) {
    v += dpp_mov<0x111, 0xf, true>(v); v += dpp_mov<0x112, 0xf, true>(v); v += dpp_mov<0x114, 0xf, true>(v); v += dpp_mov<0x118, 0xf, true>(v);
    v += dpp_mov<0x142, 0xa, false>(v); v += dpp_mov<0x143, 0xc, false>(v);
    return __builtin_bit_cast(float, __builtin_amdgcn_readlane(__builtin_bit_cast(int, v), 63));
}
__device__ __forceinline__ float wave_max(float v) {
#pragma unroll
    for (int o = 1; o < 64; o <<= 1) v = fmaxf(v, __shfl_xor(v, o));
    return v;
}
__device__ __forceinline__ int fresh_tid(int wv) { int t = (wv << 6) | (int)__builtin_amdgcn_mbcnt_hi(~0u, __builtin_amdgcn_mbcnt_lo(~0u, 0u)); asm volatile("" : "+v"(t)); return t; }
__device__ __forceinline__ unsigned pg8_pk4_fp8(f32x4 v) { int p = __builtin_amdgcn_cvt_pk_fp8_f32(v.x, v.y, 0, false); p = __builtin_amdgcn_cvt_pk_fp8_f32(v.z, v.w, p, true); return (unsigned)p; }
__device__ __forceinline__ f32x4 fp8x4(unsigned w) { const auto lo = __builtin_amdgcn_cvt_pk_f32_fp8((int)w, false), hi = __builtin_amdgcn_cvt_pk_f32_fp8((int)w, true); return (f32x4){lo[0], lo[1], hi[0], hi[1]}; }
__device__ __forceinline__ float dot4(f32x4 a, f32x4 b) { return (a.x * b.x + a.y * b.y) + (a.z * b.z + a.w * b.w); }

__device__ __forceinline__ void p0_mod_item(const P& p, int it, int tid, LAS float* scr) {
    LAS float* sl = scr;
    LAS float* part = scr + 3072;
    const float* c = p.in[1]; const float* cc = p.in[3]; const float* wm = p.in[4]; const float* bm = p.in[5];
    for (int i = tid; i < 3072; i += NTHR) { const int r = i >> 10, k = i & 1023; const float v = r < 2 ? c[r * 1024 + k] : cc[k]; sl[i] = v / (1.f + __expf(-v)); }
    __syncthreads();
    const int ks = tid >> 5, cidx = tid & 31, n0 = it * 24;
    if (cidx < 24) {
        float a0 = 0.f, a1 = 0.f, a2 = 0.f;
#pragma unroll 1
        for (int kq = 0; kq < 2; ++kq) { float wv[32];
#pragma unroll
            for (int k = 0; k < 32; ++k) wv[k] = __builtin_nontemporal_load(wm + (size_t)(ks * 64 + kq * 32 + k) * 6144 + n0 + cidx);
#pragma unroll
            for (int k = 0; k < 32; ++k) { const float w = wv[k]; const int kk = ks * 64 + kq * 32 + k; a0 += sl[kk] * w; a1 += sl[1024 + kk] * w; a2 += sl[2048 + kk] * w; } }
        part[(ks * 3 + 0) * 24 + cidx] = a0; part[(ks * 3 + 1) * 24 + cidx] = a1; part[(ks * 3 + 2) * 24 + cidx] = a2;
    }
    __syncthreads();
    if (tid < 72) { const int r = tid / 24, cx = tid % 24; float s = bm[n0 + cx];
        for (int k = 0; k < 16; ++k) s += part[(k * 3 + r) * 24 + cx];
        ((float*)(p.ws + WS_MOD))[r * 6144 + n0 + cx] = s; }
    __syncthreads();
}
__device__ __forceinline__ void p0_misc_item(const P& p, int r, int tid) {
    const double TWO_PI = 6.283185307179586476925;
    if (r == 0) {
        float* ct = (float*)(p.ws + WS_ROPE); float* st = ct + 2048;
        for (int i = tid; i < 2048; i += NTHR) { const int pos = i >> 4, j = i & 15; const double inv = pow(10000.0, -(2.0 * j) / 32.0); const double a = (double)pos * inv; ct[i] = (float)cos(a); st[i] = (float)sin(a); }
        const float* wr = p.in[17]; bf16_t* wrh = (bf16_t*)(p.ws + WS_WRT); bf16_t* wrl = wrh + 32768;
        for (int i = tid; i < 32768; i += NTHR) { const int k = i >> 5, e = i & 31; const float w = wr[i]; const unsigned hb = f2bf(w); wrh[e * 1024 + k] = (bf16_t)hb; wrl[e * 1024 + k] = (bf16_t)f2bf(w - __uint_as_float(hb << 16)); }
    } else if (r == 1) {
        for (int i = tid; i < 8192; i += NTHR) { const double a = TWO_PI * i / 8192.0; ((float2*)(p.ws + WS_FTAB))[i] = make_float2((float)cos(a), (float)sin(a)); }
    } else if (r < 6) {
        bf16_t* GA = (bf16_t*)(p.ws + WS_GA);
        for (int i = tid; i < 64 * 256; i += NTHR) { const int row = (r - 2) * 64 + (i >> 8), kk = i & 255, c = row >> 7, k1 = row & 127, n1 = kk & 127, isq = kk >> 7;
            const double a = TWO_PI * ((n1 * k1) & 127) / 128.0; const double cs = cos(a), sn = sin(a);
            const double v = c == 0 ? (isq ? -sn : cs) : (isq ? -cs : -sn); GA[row * 256 + kk] = (bf16_t)f2bf((float)v); }
    } else {
        bf16_t* GB = (bf16_t*)(p.ws + WS_GB);
        for (int i = tid; i < 64 * 128; i += NTHR) { const int k2 = i >> 7, kk = i & 127, n2 = kk >> 1, c = kk & 1; const double a = TWO_PI * ((k2 * n2) & 63) / 64.0;
            GB[i] = (bf16_t)f2bf((float)(c ? sin(a) : cos(a))); }
    }
}
template <class CM>
__device__ __forceinline__ void p0_xpose_item(const CM& cm, int ldn, const float* gain, int k0, bf16_t* dst, int Kd, int nd0, int tid, LAS float* scr) {
    f32x4 v[8];
#pragma unroll
    for (int i = 0; i < 8; ++i) { const int q = tid + NTHR * i, k = q >> 6, n = (q & 63) * 4; const float* sp = cm(nd0 + n);
        v[i] = sp ? *(const f32x4*)(sp + (size_t)(k0 + k) * ldn) : (f32x4){0.f, 0.f, 0.f, 0.f}; }
#pragma unroll
    for (int i = 0; i < 8; ++i) { const int q = tid + NTHR * i, k = q >> 6, n = (q & 63) * 4; const float g = gain ? gain[k0 + k] : 1.f;
        LAS float* d = scr + k * 257 + n; d[0] = v[i].x * g; d[1] = v[i].y * g; d[2] = v[i].z * g; d[3] = v[i].w * g; }
    __syncthreads();
#pragma unroll
    for (int i = 0; i < 4; ++i) { const int q = tid + NTHR * i, n = q >> 3, kc = q & 7; const LAS float* s = scr + (kc * 8) * 257 + n;
        u32x4 o; o.x = pk2(s[0], s[257]); o.y = pk2(s[2 * 257], s[3 * 257]); o.z = pk2(s[4 * 257], s[5 * 257]); o.w = pk2(s[6 * 257], s[7 * 257]);
        *(u32x4*)(dst + (size_t)(nd0 + n) * Kd + k0 + kc * 8) = o; }
    __syncthreads();
}
struct CmWin { const float* w; __device__ const float* operator()(int n) const { return n < 384 ? w + 256 + n : (n < 448 ? w + 896 + (n - 384) : (n < 512 ? nullptr : w + 640 + (n - 512))); } };
struct CmPlain { const float* w; int nmax; __device__ const float* operator()(int n) const { return n < nmax ? w + n : nullptr; } };
struct CmGU { const float* g; const float* u; int pn; __device__ const float* operator()(int n) const { const int j = n & 255; return j < 128 ? g + 128 * pn + j : u + 128 * pn + (j - 128); } };
__device__ __forceinline__ void p0_fold_item(const P& p, int g, int kb, int tid, LAS float* scr) {
    LAS float* Mg = scr;
    LAS float* wb = scr + 8192;
    LAS float* cs = scr + 8192 + 4160;
    const float* wf = p.in[15] + g * 4096; const float* win = p.in[10];
    if (tid < 64) { const double a = 6.283185307179586476925 * tid / 64.0; cs[tid] = (float)cos(a); cs[64 + tid] = (float)sin(a); }
    __syncthreads();
    const float sinv = 1.0f / 724.0773439350246f;
    for (int i = 0; i < 16; ++i) { const int e = tid + NTHR * i, c = e >> 7, jj = e & 127, j = jj & 63, isq = jj >> 6; float s = 0.f;
        for (int m = 0; m < 64; ++m) s += cs[isq * 64 + ((m * c) & 63)] * wf[m * 64 + j];
        Mg[c * 128 + jj] = s * sinv; }
    for (int i = 0; i < 8; ++i) { const int e = tid + NTHR * i, k = e >> 6, c = e & 63; wb[k * 65 + c] = win[(size_t)(kb * 64 + k) * 960 + g * 64 + c]; }
    __syncthreads();
    const int jj = tid >> 2, kq = tid & 3; float acc[16];
#pragma unroll
    for (int i = 0; i < 16; ++i) acc[i] = 0.f;
    for (int c = 0; c < 64; ++c) { const float mv = Mg[c * 128 + jj];
#pragma unroll
        for (int i = 0; i < 16; ++i) acc[i] += wb[(kq * 16 + i) * 65 + c] * mv; }
    bf16_t* dst = (bf16_t*)(p.ws + WS_WIN) + (size_t)(768 + g * 128 + jj) * 1024 + kb * 64 + kq * 16;
    u32x4 o0, o1; o0.x = pk2(acc[0], acc[1]); o0.y = pk2(acc[2], acc[3]); o0.z = pk2(acc[4], acc[5]); o0.w = pk2(acc[6], acc[7]);
    o1.x = pk2(acc[8], acc[9]); o1.y = pk2(acc[10], acc[11]); o1.z = pk2(acc[12], acc[13]); o1.w = pk2(acc[14], acc[15]);
    *(u32x4*)dst = o0; *(u32x4*)(dst + 8) = o1;
    __syncthreads();
}
constexpr int I_WGU = 32 * 8 * 2 * 8, I_WD = 32 * 8 * 8, NEI = I_WGU + I_WD;
constexpr int FILL_IN = 182 * 4, FILL_Q = 128 + 12 + 232 + 81, NEI_PREP = NEI - FILL_IN - FILL_Q;
__device__ __forceinline__ void p0_expert_items(const P& p, int first, int step, int end, int tid, LAS float* scr) {
        constexpr int XS = 129;
        f32x4 v[8];
#define P0_ISSUE(r_) do { const int r = (r_); const float* s0; int k0; \
            if (r < I_WGU) { const int e = r >> 7, t = (r >> 3) & 15, pn = t >> 1, hf = t & 1; k0 = (r & 7) * 128; s0 = (hf ? p.in[21] : p.in[19]) + (size_t)e * 1048576 + 128 * pn; } \
            else { const int q = r - I_WGU, e = q >> 6, nb = (q >> 3) & 7; k0 = (q & 7) * 128; s0 = p.in[23] + (size_t)e * 1048576 + nb * 128; } \
            _Pragma("unroll") for (int i = 0; i < 8; ++i) { const int q = tid + NTHR * i, k = q >> 5, n = (q & 31) * 4; v[i] = __builtin_nontemporal_load((const f32x4*)(s0 + (size_t)(k0 + k) * 1024 + n)); } } while (0)
        int it = first; LAS float* const scr0 = scr; int par = 0;
        if (it < end) P0_ISSUE(it);
        for (; it < end; it += step, par ^= 1) {
            scr = scr0 + par * (128 * XS);
#pragma unroll
            for (int i = 0; i < 8; ++i) { const int q = tid + NTHR * i, k = q >> 5, n = (q & 31) * 4; LAS float* d = scr + k * XS + ((n + 8 * (k >> 4)) & 127); d[0] = v[i].x; d[1] = v[i].y; d[2] = v[i].z; d[3] = v[i].w; }
            __syncthreads();
            if (it + step < end) P0_ISSUE(it + step);
            size_t drow; int k0;
            if (it < I_WGU) { const int e = it >> 7, t = (it >> 3) & 15, pn = t >> 1, hf = t & 1; k0 = (it & 7) * 128; drow = (size_t)e * 2048 + pn * 256 + hf * 128; }
            else { const int q = it - I_WGU, e = q >> 6, nb = (q >> 3) & 7; k0 = (q & 7) * 128; drow = (size_t)e * 1024 + nb * 128; }
            if constexpr (MOE_FP8) {
                unsigned char* dst = (unsigned char*)(p.ws + (it < I_WGU ? WS_WGU : WS_WD)) + drow * 1024 + k0;
#pragma unroll
                for (int i = 0; i < 2; ++i) { const int q = tid + NTHR * i, n = q >> 3, kc = q & 7; const LAS float* s = scr + (kc * 16) * XS + ((n + 8 * kc) & 127); u32x4 o;
                    o.x = pg8_pk4_fp8((f32x4){s[0], s[XS], s[2 * XS], s[3 * XS]} * WSCALE); o.y = pg8_pk4_fp8((f32x4){s[4 * XS], s[5 * XS], s[6 * XS], s[7 * XS]} * WSCALE);
                    o.z = pg8_pk4_fp8((f32x4){s[8 * XS], s[9 * XS], s[10 * XS], s[11 * XS]} * WSCALE); o.w = pg8_pk4_fp8((f32x4){s[12 * XS], s[13 * XS], s[14 * XS], s[15 * XS]} * WSCALE);
                    __builtin_nontemporal_store(o, (u32x4*)(dst + (size_t)n * 1024 + kc * 16)); }
            } else {
                bf16_t* dst = (bf16_t*)(p.ws + (it < I_WGU ? WS_WGU : WS_WD)) + drow * 1024 + k0;
#pragma unroll
                for (int i = 0; i < 4; ++i) { const int q = tid + NTHR * i, n = q >> 4, kc = q & 15; const LAS float* s = scr + (kc * 8) * XS + ((n + 8 * (kc >> 1)) & 127);
                    u32x4 o; o.x = pk2(s[0], s[XS]); o.y = pk2(s[2 * XS], s[3 * XS]); o.z = pk2(s[4 * XS], s[5 * XS]); o.w = pk2(s[6 * XS], s[7 * XS]);
                    *(u32x4*)(dst + (size_t)n * 1024 + kc * 8) = o; }
            }
        }
        __syncthreads();
#undef P0_ISSUE
}
__device__ __forceinline__ void ph_prologue(const P& p, int wg, int nwg, int tid, LAS unsigned char* lds) {
    LAS float* scr = (LAS float*)lds;
    constexpr int I_MOD = 256, I_MISC = 7, I_FOLD = 64, I_WIN = 3 * 16, I_WQ = 5 * 6, I_WKV = 6 * 4, I_WOUT = 4 * 16;
    constexpr int NIT = I_MOD + I_MISC + I_FOLD + I_WIN + I_WQ + I_WKV + I_WOUT;
    for (int it = wg; it < NIT; it += nwg) {
        int r = it;
        if (r < I_MOD) { p0_mod_item(p, r, tid, scr); continue; } r -= I_MOD;
        if (r < I_MISC) { p0_misc_item(p, r, tid); continue; } r -= I_MISC;
        if (r < I_FOLD) { p0_fold_item(p, r >> 4, r & 15, tid, scr); continue; } r -= I_FOLD;
        if (r < I_WIN) { CmWin cm{p.in[10]}; p0_xpose_item(cm, 960, nullptr, (r & 15) * 64, (bf16_t*)(p.ws + WS_WIN), 1024, (r >> 4) * 256, tid, scr); continue; } r -= I_WIN;
        if (r < I_WQ) { CmPlain cm{p.in[13], 1152}; p0_xpose_item(cm, 1152, p.in[11], (r % 6) * 64, (bf16_t*)(p.ws + WS_WQ), 384, (r / 6) * 256, tid, scr); continue; } r -= I_WQ;
        if (r < I_WKV) { CmPlain cm{p.in[14], 1536}; p0_xpose_item(cm, 1536, p.in[12], (r & 3) * 64, (bf16_t*)(p.ws + WS_WKV), 256, (r >> 2) * 256, tid, scr); continue; } r -= I_WKV;
        if (r < I_WOUT) { CmPlain cm{p.in[16], 1024}; p0_xpose_item(cm, 1024, nullptr, (r & 15) * 64, (bf16_t*)(p.ws + WS_WOUT), 1024, (r >> 4) * 256, tid, scr); continue; } r -= I_WOUT;
    }
    p0_expert_items(p, wg, nwg, nwg == NWG ? NEI_PREP : NEI, tid, scr);
}

template <int NR> __device__ __forceinline__ void modul_rows(const float* const (&rows)[NR], bf16_t* const (&outs)[NR], const f32x4 (&a)[4], const f32x4 (&sh)[4], int lane) {
    f32x4 v[NR][4];
#pragma unroll
    for (int r = 0; r < NR; ++r)
#pragma unroll
        for (int j = 0; j < 4; ++j) v[r][j] = __builtin_nontemporal_load((const f32x4*)(rows[r] + 4 * lane + 256 * j));
#pragma unroll
    for (int r = 0; r < NR; ++r) { float ss = 0.f;
#pragma unroll
        for (int j = 0; j < 4; ++j) ss += dot4(v[r][j], v[r][j]);
        const float rinv = rsqrtf(wave_sum(ss) * (1.f / D) + RMS_EPS);
#pragma unroll
        for (int j = 0; j < 4; ++j) { const f32x4 o = v[r][j] * rinv * a[j] + sh[j]; u32x2 w; w.x = pk2(o.x, o.y); w.y = pk2(o.z, o.w); *(u32x2*)(outs[r] + 4 * lane + 256 * j) = w; } }
}
__device__ __forceinline__ void ph_modulate(const P& p, int wg, int nwg, int tid) {
    const int lane = tid & 63, wave = tid >> 6;
    const float* x = p.in[0]; const float* ctx = p.in[2]; const float* gain = p.in[6];
    const float* MOD = (const float*)(p.ws + WS_MOD); bf16_t* HX = (bf16_t*)(p.ws + WS_HX);
    for (int ch = wg; ch < 256; ch += nwg) {
        f32x4 a[4], sh[4];
        { const int r = ch >> 7;
#pragma unroll
          for (int j = 0; j < 4; ++j) { const int c = 4 * lane + 256 * j; sh[j] = *(const f32x4*)(MOD + r * 6144 + c); a[j] = *(const f32x4*)(gain + c) * (*(const f32x4*)(MOD + r * 6144 + 1024 + c) + 1.f); } }
#pragma unroll
        for (int q = 0; q < 2; ++q) { const int m0 = ch * 64 + wave * 8 + q * 4;
            const float* const rows[4] = {x + (size_t)m0 * D, x + (size_t)(m0 + 1) * D, x + (size_t)(m0 + 2) * D, x + (size_t)(m0 + 3) * D};
            bf16_t* const outs[4] = {HX + (size_t)m0 * D, HX + (size_t)(m0 + 1) * D, HX + (size_t)(m0 + 2) * D, HX + (size_t)(m0 + 3) * D};
            modul_rows<4>(rows, outs, a, sh, lane); }
        if (wave == 7) {
#pragma unroll
            for (int j = 0; j < 4; ++j) { const int c = 4 * lane + 256 * j; sh[j] = *(const f32x4*)(MOD + 2 * 6144 + c); a[j] = *(const f32x4*)(gain + c) * (*(const f32x4*)(MOD + 2 * 6144 + 1024 + c) + 1.f); }
            const int c0 = ch * 2;
            const float* const rows[2] = {ctx + (size_t)c0 * D, ctx + (size_t)(c0 + 1) * D};
            bf16_t* const outs[2] = {HX + (size_t)(ML + c0) * D, HX + (size_t)(ML + c0 + 1) * D};
            modul_rows<2>(rows, outs, a, sh, lane); }
    }
}

template <int NR> __device__ __forceinline__ void row1_rows(const P& p, const int (&ms)[NR], int lane) {
    const bf16_t* PX = (const bf16_t*)(p.ws + WS_PX); float* RS = (float*)(p.ws + WS_RSTAT); bf16_t* KR = (bf16_t*)(p.ws + WS_KR);
    const float* ct = (const float*)(p.ws + WS_ROPE); const float* st = ct + 2048;
    u32x4 c0[NR], c1[NR];
#pragma unroll
    for (int r = 0; r < NR; ++r) { const bf16_t* pr = PX + (size_t)ms[r] * PXW; c0[r] = *(const u32x4*)(pr + 8 * lane); c1[r] = *(const u32x4*)(pr + 512 + 8 * (lane & 31)); }
#pragma unroll
    for (int r = 0; r < NR; ++r) { const int m = ms[r];
        float v[8]; v[0] = bflo(c0[r].x); v[1] = bfhi(c0[r].x); v[2] = bflo(c0[r].y); v[3] = bfhi(c0[r].y); v[4] = bflo(c0[r].z); v[5] = bfhi(c0[r].z); v[6] = bflo(c0[r].w); v[7] = bfhi(c0[r].w);
        float sq = 0.f; if (lane < 48) { for (int j = 0; j < 8; ++j) sq += v[j] * v[j]; }
        float skv = 0.f; if (lane < 32) { const float t0 = bflo(c1[r].x), t1 = bfhi(c1[r].x), t2 = bflo(c1[r].y), t3 = bfhi(c1[r].y), t4 = bflo(c1[r].z), t5 = bfhi(c1[r].z), t6 = bflo(c1[r].w), t7 = bfhi(c1[r].w);
            skv = (t0 * t0 + t1 * t1) + (t2 * t2 + t3 * t3) + (t4 * t4 + t5 * t5) + (t6 * t6 + t7 * t7); }
        const float rq = rsqrtf(wave_sum(sq) * (1.f / QL) + RMS_EPS), rkv = rsqrtf(wave_sum(skv) * (1.f / KVL) + RMS_EPS);
        if (lane == 0) { RS[2 * m] = rq; RS[2 * m + 1] = rkv; }
        if (lane >= 48 && lane < 56) {
            const int d0 = (lane - 48) * 8; int b, tt;
            if (m < ML) { b = m >> 13; tt = m & 8191; const int prow = tt >> 6, pcol = tt & 63;
#pragma unroll
                for (int q = 0; q < 4; ++q) { const int pi = (d0 >> 1) + q; const int pos = pi < 16 ? prow : pcol, j = pi & 15; const float c = ct[pos * 16 + j], s = st[pos * 16 + j];
                    const float e = v[2 * q], o = v[2 * q + 1]; v[2 * q] = e * c - o * s; v[2 * q + 1] = e * s + o * c; } }
            else { b = (m - ML) >> 8; tt = SEQ + ((m - ML) & 255); }
            u32x4 o; o.x = pk2(v[0], v[1]); o.y = pk2(v[2], v[3]); o.z = pk2(v[4], v[5]); o.w = pk2(v[6], v[7]);
            *(u32x4*)(KR + ((size_t)b * TK + tt) * DROPE + d0) = o;
        }
    }
}
__device__ __forceinline__ void ph_row1(const P& p, int wg, int nwg, int tid) {
    const int lane = tid & 63, wave = tid >> 6;
    for (int ch = wg; ch < 256; ch += nwg) {
        { const int m0 = ch * 64 + wave * 8; const int ms[8] = {m0, m0 + 1, m0 + 2, m0 + 3, m0 + 4, m0 + 5, m0 + 6, m0 + 7}; row1_rows<8>(p, ms, lane); }
        if (wave == 7) { const int ms[2] = {ML + ch * 2, ML + ch * 2 + 1}; row1_rows<2>(p, ms, lane); }
    }
}

__device__ __forceinline__ float half_max32(float v, int lane) {
    v = fmaxf(v, __builtin_bit_cast(float, __builtin_amdgcn_update_dpp(__builtin_bit_cast(int, v), __builtin_bit_cast(int, v), 0x111, 0xf, 0xf, false)));
    v = fmaxf(v, __builtin_bit_cast(float, __builtin_amdgcn_update_dpp(__builtin_bit_cast(int, v), __builtin_bit_cast(int, v), 0x112, 0xf, 0xf, false)));
    v = fmaxf(v, __builtin_bit_cast(float, __builtin_amdgcn_update_dpp(__builtin_bit_cast(int, v), __builtin_bit_cast(int, v), 0x114, 0xf, 0xf, false)));
    v = fmaxf(v, __builtin_bit_cast(float, __builtin_amdgcn_update_dpp(__builtin_bit_cast(int, v), __builtin_bit_cast(int, v), 0x118, 0xf, 0xf, false)));
    v = fmaxf(v, __builtin_bit_cast(float, __builtin_amdgcn_update_dpp(__builtin_bit_cast(int, v), __builtin_bit_cast(int, v), 0x142, 0xa, 0xf, false)));
    const float m0 = __builtin_bit_cast(float, __builtin_amdgcn_readlane(__builtin_bit_cast(int, v), 31)), m1 = __builtin_bit_cast(float, __builtin_amdgcn_readlane(__builtin_bit_cast(int, v), 63));
    return lane < 32 ? m0 : m1;
}
__device__ __forceinline__ void ph_row2(const P& p, int wg, int nwg, int tid, LAS unsigned char* lds) {
    const int lane = tid & 63, wave = tid >> 6;
    constexpr int HSTR = 2064;
    LAS unsigned char* Hhi = lds; LAS unsigned char* Hlo = lds + 32 * HSTR;
    LAS float* PL = (LAS float*)(lds + LDS_CTL + 4096);
    LAS int* hist = (LAS int*)(lds + LDS_CTL + 1024);
    const bf16_t* WRH = (const bf16_t*)(p.ws + WS_WRT); const bf16_t* WRL = WRH + 32768;
    const float* x = p.in[0]; const float* MOD = (const float*)(p.ws + WS_MOD); const float* npost = p.in[7]; const float* npre = p.in[8]; const float* br = p.in[18];
    const bf16_t* MIX = (const bf16_t*)(p.ws + WS_MIX); bf16_t* HX2 = (bf16_t*)(p.ws + WS_HX);
    int* TOPI = (int*)(p.ws + WS_TOPI); float* GATE = (float*)(p.ws + WS_GATE); int* CHCNT = (int*)(p.ws + WS_CHCNT);
    for (int ch = wg; ch < 256; ch += nwg) {
        if (tid < 32) hist[tid] = 0;
        const int b = (ch * 64) >> 13;
        f32x4 a1[4], a2[4], s2[4];
#pragma unroll
        for (int j = 0; j < 4; ++j) { const int c = 4 * lane + 256 * j;
            a1[j] = *(const f32x4*)(npost + c) * *(const f32x4*)(MOD + b * 6144 + 2048 + c);
            a2[j] = *(const f32x4*)(npre + c) * (*(const f32x4*)(MOD + b * 6144 + 4096 + c) + 1.f);
            s2[j] = *(const f32x4*)(MOD + b * 6144 + 3072 + c); }
        for (int batch = 0; batch < 2; ++batch) {
            u32x2 mw[4][4]; f32x4 xv[4][4];
#pragma unroll
            for (int i = 0; i < 4; ++i) { const int m = ch * 64 + batch * 32 + wave * 4 + i;
#pragma unroll
                for (int j = 0; j < 4; ++j) { mw[i][j] = *(const u32x2*)(MIX + (size_t)m * D + 4 * lane + 256 * j); xv[i][j] = __builtin_nontemporal_load((const f32x4*)(x + (size_t)m * D + 4 * lane + 256 * j)); } }
            const int fr = lane & 15, fq = lane >> 4, rb = (wave & 1) * 16, kq = wave >> 1;
            const bf16_t* bh = WRH + fr * 1024 + kq * 256 + fq * 8; const bf16_t* bl = WRL + fr * 1024 + kq * 256 + fq * 8;
#pragma unroll
            for (int i = 0; i < 4; ++i) {
                const int rl = wave * 4 + i, m = ch * 64 + batch * 32 + rl;
                f32x4 mx[4], h[4]; float ss = 0.f;
#pragma unroll
                for (int j = 0; j < 4; ++j) { const u32x2 w = mw[i][j]; mx[j] = (f32x4){bflo(w.x), bfhi(w.x), bflo(w.y), bfhi(w.y)}; ss += dot4(mx[j], mx[j]); }
                const float r1 = rsqrtf(wave_sum(ss) * (1.f / D) + RMS_EPS); float s2s = 0.f;
#pragma unroll
                for (int j = 0; j < 4; ++j) { h[j] = xv[i][j] + a1[j] * (mx[j] * r1); s2s += dot4(h[j], h[j]); }
                const float r2 = rsqrtf(wave_sum(s2s) * (1.f / D) + RMS_EPS);
#pragma unroll
                for (int j = 0; j < 4; ++j) { h[j] = h[j] * r2 * a2[j] + s2[j];
                    const unsigned h0 = f2bf(h[j].x), h1 = f2bf(h[j].y), h2 = f2bf(h[j].z), h3 = f2bf(h[j].w);
                    u32x2 wh; wh.x = h0 | (h1 << 16); wh.y = h2 | (h3 << 16);
                    u32x2 wl; wl.x = pk2(h[j].x - __uint_as_float(h0 << 16), h[j].y - __uint_as_float(h1 << 16)); wl.y = pk2(h[j].z - __uint_as_float(h2 << 16), h[j].w - __uint_as_float(h3 << 16));
                    if constexpr (MOE_FP8) *(unsigned*)((unsigned char*)HX2 + (size_t)m * D + 4 * lane + 256 * j) = pg8_pk4_fp8(h[j]);
                    else *(u32x2*)(HX2 + (size_t)m * D + 4 * lane + 256 * j) = wh;
                    *(LAS u32x2*)(Hhi + rl * HSTR + (4 * lane + 256 * j) * 2) = wh; *(LAS u32x2*)(Hlo + rl * HSTR + (4 * lane + 256 * j) * 2) = wl; }
            }
            bf16x8 Bh0[8], Bl0[8];
#pragma unroll
            for (int ks = 0; ks < 8; ++ks) { Bh0[ks] = *(const bf16x8*)(bh + ks * 32); Bl0[ks] = *(const bf16x8*)(bl + ks * 32); }
            __syncthreads();
            { f32x4 acc0 = {0.f, 0.f, 0.f, 0.f}, acc1 = {0.f, 0.f, 0.f, 0.f};
              bf16x8 Bh1[8], Bl1[8];
#pragma unroll
              for (int ks = 0; ks < 8; ++ks) { Bh1[ks] = *(const bf16x8*)(bh + 16 * 1024 + ks * 32); Bl1[ks] = *(const bf16x8*)(bl + 16 * 1024 + ks * 32); }
              const LAS unsigned char* ah = Hhi + (rb + fr) * HSTR + kq * 512 + fq * 16; const LAS unsigned char* al = Hlo + (rb + fr) * HSTR + kq * 512 + fq * 16;
#pragma unroll
              for (int ks = 0; ks < 8; ++ks) {
                  const bf16x8 Ah = *(const LAS bf16x8*)(ah + ks * 64), Al = *(const LAS bf16x8*)(al + ks * 64);
                  acc0 = __builtin_amdgcn_mfma_f32_16x16x32_bf16(Ah, Bh0[ks], acc0, 0, 0, 0); acc0 = __builtin_amdgcn_mfma_f32_16x16x32_bf16(Ah, Bl0[ks], acc0, 0, 0, 0); acc0 = __builtin_amdgcn_mfma_f32_16x16x32_bf16(Al, Bh0[ks], acc0, 0, 0, 0); }
#pragma unroll
              for (int ks = 0; ks < 8; ++ks) {
                  const bf16x8 Ah = *(const LAS bf16x8*)(ah + ks * 64), Al = *(const LAS bf16x8*)(al + ks * 64);
                  acc1 = __builtin_amdgcn_mfma_f32_16x16x32_bf16(Ah, Bh1[ks], acc1, 0, 0, 0); acc1 = __builtin_amdgcn_mfma_f32_16x16x32_bf16(Ah, Bl1[ks], acc1, 0, 0, 0); acc1 = __builtin_amdgcn_mfma_f32_16x16x32_bf16(Al, Bh1[ks], acc1, 0, 0, 0); }
#pragma unroll
              for (int r = 0; r < 4; ++r) { PL[(kq * 32 + rb + fq * 4 + r) * 32 + fr] = acc0[r]; PL[(kq * 32 + rb + fq * 4 + r) * 32 + 16 + fr] = acc1[r]; } }
            __syncthreads();
#pragma unroll
            for (int ps = 0; ps < 2; ++ps) {
                const int rl = wave * 4 + ps * 2 + (lane >> 5), e = lane & 31, m = ch * 64 + batch * 32 + rl;
                float v = ((PL[rl * 32 + e] + PL[(32 + rl) * 32 + e]) + (PL[(64 + rl) * 32 + e] + PL[(96 + rl) * 32 + e])) + br[e];
                int ti[4]; float tv[4];
#pragma unroll
                for (int k = 0; k < 4; ++k) { const float mx = half_max32(v, lane); const unsigned long long bal = __ballot(v == mx);
                    const unsigned hm = lane < 32 ? (unsigned)bal : (unsigned)(bal >> 32); const int idx = __ffs((int)hm) - 1;
                    ti[k] = idx; tv[k] = mx; if (e == idx) v = -3.0e38f; }
                const float e1 = __expf(tv[1] - tv[0]), e2 = __expf(tv[2] - tv[0]), e3 = __expf(tv[3] - tv[0]), inv = 1.f / (1.f + e1 + e2 + e3);
                if (e == 0) { *(int4*)(TOPI + 4 * m) = make_int4(ti[0], ti[1], ti[2], ti[3]); *(f32x4*)(GATE + 4 * m) = (f32x4){inv, e1 * inv, e2 * inv, e3 * inv};
                    atomicAdd((int*)&hist[ti[0]], 1); atomicAdd((int*)&hist[ti[1]], 1); atomicAdd((int*)&hist[ti[2]], 1); atomicAdd((int*)&hist[ti[3]], 1); }
            }
            __syncthreads();
        }
        if (tid < 32) CHCNT[ch * 32 + tid] = hist[tid];
        __syncthreads();
    }
}

__device__ __forceinline__ void ph_lists(const P& p, int wg, int nwg, int tid, LAS unsigned char* lds) {
    LAS int* ct = (LAS int*)lds;
    LAS int* part = ct + 8192;
    LAS int* tot = part + 512; LAS int* base = tot + 32; LAS int* off = base + 64; LAS int* tp = off + 32;
    const int* CHCNT = (const int*)(p.ws + WS_CHCNT); const int* TOPI = (const int*)(p.ws + WS_TOPI);
    int* TOKSLOT = (int*)(p.ws + WS_TOKSLOT); int* SLOTTOK = (int*)(p.ws + WS_SLOTTOK); int* TILEE = (int*)(p.ws + WS_TILEE);
    for (int i = tid; i < 8192; i += NTHR) ct[i] = CHCNT[i];
    __syncthreads();
    { const int e = tid & 31, pt = tid >> 5; int s = 0; for (int c = pt * 16; c < pt * 16 + 16; ++c) s += ct[c * 32 + e]; part[pt * 32 + e] = s; }
    __syncthreads();
    if (tid < 32) { int s = 0; for (int k = 0; k < 16; ++k) s += part[k * 32 + tid]; tot[tid] = s; }
    __syncthreads();
    if (tid == 0) { int run = 0; for (int e = 0; e < 32; ++e) { base[e] = run; run += ((tot[e] + 255) >> 8) << 8; } base[32] = run; }
    __syncthreads();
    for (int ch = wg; ch < 256; ch += nwg) {
        { const int e = tid & 31, pt = tid >> 5; int s = 0; for (int c = pt * 16; c < pt * 16 + 16 && c < ch; ++c) s += ct[c * 32 + e]; part[pt * 32 + e] = s; }
        if (tid < 256) tp[tid] = TOPI[ch * 256 + tid];
        __syncthreads();
        if (tid < 32) { int s = base[tid]; for (int k = 0; k < 16; ++k) s += part[k * 32 + tid]; off[tid] = s; }
        __syncthreads();
        if (tid < 256) { const int e = tp[tid]; int rank = 0; for (int q = 0; q < tid; ++q) rank += (tp[q] == e) ? 1 : 0;
            const int s = off[e] + rank; TOKSLOT[ch * 256 + tid] = s; SLOTTOK[s] = ch * 64 + (tid >> 2); }
        __syncthreads();
    }
    if (wg == 0) {
        if (tid < 32) { const int e = tid; for (int s = base[e] + tot[e]; s < base[e] + (((tot[e] + 255) >> 8) << 8); ++s) SLOTTOK[s] = 0;
            for (int t = base[e] >> 8; t < (base[e] >> 8) + ((tot[e] + 255) >> 8); ++t) TILEE[t] = e; }
        const int nt = base[32] >> 8;
        for (int t = nt + tid; t < MAXTILES; t += NTHR) TILEE[t] = -1;
        if (tid == 0) TILEE[400] = nt;
    }
}

__device__ __forceinline__ void ph_final(const P& p, int wg, int nwg, int tid) {
    const int lane = tid & 63, wave = tid >> 6;
    const float* x = p.in[0]; const float* MOD = (const float*)(p.ws + WS_MOD); const float* npost = p.in[7]; const float* nfpost = p.in[9];
    const bf16_t* MIX = (const bf16_t*)(p.ws + WS_MIX); const unsigned char* Y = (const unsigned char*)(p.ws + WS_Y);
    const int* TOKSLOT = (const int*)(p.ws + WS_TOKSLOT); const float* GATE = (const float*)(p.ws + WS_GATE);
    for (int ch = wg; ch < 256; ch += nwg) {
        const int b = (ch * 64) >> 13;
        f32x4 a1[4], a3[4];
#pragma unroll
        for (int j = 0; j < 4; ++j) { const int c = 4 * lane + 256 * j;
            a1[j] = *(const f32x4*)(npost + c) * *(const f32x4*)(MOD + b * 6144 + 2048 + c);
            a3[j] = *(const f32x4*)(nfpost + c) * *(const f32x4*)(MOD + b * 6144 + 5120 + c); }
        int4 sln[2]; f32x4 gtn[2];
#pragma unroll
        for (int q = 0; q < 2; ++q) { const int m = ch * 64 + wave * 8 + q; sln[q] = *(const int4*)(TOKSLOT + 4 * m); gtn[q] = *(const f32x4*)(GATE + 4 * m); }
#pragma unroll 1
        for (int i2 = 0; i2 < 8; i2 += 2) {
            const int4 sl[2] = {sln[0], sln[1]}; const f32x4 gt[2] = {gtn[0], gtn[1]};
            u32x2 mw[2][4]; unsigned yw[2][4][4]; f32x4 xv[2][4];
#pragma unroll
            for (int q = 0; q < 2; ++q) { const int m = ch * 64 + wave * 8 + i2 + q;
#pragma unroll
                for (int j = 0; j < 4; ++j) { const int c = 4 * lane + 256 * j;
                    mw[q][j] = __builtin_nontemporal_load((const u32x2*)(MIX + (size_t)m * D + c)); xv[q][j] = __builtin_nontemporal_load((const f32x4*)(x + (size_t)m * D + c));
                    yw[q][j][0] = __builtin_nontemporal_load((const unsigned*)(Y + (size_t)sl[q].x * D + c)); yw[q][j][1] = __builtin_nontemporal_load((const unsigned*)(Y + (size_t)sl[q].y * D + c));
                    yw[q][j][2] = __builtin_nontemporal_load((const unsigned*)(Y + (size_t)sl[q].z * D + c)); yw[q][j][3] = __builtin_nontemporal_load((const unsigned*)(Y + (size_t)sl[q].w * D + c)); } }
            if (i2 + 2 < 8) {
#pragma unroll
                for (int q = 0; q < 2; ++q) { const int m = ch * 64 + wave * 8 + i2 + 2 + q; sln[q] = *(const int4*)(TOKSLOT + 4 * m); gtn[q] = *(const f32x4*)(GATE + 4 * m); } }
#pragma unroll
            for (int q = 0; q < 2; ++q) { const int m = ch * 64 + wave * 8 + i2 + q; const f32x4 g = gt[q];
                f32x4 mx[4], y[4]; float ss = 0.f, sy = 0.f;
#pragma unroll
                for (int j = 0; j < 4; ++j) { const u32x2 w = mw[q][j]; mx[j] = (f32x4){bflo(w.x), bfhi(w.x), bflo(w.y), bfhi(w.y)}; ss += dot4(mx[j], mx[j]);
                    f32x4 t = fp8x4(yw[q][j][0]) * g.x; t += fp8x4(yw[q][j][1]) * g.y; t += fp8x4(yw[q][j][2]) * g.z; t += fp8x4(yw[q][j][3]) * g.w;
                    y[j] = t; sy += dot4(t, t); }
                const float r1 = rsqrtf(wave_sum(ss) * (1.f / D) + RMS_EPS), r3 = rsqrtf(wave_sum(sy) * (1.f / D) + RMS_EPS);
#pragma unroll
                for (int j = 0; j < 4; ++j) { const int c = 4 * lane + 256 * j;
                    const f32x4 x1 = xv[q][j] + a1[j] * (mx[j] * r1); __builtin_nontemporal_store(x1 + a3[j] * (y[j] * r3), (f32x4*)(p.out + (size_t)m * D + c)); } }
        }
    }
}

typedef float f32x2a __attribute__((ext_vector_type(2)));
__device__ __forceinline__ f32x4 act4p(f32x4 g, f32x4 u1) {
    f32x4 r;
#pragma unroll
    for (int i = 0; i < 4; i += 2) {
        const f32x2a gg = {fminf(g[i], 7.f), fminf(g[i + 1], 7.f)}; f32x2a e = gg * (f32x2a){-2.4554669595930156f, -2.4554669595930156f};
        e[0] = __builtin_amdgcn_exp2f(e[0]); e[1] = __builtin_amdgcn_exp2f(e[1]); e += (f32x2a){1.f, 1.f};
        const f32x2a rc = {__builtin_amdgcn_rcpf(e[0]), __builtin_amdgcn_rcpf(e[1])}, uu = {__builtin_amdgcn_fmed3f(u1[i], -6.f, 8.f), __builtin_amdgcn_fmed3f(u1[i + 1], -6.f, 8.f)};
        const f32x2a o = gg * rc * uu; r[i] = o[0]; r[i + 1] = o[1]; }
    return r;
}
__device__ __forceinline__ f32x4 act4(f32x4 g, f32x4 u) {
    f32x4 r;
#pragma unroll
    for (int i = 0; i < 4; ++i) { const float gg = fminf(g[i], 7.f), uu = fminf(fmaxf(u[i], -7.f), 7.f); r[i] = gg * __builtin_amdgcn_rcpf(1.f + __builtin_amdgcn_exp2f(-2.4554669595930156f * gg)) * (uu + 1.f); }
    return r;
}

namespace pg8 {
constexpr int BM = 256, BK = 64, HALF = 128, HTB = HALF * BK * 2, STAGE_BYTES = 8 * HTB, NXCD = 8, WGM = 8;
__device__ __forceinline__ int lds_byte(int r, int c) { const int st = (r >> 4) * 2 + (c >> 5), rr = r & 15, cc = c & 31, ob = rr * 64 + cc * 2; return st * 1024 + (ob ^ (((ob >> 9) & 1) << 5)); }
__device__ __forceinline__ void stage_rc(int b, int& R, int& C) { const int st = b / 1024, sb = b % 1024, swz = sb ^ (((sb >> 9) & 1) << 5); R = (st >> 1) * 16 + swz / 64; C = (st & 1) * 32 + (swz % 64) / 2; }
__device__ __forceinline__ int perm32(int rho) { const int n = rho >> 4, i = rho & 15; return 8 * (i >> 2) + 4 * n + (i & 3); }
struct GUnit { const char* B; int pm, pn, e, arow, li; };
typedef int i32x4v __attribute__((ext_vector_type(4)));
typedef int i32x8v __attribute__((ext_vector_type(8)));
template <class Epi, class Sched, bool FP8 = false>
__device__ __forceinline__ void gemm_phase(LAS unsigned char* lds, const int tid, const char* Abase, const int K, const Sched& S, const Epi& E) {
    const int wid = __builtin_amdgcn_readfirstlane(tid >> 6), lane = tid & 63, wr = wid >> 2, wc = wid & 3, fr = lane & 15, fq = lane >> 4;
    const int Kb = FP8 ? K : K * 2, nt = Kb / (BK * 2);
    unsigned voffB[2];
#pragma unroll
    for (int i = 0; i < 2; ++i) { int R, C; stage_rc(tid * 16 + i * 8192, R, C); const int Rb = (R & ~31) + perm32(R & 31); voffB[i] = (unsigned)(Rb * Kb + C * 2); }
    const size_t kstep = (size_t)(BK * 2);
    const size_t hstep = (size_t)HALF * Kb;
    const unsigned ldsw = (unsigned)wid * 1024u;
    constexpr int FC = FP8 ? 16 : 8, PSTR = FP8 ? 16 : 1024;
    const int aoff = lds_byte(wr * 64 + fr, fq * FC), boff = lds_byte(wc * 32 + fr, fq * FC);
#define PG8_SA(b, h) (((b) * 2 + (h)) * HTB)
#define PG8_SB(b, h) ((4 + (b) * 2 + (h)) * HTB)
#define PG8_STAGE_B(bufoff, gbase) do { _Pragma("unroll") for (int _i = 0; _i < 2; ++_i) \
        __builtin_amdgcn_global_load_lds((const unsigned*)((const char*)(gbase) + voffB[_i]), (LAS unsigned*)(lds + (bufoff) + ldsw + _i * 8192), 16, 0, 0); } while (0)
#define PG8_STAGE_A(bufoff, vo, koff) do { _Pragma("unroll") for (int _i = 0; _i < 2; ++_i) \
        __builtin_amdgcn_global_load_lds((const unsigned*)(Abase + (size_t)(vo)[_i] + (koff)), (LAS unsigned*)(lds + (bufoff) + ldsw + _i * 8192), 16, 0, 0); } while (0)
#define PG8_LDA(dst, b, h) do { _Pragma("unroll") for (int m = 0; m < 4; ++m) _Pragma("unroll") for (int k = 0; k < 2; ++k) dst[m][k] = *(const LAS bf16x8*)(lds + PG8_SA(b, h) + aoff + m * 2048 + k * PSTR); } while (0)
#define PG8_LDB(dst, b, h) do { _Pragma("unroll") for (int n = 0; n < 2; ++n) _Pragma("unroll") for (int k = 0; k < 2; ++k) dst[n][k] = *(const LAS bf16x8*)(lds + PG8_SB(b, h) + boff + n * 2048 + k * PSTR); } while (0)
#define PG8_CAT(x) __builtin_shufflevector(__builtin_bit_cast(i32x4v, (x)[0]), __builtin_bit_cast(i32x4v, (x)[1]), 0, 1, 2, 3, 4, 5, 6, 7)
#define PG8_MMA(ai, bj, At, Bt) do { __builtin_amdgcn_s_setprio(1); \
        if constexpr (FP8) { _Pragma("unroll") for (int m = 0; m < 4; ++m) _Pragma("unroll") for (int n = 0; n < 2; ++n) \
            acc[ai][bj][m][n] = __builtin_amdgcn_mfma_scale_f32_16x16x128_f8f6f4(PG8_CAT(Bt[n]), PG8_CAT(At[m]), acc[ai][bj][m][n], 0, 0, 0, 0x7F7F7F7F, 0, 0x7F7F7F7F); \
            _Pragma("unroll") for (int m = 0; m < 4; ++m) _Pragma("unroll") for (int n = 0; n < 2; ++n) asm volatile("" : "+v"(acc[ai][bj][m][n])); }   \
        else { _Pragma("unroll") for (int m = 0; m < 4; ++m) _Pragma("unroll") for (int n = 0; n < 2; ++n) _Pragma("unroll") for (int k = 0; k < 2; ++k) \
            acc[ai][bj][m][n] = __builtin_amdgcn_mfma_f32_16x16x32_bf16(Bt[n][k], At[m][k], acc[ai][bj][m][n], 0, 0, 0); } \
        __builtin_amdgcn_s_setprio(0); } while (0)
#define PG8_WAIT_V(n) asm volatile("s_waitcnt vmcnt(" #n ")" ::: "memory")
#define PG8_WAIT_L(n) asm volatile("s_waitcnt lgkmcnt(" #n ")" ::: "memory")
#define PG8_BAR __builtin_amdgcn_s_barrier()
#define PG8_SCHED __builtin_amdgcn_sched_barrier(0)
    GUnit cur, nxt; int ui = 0;
    if (!S.next(0, cur)) return;
    f32x4 acc[2][2][4][2];
#pragma unroll
    for (int a = 0; a < 2; ++a)
#pragma unroll
        for (int b = 0; b < 2; ++b)
#pragma unroll
            for (int m = 0; m < 4; ++m)
#pragma unroll
                for (int n = 0; n < 2; ++n) acc[a][b][m][n] = (f32x4){0.f, 0.f, 0.f, 0.f};
    bf16x8 At[4][2], B0[2][2], B1[2][2];
    unsigned cvo[2][2];
    S.aoffs(cur, tid, cvo);
    const char* cB = cur.B;
    PG8_STAGE_B(PG8_SB(0, 0), cB); PG8_STAGE_B(PG8_SB(0, 1), cB + hstep); PG8_STAGE_A(PG8_SA(0, 0), cvo[0], 0); PG8_STAGE_A(PG8_SA(0, 1), cvo[1], 0);
    if (wr == 1) PG8_BAR;
    PG8_WAIT_V(2); PG8_BAR;
    PG8_STAGE_B(PG8_SB(1, 0), cB + kstep); PG8_STAGE_A(PG8_SA(1, 0), cvo[0], kstep); PG8_STAGE_B(PG8_SB(1, 1), cB + hstep + kstep);
    PG8_WAIT_V(6); PG8_BAR;
    for (;;) {
        const bool has_next = S.next(ui + 1, nxt);
        const char* nB = has_next ? nxt.B : cB;
#pragma nounroll
        for (int t = 0; t < nt; t += 2) {
            const bool last = (t == nt - 2);
            const size_t k1 = (size_t)(t + 1) * kstep, k2 = last ? 0 : (size_t)(t + 2) * kstep, k3 = k2 + kstep;
            const char* b2 = last ? nB : cB + (size_t)(t + 2) * kstep; const char* b3 = b2 + kstep;
            PG8_LDB(B0, 0, 0); PG8_LDB(B1, 0, 1); PG8_SCHED; PG8_LDA(At, 0, 0); PG8_STAGE_A(PG8_SA(1, 1), cvo[1], k1);
            PG8_WAIT_V(8); PG8_WAIT_L(0); PG8_BAR; PG8_MMA(0, 0, At, B0); PG8_MMA(0, 1, At, B1); PG8_BAR; PG8_SCHED;
            if (last && has_next) S.aoffs(nxt, tid, cvo);
            PG8_LDA(At, 0, 1); PG8_STAGE_B(PG8_SB(0, 0), b2); PG8_STAGE_B(PG8_SB(0, 1), b2 + hstep); PG8_STAGE_A(PG8_SA(0, 0), cvo[0], k2);
            PG8_WAIT_V(8); PG8_WAIT_L(0); PG8_BAR; PG8_MMA(1, 0, At, B0); PG8_MMA(1, 1, At, B1); PG8_BAR; PG8_SCHED;
            PG8_LDB(B0, 1, 0); PG8_LDB(B1, 1, 1); PG8_SCHED; PG8_LDA(At, 1, 0); PG8_STAGE_A(PG8_SA(0, 1), cvo[1], k2);
            PG8_WAIT_V(8); PG8_WAIT_L(0); PG8_BAR; PG8_MMA(0, 0, At, B0); PG8_MMA(0, 1, At, B1); PG8_BAR; PG8_SCHED;
            PG8_LDA(At, 1, 1); PG8_STAGE_B(PG8_SB(1, 0), b3); PG8_STAGE_B(PG8_SB(1, 1), b3 + hstep); PG8_STAGE_A(PG8_SA(1, 0), cvo[0], k3);
            PG8_WAIT_V(8); PG8_WAIT_L(0); PG8_BAR; PG8_MMA(1, 0, At, B0); PG8_MMA(1, 1, At, B1); PG8_BAR; PG8_SCHED;
        }
        if (wr == 0) PG8_BAR;
        E(acc, cur, wr, wc, fr, fq);
        if (!has_next) break;
#pragma unroll
        for (int a = 0; a < 2; ++a)
#pragma unroll
            for (int b = 0; b < 2; ++b)
#pragma unroll
                for (int m = 0; m < 4; ++m)
#pragma unroll
                    for (int n = 0; n < 2; ++n) acc[a][b][m][n] = (f32x4){0.f, 0.f, 0.f, 0.f};
        cur = nxt; cB = nB; ++ui;
        if (wr == 1) PG8_BAR;
    }
    PG8_WAIT_V(0);
    PG8_BAR;
#undef PG8_SA
#undef PG8_SB
#undef PG8_STAGE_A
#undef PG8_STAGE_B
#undef PG8_LDA
#undef PG8_LDB
#undef PG8_MMA
#undef PG8_CAT
#undef PG8_WAIT_V
#undef PG8_WAIT_L
#undef PG8_BAR
#undef PG8_SCHED
}
struct DenseSched {
    int nM, nN, G, c, K, lda, acol0; const char* Bt;
    __device__ __forceinline__ bool next(int i, GUnit& u) const {
        const int nwg = nM * nN; const long L = (long)i * G + c; if (L >= nwg) return false;
        int wgid = (int)L; { const int q = nwg / NXCD, r = nwg % NXCD, xcd = wgid % NXCD, off = wgid / NXCD; wgid = (xcd < r ? xcd * (q + 1) : r * (q + 1) + (xcd - r) * q) + off; }
        const int nig = WGM * nN, gid = wgid / nig, fm = gid * WGM, gsz = (nM - fm) < WGM ? (nM - fm) : WGM;
        u.pm = fm + ((wgid % nig) % gsz); u.pn = (wgid % nig) / gsz; u.e = 0; u.arow = u.pm * BM; u.li = i; u.B = Bt + (size_t)u.pn * BM * K * 2; return true;
    }
    __device__ __forceinline__ void aoffs(const GUnit& u, int tid, unsigned (&vo)[2][2]) const {
#pragma unroll
        for (int i = 0; i < 2; ++i) { int R, C; stage_rc(tid * 16 + i * 8192, R, C);
#pragma unroll
            for (int h = 0; h < 2; ++h) vo[h][i] = (unsigned)((u.arow + R + 128 * h) * lda + acol0 + C) * 2u; }
    }
};
template <int NT, bool GATHER, bool FP8 = false> struct MoeSched {
    int G, c; const LAS int* tile; const LAS unsigned* lst; const char* W; int wrows;
    __device__ __forceinline__ bool next(int i, GUnit& u) const {
        constexpr int RPG = 32 / NT; const int L = i * G + c, x = L & 7, j = L >> 3, grp = j >> 5, jj = j & 31;
        const int rt = (grp * 8 + x) * RPG + (jj % RPG), pn = jj / RPG; if (rt >= tile[300]) return false;
        const int e = tile[rt]; u.pm = rt; u.pn = pn; u.e = e; u.arow = rt * BM; u.li = i; u.B = W + ((size_t)e * wrows + pn * BM) * (FP8 ? 1024 : 2048); return true;
    }
    __device__ __forceinline__ void aoffs(const GUnit& u, int tid, unsigned (&vo)[2][2]) const {
#pragma unroll
        for (int i = 0; i < 2; ++i) { int R, C; stage_rc(tid * 16 + i * 8192, R, C);
#pragma unroll
            for (int h = 0; h < 2; ++h) vo[h][i] = GATHER ? lst[u.li * 256 + R + 128 * h] + (unsigned)C * 2u : (unsigned)((u.arow + R + 128 * h) * (FP8 ? 1024 : 2048) + C * 2); }
    }
};
__device__ __forceinline__ u32x4 pack8(f32x4 a, f32x4 b) { u32x4 w; w.x = pk2(a.x, a.y); w.y = pk2(a.z, a.w); w.z = pk2(b.x, b.y); w.w = pk2(b.z, b.w); return w; }
#define PG8_EPI_LOOP _Pragma("unroll") for (int ai = 0; ai < 2; ++ai) _Pragma("unroll") for (int m = 0; m < 4; ++m)
struct EpiRowMajor { bf16_t* O; int ldo;
    __device__ __forceinline__ void operator()(const f32x4 (&acc)[2][2][4][2], const GUnit& u, int wr, int wc, int fr, int fq) const {
        PG8_EPI_LOOP { bf16_t* rp = O + (size_t)(u.arow + 128 * ai + 64 * wr + 16 * m + fr) * ldo + u.pn * BM + 32 * wc + 8 * fq;
#pragma unroll
            for (int bj = 0; bj < 2; ++bj) *(u32x4*)(rp + 128 * bj) = pack8(acc[ai][bj][m][0], acc[ai][bj][m][1]); }
    }
};
constexpr float QPRESCALE = 0.07216878364870322f * 1.4426950408889634f;
struct EpiQ { unsigned char* ws;
    __device__ __forceinline__ void operator()(const f32x4 (&acc)[2][2][4][2], const GUnit& u, int wr, int wc, int fr, int fq) const {
        const float* RS = (const float*)(ws + WS_RSTAT); const float* ct = (const float*)(ws + WS_ROPE); const float* st = ct + 2048; bf16_t* Q = (bf16_t*)(ws + WS_Q);
        PG8_EPI_LOOP { const int row = u.arow + 128 * ai + 64 * wr + 16 * m + fr; const float rinv = RS[2 * row] * QPRESCALE; const int b = row >> 13, t = row & 8191, prow = t >> 6, pcol = t & 63;
#pragma unroll
            for (int bj = 0; bj < 2; ++bj) { const int col = u.pn * BM + 128 * bj + 32 * wc + 8 * fq; if (col >= NH * DQK) continue;
                const int hd = col / DQK, d = col - hd * DQK; f32x4 v0 = acc[ai][bj][m][0] * rinv, v1 = acc[ai][bj][m][1] * rinv;
                if (d >= DNOPE) { const int pi = (d - DNOPE) >> 1, pos = pi < 16 ? prow : pcol, j = pi & 15; const f32x4 cs = *(const f32x4*)(ct + pos * 16 + j), sn = *(const f32x4*)(st + pos * 16 + j);
                    const f32x4 a = v0, c2 = v1; v0.x = a.x * cs.x - a.y * sn.x; v0.y = a.x * sn.x + a.y * cs.x; v0.z = a.z * cs.y - a.w * sn.y; v0.w = a.z * sn.y + a.w * cs.y;
                    v1.x = c2.x * cs.z - c2.y * sn.z; v1.y = c2.x * sn.z + c2.y * cs.z; v1.z = c2.z * cs.w - c2.w * sn.w; v1.w = c2.z * sn.w + c2.w * cs.w; }
                *(u32x4*)(Q + ((size_t)(b * NH + hd) * SEQ + t) * DQK + d) = pack8(v0, v1); }
            asm volatile("" ::: "memory"); }
    }
};
struct EpiKV { unsigned char* ws;
    __device__ __forceinline__ void operator()(const f32x4 (&acc)[2][2][4][2], const GUnit& u, int wr, int wc, int fr, int fq) const {
        const float* RS = (const float*)(ws + WS_RSTAT); bf16_t* KNp = (bf16_t*)(ws + WS_KN); bf16_t* Vp = (bf16_t*)(ws + WS_V);
        PG8_EPI_LOOP { const int row = u.arow + 128 * ai + 64 * wr + 16 * m + fr; const float rinv = RS[2 * row + 1]; int b, tt; if (row < ML) { b = row >> 13; tt = row & 8191; } else { b = (row - ML) >> 8; tt = SEQ + ((row - ML) & 255); }
            const size_t ro = ((size_t)(b * NH + u.pn) * TK + tt) * 128 + 32 * wc + 8 * fq;
            *(u32x4*)(KNp + ro) = pack8(acc[ai][0][m][0] * rinv, acc[ai][0][m][1] * rinv); *(u32x4*)(Vp + ro) = pack8(acc[ai][1][m][0] * rinv, acc[ai][1][m][1] * rinv);
            asm volatile("" ::: "memory"); }
    }
};
struct EpiAct { bf16_t* ACT; const float* bg; const float* bu;
    __device__ __forceinline__ void operator()(const f32x4 (&acc)[2][2][4][2], const GUnit& u, int wr, int wc, int fr, int fq) const {
        const int ac = u.pn * 128 + 32 * wc + 8 * fq; const float* pg = bg + u.e * 1024 + ac; const float* pu = bu + u.e * 1024 + ac;
        const f32x4 g0 = *(const f32x4*)pg, g1 = *(const f32x4*)(pg + 4), u0 = *(const f32x4*)pu, u1 = *(const f32x4*)(pu + 4);
        PG8_EPI_LOOP { const int slot = u.arow + 128 * ai + 64 * wr + 16 * m + fr;
            *(u32x4*)(ACT + (size_t)slot * 1024 + ac) = pack8(act4(acc[ai][0][m][0] + g0, acc[ai][1][m][0] + u0), act4(acc[ai][0][m][1] + g1, acc[ai][1][m][1] + u1)); }
    }
};
__device__ __forceinline__ unsigned pk4_fp8(f32x4 v) { int p = __builtin_amdgcn_cvt_pk_fp8_f32(v.x, v.y, 0, false); p = __builtin_amdgcn_cvt_pk_fp8_f32(v.z, v.w, p, true); return (unsigned)p; }
struct EpiAct8 { unsigned char* ACT; const float* bg; const float* bu; float sc;
    __device__ __forceinline__ void operator()(const f32x4 (&acc)[2][2][4][2], const GUnit& u, int wr, int wc, int fr, int fq) const {
        const int ac = u.pn * 128 + 32 * wc + 8 * fq; const float* pg = bg + u.e * 1024 + ac; const float* pu = bu + u.e * 1024 + ac;
        const f32x4 g0 = *(const f32x4*)pg, g1 = *(const f32x4*)(pg + 4), u0 = *(const f32x4*)pu + 1.f, u1 = *(const f32x4*)(pu + 4) + 1.f;
        PG8_EPI_LOOP { const int slot = u.arow + 128 * ai + 64 * wr + 16 * m + fr; u32x2 w;
            w.x = pk4_fp8(act4p(acc[ai][0][m][0] * sc + g0, acc[ai][1][m][0] * sc + u0)); w.y = pk4_fp8(act4p(acc[ai][0][m][1] * sc + g1, acc[ai][1][m][1] * sc + u1));
            *(u32x2*)(ACT + (size_t)slot * 1024 + ac) = w; }
    }
};
struct EpiY { bf16_t* Y; const float* bd; float sc;
    __device__ __forceinline__ void operator()(const f32x4 (&acc)[2][2][4][2], const GUnit& u, int wr, int wc, int fr, int fq) const {
        const int c0 = u.pn * BM + 32 * wc + 8 * fq; const float* pb = bd + u.e * 1024 + c0;
        const f32x4 b00 = *(const f32x4*)pb, b01 = *(const f32x4*)(pb + 4), b10 = *(const f32x4*)(pb + 128), b11 = *(const f32x4*)(pb + 132);
        PG8_EPI_LOOP { const int slot = u.arow + 128 * ai + 64 * wr + 16 * m + fr; bf16_t* rp = Y + (size_t)slot * 1024 + c0;
            *(u32x4*)rp = pack8(acc[ai][0][m][0] * sc + b00, acc[ai][0][m][1] * sc + b01); *(u32x4*)(rp + 128) = pack8(acc[ai][1][m][0] * sc + b10, acc[ai][1][m][1] * sc + b11); }
    }
};
struct EpiY8 { unsigned char* Y; const float* bd; float sc;
    __device__ __forceinline__ void operator()(const f32x4 (&acc)[2][2][4][2], const GUnit& u, int wr, int wc, int fr, int fq) const {
        const int c0 = u.pn * BM + 32 * wc + 8 * fq; const float* pb = bd + u.e * 1024 + c0;
        const f32x4 b00 = *(const f32x4*)pb, b01 = *(const f32x4*)(pb + 4), b10 = *(const f32x4*)(pb + 128), b11 = *(const f32x4*)(pb + 132);
        PG8_EPI_LOOP { const int slot = u.arow + 128 * ai + 64 * wr + 16 * m + fr; unsigned char* rp = Y + (size_t)slot * 1024 + c0; u32x2 w0, w1;
            w0.x = pk4_fp8(acc[ai][0][m][0] * sc + b00); w0.y = pk4_fp8(acc[ai][0][m][1] * sc + b01); w1.x = pk4_fp8(acc[ai][1][m][0] * sc + b10); w1.y = pk4_fp8(acc[ai][1][m][1] * sc + b11);
            *(u32x2*)rp = w0; *(u32x2*)(rp + 128) = w1; }
    }
};
#undef PG8_EPI_LOOP
}


namespace att {
typedef short s16x4 __attribute__((ext_vector_type(4)));
constexpr int NW = 8, QBLK = 32, KVBLK = 64, NTILE = 66, HALFKEYS = NTILE * KVBLK;
constexpr float SCALE = 0.07216878364870322f, THR = 8.f;
constexpr int SHM_V = KVBLK * 128 * 2, SHM_K = KVBLK * 128 * 2, SHM_R = KVBLK * 64 * 2;
__device__ __forceinline__ int crow(int r, int hi) { return (r & 3) + 8 * (r >> 2) + 4 * hi; }
__device__ __forceinline__ unsigned cvtpk(float lo, float hi) { return pk2(lo, hi); }
__device__ __forceinline__ int v_rd_base(int lane) { return ((lane & 3) << 3) | (((lane >> 2) & 3) << 6) | (((lane >> 4) & 1) << 5) | (((lane >> 5) & 1) << 8); }
constexpr int v_rd_off(int d0, int ks, int half) { return d0 * 512 + ks * 4096 + half * 2048; }
constexpr int SLOT_B = SHM_K + SHM_R + SHM_V, SL_K = 0, SL_R = SHM_K, SL_V = SHM_K + SHM_R, DMA_WS = 3 * SLOT_B, ATT_DMA_LDS = DMA_WS + NW * 64 * 4;
#define RSWZ(row, colB) ((row) * 128 + ((colB) ^ ((((row) >> 1) & 7) << 4)))
#define SBAR() __builtin_amdgcn_sched_barrier(0)
__device__ __forceinline__ float max3(float a, float b, float c) { return __builtin_elementwise_maximum(__builtin_elementwise_maximum(a, b), c); }
__device__ __forceinline__ float sm_max(const f32x16& p0, const f32x16& p1) {
  float a = max3(p0[0], p0[1], p0[2]), b = max3(p0[3], p0[4], p0[5]), c = max3(p1[0], p1[1], p1[2]), d = max3(p1[3], p1[4], p1[5]);
  a = max3(a, p0[6], p0[7]); b = max3(b, p0[8], p0[9]); c = max3(c, p1[6], p1[7]); d = max3(d, p1[8], p1[9]);
  a = max3(a, p0[10], p0[11]); b = max3(b, p0[12], p0[13]); c = max3(c, p1[10], p1[11]); d = max3(d, p1[12], p1[13]);
  a = max3(a, p0[14], p0[15]); c = max3(c, p1[14], p1[15]);
  float pmax = max3(a, b, max3(c, d, d));
  auto rr = __builtin_amdgcn_permlane32_swap(__float_as_uint(pmax), __float_as_uint(pmax), false, false);
  return max3(__uint_as_float(rr[0]), __uint_as_float(rr[1]), __uint_as_float(rr[1]));
}
__device__ __forceinline__ int kperm(int i) { const int a = i >> 3, h = (i >> 2) & 1, b = i & 3; return 16 * (a >> 1) + 8 * h + 4 * (a & 1) + b; }
__device__ __forceinline__ s16x4 trv(int a) { return __builtin_amdgcn_ds_read_tr16_b64_v4i16((LAS s16x4*)(uintptr_t)(unsigned)a); }
#define QK_LD(s, slot) do { if ((s) < 4) { f0[slot] = *(const LAS bf16x8*)(uintptr_t)(unsigned)(ka[(s)]); f1[slot] = *(const LAS bf16x8*)(uintptr_t)(unsigned)(ka[(s)] + 8192); } \
    else if ((s) < 8) { f0[slot] = *(const LAS bf16x8*)(uintptr_t)(unsigned)(kha[(s) - 4]); f1[slot] = *(const LAS bf16x8*)(uintptr_t)(unsigned)(kha[(s) - 4] + 8192); } \
    else { f0[slot] = *(const LAS bf16x8*)(uintptr_t)(unsigned)(ra[(s) - 8]); f1[slot] = *(const LAS bf16x8*)(uintptr_t)(unsigned)(ra[(s) - 8] + 4096); } } while (0)
#ifndef PP_KD
#define PP_KD 3
#endif
#ifndef PP_VD
#define PP_VD 6
#endif
constexpr int KD = PP_KD, KR_ = KD + 1, VD = PP_VD, VR_ = 16;
__device__ __forceinline__ void pp_qkt_head(bf16x8 (&f0)[KR_], bf16x8 (&f1)[KR_], const int (&kb)[4], const int (&rb)[4], int khd, int soff) {
  int ka[4], kha[4], ra[4];
#pragma unroll
  for (int i = 0; i < 4; ++i) { ka[i] = kb[i] + soff; kha[i] = ka[i] + khd; ra[i] = rb[i] + soff; }
#pragma unroll
  for (int s = 0; s < KD; ++s) QK_LD(s, s);
}
#define PV_LD(n) do { L[(n) & 15] = trv(vb + v_rd_off((n) & 3, (n) >> 2, 0)); H[(n) & 15] = trv(vb + v_rd_off((n) & 3, (n) >> 2, 1)); } while (0)
#define PV_MFMA(n) do { const bf16x8 pa_ = ((n) >> 2) == 0 ? pa0 : ((n) >> 2) == 1 ? pa1 : ((n) >> 2) == 2 ? pa2 : pa3; const s16x4 l_ = L[(n) & 15], h_ = H[(n) & 15]; \
    o[(n) & 3] = __builtin_amdgcn_mfma_f32_32x32x16_bf16(pa_, (bf16x8){l_[0], l_[1], l_[2], l_[3], h_[0], h_[1], h_[2], h_[3]}, o[(n) & 3], 0, 0, 0); } while (0)
template <bool PV>
__device__ __forceinline__ void pp_mphase(f32x16& p0, f32x16& p1, f32x16* o, bf16x8 (&f0)[KR_], bf16x8 (&f1)[KR_], const int (&kb)[4], int khd, const int (&rb)[4], int soff, int vb, const bf16x8* qr,
                                          bf16x8 pa0, bf16x8 pa1, bf16x8 pa2, bf16x8 pa3, const f32x16& minit) {
  int ka[4], kha[4], ra[4]; s16x4 L[VR_], H[VR_];
#pragma unroll
  for (int i = 0; i < 4; ++i) { ka[i] = kb[i] + soff; kha[i] = ka[i] + khd; ra[i] = rb[i] + soff; }
#pragma unroll
  for (int s = 0; s < 12; ++s) {
    if (s + KD < 12) QK_LD(s + KD, (s + KD) % KR_);
    else if (PV) { if (2 * (s + KD - 12) < VD) PV_LD(2 * (s + KD - 12)); if (2 * (s + KD - 12) + 1 < VD) PV_LD(2 * (s + KD - 12) + 1); }
    SBAR();
    p0 = __builtin_amdgcn_mfma_f32_32x32x16_bf16(f0[s % KR_], qr[s], s == 0 ? minit : p0, 0, 0, 0);
    p1 = __builtin_amdgcn_mfma_f32_32x32x16_bf16(f1[s % KR_], qr[s], s == 0 ? minit : p1, 0, 0, 0);
    SBAR(); }
  if (PV) {
#pragma unroll
    for (int n = 2 * KD; n < VD; ++n) PV_LD(n);
#pragma unroll
    for (int n = 0; n < 16; ++n) { if (n + VD < 16) PV_LD(n + VD); SBAR(); PV_MFMA(n); SBAR(); } }
}
__device__ __forceinline__ void pp_pv(f32x16* o, int vb, bf16x8 pa0, bf16x8 pa1, bf16x8 pa2, bf16x8 pa3) {
  s16x4 L[VR_], H[VR_];
#pragma unroll
  for (int n = 0; n < VD; ++n) PV_LD(n);
#pragma unroll
  for (int n = 0; n < 16; ++n) { if (n + VD < 16) PV_LD(n + VD); SBAR(); PV_MFMA(n); SBAR(); }
}
#undef PV_LD
#undef PV_MFMA
#undef QK_LD
typedef float f32x2p __attribute__((ext_vector_type(2)));
__device__ __forceinline__ bf16x8 pp_pack8(const f32x16& p, int b) {
  u32x4 w = {cvtpk(p[b], p[b + 1]), cvtpk(p[b + 2], p[b + 3]), cvtpk(p[b + 4], p[b + 5]), cvtpk(p[b + 6], p[b + 7])}; return *reinterpret_cast<bf16x8*>(&w); }
__device__ __forceinline__ void pp_expsum(f32x16& p0, f32x16& p1, float& l_reg, bf16x8& pa0, bf16x8& pa1, bf16x8& pa2, bf16x8& pa3) {
  f32x2p s0 = {0.f, 0.f}, s1 = {0.f, 0.f};
#pragma unroll
  for (int r = 0; r < 16; r += 2) { f32x2p v = {__builtin_amdgcn_exp2f(p0[r]), __builtin_amdgcn_exp2f(p0[r + 1])}; s0 += v; p0[r] = v[0]; p0[r + 1] = v[1]; }
#pragma unroll
  for (int r = 0; r < 16; r += 2) { f32x2p v = {__builtin_amdgcn_exp2f(p1[r]), __builtin_amdgcn_exp2f(p1[r + 1])}; s1 += v; p1[r] = v[0]; p1[r + 1] = v[1]; }
  s0 += s1; l_reg += s0[0] + s0[1];
  pa0 = pp_pack8(p0, 0); pa1 = pp_pack8(p0, 8); pa2 = pp_pack8(p1, 0); pa3 = pp_pack8(p1, 8);
}
template <int NTT, bool FULL>
__device__ __forceinline__ void attn_unit_pp(const bf16_t* __restrict__ Qb, const bf16_t* __restrict__ Kh, const bf16_t* __restrict__ Vh, const bf16_t* __restrict__ Rh,
                                             float* __restrict__ Op, float* __restrict__ MLp, LAS unsigned char* lds, const int tid) {
  const int wid = __builtin_amdgcn_readfirstlane(tid >> 6), lane = tid & 63, r32 = lane & 31, hi = lane >> 5;
  const bool grpB = wid >= 4;
  LAS float* wsx = (LAS float*)(lds + DMA_WS) + wid * 64; LAS float* al_l = wsx + 32;
  float l_reg = 0; f32x16 o[4] = {}, minit = {}; bf16x8 qr[12];
  unsigned ko[2], vo[2], ro;
#pragma unroll
  for (int i = 0; i < 2; ++i) { const int pc = 2 * wid + i;
    { const int row = 4 * pc + (lane >> 4), cl = (lane & 15) ^ (row & 15); ko[i] = (unsigned)(row * 128 + cl * 8) * 2u; }
    { const int s = pc * 64 + lane, sub = s >> 5, within = s & 31, kk = (sub >> 2) * 8 + (within >> 2), c = (sub & 3) * 32 + (within & 3) * 8;
      const int k = (kk & ~0xC) | ((kk & 4) << 1) | ((kk & 8) >> 1); vo[i] = (unsigned)(k * 128 + c) * 2u; } }
  { const int row = 8 * wid + (lane >> 3), cl = (lane & 7) ^ ((row >> 1) & 7); ro = (unsigned)(row * 64 + cl * 8) * 2u; }
#define DMA_KR(t, slot) do { const char* kt_ = (const char*)Kh + (size_t)(t) * (KVBLK * 256); const char* rt_ = (const char*)Rh + (size_t)(t) * (KVBLK * 128); const unsigned sb_ = (unsigned)lb + (unsigned)(slot) * SLOT_B; unsigned sv_; \
    asm volatile("s_mov_b32 %0, m0\n\ts_mov_b32 m0, %5\n\ts_nop 0\n\tglobal_load_lds_dwordx4 %1, %4\n\ts_mov_b32 m0, %6\n\ts_nop 0\n\tglobal_load_lds_dwordx4 %2, %4\n\ts_mov_b32 m0, %8\n\ts_nop 0\n\tglobal_load_lds_dwordx4 %3, %7\n\ts_mov_b32 m0, %0" \
                 : "=&s"(sv_) : "v"(ko[0]), "v"(ko[1]), "v"(ro), "s"(kt_), "s"(sb_ + SL_K + (2 * wid) * 1024), "s"(sb_ + SL_K + (2 * wid + 1) * 1024), "s"(rt_), "s"(sb_ + SL_R + wid * 1024) : "memory"); } while (0)
#define DMA_V(t, slot) do { const char* vt_ = (const char*)Vh + (size_t)(t) * (KVBLK * 256); const unsigned sb_ = (unsigned)lb + (unsigned)(slot) * SLOT_B; unsigned sv_; \
    asm volatile("s_mov_b32 %0, m0\n\ts_mov_b32 m0, %4\n\ts_nop 0\n\tglobal_load_lds_dwordx4 %1, %3\n\ts_mov_b32 m0, %5\n\ts_nop 0\n\tglobal_load_lds_dwordx4 %2, %3\n\ts_mov_b32 m0, %0" \
                 : "=&s"(sv_) : "v"(vo[0]), "v"(vo[1]), "s"(vt_), "s"(sb_ + SL_V + (2 * wid) * 1024), "s"(sb_ + SL_V + (2 * wid + 1) * 1024) : "memory"); } while (0)
#define BAR() do { SBAR(); asm volatile("" ::: "memory"); __builtin_amdgcn_s_barrier(); asm volatile("" ::: "memory"); SBAR(); } while (0)
#define MBAR(n) do { SBAR(); asm volatile("s_waitcnt vmcnt(" #n ") lgkmcnt(0)" ::: "memory"); __builtin_amdgcn_s_barrier(); asm volatile("" ::: "memory"); SBAR(); } while (0)
#define RESC(a) do { if (__any((a) < 1.f)) { if (hi == 0) al_l[r32] = (a); asm volatile("s_waitcnt lgkmcnt(0)" ::: "memory"); \
    _Pragma("unroll") for (int d = 0; d < 4; ++d) _Pragma("unroll") for (int r = 0; r < 16; ++r) o[d][r] *= al_l[crow(r, hi)]; } } while (0)
#define VPHASE(FIRST) do { const float rel = sm_max(p0, p1); \
    if ((FIRST) || __any(rel > THR * 1.4426950408889634f)) { const float dl = (FIRST) ? rel : fmaxf(rel, 0.f), al = __builtin_amdgcn_exp2f(-dl); \
      _Pragma("unroll") for (int r = 0; r < 16; ++r) { p0[r] -= dl; p1[r] -= dl; minit[r] -= dl; }     \
      l_reg *= al; RESC(al); } \
    pp_expsum(p0, p1, l_reg, pa0, pa1, pa2, pa3); } while (0)
  constexpr int NT = NTT;
  const int lb = __builtin_amdgcn_readfirstlane((int)(uintptr_t)lds);
  DMA_KR(0, 0); DMA_KR(1, 1); DMA_V(0, 0);
  { const unsigned qo = (unsigned)((wid * QBLK + r32) * DQK + hi * 8) * 2u;
#pragma unroll
    for (int d0 = 0; d0 < 12; ++d0) qr[d0] = *reinterpret_cast<const bf16x8*>((const char*)Qb + qo + d0 * 32); }
  const int vbase = lb + SL_V + v_rd_base(lane);
  int kb[4], rb[4];
#pragma unroll
  for (int i = 0; i < 4; ++i) { const int cb = (i * 16 + hi * 8) * 2, kr = kperm(r32); kb[i] = lb + SL_K + kr * 256 + ((((2 * i + hi) ^ (kr & 7)) + 8 * ((kr >> 3) & 1)) << 4); rb[i] = lb + SL_R + RSWZ(kr, cb); }
  const int khd = ((kperm(r32) >> 3) & 1) ? -128 : 128;
  f32x16 p0, p1; bf16x8 pa0 = {}, pa1 = {}, pa2 = {}, pa3 = {};
  bf16x8 f0[KR_], f1[KR_];
  MBAR(0);
  if (grpB) BAR();
  pp_qkt_head(f0, f1, kb, rb, khd, 0); pp_mphase<false>(p0, p1, o, f0, f1, kb, khd, rb, 0, 0, qr, pa0, pa0, pa0, pa0, minit);
  MBAR(0);
  int sa = 0, sb = 1, sc = 2;
#pragma nounroll
  for (int t = 0; t + 1 < NT; ++t) {
    if (t + 2 < NT) DMA_KR(t + 2, sc);
    DMA_V(t + 1, sb);
    VPHASE(t == 0);
    pp_qkt_head(f0, f1, kb, rb, khd, sb * SLOT_B);
    BAR();
    pp_mphase<true>(p0, p1, o, f0, f1, kb, khd, rb, sb * SLOT_B, vbase + sa * SLOT_B, qr, pa0, pa1, pa2, pa3, minit);
    MBAR(0);
    { const int tmp = sa; sa = sb; sb = sc; sc = tmp; }
  }
  VPHASE(NT == 1);
  BAR();
  pp_pv(o, vbase + sa * SLOT_B, pa0, pa1, pa2, pa3);
  asm volatile("s_waitcnt vmcnt(0)" ::: "memory");
  if (!grpB) BAR();
  { auto rr = __builtin_amdgcn_permlane32_swap(__float_as_uint(l_reg), __float_as_uint(l_reg), false, false); l_reg = __uint_as_float(rr[0]) + __uint_as_float(rr[1]); }
  if constexpr (FULL) {
    if (hi == 0) wsx[r32] = l_reg; asm volatile("s_waitcnt lgkmcnt(0)" ::: "memory");
    const unsigned oo = (unsigned)((wid * QBLK + 4 * hi) * D + r32) * 2u;
#pragma unroll
    for (int r = 0; r < 16; ++r) { const float rl = __builtin_amdgcn_rcpf(wsx[crow(r, hi)]);
#pragma unroll
      for (int d0 = 0; d0 < 4; ++d0) *(bf16_t*)((char*)Op + oo + (unsigned)(((r & 3) + 8 * (r >> 2)) * D + d0 * 32) * 2u) = (bf16_t)f2bf(o[d0][r] * rl); }
  } else {
    if (hi == 0) { *(float2*)((char*)MLp + (unsigned)(wid * QBLK + r32) * 8u) = make_float2(-minit[0], l_reg); }
    const unsigned oo = (unsigned)((wid * QBLK + 4 * hi) * 128 + r32) * 4u;
#pragma unroll
    for (int r = 0; r < 16; ++r)
#pragma unroll
      for (int d0 = 0; d0 < 4; ++d0) *(float*)((char*)Op + oo + (unsigned)(((r & 3) + 8 * (r >> 2)) * 128 + d0 * 32) * 4u) = o[d0][r]; }
#undef DMA_KR
#undef DMA_V
#undef BAR
#undef MBAR
#undef RESC
#undef VPHASE
}
#undef RSWZ
#undef SBAR
}
#ifndef ATTN_UNIT
#define ATTN_UNIT attn_unit_pp
#endif
__device__ __forceinline__ void ph_attn(const P& p, int wg, int nwg, LAS unsigned char* lds, const int wv) {
    unsigned char* ws = p.ws;
    { for (int L = wg; L < 256; L += nwg) { const int bh = L & 7, qb = (L >> 3) & 31, b = bh / NH, h = bh - b * NH;
        const int tid = fresh_tid(wv);
        __syncthreads();
        att::ATTN_UNIT<2 * att::NTILE, true>((const bf16_t*)(ws + WS_Q) + ((size_t)bh * SEQ + qb * 256) * DQK, (const bf16_t*)(ws + WS_KN) + (size_t)bh * TK * 128,
                   (const bf16_t*)(ws + WS_V) + (size_t)bh * TK * 128, (const bf16_t*)(ws + WS_KR) + (size_t)b * TK * 64,
                   (float*)((bf16_t*)(ws + WS_MIXA) + ((size_t)b * SEQ + qb * 256) * D + h * 128), nullptr, lds, tid); } }
    { for (int L = wg; L < 256; L += nwg) { const int x = L & 7, qb = (L >> 3) & 31, bh = 8 + (x >> 1), half = x & 1, b = bh / NH, key0 = half * att::HALFKEYS, pidx = ((bh - 8) * 32 + qb) * 2 + half;
        const int tid = fresh_tid(wv);
        __syncthreads();
        att::ATTN_UNIT<att::NTILE, false>((const bf16_t*)(ws + WS_Q) + ((size_t)bh * SEQ + qb * 256) * DQK, (const bf16_t*)(ws + WS_KN) + ((size_t)bh * TK + key0) * 128,
                   (const bf16_t*)(ws + WS_V) + ((size_t)bh * TK + key0) * 128, (const bf16_t*)(ws + WS_KR) + ((size_t)b * TK + key0) * 64,
                   (float*)(ws + WS_OPART) + (size_t)pidx * 32768, (float*)(ws + WS_OML) + (size_t)pidx * 512, lds, tid); } }
}
__device__ __forceinline__ void ph_acomb(const P& p, int wg, int nwg, int tid) {
    const int lane = tid & 63, gw = wg * 8 + (tid >> 6), ngw = nwg * 8; unsigned char* ws = p.ws;
    const float* OP = (const float*)(ws + WS_OPART); const float* OML = (const float*)(ws + WS_OML); bf16_t* MIXA = (bf16_t*)(ws + WS_MIXA);
    for (int rw = gw; rw < 4 * 32 * 256; rw += ngw) {
        const int pp = rw >> 8, r = rw & 255, bh = 8 + (pp >> 5), qb = pp & 31, b = bh / NH, h = bh - b * NH;
        const float2 ml1 = *(const float2*)(OML + ((size_t)(pp * 2) * 256 + r) * 2), ml2 = *(const float2*)(OML + ((size_t)(pp * 2 + 1) * 256 + r) * 2);
        typedef float f32x2v __attribute__((ext_vector_type(2)));
        const f32x2v o1 = __builtin_nontemporal_load((const f32x2v*)(OP + ((size_t)(pp * 2) * 256 + r) * 128 + 2 * lane)), o2 = __builtin_nontemporal_load((const f32x2v*)(OP + ((size_t)(pp * 2 + 1) * 256 + r) * 128 + 2 * lane));
        const float M = fmaxf(ml1.x, ml2.x), w1 = __builtin_amdgcn_exp2f(ml1.x - M), w2 = __builtin_amdgcn_exp2f(ml2.x - M), inv = 1.f / (ml1.y * w1 + ml2.y * w2);
        *(unsigned*)(MIXA + ((size_t)b * SEQ + qb * 256 + r) * D + h * 128 + 2 * lane) = pk2((o1.x * w1 + o2.x * w2) * inv, (o1.y * w1 + o2.y * w2) * inv);
    }
}

namespace fou {
typedef short s16x4 __attribute__((ext_vector_type(4)));
template <int OFF> __device__ __forceinline__ s16x4 tr_read(int vb) { s16x4 r; asm volatile("ds_read_b64_tr_b16 %0, %1 offset:%2" : "=&v"(r) : "v"(vb), "i"(OFF) : "memory"); return r; }
__device__ __forceinline__ int rd_base(int lane) { return ((lane & 3) << 3) | (((lane >> 2) & 3) << 6) | (((lane >> 4) & 1) << 5) | (((lane >> 5) & 1) << 8); }
__device__ __forceinline__ int img_off(int k, int c) { const int kk = (k & ~0xC) | ((k & 4) << 1) | ((k & 8) >> 1); return ((kk >> 3) * 2 + (c >> 5)) * 512 + ((kk & 7) * 32 + (c & 31)) * 2; }
#define FOU_PK(L, H) (bf16x8){L[0], L[1], L[2], L[3], H[0], H[1], H[2], H[3]}
template <int KS> __device__ __forceinline__ void a_step(f32x16& yr, f32x16& yi, int vb, const bf16x8 (&ar)[16], const bf16x8 (&ai)[16]) {
    const s16x4 l = tr_read<KS * 2048>(vb), h = tr_read<KS * 2048 + 1024>(vb);
    asm volatile("s_waitcnt lgkmcnt(0)" ::: "memory"); __builtin_amdgcn_sched_barrier(0);
    const bf16x8 bb = FOU_PK(l, h);
    yr = __builtin_amdgcn_mfma_f32_32x32x16_bf16(ar[KS], bb, yr, 0, 0, 0); yi = __builtin_amdgcn_mfma_f32_32x32x16_bf16(ai[KS], bb, yi, 0, 0, 0);
}
__device__ __forceinline__ void stage_a(unsigned char* ws, int bg, int n2, LAS unsigned char* lds, int tid) {
    const int b = bg >> 2, g = bg & 3, lane = tid & 63, w = tid >> 6, r32 = lane & 31, hi = lane >> 5;
    const bf16_t* PXb = (const bf16_t*)(ws + WS_PX) + (size_t)b * SEQ * PXW + 768 + g * 128;
#pragma unroll
    for (int i = 0; i < 4; ++i) { const int q = tid + NTHR * i, kk = q >> 3, jc = (q & 7) * 8, n1 = kk & 127, isq = kk >> 7;
        const bf16x8 v = __builtin_nontemporal_load((const bf16x8*)(PXb + (size_t)(64 * n1 + n2) * PXW + isq * 64 + jc)); *(LAS bf16x8*)(lds + img_off(kk, jc)) = v; }
    const int kb = w & 3, d0 = w >> 2;
    bf16x8 ar[16], ai[16];
    { const bf16_t* gar = (const bf16_t*)(ws + WS_GA) + (size_t)(kb * 32 + r32) * 256 + 8 * hi; const bf16_t* gai = gar + 128 * 256;
#pragma unroll
      for (int k = 0; k < 16; ++k) { ar[k] = *(const bf16x8*)(gar + k * 16); ai[k] = *(const bf16x8*)(gai + k * 16); } }
    __syncthreads();
    const int vb = (int)(uintptr_t)lds + rd_base(lane) + d0 * 512;
    f32x16 yr = {0}, yi = {0};
    a_step<0>(yr, yi, vb, ar, ai); a_step<1>(yr, yi, vb, ar, ai); a_step<2>(yr, yi, vb, ar, ai); a_step<3>(yr, yi, vb, ar, ai);
    a_step<4>(yr, yi, vb, ar, ai); a_step<5>(yr, yi, vb, ar, ai); a_step<6>(yr, yi, vb, ar, ai); a_step<7>(yr, yi, vb, ar, ai);
    a_step<8>(yr, yi, vb, ar, ai); a_step<9>(yr, yi, vb, ar, ai); a_step<10>(yr, yi, vb, ar, ai); a_step<11>(yr, yi, vb, ar, ai);
    a_step<12>(yr, yi, vb, ar, ai); a_step<13>(yr, yi, vb, ar, ai); a_step<14>(yr, yi, vb, ar, ai); a_step<15>(yr, yi, vb, ar, ai);
    const float2* tw = (const float2*)(ws + WS_FTAB); bf16_t* FT = (bf16_t*)(ws + WS_FT);
#pragma unroll
    for (int r = 0; r < 16; ++r) { const int k1 = kb * 32 + (r & 3) + 8 * (r >> 2) + 4 * hi; const float2 t = tw[(n2 * k1) & 8191];
        bf16_t* dst = FT + (((size_t)bg * 128 + k1) * 64 + n2) * 128 + d0 * 32 + r32;
        dst[0] = (bf16_t)f2bf(t.x * yr[r] + t.y * yi[r]); dst[64] = (bf16_t)f2bf(t.x * yi[r] - t.y * yr[r]); }
    __syncthreads();
}
template <int KS> __device__ __forceinline__ void b_step(f32x16 (&acc)[2][2], int vb, const bf16x8 (&g0)[8], const bf16x8 (&g1)[8]) {
    const s16x4 l0 = tr_read<KS * 2048>(vb), h0 = tr_read<KS * 2048 + 1024>(vb), l1 = tr_read<KS * 2048 + 512>(vb), h1 = tr_read<KS * 2048 + 1536>(vb);
    asm volatile("s_waitcnt lgkmcnt(0)" ::: "memory"); __builtin_amdgcn_sched_barrier(0);
    const bf16x8 b0 = FOU_PK(l0, h0), b1 = FOU_PK(l1, h1);
    acc[0][0] = __builtin_amdgcn_mfma_f32_32x32x16_bf16(g0[KS], b0, acc[0][0], 0, 0, 0); acc[0][1] = __builtin_amdgcn_mfma_f32_32x32x16_bf16(g0[KS], b1, acc[0][1], 0, 0, 0);
    acc[1][0] = __builtin_amdgcn_mfma_f32_32x32x16_bf16(g1[KS], b0, acc[1][0], 0, 0, 0); acc[1][1] = __builtin_amdgcn_mfma_f32_32x32x16_bf16(g1[KS], b1, acc[1][1], 0, 0, 0);
}
__device__ __forceinline__ void stage_b(unsigned char* ws, int bg, int k1base, LAS unsigned char* lds, int tid) {
    const int b = bg >> 2, g = bg & 3, lane = tid & 63, w = tid >> 6, r32 = lane & 31, hi = lane >> 5, k1 = k1base + w;
    const bf16_t* src = (const bf16_t*)(ws + WS_FT) + ((size_t)bg * 128 + k1) * 64 * 128;
    LAS unsigned char* my = lds + w * 16384;
#pragma unroll
    for (int i = 0; i < 16; ++i) { const int q = lane + 64 * i, kk = q >> 3, jc = (q & 7) * 8; const bf16x8 v = __builtin_nontemporal_load((const bf16x8*)(src + q * 8)); *(LAS bf16x8*)(my + img_off(kk, jc)) = v; }
    bf16x8 g0[8], g1[8];
    { const bf16_t* gb = (const bf16_t*)(ws + WS_GB) + (size_t)r32 * 128 + 8 * hi;
#pragma unroll
      for (int k = 0; k < 8; ++k) { g0[k] = *(const bf16x8*)(gb + k * 16); g1[k] = *(const bf16x8*)(gb + 32 * 128 + k * 16); } }
    asm volatile("s_waitcnt lgkmcnt(0)" ::: "memory"); __builtin_amdgcn_sched_barrier(0);
    const int vb = (int)(uintptr_t)my + rd_base(lane);
    f32x16 acc[2][2] = {};
    b_step<0>(acc, vb, g0, g1); b_step<1>(acc, vb, g0, g1); b_step<2>(acc, vb, g0, g1); b_step<3>(acc, vb, g0, g1); b_step<4>(acc, vb, g0, g1); b_step<5>(acc, vb, g0, g1); b_step<6>(acc, vb, g0, g1); b_step<7>(acc, vb, g0, g1);
    bf16_t* MIXA = (bf16_t*)(ws + WS_MIXA);
#pragma unroll
    for (int rb = 0; rb < 2; ++rb)
#pragma unroll
        for (int r = 0; r < 16; ++r) { const int k2 = rb * 32 + (r & 3) + 8 * (r >> 2) + 4 * hi; bf16_t* dst = MIXA + ((size_t)b * SEQ + k1 + 128 * k2) * D + 768 + g * 64 + r32;
            dst[0] = (bf16_t)f2bf(acc[rb][0][r]); dst[32] = (bf16_t)f2bf(acc[rb][1][r]); }
}
#undef FOU_PK
}


#define XB_TMO      128
#define XB_XCNT(j)  (256  + 64 * (j))
#define XB_XSUB(j)  (1280 + 64 * (j))
#define XB_XGEN(j)  (2304 + 64 * (j))
#define XB_TOP      3328
#define XB_TOPGEN   3392
#define XCD_BAR_WORDS 3456
#define XB_SPIN_CAP (1u << 18)
__device__ __forceinline__ unsigned xb_ld(unsigned* p)              { return __hip_atomic_load(p, __ATOMIC_RELAXED, __HIP_MEMORY_SCOPE_AGENT); }
__device__ __forceinline__ unsigned xb_add(unsigned* p, unsigned v) { return __hip_atomic_fetch_add(p, v, __ATOMIC_RELAXED, __HIP_MEMORY_SCOPE_AGENT); }
__device__ __forceinline__ unsigned xb_xcc_id() { return (unsigned)__builtin_amdgcn_s_getreg((3 << 11) | 20) & 0xFu; }
#define XB_SPIN(cond, bar) do { unsigned _sp = 0; while (cond) { __builtin_amdgcn_s_sleep(1); \
    if ((++_sp & 255u) == 0u) { if (xb_ld(&(bar)[XB_TMO])) break; if (_sp > XB_SPIN_CAP) { atomicAdd(&(bar)[XB_TMO], 1u); break; } } } } while (0)
struct XcdBarrier { unsigned* bar; unsigned x; volatile LAS unsigned* st; };
__device__ __forceinline__ XcdBarrier xcd_barrier_post(unsigned* bar, volatile LAS unsigned* st) {
    XcdBarrier b; b.bar = bar; b.x = xb_xcc_id(); b.st = st;
    if (threadIdx.x == 0) (void)xb_add(&bar[XB_XCNT(b.x)], 1u);
    return b;
}
__device__ __forceinline__ void xcd_barrier_complete(unsigned* bar, unsigned x, unsigned& nloc, unsigned& nx) {
    const unsigned G = gridDim.x * gridDim.y * gridDim.z;
    unsigned sum, cnt, mine, sp = 0u;
    for (;;) {
        sum = 0u; cnt = 0u; mine = 0u;
#pragma unroll
        for (unsigned j = 0; j < 16; ++j) { const unsigned c = xb_ld(&bar[XB_XCNT(j)]); sum += c; cnt += (c > 0u) ? 1u : 0u; mine = (j == x) ? c : mine; }
        if (sum == G) break;
        __builtin_amdgcn_s_sleep(1);
        if ((++sp & 255u) == 0u) { if (xb_ld(&bar[XB_TMO])) break; if (sp > XB_SPIN_CAP) { atomicAdd(&bar[XB_TMO], 1u); break; } }
    }
    nloc = mine > 0u ? mine : 1u; nx = cnt > 0u ? cnt : 1u;
}
__device__ __forceinline__ void xcd_barrier(const XcdBarrier& b) {
    asm volatile("s_waitcnt vmcnt(0)" ::: "memory");
    __syncthreads();
    if (threadIdx.x == 0) {
        unsigned* bar = b.bar;
        __builtin_amdgcn_s_waitcnt(0);
        unsigned nloc = b.st[0], nx = b.st[1];
        if (nloc == 0u) { xcd_barrier_complete(bar, b.x, nloc, nx); b.st[0] = nloc; b.st[1] = nx; }
        const unsigned old = xb_add(&bar[XB_XSUB(b.x)], 1u);
        const unsigned gen = old / nloc;
        if (old + 1u == (gen + 1u) * nloc) {
            __builtin_amdgcn_fence(__ATOMIC_RELEASE, "agent");
            asm volatile("s_waitcnt vmcnt(0)" ::: "memory");
            const unsigned og = xb_add(&bar[XB_TOP], 1u);
            const unsigned tg = og / nx;
            if (og + 1u == (tg + 1u) * nx) xb_add(&bar[XB_TOPGEN], 1u);
            else XB_SPIN(xb_ld(&bar[XB_TOPGEN]) == tg, bar);
            __builtin_amdgcn_fence(__ATOMIC_ACQUIRE, "agent");
            xb_add(&bar[XB_XGEN(b.x)], 1u);
            asm volatile("s_waitcnt vmcnt(0)" ::: "memory");
        } else {
            XB_SPIN(xb_ld(&bar[XB_XGEN(b.x)]) == gen, bar);
            __builtin_amdgcn_fence(__ATOMIC_ACQUIRE, "agent");
            asm volatile("s_waitcnt vmcnt(0)" ::: "memory");
        }
    }
    __syncthreads();
}

enum { PH_PREP = 0, PH_MODUL = 1, PH_INPROJ = 2, PH_ROW1 = 3, PH_QKV = 4, PH_ATTN = 5, PH_ACOMB = 6, PH_OUTPROJ = 7, PH_ROW2 = 8, PH_LIST = 9, PH_MOE1 = 10, PH_MOE2 = 11, PH_FINAL = 12, NPH = 13 };
__global__ void __launch_bounds__(NTHR, 2) mega(P p) {
    extern __shared__ __attribute__((aligned(16))) unsigned char lds_raw[];
    LAS unsigned char* lds = (LAS unsigned char*)lds_raw;
    const int wg = blockIdx.x, nwg = gridDim.x;
    const int lo = p.ph_lo, hi = p.ph_hi;
    int wv = __builtin_amdgcn_readfirstlane((int)(threadIdx.x >> 6)); asm volatile("" : "+s"(wv));
    if (threadIdx.x == 0) { ((volatile LAS unsigned*)(lds + LDS_CTL))[0] = 0u; ((volatile LAS unsigned*)(lds + LDS_CTL))[1] = 0u; }
    __syncthreads();
    XcdBarrier bar; bar.bar = (unsigned*)(p.ws + WS_CTL) + 4096; bar.x = 0; bar.st = (volatile LAS unsigned*)(lds + LDS_CTL);
    if (hi - lo > 1) bar = xcd_barrier_post((unsigned*)(p.ws + WS_CTL) + 4096, (volatile LAS unsigned*)(lds + LDS_CTL));
#define SEAM(k) do { if (lo <= (k) && (k) + 1 < hi) xcd_barrier(bar); } while (0)
#ifndef PHMASK
#define PHMASK 0xFFFF
#endif
#define IN(k) (((PHMASK >> (k)) & 1) && lo <= (k) && (k) < hi)
    unsigned char* ws = p.ws;
#ifndef REPMASK
#define REPMASK 0
#endif
#define PHASE(k, ...) do { if (IN(k)) { _Pragma("unroll") for (int rep_ = 0; rep_ < 1 + ((REPMASK >> (k)) & 1); ++rep_) { if (rep_) xcd_barrier(bar); __VA_ARGS__ } } SEAM(k); } while (0)
    PHASE(PH_PREP, ph_prologue(p, wg, nwg, fresh_tid(wv), lds););
    PHASE(PH_MODUL, ph_modulate(p, wg, nwg, fresh_tid(wv)););
    PHASE(PH_INPROJ, { const pg8::DenseSched S{MA / 256, PXW / 256, nwg, wg, D, D, 0, (const char*)(ws + WS_WIN)}; const pg8::EpiRowMajor E{(bf16_t*)(ws + WS_PX), PXW};
        pg8::gemm_phase(lds, fresh_tid(wv), (const char*)(ws + WS_HX), D, S, E);
        if (nwg == NWG && wg >= 74) p0_expert_items(p, NEI_PREP + (wg - 74), 182, NEI_PREP + FILL_IN, fresh_tid(wv), (LAS float*)lds); });
    PHASE(PH_ROW1, { ph_row1(p, wg, nwg, fresh_tid(wv));
        { const int tid = fresh_tid(wv); __syncthreads(); for (int u = wg; u < 512; u += nwg) fou::stage_a(ws, u >> 6, u & 63, lds, tid); } });
    PHASE(PH_QKV, {
        { const int tid = fresh_tid(wv); for (int u = (wg + nwg / 2) % nwg; u < 128; u += nwg) fou::stage_b(ws, u >> 4, (u & 15) * 8, lds, tid); __syncthreads(); }
        { const pg8::DenseSched S{ML / 256, 5, nwg, wg, QL, PXW, 0, (const char*)(ws + WS_WQ)}; const pg8::EpiQ E{ws}; pg8::gemm_phase(lds, fresh_tid(wv), (const char*)(ws + WS_PX), QL, S, E); }
        { const pg8::DenseSched S{MA / 256, 6, nwg, wg, KVL, PXW, 512, (const char*)(ws + WS_WKV)}; const pg8::EpiKV E{ws}; pg8::gemm_phase(lds, fresh_tid(wv), (const char*)(ws + WS_PX), KVL, S, E); }
        if (nwg == NWG && wg >= 64) { const int tid = fresh_tid(wv); constexpr int QB = NEI_PREP + FILL_IN;
            if (wg < 128) p0_expert_items(p, QB + (wg - 64), 64, QB + 128, tid, (LAS float*)lds);
            else if (wg < 140) p0_expert_items(p, QB + 128 + (wg - 128), 12, QB + 140, tid, (LAS float*)lds);
            else { p0_expert_items(p, QB + 140 + (wg - 140), 116, QB + 372, tid, (LAS float*)lds);
                   if (wg <= 220) p0_expert_items(p, QB + 372 + (wg - 140), 81, QB + 453, tid, (LAS float*)lds); } } });
    static_assert(NEI_PREP + FILL_IN + 453 == NEI, "filler shares");
    PHASE(PH_ATTN, ph_attn(p, wg, nwg, lds, wv););
    PHASE(PH_ACOMB, ph_acomb(p, wg, nwg, fresh_tid(wv)););
    PHASE(PH_OUTPROJ, { const pg8::DenseSched S{ML / 256, D / 256, nwg, wg, D, D, 0, (const char*)(ws + WS_WOUT)}; const pg8::EpiRowMajor E{(bf16_t*)(ws + WS_MIX), D};
        pg8::gemm_phase(lds, fresh_tid(wv), (const char*)(ws + WS_MIXA), D, S, E); });
    PHASE(PH_ROW2, ph_row2(p, wg, nwg, fresh_tid(wv), lds););
    PHASE(PH_LIST, ph_lists(p, wg, nwg, fresh_tid(wv), lds););
    PHASE(PH_MOE1, { const int tid = fresh_tid(wv);
        LAS int* tileL = (LAS int*)(lds + LDS_CTL + 2048); LAS unsigned* lstL = (LAS unsigned*)(lds + LDS_CTL + 4096);
        const int* TILEE = (const int*)(ws + WS_TILEE); const int* SLOTTOK = (const int*)(ws + WS_SLOTTOK);
        for (int i = tid; i < MAXTILES; i += NTHR) tileL[i] = TILEE[i];
        if (tid == 0) tileL[300] = TILEE[400];
        __syncthreads();
        const pg8::MoeSched<8, true, MOE_FP8> S{nwg, wg, tileL, lstL, (const char*)(ws + WS_WGU), 2048};
        { pg8::GUnit u; for (int i = 0; i < 16 && S.next(i, u); ++i) if (tid < 256) lstL[i * 256 + tid] = (unsigned)SLOTTOK[u.arow + tid] * (MOE_FP8 ? 1024u : 2048u); }
        __syncthreads();
        if constexpr (MOE_FP8) { const pg8::EpiAct8 E{ws + WS_ACT, p.in[20], p.in[22], 1.f / WSCALE}; pg8::gemm_phase<pg8::EpiAct8, pg8::MoeSched<8, true, MOE_FP8>, true>(lds, tid, (const char*)(ws + WS_HX), D, S, E); }
        else { const pg8::EpiAct E{(bf16_t*)(ws + WS_ACT), p.in[20], p.in[22]}; pg8::gemm_phase(lds, fresh_tid(wv), (const char*)(ws + WS_HX), D, S, E); } });
    PHASE(PH_MOE2, { const int tid = fresh_tid(wv);
        LAS int* tileL = (LAS int*)(lds + LDS_CTL + 2048); LAS unsigned* lstL = (LAS unsigned*)(lds + LDS_CTL + 4096);
        const int* TILEE = (const int*)(ws + WS_TILEE);
        for (int i = tid; i < MAXTILES; i += NTHR) tileL[i] = TILEE[i];
        if (tid == 0) tileL[300] = TILEE[400];
        __syncthreads();
        const pg8::MoeSched<4, false, MOE_FP8> S{nwg, wg, tileL, lstL, (const char*)(ws + WS_WD), 1024};
        const pg8::EpiY8 E{ws + WS_Y, p.in[24], MOE_FP8 ? 1.f / WSCALE : 1.f};
        pg8::gemm_phase<pg8::EpiY8, pg8::MoeSched<4, false, MOE_FP8>, MOE_FP8>(lds, tid, (const char*)(ws + WS_ACT), D, S, E); });
    PHASE(PH_FINAL, ph_final(p, wg, nwg, fresh_tid(wv)););
#undef PHASE
#undef IN
#undef SEAM
}

extern "C" void kernel_launch(void* const* d_in, const int* in_sizes, int n_in, void* d_out, int out_size, void* d_ws, size_t ws_size, hipStream_t stream) {
    static int ok = 0;
    if (ok == 0) {
        if (n_in != 25 || in_sizes[0] != ML * D || out_size != ML * D || ws_size < WS_END) { fprintf(stderr, "kernel_launch: unexpected shapes (n_in %d, in0 %d, out %d, ws %zu < %zu)\n", n_in, n_in > 0 ? in_sizes[0] : -1, out_size, ws_size, (size_t)WS_END); ok = -1; return; }
        if (hipFuncSetAttribute((const void*)mega, hipFuncAttributeMaxDynamicSharedMemorySize, LDS_BYTES) != hipSuccess) { fprintf(stderr, "kernel_launch: hipFuncSetAttribute failed\n"); ok = -1; return; }
        int dev = 0, cus = 0, per_cu = 0;
        if (hipGetDevice(&dev) != hipSuccess || hipDeviceGetAttribute(&cus, hipDeviceAttributeMultiprocessorCount, dev) != hipSuccess) { fprintf(stderr, "kernel_launch: device query failed\n"); ok = -1; return; }
        if (hipOccupancyMaxActiveBlocksPerMultiprocessor(&per_cu, (const void*)mega, NTHR, LDS_BYTES) != hipSuccess || per_cu < 1) { fprintf(stderr, "kernel_launch: occupancy query says %d blocks per CU\n", per_cu); (void)hipGetLastError(); }
        if (cus != NWG) fprintf(stderr, "kernel_launch: %d CUs (built for %d)\n", cus, NWG);
        ok = cus < NWG ? cus : NWG;
    }
    if (ok < 0) return;
    const int grid = ok;
    (void)hipMemsetAsync((char*)d_ws + WS_CTL, 0, CTL_BYTES, stream);
    P p{}; for (int i = 0; i < 25; ++i) p.in[i] = (const float*)d_in[i]; p.out = (float*)d_out; p.ws = (unsigned char*)d_ws;
#define MEGA(a, b) do { p.ph_lo = (a); p.ph_hi = (b); hipLaunchKernelGGL(mega, dim3(grid), dim3(NTHR), LDS_BYTES, stream, p); } while (0)
#ifdef MULTI_LAUNCH
    for (int ph = 0; ph < NPH; ++ph) MEGA(ph, ph + 1);
#else
    MEGA(0, NPH);
#endif
#undef MEGA
    const hipError_t le = hipPeekAtLastError();
    if (le != hipSuccess) fprintf(stderr, "kernel_launch: launch failed: %s\n", hipGetErrorName(le));
}
```

```cpp
#include <hip/hip_runtime.h>
#include <cstdint>
#include <cstdio>

#define GAS __attribute__((address_space(1)))
#define LAS __attribute__((address_space(3)))
typedef unsigned short bf16_t;
typedef short bf16x8 __attribute__((ext_vector_type(8)));
typedef float f32x4 __attribute__((ext_vector_type(4)));
typedef float f32x16 __attribute__((ext_vector_type(16)));
typedef unsigned u32x4 __attribute__((ext_vector_type(4)));
typedef unsigned u32x2 __attribute__((ext_vector_type(2)));

constexpr int D = 1024, SEQ = 8192, CTXL = 256, NH = 6, DQK = 192, DNOPE = 128, DROPE = 64, DV = 128;
constexpr int QL = 384, KVL = 256;
constexpr int ML = 2 * SEQ, MC = 2 * CTXL, MA = ML + MC;
constexpr int TK = SEQ + CTXL;
constexpr int PXW = 1280;
constexpr int NE = 32, DFF = 1024;
constexpr int MAXTILES = 288, SLOTS = MAXTILES * 256;
constexpr float RMS_EPS = 1e-6f;
constexpr int NWG = 256, NTHR = 512;
#ifndef MOE_FP8_ON
#define MOE_FP8_ON 1
#endif
constexpr bool MOE_FP8 = MOE_FP8_ON;
constexpr float WSCALE = 32.f;

constexpr size_t KiB = 1024, MiB = 1024 * 1024;
constexpr size_t WS_CTL = 0, CTL_BYTES = 64 * KiB;
constexpr size_t WS_MOD = 1 * MiB;
constexpr size_t WS_ROPE = WS_MOD + 96 * KiB;
constexpr size_t WS_RSTAT = WS_ROPE + 16 * KiB;
constexpr size_t WS_TOPI = 1 * MiB + 256 * KiB;
constexpr size_t WS_GATE = WS_TOPI + 256 * KiB;
constexpr size_t WS_TOKSLOT = WS_GATE + 256 * KiB;
constexpr size_t WS_SLOTTOK = 2 * MiB;
constexpr size_t WS_CHCNT = WS_SLOTTOK + 320 * KiB;
constexpr size_t WS_TILEE = WS_CHCNT + 32 * KiB;
constexpr size_t WS_FTAB = WS_TILEE + 32 * KiB;
constexpr size_t WS_WRT = WS_FTAB + 64 * KiB;
constexpr size_t WS_GA = WS_WRT + 128 * KiB;
constexpr size_t WS_GB = WS_GA + 128 * KiB;
constexpr size_t WS_WIN = 4 * MiB;
constexpr size_t WS_WQ = 7 * MiB;
constexpr size_t WS_WKV = 8 * MiB;
constexpr size_t WS_WOUT = 9 * MiB;
constexpr size_t WS_WD = 16 * MiB;
constexpr size_t WS_WGU = 80 * MiB;
constexpr size_t WS_HX = 208 * MiB;
constexpr size_t WS_Y = 80 * MiB;
constexpr size_t WS_MIX = 242 * MiB;
constexpr size_t WS_ACT = 274 * MiB;
constexpr size_t WS_PX = 274 * MiB;
constexpr size_t WS_Q = 316 * MiB;
constexpr size_t WS_KN = 352 * MiB;
constexpr size_t WS_V = 377 * MiB;
constexpr size_t WS_KR = 402 * MiB;
constexpr size_t WS_FT = 405 * MiB;
constexpr size_t WS_MIXA = 421 * MiB;
constexpr size_t WS_OPART = 208 * MiB;
constexpr size_t WS_OML = 304 * MiB;
constexpr size_t WS_END = 453 * MiB;

constexpr int LDS_BYTES = 163840;
constexpr int LDS_CTL = 139264;

struct P { const float* in[25]; float* out; unsigned char* ws; int ph_lo, ph_hi; };

__device__ __forceinline__ unsigned f2bf(float f) { unsigned u = __float_as_uint(f); return (u + 0x7fffu + ((u >> 16) & 1u)) >> 16; }
__device__ __forceinline__ float bflo(unsigned w) { return __uint_as_float(w << 16); }
__device__ __forceinline__ float bfhi(unsigned w) { return __uint_as_float(w & 0xffff0000u); }
typedef __bf16 bf16x2c __attribute__((ext_vector_type(2)));
typedef float f32x2c __attribute__((ext_vector_type(2)));
__device__ __forceinline__ unsigned pk2(float lo, float hi) { const f32x2c v = {lo, hi}; return __builtin_bit_cast(unsigned, __builtin_convertvector(v, bf16x2c)); }
template <int CTRL, int RMASK, bool BC> __device__ __forceinline__ float dpp_mov(float v) { return __builtin_bit_cast(float, __builtin_amdgcn_update_dpp(0, __builtin_bit_cast(int, v), CTRL, RMASK, 0xf, BC)); }
__device__ __forceinline__ float wave_sum(float v) {
    v += dpp_mov<0x111, 0xf, true>(v); v += dpp_mov<0x112, 0xf, true>(v); v += dpp_mov<0x114, 0xf, true>(v); v += dpp_mov<0x118, 0xf, true>(v);
    v += dpp_mov<0x142, 0xa, false>(v); v += dpp_mov<0x143, 0xc, false>(v);
    return __builtin_bit_cast(float, __builtin_amdgcn_readlane(__builtin_bit_cast(int, v), 63));
}
__device__ __forceinline__ float wave_max(float v) {
#pragma unroll
    for (int o = 1; o < 64; o <<= 1) v = fmaxf(v, __shfl_xor(v, o));
    return v;
}
__device__ __forceinline__ int fresh_tid(int wv) { int t = (wv << 6) | (int)__builtin_amdgcn_mbcnt_hi(~0u, __builtin_amdgcn_mbcnt_lo(~0u, 0u)); asm volatile("" : "+v"(t)); return t; }
__device__ __forceinline__ unsigned pg8_pk4_fp8(f32x4 v) { int p = __builtin_amdgcn_cvt_pk_fp8_f32(v.x, v.y, 0, false); p = __builtin_amdgcn_cvt_pk_fp8_f32(v.z, v.w, p, true); return (unsigned)p; }
__device__ __forceinline__ f32x4 fp8x4(unsigned w) { const auto lo = __builtin_amdgcn_cvt_pk_f32_fp8((int)w, false), hi = __builtin_amdgcn_cvt_pk_f32_fp8((int)w, true); return (f32x4){lo[0], lo[1], hi[0], hi[1]}; }
__device__ __forceinline__ float dot4(f32x4 a, f32x4 b) { return (a.x * b.x + a.y * b.y) + (a.z * b.z + a.w * b.w); }

__device__ __forceinline__ void p0_mod_item(const P& p, int it, int tid, LAS float* scr) {
    LAS float* sl = scr;
    LAS float* part = scr + 3072;
    const float* c = p.in[1]; const float* cc = p.in[3]; const float* wm = p.in[4]; const float* bm = p.in[5];
    for (int i = tid; i < 3072; i += NTHR) { const int r = i >> 10, k = i & 1023; const float v = r < 2 ? c[r * 1024 + k] : cc[k]; sl[i] = v / (1.f + __expf(-v)); }
    __syncthreads();
    const int ks = tid >> 5, cidx = tid & 31, n0 = it * 24;
    if (cidx < 24) {
        float a0 = 0.f, a1 = 0.f, a2 = 0.f;
#pragma unroll 1
        for (int kq = 0; kq < 2; ++kq) { float wv[32];
#pragma unroll
            for (int k = 0; k < 32; ++k) wv[k] = __builtin_nontemporal_load(wm + (size_t)(ks * 64 + kq * 32 + k) * 6144 + n0 + cidx);
#pragma unroll
            for (int k = 0; k < 32; ++k) { const float w = wv[k]; const int kk = ks * 64 + kq * 32 + k; a0 += sl[kk] * w; a1 += sl[1024 + kk] * w; a2 += sl[2048 + kk] * w; } }
        part[(ks * 3 + 0) * 24 + cidx] = a0; part[(ks * 3 + 1) * 24 + cidx] = a1; part[(ks * 3 + 2) * 24 + cidx] = a2;
    }
    __syncthreads();
    if (tid < 72) { const int r = tid / 24, cx = tid % 24; float s = bm[n0 + cx];
        for (int k = 0; k < 16; ++k) s += part[(k * 3 + r) * 24 + cx];
        ((float*)(p.ws + WS_MOD))[r * 6144 + n0 + cx] = s; }
    __syncthreads();
}
__device__ __forceinline__ void p0_misc_item(const P& p, int r, int tid) {
    const double TWO_PI = 6.283185307179586476925;
    if (r == 0) {
        float* ct = (float*)(p.ws + WS_ROPE); float* st = ct + 2048;
        for (int i = tid; i < 2048; i += NTHR) { const int pos = i >> 4, j = i & 15; const double inv = pow(10000.0, -(2.0 * j) / 32.0); const double a = (double)pos * inv; ct[i] = (float)cos(a); st[i] = (float)sin(a); }
        const float* wr = p.in[17]; bf16_t* wrh = (bf16_t*)(p.ws + WS_WRT); bf16_t* wrl = wrh + 32768;
        for (int i = tid; i < 32768; i += NTHR) { const int k = i >> 5, e = i & 31; const float w = wr[i]; const unsigned hb = f2bf(w); wrh[e * 1024 + k] = (bf16_t)hb; wrl[e * 1024 + k] = (bf16_t)f2bf(w - __uint_as_float(hb << 16)); }
    } else if (r == 1) {
        for (int i = tid; i < 8192; i += NTHR) { const double a = TWO_PI * i / 8192.0; ((float2*)(p.ws + WS_FTAB))[i] = make_float2((float)cos(a), (float)sin(a)); }
    } else if (r < 6) {
        bf16_t* GA = (bf16_t*)(p.ws + WS_GA);
        for (int i = tid; i < 64 * 256; i += NTHR) { const int row = (r - 2) * 64 + (i >> 8), kk = i & 255, c = row >> 7, k1 = row & 127, n1 = kk & 127, isq = kk >> 7;
            const double a = TWO_PI * ((n1 * k1) & 127) / 128.0; const double cs = cos(a), sn = sin(a);
            const double v = c == 0 ? (isq ? -sn : cs) : (isq ? -cs : -sn); GA[row * 256 + kk] = (bf16_t)f2bf((float)v); }
    } else {
        bf16_t* GB = (bf16_t*)(p.ws + WS_GB);
        for (int i = tid; i < 64 * 128; i += NTHR) { const int k2 = i >> 7, kk = i & 127, n2 = kk >> 1, c = kk & 1; const double a = TWO_PI * ((k2 * n2) & 63) / 64.0;
            GB[i] = (bf16_t)f2bf((float)(c ? sin(a) : cos(a))); }
    }
}
template <class CM>
__device__ __forceinline__ void p0_xpose_item(const CM& cm, int ldn, const float* gain, int k0, bf16_t* dst, int Kd, int nd0, int tid, LAS float* scr) {
    f32x4 v[8];
#pragma unroll
    for (int i = 0; i < 8; ++i) { const int q = tid + NTHR * i, k = q >> 6, n = (q & 63) * 4; const float* sp = cm(nd0 + n);
        v[i] = sp ? *(const f32x4*)(sp + (size_t)(k0 + k) * ldn) : (f32x4){0.f, 0.f, 0.f, 0.f}; }
#pragma unroll
    for (int i = 0; i < 8; ++i) { const int q = tid + NTHR * i, k = q >> 6, n = (q & 63) * 4; const float g = gain ? gain[k0 + k] : 1.f;
        LAS float* d = scr + k * 257 + n; d[0] = v[i].x * g; d[1] = v[i].y * g; d[2] = v[i].z * g; d[3] = v[i].w * g; }
    __syncthreads();
#pragma unroll
    for (int i = 0; i < 4; ++i) { const int q = tid + NTHR * i, n = q >> 3, kc = q & 7; const LAS float* s = scr + (kc * 8) * 257 + n;
        u32x4 o; o.x = pk2(s[0], s[257]); o.y = pk2(s[2 * 257], s[3 * 257]); o.z = pk2(s[4 * 257], s[5 * 257]); o.w = pk2(s[6 * 257], s[7 * 257]);
        *(u32x4*)(dst + (size_t)(nd0 + n) * Kd + k0 + kc * 8) = o; }
    __syncthreads();
}
struct CmWin { const float* w; __device__ const float* operator()(int n) const { return n < 384 ? w + 256 + n : (n < 448 ? w + 896 + (n - 384) : (n < 512 ? nullptr : w + 640 + (n - 512))); } };
struct CmPlain { const float* w; int nmax; __device__ const float* operator()(int n) const { return n < nmax ? w + n : nullptr; } };
struct CmGU { const float* g; const float* u; int pn; __device__ const float* operator()(int n) const { const int j = n & 255; return j < 128 ? g + 128 * pn + j : u + 128 * pn + (j - 128); } };
__device__ __forceinline__ void p0_fold_item(const P& p, int g, int kb, int tid, LAS float* scr) {
    LAS float* Mg = scr;
    LAS float* wb = scr + 8192;
    LAS float* cs = scr + 8192 + 4160;
    const float* wf = p.in[15] + g * 4096; const float* win = p.in[10];
    if (tid < 64) { const double a = 6.283185307179586476925 * tid / 64.0; cs[tid] = (float)cos(a); cs[64 + tid] = (float)sin(a); }
    __syncthreads();
    const float sinv = 1.0f / 724.0773439350246f;
    for (int i = 0; i < 16; ++i) { const int e = tid + NTHR * i, c = e >> 7, jj = e & 127, j = jj & 63, isq = jj >> 6; float s = 0.f;
        for (int m = 0; m < 64; ++m) s += cs[isq * 64 + ((m * c) & 63)] * wf[m * 64 + j];
        Mg[c * 128 + jj] = s * sinv; }
    for (int i = 0; i < 8; ++i) { const int e = tid + NTHR * i, k = e >> 6, c = e & 63; wb[k * 65 + c] = win[(size_t)(kb * 64 + k) * 960 + g * 64 + c]; }
    __syncthreads();
    const int jj = tid >> 2, kq = tid & 3; float acc[16];
#pragma unroll
    for (int i = 0; i < 16; ++i) acc[i] = 0.f;
    for (int c = 0; c < 64; ++c) { const float mv = Mg[c * 128 + jj];
#pragma unroll
        for (int i = 0; i < 16; ++i) acc[i] += wb[(kq * 16 + i) * 65 + c] * mv; }
    bf16_t* dst = (bf16_t*)(p.ws + WS_WIN) + (size_t)(768 + g * 128 + jj) * 1024 + kb * 64 + kq * 16;
    u32x4 o0, o1; o0.x = pk2(acc[0], acc[1]); o0.y = pk2(acc[2], acc[3]); o0.z = pk2(acc[4], acc[5]); o0.w = pk2(acc[6], acc[7]);
    o1.x = pk2(acc[8], acc[9]); o1.y = pk2(acc[10], acc[11]); o1.z = pk2(acc[12], acc[13]); o1.w = pk2(acc[14], acc[15]);
    *(u32x4*)dst = o0; *(u32x4*)(dst + 8) = o1;
    __syncthreads();
}
constexpr int I_WGU = 32 * 8 * 2 * 8, I_WD = 32 * 8 * 8, NEI = I_WGU + I_WD;
constexpr int FILL_IN = 182 * 4, FILL_Q = 128 + 12 + 232 + 81, NEI_PREP = NEI - FILL_IN - FILL_Q;
template <bool DYN = false>
__device__ __forceinline__ void p0_expert_items(const P& p, int first, int step, int end, int tid, LAS float* scr, unsigned* ctr = nullptr) {
        constexpr int XS = 129;
        f32x4 v[8];
#define P0_ISSUE(r_) do { const int r = (r_); const float* s0; int k0; \
            if (r < I_WGU) { const int e = r >> 7, t = (r >> 3) & 15, pn = t >> 1, hf = t & 1; k0 = (r & 7) * 128; s0 = (hf ? p.in[21] : p.in[19]) + (size_t)e * 1048576 + 128 * pn; } \
            else { const int q = r - I_WGU, e = q >> 6, nb = (q >> 3) & 7; k0 = (q & 7) * 128; s0 = p.in[23] + (size_t)e * 1048576 + nb * 128; } \
            _Pragma("unroll") for (int i = 0; i < 8; ++i) { const int q = tid + NTHR * i, k = q >> 5, n = (q & 31) * 4; v[i] = __builtin_nontemporal_load((const f32x4*)(s0 + (size_t)(k0 + k) * 1024 + n)); } } while (0)
        int it = first; LAS float* const scr0 = scr; int par = 0;
        LAS int* const nxw = (LAS int*)((LAS unsigned char*)scr0 + LDS_CTL + 128); unsigned pend = 0;
        if constexpr (DYN) { if (tid == 0) { nxw[0] = (int)__hip_atomic_fetch_add(ctr, 1u, __ATOMIC_RELAXED, __HIP_MEMORY_SCOPE_AGENT); pend = __hip_atomic_fetch_add(ctr, 1u, __ATOMIC_RELAXED, __HIP_MEMORY_SCOPE_AGENT); }
            __syncthreads(); it = nxw[0]; __syncthreads(); }
        if (it < end) P0_ISSUE(it);
        for (; it < end; par ^= 1) {
            int nx = it + step;
            scr = scr0 + par * (128 * XS);
#pragma unroll
            for (int i = 0; i < 8; ++i) { const int q = tid + NTHR * i, k = q >> 5, n = (q & 31) * 4; LAS float* d = scr + k * XS + ((n + 8 * (k >> 4)) & 127); d[0] = v[i].x; d[1] = v[i].y; d[2] = v[i].z; d[3] = v[i].w; }
            if constexpr (DYN) { if (tid == 0) { nxw[par] = (int)pend; pend = __hip_atomic_fetch_add(ctr, 1u, __ATOMIC_RELAXED, __HIP_MEMORY_SCOPE_AGENT); } }
            __syncthreads();
            if constexpr (DYN) nx = nxw[par];
            if (nx < end) P0_ISSUE(nx);
            size_t drow; int k0;
            if (it < I_WGU) { const int e = it >> 7, t = (it >> 3) & 15, pn = t >> 1, hf = t & 1; k0 = (it & 7) * 128; drow = (size_t)e * 2048 + pn * 256 + hf * 128; }
            else { const int q = it - I_WGU, e = q >> 6, nb = (q >> 3) & 7; k0 = (q & 7) * 128; drow = (size_t)e * 1024 + nb * 128; }
            if constexpr (MOE_FP8) {
                unsigned char* dst = (unsigned char*)(p.ws + (it < I_WGU ? WS_WGU : WS_WD)) + drow * 1024 + k0;
#pragma unroll
                for (int i = 0; i < 2; ++i) { const int q = tid + NTHR * i, n = q >> 3, kc = q & 7; const LAS float* s = scr + (kc * 16) * XS + ((n + 8 * kc) & 127); u32x4 o;
                    o.x = pg8_pk4_fp8((f32x4){s[0], s[XS], s[2 * XS], s[3 * XS]} * WSCALE); o.y = pg8_pk4_fp8((f32x4){s[4 * XS], s[5 * XS], s[6 * XS], s[7 * XS]} * WSCALE);
                    o.z = pg8_pk4_fp8((f32x4){s[8 * XS], s[9 * XS], s[10 * XS], s[11 * XS]} * WSCALE); o.w = pg8_pk4_fp8((f32x4){s[12 * XS], s[13 * XS], s[14 * XS], s[15 * XS]} * WSCALE);
                    __builtin_nontemporal_store(o, (u32x4*)(dst + (size_t)n * 1024 + kc * 16)); }
            } else {
                bf16_t* dst = (bf16_t*)(p.ws + (it < I_WGU ? WS_WGU : WS_WD)) + drow * 1024 + k0;
#pragma unroll
                for (int i = 0; i < 4; ++i) { const int q = tid + NTHR * i, n = q >> 4, kc = q & 15; const LAS float* s = scr + (kc * 8) * XS + ((n + 8 * (kc >> 1)) & 127);
                    u32x4 o; o.x = pk2(s[0], s[XS]); o.y = pk2(s[2 * XS], s[3 * XS]); o.z = pk2(s[4 * XS], s[5 * XS]); o.w = pk2(s[6 * XS], s[7 * XS]);
                    *(u32x4*)(dst + (size_t)n * 1024 + kc * 8) = o; }
            }
            it = nx;
        }
        __syncthreads();
#undef P0_ISSUE
}
__device__ __forceinline__ void ph_prologue(const P& p, int wg, int nwg, int tid, LAS unsigned char* lds) {
    LAS float* scr = (LAS float*)lds;
    constexpr int I_MOD = 256, I_MISC = 7, I_FOLD = 64, I_WIN = 3 * 16, I_WQ = 5 * 6, I_WKV = 6 * 4, I_WOUT = 4 * 16;
    constexpr int NIT = I_MOD + I_MISC + I_FOLD + I_WIN + I_WQ + I_WKV + I_WOUT;
    for (int it = wg; it < NIT; it += nwg) {
        int r = it;
        if (r < I_MOD) { p0_mod_item(p, r, tid, scr); continue; } r -= I_MOD;
        if (r < I_MISC) { p0_misc_item(p, r, tid); continue; } r -= I_MISC;
        if (r < I_FOLD) { p0_fold_item(p, r >> 4, r & 15, tid, scr); continue; } r -= I_FOLD;
        if (r < I_WIN) { CmWin cm{p.in[10]}; p0_xpose_item(cm, 960, nullptr, (r & 15) * 64, (bf16_t*)(p.ws + WS_WIN), 1024, (r >> 4) * 256, tid, scr); continue; } r -= I_WIN;
        if (r < I_WQ) { CmPlain cm{p.in[13], 1152}; p0_xpose_item(cm, 1152, p.in[11], (r % 6) * 64, (bf16_t*)(p.ws + WS_WQ), 384, (r / 6) * 256, tid, scr); continue; } r -= I_WQ;
        if (r < I_WKV) { CmPlain cm{p.in[14], 1536}; p0_xpose_item(cm, 1536, p.in[12], (r & 3) * 64, (bf16_t*)(p.ws + WS_WKV), 256, (r >> 2) * 256, tid, scr); continue; } r -= I_WKV;
        if (r < I_WOUT) { CmPlain cm{p.in[16], 1024}; p0_xpose_item(cm, 1024, nullptr, (r & 15) * 64, (bf16_t*)(p.ws + WS_WOUT), 1024, (r >> 4) * 256, tid, scr); continue; } r -= I_WOUT;
    }
    p0_expert_items<true>(p, wg, nwg, nwg == NWG ? NEI_PREP : NEI, tid, scr, (unsigned*)(p.ws + WS_CTL) + 64);
}

template <int NR> __device__ __forceinline__ void modul_rows(const float* const (&rows)[NR], bf16_t* const (&outs)[NR], const f32x4 (&a)[4], const f32x4 (&sh)[4], int lane) {
    f32x4 v[NR][4];
#pragma unroll
    for (int r = 0; r < NR; ++r)
#pragma unroll
        for (int j = 0; j < 4; ++j) v[r][j] = __builtin_nontemporal_load((const f32x4*)(rows[r] + 4 * lane + 256 * j));
#pragma unroll
    for (int r = 0; r < NR; ++r) { float ss = 0.f;
#pragma unroll
        for (int j = 0; j < 4; ++j) ss += dot4(v[r][j], v[r][j]);
        const float rinv = rsqrtf(wave_sum(ss) * (1.f / D) + RMS_EPS);
#pragma unroll
        for (int j = 0; j < 4; ++j) { const f32x4 o = v[r][j] * rinv * a[j] + sh[j]; u32x2 w; w.x = pk2(o.x, o.y); w.y = pk2(o.z, o.w); *(u32x2*)(outs[r] + 4 * lane + 256 * j) = w; } }
}
__device__ __forceinline__ void ph_modulate(const P& p, int wg, int nwg, int tid) {
    const int lane = tid & 63, wave = tid >> 6;
    const float* x = p.in[0]; const float* ctx = p.in[2]; const float* gain = p.in[6];
    const float* MOD = (const float*)(p.ws + WS_MOD); bf16_t* HX = (bf16_t*)(p.ws + WS_HX);
    for (int ch = wg; ch < 256; ch += nwg) {
        f32x4 a[4], sh[4];
        { const int r = ch >> 7;
#pragma unroll
          for (int j = 0; j < 4; ++j) { const int c = 4 * lane + 256 * j; sh[j] = *(const f32x4*)(MOD + r * 6144 + c); a[j] = *(const f32x4*)(gain + c) * (*(const f32x4*)(MOD + r * 6144 + 1024 + c) + 1.f); } }
#pragma unroll
        for (int q = 0; q < 2; ++q) { const int m0 = ch * 64 + wave * 8 + q * 4;
            const float* const rows[4] = {x + (size_t)m0 * D, x + (size_t)(m0 + 1) * D, x + (size_t)(m0 + 2) * D, x + (size_t)(m0 + 3) * D};
            bf16_t* const outs[4] = {HX + (size_t)m0 * D, HX + (size_t)(m0 + 1) * D, HX + (size_t)(m0 + 2) * D, HX + (size_t)(m0 + 3) * D};
            modul_rows<4>(rows, outs, a, sh, lane); }
        if (wave == 7) {
#pragma unroll
            for (int j = 0; j < 4; ++j) { const int c = 4 * lane + 256 * j; sh[j] = *(const f32x4*)(MOD + 2 * 6144 + c); a[j] = *(const f32x4*)(gain + c) * (*(const f32x4*)(MOD + 2 * 6144 + 1024 + c) + 1.f); }
            const int c0 = ch * 2;
            const float* const rows[2] = {ctx + (size_t)c0 * D, ctx + (size_t)(c0 + 1) * D};
            bf16_t* const outs[2] = {HX + (size_t)(ML + c0) * D, HX + (size_t)(ML + c0 + 1) * D};
            modul_rows<2>(rows, outs, a, sh, lane); }
    }
}

template <int NR> __device__ __forceinline__ void row1_rows(const P& p, const int (&ms)[NR], int lane) {
    const bf16_t* PX = (const bf16_t*)(p.ws + WS_PX); float* RS = (float*)(p.ws + WS_RSTAT); bf16_t* KR = (bf16_t*)(p.ws + WS_KR);
    const float* ct = (const float*)(p.ws + WS_ROPE); const float* st = ct + 2048;
    u32x4 c0[NR], c1[NR];
#pragma unroll
    for (int r = 0; r < NR; ++r) { const bf16_t* pr = PX + (size_t)ms[r] * PXW; c0[r] = *(const u32x4*)(pr + 8 * lane); c1[r] = *(const u32x4*)(pr + 512 + 8 * (lane & 31)); }
#pragma unroll
    for (int r = 0; r < NR; ++r) { const int m = ms[r];
        float v[8]; v[0] = bflo(c0[r].x); v[1] = bfhi(c0[r].x); v[2] = bflo(c0[r].y); v[3] = bfhi(c0[r].y); v[4] = bflo(c0[r].z); v[5] = bfhi(c0[r].z); v[6] = bflo(c0[r].w); v[7] = bfhi(c0[r].w);
        float sq = 0.f; if (lane < 48) { for (int j = 0; j < 8; ++j) sq += v[j] * v[j]; }
        float skv = 0.f; if (lane < 32) { const float t0 = bflo(c1[r].x), t1 = bfhi(c1[r].x), t2 = bflo(c1[r].y), t3 = bfhi(c1[r].y), t4 = bflo(c1[r].z), t5 = bfhi(c1[r].z), t6 = bflo(c1[r].w), t7 = bfhi(c1[r].w);
            skv = (t0 * t0 + t1 * t1) + (t2 * t2 + t3 * t3) + (t4 * t4 + t5 * t5) + (t6 * t6 + t7 * t7); }
        const float rq = rsqrtf(wave_sum(sq) * (1.f / QL) + RMS_EPS), rkv = rsqrtf(wave_sum(skv) * (1.f / KVL) + RMS_EPS);
        if (lane == 0) { RS[2 * m] = rq; RS[2 * m + 1] = rkv; }
        if (lane >= 48 && lane < 56) {
            const int d0 = (lane - 48) * 8; int b, tt;
            if (m < ML) { b = m >> 13; tt = m & 8191; const int prow = tt >> 6, pcol = tt & 63;
#pragma unroll
                for (int q = 0; q < 4; ++q) { const int pi = (d0 >> 1) + q; const int pos = pi < 16 ? prow : pcol, j = pi & 15; const float c = ct[pos * 16 + j], s = st[pos * 16 + j];
                    const float e = v[2 * q], o = v[2 * q + 1]; v[2 * q] = e * c - o * s; v[2 * q + 1] = e * s + o * c; } }
            else { b = (m - ML) >> 8; tt = SEQ + ((m - ML) & 255); }
            u32x4 o; o.x = pk2(v[0], v[1]); o.y = pk2(v[2], v[3]); o.z = pk2(v[4], v[5]); o.w = pk2(v[6], v[7]);
            *(u32x4*)(KR + ((size_t)b * TK + tt) * DROPE + d0) = o;
        }
    }
}
__device__ __forceinline__ void ph_row1(const P& p, int wg, int nwg, int tid) {
    const int lane = tid & 63, wave = tid >> 6;
    for (int ch = wg; ch < 256; ch += nwg) {
        { const int m0 = ch * 64 + wave * 8; const int ms[8] = {m0, m0 + 1, m0 + 2, m0 + 3, m0 + 4, m0 + 5, m0 + 6, m0 + 7}; row1_rows<8>(p, ms, lane); }
        if (wave == 7) { const int ms[2] = {ML + ch * 2, ML + ch * 2 + 1}; row1_rows<2>(p, ms, lane); }
    }
}

__device__ __forceinline__ float half_max32(float v, int lane) {
    v = fmaxf(v, __builtin_bit_cast(float, __builtin_amdgcn_update_dpp(__builtin_bit_cast(int, v), __builtin_bit_cast(int, v), 0x111, 0xf, 0xf, false)));
    v = fmaxf(v, __builtin_bit_cast(float, __builtin_amdgcn_update_dpp(__builtin_bit_cast(int, v), __builtin_bit_cast(int, v), 0x112, 0xf, 0xf, false)));
    v = fmaxf(v, __builtin_bit_cast(float, __builtin_amdgcn_update_dpp(__builtin_bit_cast(int, v), __builtin_bit_cast(int, v), 0x114, 0xf, 0xf, false)));
    v = fmaxf(v, __builtin_bit_cast(float, __builtin_amdgcn_update_dpp(__builtin_bit_cast(int, v), __builtin_bit_cast(int, v), 0x118, 0xf, 0xf, false)));
    v = fmaxf(v, __builtin_bit_cast(float, __builtin_amdgcn_update_dpp(__builtin_bit_cast(int, v), __builtin_bit_cast(int, v), 0x142, 0xa, 0xf, false)));
    const float m0 = __builtin_bit_cast(float, __builtin_amdgcn_readlane(__builtin_bit_cast(int, v), 31)), m1 = __builtin_bit_cast(float, __builtin_amdgcn_readlane(__builtin_bit_cast(int, v), 63));
    return lane < 32 ? m0 : m1;
}
__device__ __forceinline__ void ph_row2(const P& p, int wg, int nwg, int tid, LAS unsigned char* lds) {
    const int lane = tid & 63, wave = tid >> 6;
    constexpr int HSTR = 2064;
    LAS unsigned char* Hhi = lds; LAS unsigned char* Hlo = lds + 32 * HSTR;
    LAS float* PL = (LAS float*)(lds + LDS_CTL + 4096);
    LAS int* hist = (LAS int*)(lds + LDS_CTL + 1024);
    const bf16_t* WRH = (const bf16_t*)(p.ws + WS_WRT); const bf16_t* WRL = WRH + 32768;
    const float* x = p.in[0]; const float* MOD = (const float*)(p.ws + WS_MOD); const float* npost = p.in[7]; const float* npre = p.in[8]; const float* br = p.in[18];
    const bf16_t* MIX = (const bf16_t*)(p.ws + WS_MIX); bf16_t* HX2 = (bf16_t*)(p.ws + WS_HX);
    int* TOPI = (int*)(p.ws + WS_TOPI); float* GATE = (float*)(p.ws + WS_GATE); int* CHCNT = (int*)(p.ws + WS_CHCNT);
    for (int ch = wg; ch < 256; ch += nwg) {
        if (tid < 32) hist[tid] = 0;
        const int b = (ch * 64) >> 13;
        f32x4 a1[4], a2[4], s2[4];
#pragma unroll
        for (int j = 0; j < 4; ++j) { const int c = 4 * lane + 256 * j;
            a1[j] = *(const f32x4*)(npost + c) * *(const f32x4*)(MOD + b * 6144 + 2048 + c);
            a2[j] = *(const f32x4*)(npre + c) * (*(const f32x4*)(MOD + b * 6144 + 4096 + c) + 1.f);
            s2[j] = *(const f32x4*)(MOD + b * 6144 + 3072 + c); }
        for (int batch = 0; batch < 2; ++batch) {
            u32x2 mw[4][4]; f32x4 xv[4][4];
#pragma unroll
            for (int i = 0; i < 4; ++i) { const int m = ch * 64 + batch * 32 + wave * 4 + i;
#pragma unroll
                for (int j = 0; j < 4; ++j) { mw[i][j] = *(const u32x2*)(MIX + (size_t)m * D + 4 * lane + 256 * j); xv[i][j] = __builtin_nontemporal_load((const f32x4*)(x + (size_t)m * D + 4 * lane + 256 * j)); } }
            const int fr = lane & 15, fq = lane >> 4, rb = (wave & 1) * 16, kq = wave >> 1;
            const bf16_t* bh = WRH + fr * 1024 + kq * 256 + fq * 8; const bf16_t* bl = WRL + fr * 1024 + kq * 256 + fq * 8;
#pragma unroll
            for (int i = 0; i < 4; ++i) {
                const int rl = wave * 4 + i, m = ch * 64 + batch * 32 + rl;
                f32x4 mx[4], h[4]; float ss = 0.f;
#pragma unroll
                for (int j = 0; j < 4; ++j) { const u32x2 w = mw[i][j]; mx[j] = (f32x4){bflo(w.x), bfhi(w.x), bflo(w.y), bfhi(w.y)}; ss += dot4(mx[j], mx[j]); }
                const float r1 = rsqrtf(wave_sum(ss) * (1.f / D) + RMS_EPS); float s2s = 0.f;
#pragma unroll
                for (int j = 0; j < 4; ++j) { h[j] = xv[i][j] + a1[j] * (mx[j] * r1); s2s += dot4(h[j], h[j]); }
                const float r2 = rsqrtf(wave_sum(s2s) * (1.f / D) + RMS_EPS);
#pragma unroll
                for (int j = 0; j < 4; ++j) { h[j] = h[j] * r2 * a2[j] + s2[j];
                    const unsigned h0 = f2bf(h[j].x), h1 = f2bf(h[j].y), h2 = f2bf(h[j].z), h3 = f2bf(h[j].w);
                    u32x2 wh; wh.x = h0 | (h1 << 16); wh.y = h2 | (h3 << 16);
                    u32x2 wl; wl.x = pk2(h[j].x - __uint_as_float(h0 << 16), h[j].y - __uint_as_float(h1 << 16)); wl.y = pk2(h[j].z - __uint_as_float(h2 << 16), h[j].w - __uint_as_float(h3 << 16));
                    if constexpr (MOE_FP8) *(unsigned*)((unsigned char*)HX2 + (size_t)m * D + 4 * lane + 256 * j) = pg8_pk4_fp8(h[j]);
                    else *(u32x2*)(HX2 + (size_t)m * D + 4 * lane + 256 * j) = wh;
                    *(LAS u32x2*)(Hhi + rl * HSTR + (4 * lane + 256 * j) * 2) = wh; *(LAS u32x2*)(Hlo + rl * HSTR + (4 * lane + 256 * j) * 2) = wl; }
            }
            bf16x8 Bh0[8], Bl0[8];
#pragma unroll
            for (int ks = 0; ks < 8; ++ks) { Bh0[ks] = *(const bf16x8*)(bh + ks * 32); Bl0[ks] = *(const bf16x8*)(bl + ks * 32); }
            __syncthreads();
            { f32x4 acc0 = {0.f, 0.f, 0.f, 0.f}, acc1 = {0.f, 0.f, 0.f, 0.f};
              bf16x8 Bh1[8], Bl1[8];
#pragma unroll
              for (int ks = 0; ks < 8; ++ks) { Bh1[ks] = *(const bf16x8*)(bh + 16 * 1024 + ks * 32); Bl1[ks] = *(const bf16x8*)(bl + 16 * 1024 + ks * 32); }
              const LAS unsigned char* ah = Hhi + (rb + fr) * HSTR + kq * 512 + fq * 16; const LAS unsigned char* al = Hlo + (rb + fr) * HSTR + kq * 512 + fq * 16;
#pragma unroll
              for (int ks = 0; ks < 8; ++ks) {
                  const bf16x8 Ah = *(const LAS bf16x8*)(ah + ks * 64), Al = *(const LAS bf16x8*)(al + ks * 64);
                  acc0 = __builtin_amdgcn_mfma_f32_16x16x32_bf16(Ah, Bh0[ks], acc0, 0, 0, 0); acc0 = __builtin_amdgcn_mfma_f32_16x16x32_bf16(Ah, Bl0[ks], acc0, 0, 0, 0); acc0 = __builtin_amdgcn_mfma_f32_16x16x32_bf16(Al, Bh0[ks], acc0, 0, 0, 0); }
#pragma unroll
              for (int ks = 0; ks < 8; ++ks) {
                  const bf16x8 Ah = *(const LAS bf16x8*)(ah + ks * 64), Al = *(const LAS bf16x8*)(al + ks * 64);
                  acc1 = __builtin_amdgcn_mfma_f32_16x16x32_bf16(Ah, Bh1[ks], acc1, 0, 0, 0); acc1 = __builtin_amdgcn_mfma_f32_16x16x32_bf16(Ah, Bl1[ks], acc1, 0, 0, 0); acc1 = __builtin_amdgcn_mfma_f32_16x16x32_bf16(Al, Bh1[ks], acc1, 0, 0, 0); }
#pragma unroll
              for (int r = 0; r < 4; ++r) { PL[(kq * 32 + rb + fq * 4 + r) * 32 + fr] = acc0[r]; PL[(kq * 32 + rb + fq * 4 + r) * 32 + 16 + fr] = acc1[r]; } }
            __syncthreads();
#pragma unroll
            for (int ps = 0; ps < 2; ++ps) {
                const int rl = wave * 4 + ps * 2 + (lane >> 5), e = lane & 31, m = ch * 64 + batch * 32 + rl;
                float v = ((PL[rl * 32 + e] + PL[(32 + rl) * 32 + e]) + (PL[(64 + rl) * 32 + e] + PL[(96 + rl) * 32 + e])) + br[e];
                int ti[4]; float tv[4];
#pragma unroll
                for (int k = 0; k < 4; ++k) { const float mx = half_max32(v, lane); const unsigned long long bal = __ballot(v == mx);
                    const unsigned hm = lane < 32 ? (unsigned)bal : (unsigned)(bal >> 32); const int idx = __ffs((int)hm) - 1;
                    ti[k] = idx; tv[k] = mx; if (e == idx) v = -3.0e38f; }
                const float e1 = __expf(tv[1] - tv[0]), e2 = __expf(tv[2] - tv[0]), e3 = __expf(tv[3] - tv[0]), inv = 1.f / (1.f + e1 + e2 + e3);
                if (e == 0) { *(int4*)(TOPI + 4 * m) = make_int4(ti[0], ti[1], ti[2], ti[3]); *(f32x4*)(GATE + 4 * m) = (f32x4){inv, e1 * inv, e2 * inv, e3 * inv};
                    atomicAdd((int*)&hist[ti[0]], 1); atomicAdd((int*)&hist[ti[1]], 1); atomicAdd((int*)&hist[ti[2]], 1); atomicAdd((int*)&hist[ti[3]], 1); }
            }
            __syncthreads();
        }
        if (tid < 32) CHCNT[ch * 32 + tid] = hist[tid];
        __syncthreads();
    }
}

__device__ __forceinline__ void ph_lists(const P& p, int wg, int nwg, int tid, LAS unsigned char* lds) {
    LAS int* ct = (LAS int*)lds;
    LAS int* part = ct + 8192;
    LAS int* tot = part + 512; LAS int* base = tot + 32; LAS int* off = base + 64; LAS int* tp = off + 32;
    const int* CHCNT = (const int*)(p.ws + WS_CHCNT); const int* TOPI = (const int*)(p.ws + WS_TOPI);
    int* TOKSLOT = (int*)(p.ws + WS_TOKSLOT); int* SLOTTOK = (int*)(p.ws + WS_SLOTTOK); int* TILEE = (int*)(p.ws + WS_TILEE);
    for (int i = tid; i < 8192; i += NTHR) ct[i] = CHCNT[i];
    __syncthreads();
    { const int e = tid & 31, pt = tid >> 5; int s = 0; for (int c = pt * 16; c < pt * 16 + 16; ++c) s += ct[c * 32 + e]; part[pt * 32 + e] = s; }
    __syncthreads();
    if (tid < 32) { int s = 0; for (int k = 0; k < 16; ++k) s += part[k * 32 + tid]; tot[tid] = s; }
    __syncthreads();
    if (tid == 0) { int run = 0; for (int e = 0; e < 32; ++e) { base[e] = run; run += ((tot[e] + 255) >> 8) << 8; } base[32] = run; }
    __syncthreads();
    for (int ch = wg; ch < 256; ch += nwg) {
        { const int e = tid & 31, pt = tid >> 5; int s = 0; for (int c = pt * 16; c < pt * 16 + 16 && c < ch; ++c) s += ct[c * 32 + e]; part[pt * 32 + e] = s; }
        if (tid < 256) tp[tid] = TOPI[ch * 256 + tid];
        __syncthreads();
        if (tid < 32) { int s = base[tid]; for (int k = 0; k < 16; ++k) s += part[k * 32 + tid]; off[tid] = s; }
        __syncthreads();
        if (tid < 256) { const int e = tp[tid]; int rank = 0; for (int q = 0; q < tid; ++q) rank += (tp[q] == e) ? 1 : 0;
            const int s = off[e] + rank; TOKSLOT[ch * 256 + tid] = s; SLOTTOK[s] = ch * 64 + (tid >> 2); }
        __syncthreads();
    }
    if (wg == 0) {
        if (tid < 32) { const int e = tid; for (int s = base[e] + tot[e]; s < base[e] + (((tot[e] + 255) >> 8) << 8); ++s) SLOTTOK[s] = 0;
            for (int t = base[e] >> 8; t < (base[e] >> 8) + ((tot[e] + 255) >> 8); ++t) TILEE[t] = e; }
        const int nt = base[32] >> 8;
        for (int t = nt + tid; t < MAXTILES; t += NTHR) TILEE[t] = -1;
        if (tid == 0) TILEE[400] = nt;
    }
}

__device__ __forceinline__ void ph_final(const P& p, int wg, int nwg, int tid) {
    const int lane = tid & 63, wave = tid >> 6;
    const float* x = p.in[0]; const float* MOD = (const float*)(p.ws + WS_MOD); const float* npost = p.in[7]; const float* nfpost = p.in[9];
    const bf16_t* MIX = (const bf16_t*)(p.ws + WS_MIX); const unsigned char* Y = (const unsigned char*)(p.ws + WS_Y);
    const int* TOKSLOT = (const int*)(p.ws + WS_TOKSLOT); const float* GATE = (const float*)(p.ws + WS_GATE);
    for (int ch = wg; ch < 256; ch += nwg) {
        const int b = (ch * 64) >> 13;
        f32x4 a1[4], a3[4];
#pragma unroll
        for (int j = 0; j < 4; ++j) { const int c = 4 * lane + 256 * j;
            a1[j] = *(const f32x4*)(npost + c) * *(const f32x4*)(MOD + b * 6144 + 2048 + c);
            a3[j] = *(const f32x4*)(nfpost + c) * *(const f32x4*)(MOD + b * 6144 + 5120 + c); }
        int4 sln[2]; f32x4 gtn[2];
#pragma unroll
        for (int q = 0; q < 2; ++q) { const int m = ch * 64 + wave * 8 + q; sln[q] = *(const int4*)(TOKSLOT + 4 * m); gtn[q] = *(const f32x4*)(GATE + 4 * m); }
#pragma unroll 1
        for (int i2 = 0; i2 < 8; i2 += 2) {
            const int4 sl[2] = {sln[0], sln[1]}; const f32x4 gt[2] = {gtn[0], gtn[1]};
            u32x2 mw[2][4]; unsigned yw[2][4][4]; f32x4 xv[2][4];
#pragma unroll
            for (int q = 0; q < 2; ++q) { const int m = ch * 64 + wave * 8 + i2 + q;
#pragma unroll
                for (int j = 0; j < 4; ++j) { const int c = 4 * lane + 256 * j;
                    mw[q][j] = __builtin_nontemporal_load((const u32x2*)(MIX + (size_t)m * D + c)); xv[q][j] = __builtin_nontemporal_load((const f32x4*)(x + (size_t)m * D + c));
                    yw[q][j][0] = __builtin_nontemporal_load((const unsigned*)(Y + (size_t)sl[q].x * D + c)); yw[q][j][1] = __builtin_nontemporal_load((const unsigned*)(Y + (size_t)sl[q].y * D + c));
                    yw[q][j][2] = __builtin_nontemporal_load((const unsigned*)(Y + (size_t)sl[q].z * D + c)); yw[q][j][3] = __builtin_nontemporal_load((const unsigned*)(Y + (size_t)sl[q].w * D + c)); } }
            if (i2 + 2 < 8) {
#pragma unroll
                for (int q = 0; q < 2; ++q) { const int m = ch * 64 + wave * 8 + i2 + 2 + q; sln[q] = *(const int4*)(TOKSLOT + 4 * m); gtn[q] = *(const f32x4*)(GATE + 4 * m); } }
#pragma unroll
            for (int q = 0; q < 2; ++q) { const int m = ch * 64 + wave * 8 + i2 + q; const f32x4 g = gt[q];
                f32x4 mx[4], y[4]; float ss = 0.f, sy = 0.f;
#pragma unroll
                for (int j = 0; j < 4; ++j) { const u32x2 w = mw[q][j]; mx[j] = (f32x4){bflo(w.x), bfhi(w.x), bflo(w.y), bfhi(w.y)}; ss += dot4(mx[j], mx[j]);
                    f32x4 t = fp8x4(yw[q][j][0]) * g.x; t += fp8x4(yw[q][j][1]) * g.y; t += fp8x4(yw[q][j][2]) * g.z; t += fp8x4(yw[q][j][3]) * g.w;
                    y[j] = t; sy += dot4(t, t); }
                const float r1 = rsqrtf(wave_sum(ss) * (1.f / D) + RMS_EPS), r3 = rsqrtf(wave_sum(sy) * (1.f / D) + RMS_EPS);
#pragma unroll
                for (int j = 0; j < 4; ++j) { const int c = 4 * lane + 256 * j;
                    const f32x4 x1 = xv[q][j] + a1[j] * (mx[j] * r1); __builtin_nontemporal_store(x1 + a3[j] * (y[j] * r3), (f32x4*)(p.out + (size_t)m * D + c)); } }
        }
    }
}

typedef float f32x2a __attribute__((ext_vector_type(2)));
__device__ __forceinline__ f32x4 act4p(f32x4 g, f32x4 u1) {
    f32x4 r;
#pragma unroll
    for (int i = 0; i < 4; i += 2) {
        const f32x2a gg = {fminf(g[i], 7.f), fminf(g[i + 1], 7.f)}; f32x2a e = gg * (f32x2a){-2.4554669595930156f, -2.4554669595930156f};
        e[0] = __builtin_amdgcn_exp2f(e[0]); e[1] = __builtin_amdgcn_exp2f(e[1]); e += (f32x2a){1.f, 1.f};
        const f32x2a rc = {__builtin_amdgcn_rcpf(e[0]), __builtin_amdgcn_rcpf(e[1])}, uu = {__builtin_amdgcn_fmed3f(u1[i], -6.f, 8.f), __builtin_amdgcn_fmed3f(u1[i + 1], -6.f, 8.f)};
        const f32x2a o = gg * rc * uu; r[i] = o[0]; r[i + 1] = o[1]; }
    return r;
}
__device__ __forceinline__ f32x4 act4(f32x4 g, f32x4 u) {
    f32x4 r;
#pragma unroll
    for (int i = 0; i < 4; ++i) { const float gg = fminf(g[i], 7.f), uu = fminf(fmaxf(u[i], -7.f), 7.f); r[i] = gg * __builtin_amdgcn_rcpf(1.f + __builtin_amdgcn_exp2f(-2.4554669595930156f * gg)) * (uu + 1.f); }
    return r;
}

namespace pg8 {
constexpr int BM = 256, BK = 64, HALF = 128, HTB = HALF * BK * 2, STAGE_BYTES = 8 * HTB, NXCD = 8, WGM = 8;
__device__ __forceinline__ int lds_byte(int r, int c) { const int st = (r >> 4) * 2 + (c >> 5), rr = r & 15, cc = c & 31, ob = rr * 64 + cc * 2; return st * 1024 + (ob ^ (((ob >> 9) & 1) << 5)); }
__device__ __forceinline__ void stage_rc(int b, int& R, int& C) { const int st = b / 1024, sb = b % 1024, swz = sb ^ (((sb >> 9) & 1) << 5); R = (st >> 1) * 16 + swz / 64; C = (st & 1) * 32 + (swz % 64) / 2; }
__device__ __forceinline__ int perm32(int rho) { const int n = rho >> 4, i = rho & 15; return 8 * (i >> 2) + 4 * n + (i & 3); }
struct GUnit { const char* B; int pm, pn, e, arow, li; };
typedef int i32x4v __attribute__((ext_vector_type(4)));
typedef int i32x8v __attribute__((ext_vector_type(8)));
template <class Epi, class Sched, bool FP8 = false>
__device__ __forceinline__ void gemm_phase(LAS unsigned char* lds, const int tid, const char* Abase, const int K, const Sched& S, const Epi& E) {
    const int wid = __builtin_amdgcn_readfirstlane(tid >> 6), lane = tid & 63, wr = wid >> 2, wc = wid & 3, fr = lane & 15, fq = lane >> 4;
    const int Kb = FP8 ? K : K * 2, nt = Kb / (BK * 2);
    unsigned voffB[2];
#pragma unroll
    for (int i = 0; i < 2; ++i) { int R, C; stage_rc(tid * 16 + i * 8192, R, C); const int Rb = (R & ~31) + perm32(R & 31); voffB[i] = (unsigned)(Rb * Kb + C * 2); }
    const size_t kstep = (size_t)(BK * 2);
    const size_t hstep = (size_t)HALF * Kb;
    const unsigned ldsw = (unsigned)wid * 1024u;
    constexpr int FC = FP8 ? 16 : 8, PSTR = FP8 ? 16 : 1024;
    const int aoff = lds_byte(wr * 64 + fr, fq * FC), boff = lds_byte(wc * 32 + fr, fq * FC);
#define PG8_SA(b, h) (((b) * 2 + (h)) * HTB)
#define PG8_SB(b, h) ((4 + (b) * 2 + (h)) * HTB)
#define PG8_STAGE_B(bufoff, gbase) do { _Pragma("unroll") for (int _i = 0; _i < 2; ++_i) \
        __builtin_amdgcn_global_load_lds((const unsigned*)((const char*)(gbase) + voffB[_i]), (LAS unsigned*)(lds + (bufoff) + ldsw + _i * 8192), 16, 0, 0); } while (0)
#define PG8_STAGE_A(bufoff, vo, koff) do { _Pragma("unroll") for (int _i = 0; _i < 2; ++_i) \
        __builtin_amdgcn_global_load_lds((const unsigned*)(Abase + (size_t)(vo)[_i] + (koff)), (LAS unsigned*)(lds + (bufoff) + ldsw + _i * 8192), 16, 0, 0); } while (0)
#define PG8_LDA(dst, b, h) do { _Pragma("unroll") for (int m = 0; m < 4; ++m) _Pragma("unroll") for (int k = 0; k < 2; ++k) dst[m][k] = *(const LAS bf16x8*)(lds + PG8_SA(b, h) + aoff + m * 2048 + k * PSTR); } while (0)
#define PG8_LDB(dst, b, h) do { _Pragma("unroll") for (int n = 0; n < 2; ++n) _Pragma("unroll") for (int k = 0; k < 2; ++k) dst[n][k] = *(const LAS bf16x8*)(lds + PG8_SB(b, h) + boff + n * 2048 + k * PSTR); } while (0)
#define PG8_CAT(x) __builtin_shufflevector(__builtin_bit_cast(i32x4v, (x)[0]), __builtin_bit_cast(i32x4v, (x)[1]), 0, 1, 2, 3, 4, 5, 6, 7)
#define PG8_MMA(ai, bj, At, Bt) do { __builtin_amdgcn_s_setprio(1); \
        if constexpr (FP8) { _Pragma("unroll") for (int m = 0; m < 4; ++m) _Pragma("unroll") for (int n = 0; n < 2; ++n) \
            acc[ai][bj][m][n] = __builtin_amdgcn_mfma_scale_f32_16x16x128_f8f6f4(PG8_CAT(Bt[n]), PG8_CAT(At[m]), acc[ai][bj][m][n], 0, 0, 0, 0x7F7F7F7F, 0, 0x7F7F7F7F); \
            _Pragma("unroll") for (int m = 0; m < 4; ++m) _Pragma("unroll") for (int n = 0; n < 2; ++n) asm volatile("" : "+v"(acc[ai][bj][m][n])); }   \
        else { _Pragma("unroll") for (int m = 0; m < 4; ++m) _Pragma("unroll") for (int n = 0; n < 2; ++n) _Pragma("unroll") for (int k = 0; k < 2; ++k) \
            acc[ai][bj][m][n] = __builtin_amdgcn_mfma_f32_16x16x32_bf16(Bt[n][k], At[m][k], acc[ai][bj][m][n], 0, 0, 0); } \
        __builtin_amdgcn_s_setprio(0); } while (0)
#define PG8_WAIT_V(n) asm volatile("s_waitcnt vmcnt(" #n ")" ::: "memory")
#define PG8_WAIT_L(n) asm volatile("s_waitcnt lgkmcnt(" #n ")" ::: "memory")
#define PG8_BAR __builtin_amdgcn_s_barrier()
#define PG8_SCHED __builtin_amdgcn_sched_barrier(0)
    GUnit cur, nxt; int ui = 0;
    if (!S.next(0, cur)) return;
    f32x4 acc[2][2][4][2];
#pragma unroll
    for (int a = 0; a < 2; ++a)
#pragma unroll
        for (int b = 0; b < 2; ++b)
#pragma unroll
            for (int m = 0; m < 4; ++m)
#pragma unroll
                for (int n = 0; n < 2; ++n) acc[a][b][m][n] = (f32x4){0.f, 0.f, 0.f, 0.f};
    bf16x8 At[4][2], B0[2][2], B1[2][2];
    unsigned cvo[2][2];
    S.aoffs(cur, tid, cvo);
    const char* cB = cur.B;
    PG8_STAGE_B(PG8_SB(0, 0), cB); PG8_STAGE_B(PG8_SB(0, 1), cB + hstep); PG8_STAGE_A(PG8_SA(0, 0), cvo[0], 0); PG8_STAGE_A(PG8_SA(0, 1), cvo[1], 0);
    if (wr == 1) PG8_BAR;
    PG8_WAIT_V(2); PG8_BAR;
    PG8_STAGE_B(PG8_SB(1, 0), cB + kstep); PG8_STAGE_A(PG8_SA(1, 0), cvo[0], kstep); PG8_STAGE_B(PG8_SB(1, 1), cB + hstep + kstep);
    PG8_WAIT_V(6); PG8_BAR;
    for (;;) {
        const bool has_next = S.next(ui + 1, nxt);
        const char* nB = has_next ? nxt.B : cB;
#pragma nounroll
        for (int t = 0; t < nt; t += 2) {
            const bool last = (t == nt - 2);
            const size_t k1 = (size_t)(t + 1) * kstep, k2 = last ? 0 : (size_t)(t + 2) * kstep, k3 = k2 + kstep;
            const char* b2 = last ? nB : cB + (size_t)(t + 2) * kstep; const char* b3 = b2 + kstep;
            PG8_LDB(B0, 0, 0); PG8_LDB(B1, 0, 1); PG8_SCHED; PG8_LDA(At, 0, 0); PG8_STAGE_A(PG8_SA(1, 1), cvo[1], k1);
            PG8_WAIT_V(8); PG8_WAIT_L(0); PG8_BAR; PG8_MMA(0, 0, At, B0); PG8_MMA(0, 1, At, B1); PG8_BAR; PG8_SCHED;
            if (last && has_next) S.aoffs(nxt, tid, cvo);
            PG8_LDA(At, 0, 1); PG8_STAGE_B(PG8_SB(0, 0), b2); PG8_STAGE_B(PG8_SB(0, 1), b2 + hstep); PG8_STAGE_A(PG8_SA(0, 0), cvo[0], k2);
            PG8_WAIT_V(8); PG8_WAIT_L(0); PG8_BAR; PG8_MMA(1, 0, At, B0); PG8_MMA(1, 1, At, B1); PG8_BAR; PG8_SCHED;
            PG8_LDB(B0, 1, 0); PG8_LDB(B1, 1, 1); PG8_SCHED; PG8_LDA(At, 1, 0); PG8_STAGE_A(PG8_SA(0, 1), cvo[1], k2);
            PG8_WAIT_V(8); PG8_WAIT_L(0); PG8_BAR; PG8_MMA(0, 0, At, B0); PG8_MMA(0, 1, At, B1); PG8_BAR; PG8_SCHED;
            PG8_LDA(At, 1, 1); PG8_STAGE_B(PG8_SB(1, 0), b3); PG8_STAGE_B(PG8_SB(1, 1), b3 + hstep); PG8_STAGE_A(PG8_SA(1, 0), cvo[0], k3);
            PG8_WAIT_V(8); PG8_WAIT_L(0); PG8_BAR; PG8_MMA(1, 0, At, B0); PG8_MMA(1, 1, At, B1); PG8_BAR; PG8_SCHED;
        }
        if (wr == 0) PG8_BAR;
        E(acc, cur, wr, wc, fr, fq);
        if (!has_next) break;
#pragma unroll
        for (int a = 0; a < 2; ++a)
#pragma unroll
            for (int b = 0; b < 2; ++b)
#pragma unroll
                for (int m = 0; m < 4; ++m)
#pragma unroll
                    for (int n = 0; n < 2; ++n) acc[a][b][m][n] = (f32x4){0.f, 0.f, 0.f, 0.f};
        cur = nxt; cB = nB; ++ui;
        if (wr == 1) PG8_BAR;
    }
    PG8_WAIT_V(0);
    PG8_BAR;
#undef PG8_SA
#undef PG8_SB
#undef PG8_STAGE_A
#undef PG8_STAGE_B
#undef PG8_LDA
#undef PG8_LDB
#undef PG8_MMA
#undef PG8_CAT
#undef PG8_WAIT_V
#undef PG8_WAIT_L
#undef PG8_BAR
#undef PG8_SCHED
}
struct DenseSched {
    int nM, nN, G, c, K, lda, acol0; const char* Bt;
    __device__ __forceinline__ bool next(int i, GUnit& u) const {
        const int nwg = nM * nN; const long L = (long)i * G + c; if (L >= nwg) return false;
        int wgid = (int)L; { const int q = nwg / NXCD, r = nwg % NXCD, xcd = wgid % NXCD, off = wgid / NXCD; wgid = (xcd < r ? xcd * (q + 1) : r * (q + 1) + (xcd - r) * q) + off; }
        const int nig = WGM * nN, gid = wgid / nig, fm = gid * WGM, gsz = (nM - fm) < WGM ? (nM - fm) : WGM;
        u.pm = fm + ((wgid % nig) % gsz); u.pn = (wgid % nig) / gsz; u.e = 0; u.arow = u.pm * BM; u.li = i; u.B = Bt + (size_t)u.pn * BM * K * 2; return true;
    }
    __device__ __forceinline__ void aoffs(const GUnit& u, int tid, unsigned (&vo)[2][2]) const {
#pragma unroll
        for (int i = 0; i < 2; ++i) { int R, C; stage_rc(tid * 16 + i * 8192, R, C);
#pragma unroll
            for (int h = 0; h < 2; ++h) vo[h][i] = (unsigned)((u.arow + R + 128 * h) * lda + acol0 + C) * 2u; }
    }
};
template <int NT, bool GATHER, bool FP8 = false> struct MoeSched {
    int G, c; const LAS int* tile; const LAS unsigned* lst; const char* W; int wrows;
    __device__ __forceinline__ bool next(int i, GUnit& u) const {
        constexpr int RPG = 32 / NT; const int L = i * G + c, x = L & 7, j = L >> 3, grp = j >> 5, jj = j & 31;
        const int rt = (grp * 8 + x) * RPG + (jj % RPG), pn = jj / RPG; if (rt >= tile[300]) return false;
        const int e = tile[rt]; u.pm = rt; u.pn = pn; u.e = e; u.arow = rt * BM; u.li = i; u.B = W + ((size_t)e * wrows + pn * BM) * (FP8 ? 1024 : 2048); return true;
    }
    __device__ __forceinline__ void aoffs(const GUnit& u, int tid, unsigned (&vo)[2][2]) const {
#pragma unroll
        for (int i = 0; i < 2; ++i) { int R, C; stage_rc(tid * 16 + i * 8192, R, C);
#pragma unroll
            for (int h = 0; h < 2; ++h) vo[h][i] = GATHER ? lst[u.li * 256 + R + 128 * h] + (unsigned)C * 2u : (unsigned)((u.arow + R + 128 * h) * (FP8 ? 1024 : 2048) + C * 2); }
    }
};
__device__ __forceinline__ u32x4 pack8(f32x4 a, f32x4 b) { u32x4 w; w.x = pk2(a.x, a.y); w.y = pk2(a.z, a.w); w.z = pk2(b.x, b.y); w.w = pk2(b.z, b.w); return w; }
#define PG8_EPI_LOOP _Pragma("unroll") for (int ai = 0; ai < 2; ++ai) _Pragma("unroll") for (int m = 0; m < 4; ++m)
struct EpiRowMajor { bf16_t* O; int ldo;
    __device__ __forceinline__ void operator()(const f32x4 (&acc)[2][2][4][2], const GUnit& u, int wr, int wc, int fr, int fq) const {
        PG8_EPI_LOOP { bf16_t* rp = O + (size_t)(u.arow + 128 * ai + 64 * wr + 16 * m + fr) * ldo + u.pn * BM + 32 * wc + 8 * fq;
#pragma unroll
            for (int bj = 0; bj < 2; ++bj) *(u32x4*)(rp + 128 * bj) = pack8(acc[ai][bj][m][0], acc[ai][bj][m][1]); }
    }
};
constexpr float QPRESCALE = 0.07216878364870322f * 1.4426950408889634f;
struct EpiQ { unsigned char* ws;
    __device__ __forceinline__ void operator()(const f32x4 (&acc)[2][2][4][2], const GUnit& u, int wr, int wc, int fr, int fq) const {
        const float* RS = (const float*)(ws + WS_RSTAT); const float* ct = (const float*)(ws + WS_ROPE); const float* st = ct + 2048; bf16_t* Q = (bf16_t*)(ws + WS_Q);
        PG8_EPI_LOOP { const int row = u.arow + 128 * ai + 64 * wr + 16 * m + fr; const float rinv = RS[2 * row] * QPRESCALE; const int b = row >> 13, t = row & 8191, prow = t >> 6, pcol = t & 63;
#pragma unroll
            for (int bj = 0; bj < 2; ++bj) { const int col = u.pn * BM + 128 * bj + 32 * wc + 8 * fq; if (col >= NH * DQK) continue;
                const int hd = col / DQK, d = col - hd * DQK; f32x4 v0 = acc[ai][bj][m][0] * rinv, v1 = acc[ai][bj][m][1] * rinv;
                if (d >= DNOPE) { const int pi = (d - DNOPE) >> 1, pos = pi < 16 ? prow : pcol, j = pi & 15; const f32x4 cs = *(const f32x4*)(ct + pos * 16 + j), sn = *(const f32x4*)(st + pos * 16 + j);
                    const f32x4 a = v0, c2 = v1; v0.x = a.x * cs.x - a.y * sn.x; v0.y = a.x * sn.x + a.y * cs.x; v0.z = a.z * cs.y - a.w * sn.y; v0.w = a.z * sn.y + a.w * cs.y;
                    v1.x = c2.x * cs.z - c2.y * sn.z; v1.y = c2.x * sn.z + c2.y * cs.z; v1.z = c2.z * cs.w - c2.w * sn.w; v1.w = c2.z * sn.w + c2.w * cs.w; }
                *(u32x4*)(Q + ((size_t)(b * NH + hd) * SEQ + t) * DQK + d) = pack8(v0, v1); }
            asm volatile("" ::: "memory"); }
    }
};
struct EpiKV { unsigned char* ws;
    __device__ __forceinline__ void operator()(const f32x4 (&acc)[2][2][4][2], const GUnit& u, int wr, int wc, int fr, int fq) const {
        const float* RS = (const float*)(ws + WS_RSTAT); bf16_t* KNp = (bf16_t*)(ws + WS_KN); bf16_t* Vp = (bf16_t*)(ws + WS_V);
        PG8_EPI_LOOP { const int row = u.arow + 128 * ai + 64 * wr + 16 * m + fr; const float rinv = RS[2 * row + 1]; int b, tt; if (row < ML) { b = row >> 13; tt = row & 8191; } else { b = (row - ML) >> 8; tt = SEQ + ((row - ML) & 255); }
            const size_t ro = ((size_t)(b * NH + u.pn) * TK + tt) * 128 + 32 * wc + 8 * fq;
            *(u32x4*)(KNp + ro) = pack8(acc[ai][0][m][0] * rinv, acc[ai][0][m][1] * rinv); *(u32x4*)(Vp + ro) = pack8(acc[ai][1][m][0] * rinv, acc[ai][1][m][1] * rinv);
            asm volatile("" ::: "memory"); }
    }
};
struct EpiAct { bf16_t* ACT; const float* bg; const float* bu;
    __device__ __forceinline__ void operator()(const f32x4 (&acc)[2][2][4][2], const GUnit& u, int wr, int wc, int fr, int fq) const {
        const int ac = u.pn * 128 + 32 * wc + 8 * fq; const float* pg = bg + u.e * 1024 + ac; const float* pu = bu + u.e * 1024 + ac;
        const f32x4 g0 = *(const f32x4*)pg, g1 = *(const f32x4*)(pg + 4), u0 = *(const f32x4*)pu, u1 = *(const f32x4*)(pu + 4);
        PG8_EPI_LOOP { const int slot = u.arow + 128 * ai + 64 * wr + 16 * m + fr;
            *(u32x4*)(ACT + (size_t)slot * 1024 + ac) = pack8(act4(acc[ai][0][m][0] + g0, acc[ai][1][m][0] + u0), act4(acc[ai][0][m][1] + g1, acc[ai][1][m][1] + u1)); }
    }
};
__device__ __forceinline__ unsigned pk4_fp8(f32x4 v) { int p = __builtin_amdgcn_cvt_pk_fp8_f32(v.x, v.y, 0, false); p = __builtin_amdgcn_cvt_pk_fp8_f32(v.z, v.w, p, true); return (unsigned)p; }
struct EpiAct8 { unsigned char* ACT; const float* bg; const float* bu; float sc;
    __device__ __forceinline__ void operator()(const f32x4 (&acc)[2][2][4][2], const GUnit& u, int wr, int wc, int fr, int fq) const {
        const int ac = u.pn * 128 + 32 * wc + 8 * fq; const float* pg = bg + u.e * 1024 + ac; const float* pu = bu + u.e * 1024 + ac;
        const f32x4 g0 = *(const f32x4*)pg, g1 = *(const f32x4*)(pg + 4), u0 = *(const f32x4*)pu + 1.f, u1 = *(const f32x4*)(pu + 4) + 1.f;
        PG8_EPI_LOOP { const int slot = u.arow + 128 * ai + 64 * wr + 16 * m + fr; u32x2 w;
            w.x = pk4_fp8(act4p(acc[ai][0][m][0] * sc + g0, acc[ai][1][m][0] * sc + u0)); w.y = pk4_fp8(act4p(acc[ai][0][m][1] * sc + g1, acc[ai][1][m][1] * sc + u1));
            *(u32x2*)(ACT + (size_t)slot * 1024 + ac) = w; }
    }
};
struct EpiY { bf16_t* Y; const float* bd; float sc;
    __device__ __forceinline__ void operator()(const f32x4 (&acc)[2][2][4][2], const GUnit& u, int wr, int wc, int fr, int fq) const {
        const int c0 = u.pn * BM + 32 * wc + 8 * fq; const float* pb = bd + u.e * 1024 + c0;
        const f32x4 b00 = *(const f32x4*)pb, b01 = *(const f32x4*)(pb + 4), b10 = *(const f32x4*)(pb + 128), b11 = *(const f32x4*)(pb + 132);
        PG8_EPI_LOOP { const int slot = u.arow + 128 * ai + 64 * wr + 16 * m + fr; bf16_t* rp = Y + (size_t)slot * 1024 + c0;
            *(u32x4*)rp = pack8(acc[ai][0][m][0] * sc + b00, acc[ai][0][m][1] * sc + b01); *(u32x4*)(rp + 128) = pack8(acc[ai][1][m][0] * sc + b10, acc[ai][1][m][1] * sc + b11); }
    }
};
struct EpiY8 { unsigned char* Y; const float* bd; float sc;
    __device__ __forceinline__ void operator()(const f32x4 (&acc)[2][2][4][2], const GUnit& u, int wr, int wc, int fr, int fq) const {
        const int c0 = u.pn * BM + 32 * wc + 8 * fq; const float* pb = bd + u.e * 1024 + c0;
        const f32x4 b00 = *(const f32x4*)pb, b01 = *(const f32x4*)(pb + 4), b10 = *(const f32x4*)(pb + 128), b11 = *(const f32x4*)(pb + 132);
        PG8_EPI_LOOP { const int slot = u.arow + 128 * ai + 64 * wr + 16 * m + fr; unsigned char* rp = Y + (size_t)slot * 1024 + c0; u32x2 w0, w1;
            w0.x = pk4_fp8(acc[ai][0][m][0] * sc + b00); w0.y = pk4_fp8(acc[ai][0][m][1] * sc + b01); w1.x = pk4_fp8(acc[ai][1][m][0] * sc + b10); w1.y = pk4_fp8(acc[ai][1][m][1] * sc + b11);
            *(u32x2*)rp = w0; *(u32x2*)(rp + 128) = w1; }
    }
};
#undef PG8_EPI_LOOP
}


namespace att {
typedef short s16x4 __attribute__((ext_vector_type(4)));
constexpr int NW = 8, QBLK = 32, KVBLK = 64, NTILE = 66, HALFKEYS = NTILE * KVBLK;
constexpr float SCALE = 0.07216878364870322f, THR = 8.f;
constexpr int SHM_V = KVBLK * 128 * 2, SHM_K = KVBLK * 128 * 2, SHM_R = KVBLK * 64 * 2;
__device__ __forceinline__ int crow(int r, int hi) { return (r & 3) + 8 * (r >> 2) + 4 * hi; }
__device__ __forceinline__ unsigned cvtpk(float lo, float hi) { return pk2(lo, hi); }
__device__ __forceinline__ int v_rd_base(int lane) { return ((lane & 3) << 3) | (((lane >> 2) & 3) << 6) | (((lane >> 4) & 1) << 5) | (((lane >> 5) & 1) << 8); }
constexpr int v_rd_off(int d0, int ks, int half) { return d0 * 512 + ks * 4096 + half * 2048; }
constexpr int SLOT_B = SHM_K + SHM_R + SHM_V, SL_K = 0, SL_R = SHM_K, SL_V = SHM_K + SHM_R, DMA_WS = 3 * SLOT_B, ATT_DMA_LDS = DMA_WS + NW * 64 * 4;
#define RSWZ(row, colB) ((row) * 128 + ((colB) ^ ((((row) >> 1) & 7) << 4)))
#define SBAR() __builtin_amdgcn_sched_barrier(0)
__device__ __forceinline__ float max3(float a, float b, float c) { return __builtin_elementwise_maximum(__builtin_elementwise_maximum(a, b), c); }
__device__ __forceinline__ float sm_max(const f32x16& p0, const f32x16& p1) {
  float a = max3(p0[0], p0[1], p0[2]), b = max3(p0[3], p0[4], p0[5]), c = max3(p1[0], p1[1], p1[2]), d = max3(p1[3], p1[4], p1[5]);
  a = max3(a, p0[6], p0[7]); b = max3(b, p0[8], p0[9]); c = max3(c, p1[6], p1[7]); d = max3(d, p1[8], p1[9]);
  a = max3(a, p0[10], p0[11]); b = max3(b, p0[12], p0[13]); c = max3(c, p1[10], p1[11]); d = max3(d, p1[12], p1[13]);
  a = max3(a, p0[14], p0[15]); c = max3(c, p1[14], p1[15]);
  float pmax = max3(a, b, max3(c, d, d));
  auto rr = __builtin_amdgcn_permlane32_swap(__float_as_uint(pmax), __float_as_uint(pmax), false, false);
  return max3(__uint_as_float(rr[0]), __uint_as_float(rr[1]), __uint_as_float(rr[1]));
}
__device__ __forceinline__ int kperm(int i) { const int a = i >> 3, h = (i >> 2) & 1, b = i & 3; return 16 * (a >> 1) + 8 * h + 4 * (a & 1) + b; }
__device__ __forceinline__ s16x4 trv(int a) { return __builtin_amdgcn_ds_read_tr16_b64_v4i16((LAS s16x4*)(uintptr_t)(unsigned)a); }
#define QK_LD(s, slot) do { if ((s) < 4) { f0[slot] = *(const LAS bf16x8*)(uintptr_t)(unsigned)(ka[(s)]); f1[slot] = *(const LAS bf16x8*)(uintptr_t)(unsigned)(ka[(s)] + 8192); } \
    else if ((s) < 8) { f0[slot] = *(const LAS bf16x8*)(uintptr_t)(unsigned)(kha[(s) - 4]); f1[slot] = *(const LAS bf16x8*)(uintptr_t)(unsigned)(kha[(s) - 4] + 8192); } \
    else { f0[slot] = *(const LAS bf16x8*)(uintptr_t)(unsigned)(ra[(s) - 8]); f1[slot] = *(const LAS bf16x8*)(uintptr_t)(unsigned)(ra[(s) - 8] + 4096); } } while (0)
#ifndef PP_KD
#define PP_KD 3
#endif
#ifndef PP_VD
#define PP_VD 6
#endif
constexpr int KD = PP_KD, KR_ = KD + 1, VD = PP_VD, VR_ = 16;
__device__ __forceinline__ void pp_qkt_head(bf16x8 (&f0)[KR_], bf16x8 (&f1)[KR_], const int (&kb)[4], const int (&rb)[4], int khd, int soff) {
  int ka[4], kha[4], ra[4];
#pragma unroll
  for (int i = 0; i < 4; ++i) { ka[i] = kb[i] + soff; kha[i] = ka[i] + khd; ra[i] = rb[i] + soff; }
#pragma unroll
  for (int s = 0; s < KD; ++s) QK_LD(s, s);
}
#define PV_LD(n) do { L[(n) & 15] = trv(vb + v_rd_off((n) & 3, (n) >> 2, 0)); H[(n) & 15] = trv(vb + v_rd_off((n) & 3, (n) >> 2, 1)); } while (0)
#define PV_MFMA(n) do { const bf16x8 pa_ = ((n) >> 2) == 0 ? pa0 : ((n) >> 2) == 1 ? pa1 : ((n) >> 2) == 2 ? pa2 : pa3; const s16x4 l_ = L[(n) & 15], h_ = H[(n) & 15]; \
    o[(n) & 3] = __builtin_amdgcn_mfma_f32_32x32x16_bf16(pa_, (bf16x8){l_[0], l_[1], l_[2], l_[3], h_[0], h_[1], h_[2], h_[3]}, o[(n) & 3], 0, 0, 0); } while (0)
template <bool PV>
__device__ __forceinline__ void pp_mphase(f32x16& p0, f32x16& p1, f32x16* o, bf16x8 (&f0)[KR_], bf16x8 (&f1)[KR_], const int (&kb)[4], int khd, const int (&rb)[4], int soff, int vb, const bf16x8* qr,
                                          bf16x8 pa0, bf16x8 pa1, bf16x8 pa2, bf16x8 pa3, const f32x16& minit) {
  int ka[4], kha[4], ra[4]; s16x4 L[VR_], H[VR_];
#pragma unroll
  for (int i = 0; i < 4; ++i) { ka[i] = kb[i] + soff; kha[i] = ka[i] + khd; ra[i] = rb[i] + soff; }
#pragma unroll
  for (int s = 0; s < 12; ++s) {
    if (s + KD < 12) QK_LD(s + KD, (s + KD) % KR_);
    else if (PV) { if (2 * (s + KD - 12) < VD) PV_LD(2 * (s + KD - 12)); if (2 * (s + KD - 12) + 1 < VD) PV_LD(2 * (s + KD - 12) + 1); }
    SBAR();
    p0 = __builtin_amdgcn_mfma_f32_32x32x16_bf16(f0[s % KR_], qr[s], s == 0 ? minit : p0, 0, 0, 0);
    p1 = __builtin_amdgcn_mfma_f32_32x32x16_bf16(f1[s % KR_], qr[s], s == 0 ? minit : p1, 0, 0, 0);
    SBAR(); }
  if (PV) {
#pragma unroll
    for (int n = 2 * KD; n < VD; ++n) PV_LD(n);
#pragma unroll
    for (int n = 0; n < 16; ++n) { if (n + VD < 16) PV_LD(n + VD); SBAR(); PV_MFMA(n); SBAR(); } }
}
__device__ __forceinline__ void pp_pv(f32x16* o, int vb, bf16x8 pa0, bf16x8 pa1, bf16x8 pa2, bf16x8 pa3) {
  s16x4 L[VR_], H[VR_];
#pragma unroll
  for (int n = 0; n < VD; ++n) PV_LD(n);
#pragma unroll
  for (int n = 0; n < 16; ++n) { if (n + VD < 16) PV_LD(n + VD); SBAR(); PV_MFMA(n); SBAR(); }
}
#undef PV_LD
#undef PV_MFMA
#undef QK_LD
typedef float f32x2p __attribute__((ext_vector_type(2)));
__device__ __forceinline__ bf16x8 pp_pack8(const f32x16& p, int b) {
  u32x4 w = {cvtpk(p[b], p[b + 1]), cvtpk(p[b + 2], p[b + 3]), cvtpk(p[b + 4], p[b + 5]), cvtpk(p[b + 6], p[b + 7])}; return *reinterpret_cast<bf16x8*>(&w); }
__device__ __forceinline__ void pp_expsum(f32x16& p0, f32x16& p1, float& l_reg, bf16x8& pa0, bf16x8& pa1, bf16x8& pa2, bf16x8& pa3) {
  f32x2p s0 = {0.f, 0.f}, s1 = {0.f, 0.f};
#pragma unroll
  for (int r = 0; r < 16; r += 2) { f32x2p v = {__builtin_amdgcn_exp2f(p0[r]), __builtin_amdgcn_exp2f(p0[r + 1])}; s0 += v; p0[r] = v[0]; p0[r + 1] = v[1]; }
#pragma unroll
  for (int r = 0; r < 16; r += 2) { f32x2p v = {__builtin_amdgcn_exp2f(p1[r]), __builtin_amdgcn_exp2f(p1[r + 1])}; s1 += v; p1[r] = v[0]; p1[r + 1] = v[1]; }
  s0 += s1; l_reg += s0[0] + s0[1];
  pa0 = pp_pack8(p0, 0); pa1 = pp_pack8(p0, 8); pa2 = pp_pack8(p1, 0); pa3 = pp_pack8(p1, 8);
}
template <int NTT, bool FULL>
__device__ __forceinline__ void attn_unit_pp(const bf16_t* __restrict__ Qb, const bf16_t* __restrict__ Kh, const bf16_t* __restrict__ Vh, const bf16_t* __restrict__ Rh,
                                             float* __restrict__ Op, float* __restrict__ MLp, LAS unsigned char* lds, const int tid) {
  const int wid = __builtin_amdgcn_readfirstlane(tid >> 6), lane = tid & 63, r32 = lane & 31, hi = lane >> 5;
  const bool grpB = wid >= 4;
  LAS float* wsx = (LAS float*)(lds + DMA_WS) + wid * 64; LAS float* al_l = wsx + 32;
  float l_reg = 0; f32x16 o[4] = {}, minit = {}; bf16x8 qr[12];
  unsigned ko[2], vo[2], ro;
#pragma unroll
  for (int i = 0; i < 2; ++i) { const int pc = 2 * wid + i;
    { const int row = 4 * pc + (lane >> 4), cl = (lane & 15) ^ (row & 15); ko[i] = (unsigned)(row * 128 + cl * 8) * 2u; }
    { const int s = pc * 64 + lane, sub = s >> 5, within = s & 31, kk = (sub >> 2) * 8 + (within >> 2), c = (sub & 3) * 32 + (within & 3) * 8;
      const int k = (kk & ~0xC) | ((kk & 4) << 1) | ((kk & 8) >> 1); vo[i] = (unsigned)(k * 128 + c) * 2u; } }
  { const int row = 8 * wid + (lane >> 3), cl = (lane & 7) ^ ((row >> 1) & 7); ro = (unsigned)(row * 64 + cl * 8) * 2u; }
#define DMA_KR(t, slot) do { const char* kt_ = (const char*)Kh + (size_t)(t) * (KVBLK * 256); const char* rt_ = (const char*)Rh + (size_t)(t) * (KVBLK * 128); const unsigned sb_ = (unsigned)lb + (unsigned)(slot) * SLOT_B; unsigned sv_; \
    asm volatile("s_mov_b32 %0, m0\n\ts_mov_b32 m0, %5\n\ts_nop 0\n\tglobal_load_lds_dwordx4 %1, %4\n\ts_mov_b32 m0, %6\n\ts_nop 0\n\tglobal_load_lds_dwordx4 %2, %4\n\ts_mov_b32 m0, %8\n\ts_nop 0\n\tglobal_load_lds_dwordx4 %3, %7\n\ts_mov_b32 m0, %0" \
                 : "=&s"(sv_) : "v"(ko[0]), "v"(ko[1]), "v"(ro), "s"(kt_), "s"(sb_ + SL_K + (2 * wid) * 1024), "s"(sb_ + SL_K + (2 * wid + 1) * 1024), "s"(rt_), "s"(sb_ + SL_R + wid * 1024) : "memory"); } while (0)
#define DMA_V(t, slot) do { const char* vt_ = (const char*)Vh + (size_t)(t) * (KVBLK * 256); const unsigned sb_ = (unsigned)lb + (unsigned)(slot) * SLOT_B; unsigned sv_; \
    asm volatile("s_mov_b32 %0, m0\n\ts_mov_b32 m0, %4\n\ts_nop 0\n\tglobal_load_lds_dwordx4 %1, %3\n\ts_mov_b32 m0, %5\n\ts_nop 0\n\tglobal_load_lds_dwordx4 %2, %3\n\ts_mov_b32 m0, %0" \
                 : "=&s"(sv_) : "v"(vo[0]), "v"(vo[1]), "s"(vt_), "s"(sb_ + SL_V + (2 * wid) * 1024), "s"(sb_ + SL_V + (2 * wid + 1) * 1024) : "memory"); } while (0)
#define BAR() do { SBAR(); asm volatile("" ::: "memory"); __builtin_amdgcn_s_barrier(); asm volatile("" ::: "memory"); SBAR(); } while (0)
#define MBAR(n) do { SBAR(); asm volatile("s_waitcnt vmcnt(" #n ") lgkmcnt(0)" ::: "memory"); __builtin_amdgcn_s_barrier(); asm volatile("" ::: "memory"); SBAR(); } while (0)
#define RESC(a) do { if (__any((a) < 1.f)) { if (hi == 0) al_l[r32] = (a); asm volatile("s_waitcnt lgkmcnt(0)" ::: "memory"); \
    _Pragma("unroll") for (int d = 0; d < 4; ++d) _Pragma("unroll") for (int r = 0; r < 16; ++r) o[d][r] *= al_l[crow(r, hi)]; } } while (0)
#define VPHASE(FIRST) do { const float rel = sm_max(p0, p1); \
    if ((FIRST) || __any(rel > THR * 1.4426950408889634f)) { const float dl = (FIRST) ? rel : fmaxf(rel, 0.f), al = __builtin_amdgcn_exp2f(-dl); \
      _Pragma("unroll") for (int r = 0; r < 16; ++r) { p0[r] -= dl; p1[r] -= dl; minit[r] -= dl; }     \
      l_reg *= al; RESC(al); } \
    pp_expsum(p0, p1, l_reg, pa0, pa1, pa2, pa3); } while (0)
  constexpr int NT = NTT;
  const int lb = __builtin_amdgcn_readfirstlane((int)(uintptr_t)lds);
  DMA_KR(0, 0); DMA_KR(1, 1); DMA_V(0, 0);
  { const unsigned qo = (unsigned)((wid * QBLK + r32) * DQK + hi * 8) * 2u;
#pragma unroll
    for (int d0 = 0; d0 < 12; ++d0) qr[d0] = *reinterpret_cast<const bf16x8*>((const char*)Qb + qo + d0 * 32); }
  const int vbase = lb + SL_V + v_rd_base(lane);
  int kb[4], rb[4];
#pragma unroll
  for (int i = 0; i < 4; ++i) { const int cb = (i * 16 + hi * 8) * 2, kr = kperm(r32); kb[i] = lb + SL_K + kr * 256 + ((((2 * i + hi) ^ (kr & 7)) + 8 * ((kr >> 3) & 1)) << 4); rb[i] = lb + SL_R + RSWZ(kr, cb); }
  const int khd = ((kperm(r32) >> 3) & 1) ? -128 : 128;
  f32x16 p0, p1; bf16x8 pa0 = {}, pa1 = {}, pa2 = {}, pa3 = {};
  bf16x8 f0[KR_], f1[KR_];
  MBAR(0);
  if (grpB) BAR();
  pp_qkt_head(f0, f1, kb, rb, khd, 0); pp_mphase<false>(p0, p1, o, f0, f1, kb, khd, rb, 0, 0, qr, pa0, pa0, pa0, pa0, minit);
  MBAR(0);
  int sa = 0, sb = 1, sc = 2;
#pragma nounroll
  for (int t = 0; t + 1 < NT; ++t) {
    if (t + 2 < NT) DMA_KR(t + 2, sc);
    DMA_V(t + 1, sb);
    VPHASE(t == 0);
    pp_qkt_head(f0, f1, kb, rb, khd, sb * SLOT_B);
    BAR();
    pp_mphase<true>(p0, p1, o, f0, f1, kb, khd, rb, sb * SLOT_B, vbase + sa * SLOT_B, qr, pa0, pa1, pa2, pa3, minit);
    MBAR(0);
    { const int tmp = sa; sa = sb; sb = sc; sc = tmp; }
  }
  VPHASE(NT == 1);
  BAR();
  pp_pv(o, vbase + sa * SLOT_B, pa0, pa1, pa2, pa3);
  asm volatile("s_waitcnt vmcnt(0)" ::: "memory");
  if (!grpB) BAR();
  { auto rr = __builtin_amdgcn_permlane32_swap(__float_as_uint(l_reg), __float_as_uint(l_reg), false, false); l_reg = __uint_as_float(rr[0]) + __uint_as_float(rr[1]); }
  if constexpr (FULL) {
    if (hi == 0) wsx[r32] = l_reg; asm volatile("s_waitcnt lgkmcnt(0)" ::: "memory");
    const unsigned oo = (unsigned)((wid * QBLK + 4 * hi) * D + r32) * 2u;
#pragma unroll
    for (int r = 0; r < 16; ++r) { const float rl = __builtin_amdgcn_rcpf(wsx[crow(r, hi)]);
#pragma unroll
      for (int d0 = 0; d0 < 4; ++d0) *(bf16_t*)((char*)Op + oo + (unsigned)(((r & 3) + 8 * (r >> 2)) * D + d0 * 32) * 2u) = (bf16_t)f2bf(o[d0][r] * rl); }
  } else {
    if (hi == 0) { *(float2*)((char*)MLp + (unsigned)(wid * QBLK + r32) * 8u) = make_float2(-minit[0], l_reg); }
    const unsigned oo = (unsigned)((wid * QBLK + 4 * hi) * 128 + r32) * 4u;
#pragma unroll
    for (int r = 0; r < 16; ++r)
#pragma unroll
      for (int d0 = 0; d0 < 4; ++d0) *(float*)((char*)Op + oo + (unsigned)(((r & 3) + 8 * (r >> 2)) * 128 + d0 * 32) * 4u) = o[d0][r]; }
#undef DMA_KR
#undef DMA_V
#undef BAR
#undef MBAR
#undef RESC
#undef VPHASE
}
#undef RSWZ
#undef SBAR
}
#ifndef ATTN_UNIT
#define ATTN_UNIT attn_unit_pp
#endif
__device__ __forceinline__ void ph_attn(const P& p, int wg, int nwg, LAS unsigned char* lds, const int wv) {
    unsigned char* ws = p.ws;
    { for (int L = wg; L < 256; L += nwg) { const int bh = L & 7, qb = (L >> 3) & 31, b = bh / NH, h = bh - b * NH;
        const int tid = fresh_tid(wv);
        __syncthreads();
        att::ATTN_UNIT<2 * att::NTILE, true>((const bf16_t*)(ws + WS_Q) + ((size_t)bh * SEQ + qb * 256) * DQK, (const bf16_t*)(ws + WS_KN) + (size_t)bh * TK * 128,
                   (const bf16_t*)(ws + WS_V) + (size_t)bh * TK * 128, (const bf16_t*)(ws + WS_KR) + (size_t)b * TK * 64,
                   (float*)((bf16_t*)(ws + WS_MIXA) + ((size_t)b * SEQ + qb * 256) * D + h * 128), nullptr, lds, tid); } }
    { for (int L = wg; L < 256; L += nwg) { const int x = L & 7, qb = (L >> 3) & 31, bh = 8 + (x >> 1), half = x & 1, b = bh / NH, key0 = half * att::HALFKEYS, pidx = ((bh - 8) * 32 + qb) * 2 + half;
        const int tid = fresh_tid(wv);
        __syncthreads();
        att::ATTN_UNIT<att::NTILE, false>((const bf16_t*)(ws + WS_Q) + ((size_t)bh * SEQ + qb * 256) * DQK, (const bf16_t*)(ws + WS_KN) + ((size_t)bh * TK + key0) * 128,
                   (const bf16_t*)(ws + WS_V) + ((size_t)bh * TK + key0) * 128, (const bf16_t*)(ws + WS_KR) + ((size_t)b * TK + key0) * 64,
                   (float*)(ws + WS_OPART) + (size_t)pidx * 32768, (float*)(ws + WS_OML) + (size_t)pidx * 512, lds, tid); } }
}
__device__ __forceinline__ void ph_acomb(const P& p, int wg, int nwg, int tid) {
    const int lane = tid & 63, gw = wg * 8 + (tid >> 6), ngw = nwg * 8; unsigned char* ws = p.ws;
    const float* OP = (const float*)(ws + WS_OPART); const float* OML = (const float*)(ws + WS_OML); bf16_t* MIXA = (bf16_t*)(ws + WS_MIXA);
    for (int rw = gw; rw < 4 * 32 * 256; rw += ngw) {
        const int pp = rw >> 8, r = rw & 255, bh = 8 + (pp >> 5), qb = pp & 31, b = bh / NH, h = bh - b * NH;
        const float2 ml1 = *(const float2*)(OML + ((size_t)(pp * 2) * 256 + r) * 2), ml2 = *(const float2*)(OML + ((size_t)(pp * 2 + 1) * 256 + r) * 2);
        typedef float f32x2v __attribute__((ext_vector_type(2)));
        const f32x2v o1 = __builtin_nontemporal_load((const f32x2v*)(OP + ((size_t)(pp * 2) * 256 + r) * 128 + 2 * lane)), o2 = __builtin_nontemporal_load((const f32x2v*)(OP + ((size_t)(pp * 2 + 1) * 256 + r) * 128 + 2 * lane));
        const float M = fmaxf(ml1.x, ml2.x), w1 = __builtin_amdgcn_exp2f(ml1.x - M), w2 = __builtin_amdgcn_exp2f(ml2.x - M), inv = 1.f / (ml1.y * w1 + ml2.y * w2);
        *(unsigned*)(MIXA + ((size_t)b * SEQ + qb * 256 + r) * D + h * 128 + 2 * lane) = pk2((o1.x * w1 + o2.x * w2) * inv, (o1.y * w1 + o2.y * w2) * inv);
    }
}

namespace fou {
typedef short s16x4 __attribute__((ext_vector_type(4)));
template <int OFF> __device__ __forceinline__ s16x4 tr_read(int vb) { s16x4 r; asm volatile("ds_read_b64_tr_b16 %0, %1 offset:%2" : "=&v"(r) : "v"(vb), "i"(OFF) : "memory"); return r; }
__device__ __forceinline__ int rd_base(int lane) { return ((lane & 3) << 3) | (((lane >> 2) & 3) << 6) | (((lane >> 4) & 1) << 5) | (((lane >> 5) & 1) << 8); }
__device__ __forceinline__ int img_off(int k, int c) { const int kk = (k & ~0xC) | ((k & 4) << 1) | ((k & 8) >> 1); return ((kk >> 3) * 2 + (c >> 5)) * 512 + ((kk & 7) * 32 + (c & 31)) * 2; }
#define FOU_PK(L, H) (bf16x8){L[0], L[1], L[2], L[3], H[0], H[1], H[2], H[3]}
template <int KS> __device__ __forceinline__ void a_step(f32x16& yr, f32x16& yi, int vb, const bf16x8 (&ar)[16], const bf16x8 (&ai)[16]) {
    const s16x4 l = tr_read<KS * 2048>(vb), h = tr_read<KS * 2048 + 1024>(vb);
    asm volatile("s_waitcnt lgkmcnt(0)" ::: "memory"); __builtin_amdgcn_sched_barrier(0);
    const bf16x8 bb = FOU_PK(l, h);
    yr = __builtin_amdgcn_mfma_f32_32x32x16_bf16(ar[KS], bb, yr, 0, 0, 0); yi = __builtin_amdgcn_mfma_f32_32x32x16_bf16(ai[KS], bb, yi, 0, 0, 0);
}
__device__ __forceinline__ void stage_a(unsigned char* ws, int bg, int n2, LAS unsigned char* lds, int tid) {
    const int b = bg >> 2, g = bg & 3, lane = tid & 63, w = tid >> 6, r32 = lane & 31, hi = lane >> 5;
    const bf16_t* PXb = (const bf16_t*)(ws + WS_PX) + (size_t)b * SEQ * PXW + 768 + g * 128;
#pragma unroll
    for (int i = 0; i < 4; ++i) { const int q = tid + NTHR * i, kk = q >> 3, jc = (q & 7) * 8, n1 = kk & 127, isq = kk >> 7;
        const bf16x8 v = __builtin_nontemporal_load((const bf16x8*)(PXb + (size_t)(64 * n1 + n2) * PXW + isq * 64 + jc)); *(LAS bf16x8*)(lds + img_off(kk, jc)) = v; }
    const int kb = w & 3, d0 = w >> 2;
    bf16x8 ar[16], ai[16];
    { const bf16_t* gar = (const bf16_t*)(ws + WS_GA) + (size_t)(kb * 32 + r32) * 256 + 8 * hi; const bf16_t* gai = gar + 128 * 256;
#pragma unroll
      for (int k = 0; k < 16; ++k) { ar[k] = *(const bf16x8*)(gar + k * 16); ai[k] = *(const bf16x8*)(gai + k * 16); } }
    __syncthreads();
    const int vb = (int)(uintptr_t)lds + rd_base(lane) + d0 * 512;
    f32x16 yr = {0}, yi = {0};
    a_step<0>(yr, yi, vb, ar, ai); a_step<1>(yr, yi, vb, ar, ai); a_step<2>(yr, yi, vb, ar, ai); a_step<3>(yr, yi, vb, ar, ai);
    a_step<4>(yr, yi, vb, ar, ai); a_step<5>(yr, yi, vb, ar, ai); a_step<6>(yr, yi, vb, ar, ai); a_step<7>(yr, yi, vb, ar, ai);
    a_step<8>(yr, yi, vb, ar, ai); a_step<9>(yr, yi, vb, ar, ai); a_step<10>(yr, yi, vb, ar, ai); a_step<11>(yr, yi, vb, ar, ai);
    a_step<12>(yr, yi, vb, ar, ai); a_step<13>(yr, yi, vb, ar, ai); a_step<14>(yr, yi, vb, ar, ai); a_step<15>(yr, yi, vb, ar, ai);
    const float2* tw = (const float2*)(ws + WS_FTAB); bf16_t* FT = (bf16_t*)(ws + WS_FT);
#pragma unroll
    for (int r = 0; r < 16; ++r) { const int k1 = kb * 32 + (r & 3) + 8 * (r >> 2) + 4 * hi; const float2 t = tw[(n2 * k1) & 8191];
        bf16_t* dst = FT + (((size_t)bg * 128 + k1) * 64 + n2) * 128 + d0 * 32 + r32;
        dst[0] = (bf16_t)f2bf(t.x * yr[r] + t.y * yi[r]); dst[64] = (bf16_t)f2bf(t.x * yi[r] - t.y * yr[r]); }
    __syncthreads();
}
template <int KS> __device__ __forceinline__ void b_step(f32x16 (&acc)[2][2], int vb, const bf16x8 (&g0)[8], const bf16x8 (&g1)[8]) {
    const s16x4 l0 = tr_read<KS * 2048>(vb), h0 = tr_read<KS * 2048 + 1024>(vb), l1 = tr_read<KS * 2048 + 512>(vb), h1 = tr_read<KS * 2048 + 1536>(vb);
    asm volatile("s_waitcnt lgkmcnt(0)" ::: "memory"); __builtin_amdgcn_sched_barrier(0);
    const bf16x8 b0 = FOU_PK(l0, h0), b1 = FOU_PK(l1, h1);
    acc[0][0] = __builtin_amdgcn_mfma_f32_32x32x16_bf16(g0[KS], b0, acc[0][0], 0, 0, 0); acc[0][1] = __builtin_amdgcn_mfma_f32_32x32x16_bf16(g0[KS], b1, acc[0][1], 0, 0, 0);
    acc[1][0] = __builtin_amdgcn_mfma_f32_32x32x16_bf16(g1[KS], b0, acc[1][0], 0, 0, 0); acc[1][1] = __builtin_amdgcn_mfma_f32_32x32x16_bf16(g1[KS], b1, acc[1][1], 0, 0, 0);
}
__device__ __forceinline__ void stage_b(unsigned char* ws, int bg, int k1base, LAS unsigned char* lds, int tid) {
    const int b = bg >> 2, g = bg & 3, lane = tid & 63, w = tid >> 6, r32 = lane & 31, hi = lane >> 5, k1 = k1base + w;
    const bf16_t* src = (const bf16_t*)(ws + WS_FT) + ((size_t)bg * 128 + k1) * 64 * 128;
    LAS unsigned char* my = lds + w * 16384;
#pragma unroll
    for (int i = 0; i < 16; ++i) { const int q = lane + 64 * i, kk = q >> 3, jc = (q & 7) * 8; const bf16x8 v = __builtin_nontemporal_load((const bf16x8*)(src + q * 8)); *(LAS bf16x8*)(my + img_off(kk, jc)) = v; }
    bf16x8 g0[8], g1[8];
    { const bf16_t* gb = (const bf16_t*)(ws + WS_GB) + (size_t)r32 * 128 + 8 * hi;
#pragma unroll
      for (int k = 0; k < 8; ++k) { g0[k] = *(const bf16x8*)(gb + k * 16); g1[k] = *(const bf16x8*)(gb + 32 * 128 + k * 16); } }
    asm volatile("s_waitcnt lgkmcnt(0)" ::: "memory"); __builtin_amdgcn_sched_barrier(0);
    const int vb = (int)(uintptr_t)my + rd_base(lane);
    f32x16 acc[2][2] = {};
    b_step<0>(acc, vb, g0, g1); b_step<1>(acc, vb, g0, g1); b_step<2>(acc, vb, g0, g1); b_step<3>(acc, vb, g0, g1); b_step<4>(acc, vb, g0, g1); b_step<5>(acc, vb, g0, g1); b_step<6>(acc, vb, g0, g1); b_step<7>(acc, vb, g0, g1);
    bf16_t* MIXA = (bf16_t*)(ws + WS_MIXA);
#pragma unroll
    for (int rb = 0; rb < 2; ++rb)
#pragma unroll
        for (int r = 0; r < 16; ++r) { const int k2 = rb * 32 + (r & 3) + 8 * (r >> 2) + 4 * hi; bf16_t* dst = MIXA + ((size_t)b * SEQ + k1 + 128 * k2) * D + 768 + g * 64 + r32;
            dst[0] = (bf16_t)f2bf(acc[rb][0][r]); dst[32] = (bf16_t)f2bf(acc[rb][1][r]); }
}
#undef FOU_PK
}


#define XB_TMO      128
#define XB_XCNT(j)  (256  + 64 * (j))
#define XB_XSUB(j)  (1280 + 64 * (j))
#define XB_XGEN(j)  (2304 + 64 * (j))
#define XB_TOP      3328
#define XB_TOPGEN   3392
#define XCD_BAR_WORDS 3456
#define XB_SPIN_CAP (1u << 18)
__device__ __forceinline__ unsigned xb_ld(unsigned* p)              { return __hip_atomic_load(p, __ATOMIC_RELAXED, __HIP_MEMORY_SCOPE_AGENT); }
__device__ __forceinline__ unsigned xb_add(unsigned* p, unsigned v) { return __hip_atomic_fetch_add(p, v, __ATOMIC_RELAXED, __HIP_MEMORY_SCOPE_AGENT); }
__device__ __forceinline__ unsigned xb_xcc_id() { return (unsigned)__builtin_amdgcn_s_getreg((3 << 11) | 20) & 0xFu; }
#define XB_SPIN(cond, bar) do { unsigned _sp = 0; while (cond) { __builtin_amdgcn_s_sleep(1); \
    if ((++_sp & 255u) == 0u) { if (xb_ld(&(bar)[XB_TMO])) break; if (_sp > XB_SPIN_CAP) { atomicAdd(&(bar)[XB_TMO], 1u); break; } } } } while (0)
struct XcdBarrier { unsigned* bar; unsigned x; volatile LAS unsigned* st; };
__device__ __forceinline__ XcdBarrier xcd_barrier_post(unsigned* bar, volatile LAS unsigned* st) {
    XcdBarrier b; b.bar = bar; b.x = xb_xcc_id(); b.st = st;
    if (threadIdx.x == 0) (void)xb_add(&bar[XB_XCNT(b.x)], 1u);
    return b;
}
__device__ __forceinline__ void xcd_barrier_complete(unsigned* bar, unsigned x, unsigned& nloc, unsigned& nx) {
    const unsigned G = gridDim.x * gridDim.y * gridDim.z;
    unsigned sum, cnt, mine, sp = 0u;
    for (;;) {
        sum = 0u; cnt = 0u; mine = 0u;
#pragma unroll
        for (unsigned j = 0; j < 16; ++j) { const unsigned c = xb_ld(&bar[XB_XCNT(j)]); sum += c; cnt += (c > 0u) ? 1u : 0u; mine = (j == x) ? c : mine; }
        if (sum == G) break;
        __builtin_amdgcn_s_sleep(1);
        if ((++sp & 255u) == 0u) { if (xb_ld(&bar[XB_TMO])) break; if (sp > XB_SPIN_CAP) { atomicAdd(&bar[XB_TMO], 1u); break; } }
    }
    nloc = mine > 0u ? mine : 1u; nx = cnt > 0u ? cnt : 1u;
}
__device__ __forceinline__ void xcd_barrier(const XcdBarrier& b) {
    asm volatile("s_waitcnt vmcnt(0)" ::: "memory");
    __syncthreads();
    if (threadIdx.x == 0) {
        unsigned* bar = b.bar;
        __builtin_amdgcn_s_waitcnt(0);
        unsigned nloc = b.st[0], nx = b.st[1];
        if (nloc == 0u) { xcd_barrier_complete(bar, b.x, nloc, nx); b.st[0] = nloc; b.st[1] = nx; }
        const unsigned old = xb_add(&bar[XB_XSUB(b.x)], 1u);
        const unsigned gen = old / nloc;
        if (old + 1u == (gen + 1u) * nloc) {
            __builtin_amdgcn_fence(__ATOMIC_RELEASE, "agent");
            asm volatile("s_waitcnt vmcnt(0)" ::: "memory");
            const unsigned og = xb_add(&bar[XB_TOP], 1u);
            const unsigned tg = og / nx;
            if (og + 1u == (tg + 1u) * nx) xb_add(&bar[XB_TOPGEN], 1u);
            else XB_SPIN(xb_ld(&bar[XB_TOPGEN]) == tg, bar);
            __builtin_amdgcn_fence(__ATOMIC_ACQUIRE, "agent");
            xb_add(&bar[XB_XGEN(b.x)], 1u);
            asm volatile("s_waitcnt vmcnt(0)" ::: "memory");
        } else {
            XB_SPIN(xb_ld(&bar[XB_XGEN(b.x)]) == gen, bar);
            __builtin_amdgcn_fence(__ATOMIC_ACQUIRE, "agent");
            asm volatile("s_waitcnt vmcnt(0)" ::: "memory");
        }
    }
    __syncthreads();
}

enum { PH_PREP = 0, PH_MODUL = 1, PH_INPROJ = 2, PH_ROW1 = 3, PH_QKV = 4, PH_ATTN = 5, PH_ACOMB = 6, PH_OUTPROJ = 7, PH_ROW2 = 8, PH_LIST = 9, PH_MOE1 = 10, PH_MOE2 = 11, PH_FINAL = 12, NPH = 13 };
__global__ void __launch_bounds__(NTHR, 2) mega(P p) {
    extern __shared__ __attribute__((aligned(16))) unsigned char lds_raw[];
    LAS unsigned char* lds = (LAS unsigned char*)lds_raw;
    const int wg = blockIdx.x, nwg = gridDim.x;
    const int lo = p.ph_lo, hi = p.ph_hi;
    int wv = __builtin_amdgcn_readfirstlane((int)(threadIdx.x >> 6)); asm volatile("" : "+s"(wv));
    if (threadIdx.x == 0) { ((volatile LAS unsigned*)(lds + LDS_CTL))[0] = 0u; ((volatile LAS unsigned*)(lds + LDS_CTL))[1] = 0u; }
    __syncthreads();
    XcdBarrier bar; bar.bar = (unsigned*)(p.ws + WS_CTL) + 4096; bar.x = 0; bar.st = (volatile LAS unsigned*)(lds + LDS_CTL);
    if (hi - lo > 1) bar = xcd_barrier_post((unsigned*)(p.ws + WS_CTL) + 4096, (volatile LAS unsigned*)(lds + LDS_CTL));
#define SEAM(k) do { if (lo <= (k) && (k) + 1 < hi) xcd_barrier(bar); } while (0)
#ifndef PHMASK
#define PHMASK 0xFFFF
#endif
#define IN(k) (((PHMASK >> (k)) & 1) && lo <= (k) && (k) < hi)
    unsigned char* ws = p.ws;
#ifndef REPMASK
#define REPMASK 0
#endif
#define PHASE(k, ...) do { if (IN(k)) { _Pragma("unroll") for (int rep_ = 0; rep_ < 1 + ((REPMASK >> (k)) & 1); ++rep_) { if (rep_) xcd_barrier(bar); __VA_ARGS__ } } SEAM(k); } while (0)
    PHASE(PH_PREP, ph_prologue(p, wg, nwg, fresh_tid(wv), lds););
    PHASE(PH_MODUL, ph_modulate(p, wg, nwg, fresh_tid(wv)););
    PHASE(PH_INPROJ, { const pg8::DenseSched S{MA / 256, PXW / 256, nwg, wg, D, D, 0, (const char*)(ws + WS_WIN)}; const pg8::EpiRowMajor E{(bf16_t*)(ws + WS_PX), PXW};
        pg8::gemm_phase(lds, fresh_tid(wv), (const char*)(ws + WS_HX), D, S, E);
        if (nwg == NWG && wg >= 74) p0_expert_items(p, NEI_PREP + (wg - 74), 182, NEI_PREP + FILL_IN, fresh_tid(wv), (LAS float*)lds); });
    PHASE(PH_ROW1, { ph_row1(p, wg, nwg, fresh_tid(wv));
        { const int tid = fresh_tid(wv); __syncthreads(); for (int u = wg; u < 512; u += nwg) fou::stage_a(ws, u >> 6, u & 63, lds, tid); } });
    PHASE(PH_QKV, {
        { const int tid = fresh_tid(wv); for (int u = (wg + nwg / 2) % nwg; u < 128; u += nwg) fou::stage_b(ws, u >> 4, (u & 15) * 8, lds, tid); __syncthreads(); }
        { const pg8::DenseSched S{ML / 256, 5, nwg, wg, QL, PXW, 0, (const char*)(ws + WS_WQ)}; const pg8::EpiQ E{ws}; pg8::gemm_phase(lds, fresh_tid(wv), (const char*)(ws + WS_PX), QL, S, E); }
        { const pg8::DenseSched S{MA / 256, 6, nwg, wg, KVL, PXW, 512, (const char*)(ws + WS_WKV)}; const pg8::EpiKV E{ws}; pg8::gemm_phase(lds, fresh_tid(wv), (const char*)(ws + WS_PX), KVL, S, E); }
        if (nwg == NWG && wg >= 64) { const int tid = fresh_tid(wv); constexpr int QB = NEI_PREP + FILL_IN;
            if (wg < 128) p0_expert_items(p, QB + (wg - 64), 64, QB + 128, tid, (LAS float*)lds);
            else if (wg < 140) p0_expert_items(p, QB + 128 + (wg - 128), 12, QB + 140, tid, (LAS float*)lds);
            else { p0_expert_items(p, QB + 140 + (wg - 140), 116, QB + 372, tid, (LAS float*)lds);
                   if (wg <= 220) p0_expert_items(p, QB + 372 + (wg - 140), 81, QB + 453, tid, (LAS float*)lds); } } });
    static_assert(NEI_PREP + FILL_IN + 453 == NEI, "filler shares");
    PHASE(PH_ATTN, ph_attn(p, wg, nwg, lds, wv););
    PHASE(PH_ACOMB, ph_acomb(p, wg, nwg, fresh_tid(wv)););
    PHASE(PH_OUTPROJ, { const pg8::DenseSched S{ML / 256, D / 256, nwg, wg, D, D, 0, (const char*)(ws + WS_WOUT)}; const pg8::EpiRowMajor E{(bf16_t*)(ws + WS_MIX), D};
        pg8::gemm_phase(lds, fresh_tid(wv), (const char*)(ws + WS_MIXA), D, S, E); });
    PHASE(PH_ROW2, ph_row2(p, wg, nwg, fresh_tid(wv), lds););
    PHASE(PH_LIST, ph_lists(p, wg, nwg, fresh_tid(wv), lds););
    PHASE(PH_MOE1, { const int tid = fresh_tid(wv);
        LAS int* tileL = (LAS int*)(lds + LDS_CTL + 2048); LAS unsigned* lstL = (LAS unsigned*)(lds + LDS_CTL + 4096);
        const int* TILEE = (const int*)(ws + WS_TILEE); const int* SLOTTOK = (const int*)(ws + WS_SLOTTOK);
        for (int i = tid; i < MAXTILES; i += NTHR) tileL[i] = TILEE[i];
        if (tid == 0) tileL[300] = TILEE[400];
        __syncthreads();
        const pg8::MoeSched<8, true, MOE_FP8> S{nwg, wg, tileL, lstL, (const char*)(ws + WS_WGU), 2048};
        { pg8::GUnit u; for (int i = 0; i < 16 && S.next(i, u); ++i) if (tid < 256) lstL[i * 256 + tid] = (unsigned)SLOTTOK[u.arow + tid] * (MOE_FP8 ? 1024u : 2048u); }
        __syncthreads();
        if constexpr (MOE_FP8) { const pg8::EpiAct8 E{ws + WS_ACT, p.in[20], p.in[22], 1.f / WSCALE}; pg8::gemm_phase<pg8::EpiAct8, pg8::MoeSched<8, true, MOE_FP8>, true>(lds, tid, (const char*)(ws + WS_HX), D, S, E); }
        else { const pg8::EpiAct E{(bf16_t*)(ws + WS_ACT), p.in[20], p.in[22]}; pg8::gemm_phase(lds, fresh_tid(wv), (const char*)(ws + WS_HX), D, S, E); } });
    PHASE(PH_MOE2, { const int tid = fresh_tid(wv);
        LAS int* tileL = (LAS int*)(lds + LDS_CTL + 2048); LAS unsigned* lstL = (LAS unsigned*)(lds + LDS_CTL + 4096);
        const int* TILEE = (const int*)(ws + WS_TILEE);
        for (int i = tid; i < MAXTILES; i += NTHR) tileL[i] = TILEE[i];
        if (tid == 0) tileL[300] = TILEE[400];
        __syncthreads();
        const pg8::MoeSched<4, false, MOE_FP8> S{nwg, wg, tileL, lstL, (const char*)(ws + WS_WD), 1024};
        const pg8::EpiY8 E{ws + WS_Y, p.in[24], MOE_FP8 ? 1.f / WSCALE : 1.f};
        pg8::gemm_phase<pg8::EpiY8, pg8::MoeSched<4, false, MOE_FP8>, MOE_FP8>(lds, tid, (const char*)(ws + WS_ACT), D, S, E); });
    PHASE(PH_FINAL, ph_final(p, wg, nwg, fresh_tid(wv)););
#undef PHASE
#undef IN
#undef SEAM
}

extern "C" void kernel_launch(void* const* d_in, const int* in_sizes, int n_in, void* d_out, int out_size, void* d_ws, size_t ws_size, hipStream_t stream) {
    static int ok = 0;
    if (ok == 0) {
        if (n_in != 25 || in_sizes[0] != ML * D || out_size != ML * D || ws_size < WS_END) { fprintf(stderr, "kernel_launch: unexpected shapes (n_in %d, in0 %d, out %d, ws %zu < %zu)\n", n_in, n_in > 0 ? in_sizes[0] : -1, out_size, ws_size, (size_t)WS_END); ok = -1; return; }
        if (hipFuncSetAttribute((const void*)mega, hipFuncAttributeMaxDynamicSharedMemorySize, LDS_BYTES) != hipSuccess) { fprintf(stderr, "kernel_launch: hipFuncSetAttribute failed\n"); ok = -1; return; }
        int dev = 0, cus = 0, per_cu = 0;
        if (hipGetDevice(&dev) != hipSuccess || hipDeviceGetAttribute(&cus, hipDeviceAttributeMultiprocessorCount, dev) != hipSuccess) { fprintf(stderr, "kernel_launch: device query failed\n"); ok = -1; return; }
        if (hipOccupancyMaxActiveBlocksPerMultiprocessor(&per_cu, (const void*)mega, NTHR, LDS_BYTES) != hipSuccess || per_cu < 1) { fprintf(stderr, "kernel_launch: occupancy query says %d blocks per CU\n", per_cu); (void)hipGetLastError(); }
        if (cus != NWG) fprintf(stderr, "kernel_launch: %d CUs (built for %d)\n", cus, NWG);
        ok = cus < NWG ? cus : NWG;
    }
    if (ok < 0) return;
    const int grid = ok;
    (void)hipMemsetAsync((char*)d_ws + WS_CTL, 0, CTL_BYTES, stream);
    P p{}; for (int i = 0; i < 25; ++i) p.in[i] = (const float*)d_in[i]; p.out = (float*)d_out; p.ws = (unsigned char*)d_ws;
#define MEGA(a, b) do { p.ph_lo = (a); p.ph_hi = (b); hipLaunchKernelGGL(mega, dim3(grid), dim3(NTHR), LDS_BYTES, stream, p); } while (0)
#ifdef MULTI_LAUNCH
    for (int ph = 0; ph < NPH; ++ph) MEGA(ph, ph + 1);
#else
    MEGA(0, NPH);
#endif
#undef MEGA
    const hipError_t le = hipPeekAtLastError();
    if (le != hipSuccess) fprintf(stderr, "kernel_launch: launch failed: %s\n", hipGetErrorName(le));
}
```

```cpp
#include <hip/hip_runtime.h>
#include <cstdint>
#include <cstdio>

#define GAS __attribute__((address_space(1)))
#define LAS __attribute__((address_space(3)))
typedef unsigned short bf16_t;
typedef short bf16x8 __attribute__((ext_vector_type(8)));
typedef float f32x4 __attribute__((ext_vector_type(4)));
typedef float f32x16 __attribute__((ext_vector_type(16)));
typedef unsigned u32x4 __attribute__((ext_vector_type(4)));
typedef unsigned u32x2 __attribute__((ext_vector_type(2)));

constexpr int D = 1024, SEQ = 8192, CTXL = 256, NH = 6, DQK = 192, DNOPE = 128, DROPE = 64, DV = 128;
constexpr int QL = 384, KVL = 256;
constexpr int ML = 2 * SEQ, MC = 2 * CTXL, MA = ML + MC;
constexpr int TK = SEQ + CTXL;
constexpr int PXW = 1280;
constexpr int NE = 32, DFF = 1024;
constexpr int MAXTILES = 288, SLOTS = MAXTILES * 256;
constexpr float RMS_EPS = 1e-6f;
constexpr int NWG = 256, NTHR = 512;
#ifndef MOE_FP8_ON
#define MOE_FP8_ON 1
#endif
constexpr bool MOE_FP8 = MOE_FP8_ON;
constexpr float WSCALE = 32.f;

constexpr size_t KiB = 1024, MiB = 1024 * 1024;
constexpr size_t WS_CTL = 0, CTL_BYTES = 64 * KiB;
constexpr size_t WS_MOD = 1 * MiB;
constexpr size_t WS_ROPE = WS_MOD + 96 * KiB;
constexpr size_t WS_RSTAT = WS_ROPE + 16 * KiB;
constexpr size_t WS_TOPI = 1 * MiB + 256 * KiB;
constexpr size_t WS_GATE = WS_TOPI + 256 * KiB;
constexpr size_t WS_TOKSLOT = WS_GATE + 256 * KiB;
constexpr size_t WS_SLOTTOK = 2 * MiB;
constexpr size_t WS_CHCNT = WS_SLOTTOK + 320 * KiB;
constexpr size_t WS_TILEE = WS_CHCNT + 32 * KiB;
constexpr size_t WS_FTAB = WS_TILEE + 32 * KiB;
constexpr size_t WS_WRT = WS_FTAB + 64 * KiB;
constexpr size_t WS_GA = WS_WRT + 128 * KiB;
constexpr size_t WS_GB = WS_GA + 128 * KiB;
constexpr size_t WS_WIN = 4 * MiB;
constexpr size_t WS_WQ = 7 * MiB;
constexpr size_t WS_WKV = 8 * MiB;
constexpr size_t WS_WOUT = 9 * MiB;
constexpr size_t WS_WD = 16 * MiB;
constexpr size_t WS_WGU = 80 * MiB;
constexpr size_t WS_HX = 208 * MiB;
constexpr size_t WS_Y = 80 * MiB;
constexpr size_t WS_MIX = 242 * MiB;
constexpr size_t WS_ACT = 274 * MiB;
constexpr size_t WS_PX = 274 * MiB;
constexpr size_t WS_Q = 316 * MiB;
constexpr size_t WS_KN = 352 * MiB;
constexpr size_t WS_V = 377 * MiB;
constexpr size_t WS_KR = 402 * MiB;
constexpr size_t WS_FT = 405 * MiB;
constexpr size_t WS_MIXA = 421 * MiB;
constexpr size_t WS_OPART = 208 * MiB;
constexpr size_t WS_OML = 304 * MiB;
constexpr size_t WS_END = 453 * MiB;

constexpr int LDS_BYTES = 163840;
constexpr int LDS_CTL = 139264;

struct P { const float* in[25]; float* out; unsigned char* ws; int ph_lo, ph_hi; };

__device__ __forceinline__ unsigned f2bf(float f) { unsigned u = __float_as_uint(f); return (u + 0x7fffu + ((u >> 16) & 1u)) >> 16; }
__device__ __forceinline__ float bflo(unsigned w) { return __uint_as_float(w << 16); }
__device__ __forceinline__ float bfhi(unsigned w) { return __uint_as_float(w & 0xffff0000u); }
typedef __bf16 bf16x2c __attribute__((ext_vector_type(2)));
typedef float f32x2c __attribute__((ext_vector_type(2)));
__device__ __forceinline__ unsigned pk2(float lo, float hi) { const f32x2c v = {lo, hi}; return __builtin_bit_cast(unsigned, __builtin_convertvector(v, bf16x2c)); }
template <int CTRL, int RMASK, bool BC> __device__ __forceinline__ float dpp_mov(float v) { return __builtin_bit_cast(float, __builtin_amdgcn_update_dpp(0, __builtin_bit_cast(int, v), CTRL, RMASK, 0xf, BC)); }
__device__ __forceinline__ float wave_sum(float v) {
    v += dpp_mov<0x111, 0xf, true>(v); v += dpp_mov<0x112, 0xf, true>(v); v += dpp_mov<0x114, 0xf, true>(v); v += dpp_mov<0x118, 0xf, true>(v);
    v += dpp_mov<0x142, 0xa, false>(v); v += dpp_mov<0x143, 0xc, false>(v);
    return __builtin_bit_cast(float, __builtin_amdgcn_readlane(__builtin_bit_cast(int, v), 63));
}
__device__ __forceinline__ float wave_max(float v) {
#pragma unroll
    for (int o = 1; o < 64; o <<= 1) v = fmaxf(v, __shfl_xor(v, o));
    return v;
}
__device__ __forceinline__ int fresh_tid(int wv) { int t = (wv << 6) | (int)__builtin_amdgcn_mbcnt_hi(~0u, __builtin_amdgcn_mbcnt_lo(~0u, 0u)); asm volatile("" : "+v"(t)); return t; }
__device__ __forceinline__ unsigned pg8_pk4_fp8(f32x4 v) { int p = __builtin_amdgcn_cvt_pk_fp8_f32(v.x, v.y, 0, false); p = __builtin_amdgcn_cvt_pk_fp8_f32(v.z, v.w, p, true); return (unsigned)p; }
__device__ __forceinline__ f32x4 fp8x4(unsigned w) { const auto lo = __builtin_amdgcn_cvt_pk_f32_fp8((int)w, false), hi = __builtin_amdgcn_cvt_pk_f32_fp8((int)w, true); return (f32x4){lo[0], lo[1], hi[0], hi[1]}; }
__device__ __forceinline__ float dot4(f32x4 a, f32x4 b) { return (a.x * b.x + a.y * b.y) + (a.z * b.z + a.w * b.w); }

__device__ __forceinline__ void p0_mod_item(const P& p, int it, int tid, LAS float* scr) {
    LAS float* sl = scr;
    LAS float* part = scr + 3072;
    const float* c = p.in[1]; const float* cc = p.in[3]; const float* wm = p.in[4]; const float* bm = p.in[5];
    for (int i = tid; i < 3072; i += NTHR) { const int r = i >> 10, k = i & 1023; const float v = r < 2 ? c[r * 1024 + k] : cc[k]; sl[i] = v / (1.f + __expf(-v)); }
    __syncthreads();
    const int ks = tid >> 5, cidx = tid & 31, n0 = it * 24;
    if (cidx < 24) {
        float a0 = 0.f, a1 = 0.f, a2 = 0.f;
#pragma unroll 1
        for (int kq = 0; kq < 2; ++kq) { float wv[32];
#pragma unroll
            for (int k = 0; k < 32; ++k) wv[k] = __builtin_nontemporal_load(wm + (size_t)(ks * 64 + kq * 32 + k) * 6144 + n0 + cidx);
#pragma unroll
            for (int k = 0; k < 32; ++k) { const float w = wv[k]; const int kk = ks * 64 + kq * 32 + k; a0 += sl[kk] * w; a1 += sl[1024 + kk] * w; a2 += sl[2048 + kk] * w; } }
        part[(ks * 3 + 0) * 24 + cidx] = a0; part[(ks * 3 + 1) * 24 + cidx] = a1; part[(ks * 3 + 2) * 24 + cidx] = a2;
    }
    __syncthreads();
    if (tid < 72) { const int r = tid / 24, cx = tid % 24; float s = bm[n0 + cx];
        for (int k = 0; k < 16; ++k) s += part[(k * 3 + r) * 24 + cx];
        ((float*)(p.ws + WS_MOD))[r * 6144 + n0 + cx] = s; }
    __syncthreads();
}
__device__ __forceinline__ void p0_misc_item(const P& p, int r, int tid) {
    const double TWO_PI = 6.283185307179586476925;
    if (r == 0) {
        float* ct = (float*)(p.ws + WS_ROPE); float* st = ct + 2048;
        for (int i = tid; i < 2048; i += NTHR) { const int pos = i >> 4, j = i & 15; const double inv = pow(10000.0, -(2.0 * j) / 32.0); const double a = (double)pos * inv; ct[i] = (float)cos(a); st[i] = (float)sin(a); }
        const float* wr = p.in[17]; bf16_t* wrh = (bf16_t*)(p.ws + WS_WRT); bf16_t* wrl = wrh + 32768;
        for (int i = tid; i < 32768; i += NTHR) { const int k = i >> 5, e = i & 31; const float w = wr[i]; const unsigned hb = f2bf(w); wrh[e * 1024 + k] = (bf16_t)hb; wrl[e * 1024 + k] = (bf16_t)f2bf(w - __uint_as_float(hb << 16)); }
    } else if (r == 1) {
        for (int i = tid; i < 8192; i += NTHR) { const double a = TWO_PI * i / 8192.0; ((float2*)(p.ws + WS_FTAB))[i] = make_float2((float)cos(a), (float)sin(a)); }
    } else if (r < 6) {
        bf16_t* GA = (bf16_t*)(p.ws + WS_GA);
        for (int i = tid; i < 64 * 256; i += NTHR) { const int row = (r - 2) * 64 + (i >> 8), kk = i & 255, c = row >> 7, k1 = row & 127, n1 = kk & 127, isq = kk >> 7;
            const double a = TWO_PI * ((n1 * k1) & 127) / 128.0; const double cs = cos(a), sn = sin(a);
            const double v = c == 0 ? (isq ? -sn : cs) : (isq ? -cs : -sn); GA[row * 256 + kk] = (bf16_t)f2bf((float)v); }
    } else {
        bf16_t* GB = (bf16_t*)(p.ws + WS_GB);
        for (int i = tid; i < 64 * 128; i += NTHR) { const int k2 = i >> 7, kk = i & 127, n2 = kk >> 1, c = kk & 1; const double a = TWO_PI * ((k2 * n2) & 63) / 64.0;
            GB[i] = (bf16_t)f2bf((float)(c ? sin(a) : cos(a))); }
    }
}
template <class CM>
__device__ __forceinline__ void p0_xpose_item(const CM& cm, int ldn, const float* gain, int k0, bf16_t* dst, int Kd, int nd0, int tid, LAS float* scr) {
    f32x4 v[8];
#pragma unroll
    for (int i = 0; i < 8; ++i) { const int q = tid + NTHR * i, k = q >> 6, n = (q & 63) * 4; const float* sp = cm(nd0 + n);
        v[i] = sp ? *(const f32x4*)(sp + (size_t)(k0 + k) * ldn) : (f32x4){0.f, 0.f, 0.f, 0.f}; }
#pragma unroll
    for (int i = 0; i < 8; ++i) { const int q = tid + NTHR * i, k = q >> 6, n = (q & 63) * 4; const float g = gain ? gain[k0 + k] : 1.f;
        LAS float* d = scr + k * 257 + n; d[0] = v[i].x * g; d[1] = v[i].y * g; d[2] = v[i].z * g; d[3] = v[i].w * g; }
    __syncthreads();
#pragma unroll
    for (int i = 0; i < 4; ++i) { const int q = tid + NTHR * i, n = q >> 3, kc = q & 7; const LAS float* s = scr + (kc * 8) * 257 + n;
        u32x4 o; o.x = pk2(s[0], s[257]); o.y = pk2(s[2 * 257], s[3 * 257]); o.z = pk2(s[4 * 257], s[5 * 257]); o.w = pk2(s[6 * 257], s[7 * 257]);
        *(u32x4*)(dst + (size_t)(nd0 + n) * Kd + k0 + kc * 8) = o; }
    __syncthreads();
}
struct CmWin { const float* w; __device__ const float* operator()(int n) const { return n < 384 ? w + 256 + n : (n < 448 ? w + 896 + (n - 384) : (n < 512 ? nullptr : w + 640 + (n - 512))); } };
struct CmPlain { const float* w; int nmax; __device__ const float* operator()(int n) const { return n < nmax ? w + n : nullptr; } };
struct CmGU { const float* g; const float* u; int pn; __device__ const float* operator()(int n) const { const int j = n & 255; return j < 128 ? g + 128 * pn + j : u + 128 * pn + (j - 128); } };
__device__ __forceinline__ void p0_fold_item(const P& p, int g, int kb, int tid, LAS float* scr) {
    LAS float* Mg = scr;
    LAS float* wb = scr + 8192;
    LAS float* cs = scr + 8192 + 4160;
    const float* wf = p.in[15] + g * 4096; const float* win = p.in[10];
    if (tid < 64) { const double a = 6.283185307179586476925 * tid / 64.0; cs[tid] = (float)cos(a); cs[64 + tid] = (float)sin(a); }
    __syncthreads();
    const float sinv = 1.0f / 724.0773439350246f;
    for (int i = 0; i < 16; ++i) { const int e = tid + NTHR * i, c = e >> 7, jj = e & 127, j = jj & 63, isq = jj >> 6; float s = 0.f;
        for (int m = 0; m < 64; ++m) s += cs[isq * 64 + ((m * c) & 63)] * wf[m * 64 + j];
        Mg[c * 128 + jj] = s * sinv; }
    for (int i = 0; i < 8; ++i) { const int e = tid + NTHR * i, k = e >> 6, c = e & 63; wb[k * 65 + c] = win[(size_t)(kb * 64 + k) * 960 + g * 64 + c]; }
    __syncthreads();
    const int jj = tid >> 2, kq = tid & 3; float acc[16];
#pragma unroll
    for (int i = 0; i < 16; ++i) acc[i] = 0.f;
    for (int c = 0; c < 64; ++c) { const float mv = Mg[c * 128 + jj];
#pragma unroll
        for (int i = 0; i < 16; ++i) acc[i] += wb[(kq * 16 + i) * 65 + c] * mv; }
    bf16_t* dst = (bf16_t*)(p.ws + WS_WIN) + (size_t)(768 + g * 128 + jj) * 1024 + kb * 64 + kq * 16;
    u32x4 o0, o1; o0.x = pk2(acc[0], acc[1]); o0.y = pk2(acc[2], acc[3]); o0.z = pk2(acc[4], acc[5]); o0.w = pk2(acc[6], acc[7]);
    o1.x = pk2(acc[8], acc[9]); o1.y = pk2(acc[10], acc[11]); o1.z = pk2(acc[12], acc[13]); o1.w = pk2(acc[14], acc[15]);
    *(u32x4*)dst = o0; *(u32x4*)(dst + 8) = o1;
    __syncthreads();
}
constexpr int I_WGU = 32 * 8 * 2 * 8, I_WD = 32 * 8 * 8, NEI = I_WGU + I_WD;
constexpr int FILL_IN = 182 * 4, FILL_Q = 128 + 12 + 232 + 81, NEI_PREP = NEI - FILL_IN - FILL_Q;
template <bool DYN = false>
__device__ __forceinline__ void p0_expert_items(const P& p, int first, int step, int end, int tid, LAS float* scr, unsigned* ctr = nullptr) {
        constexpr int XS = 129;
        f32x4 v[8];
#define P0_ISSUE(r_) do { const int r = (r_); const float* s0; int k0; \
            if (r < I_WGU) { const int e = r >> 7, t = (r >> 3) & 15, pn = t >> 1, hf = t & 1; k0 = (r & 7) * 128; s0 = (hf ? p.in[21] : p.in[19]) + (size_t)e * 1048576 + 128 * pn; } \
            else { const int q = r - I_WGU, e = q >> 6, nb = (q >> 3) & 7; k0 = (q & 7) * 128; s0 = p.in[23] + (size_t)e * 1048576 + nb * 128; } \
            _Pragma("unroll") for (int i = 0; i < 8; ++i) { const int q = tid + NTHR * i, k = q >> 5, n = (q & 31) * 4; v[i] = __builtin_nontemporal_load((const f32x4*)(s0 + (size_t)(k0 + k) * 1024 + n)); } } while (0)
        int it = first; LAS float* const scr0 = scr; int par = 0;
        LAS int* const nxw = (LAS int*)((LAS unsigned char*)scr0 + LDS_CTL + 128); unsigned pend = 0;
        if constexpr (DYN) { if (tid == 0) { nxw[0] = (int)__hip_atomic_fetch_add(ctr, 1u, __ATOMIC_RELAXED, __HIP_MEMORY_SCOPE_AGENT); pend = __hip_atomic_fetch_add(ctr, 1u, __ATOMIC_RELAXED, __HIP_MEMORY_SCOPE_AGENT); }
            __syncthreads(); it = nxw[0]; __syncthreads(); }
        if (it < end) P0_ISSUE(it);
        for (; it < end; par ^= 1) {
            int nx = it + step;
            scr = scr0 + par * (128 * XS);
#pragma unroll
            for (int i = 0; i < 8; ++i) { const int q = tid + NTHR * i, k = q >> 5, n = (q & 31) * 4; LAS float* d = scr + k * XS + ((n + 8 * (k >> 4)) & 127); d[0] = v[i].x; d[1] = v[i].y; d[2] = v[i].z; d[3] = v[i].w; }
            if constexpr (DYN) { if (tid == 0) { nxw[par] = (int)pend; pend = __hip_atomic_fetch_add(ctr, 1u, __ATOMIC_RELAXED, __HIP_MEMORY_SCOPE_AGENT); } }
            __syncthreads();
            if constexpr (DYN) nx = nxw[par];
            if (nx < end) P0_ISSUE(nx);
            size_t drow; int k0;
            if (it < I_WGU) { const int e = it >> 7, t = (it >> 3) & 15, pn = t >> 1, hf = t & 1; k0 = (it & 7) * 128; drow = (size_t)e * 2048 + pn * 256 + hf * 128; }
            else { const int q = it - I_WGU, e = q >> 6, nb = (q >> 3) & 7; k0 = (q & 7) * 128; drow = (size_t)e * 1024 + nb * 128; }
            if constexpr (MOE_FP8) {
                unsigned char* dst = (unsigned char*)(p.ws + (it < I_WGU ? WS_WGU : WS_WD)) + drow * 1024 + k0;
#pragma unroll
                for (int i = 0; i < 2; ++i) { const int q = tid + NTHR * i, n = q >> 3, kc = q & 7; const LAS float* s = scr + (kc * 16) * XS + ((n + 8 * kc) & 127); u32x4 o;
                    o.x = pg8_pk4_fp8((f32x4){s[0], s[XS], s[2 * XS], s[3 * XS]} * WSCALE); o.y = pg8_pk4_fp8((f32x4){s[4 * XS], s[5 * XS], s[6 * XS], s[7 * XS]} * WSCALE);
                    o.z = pg8_pk4_fp8((f32x4){s[8 * XS], s[9 * XS], s[10 * XS], s[11 * XS]} * WSCALE); o.w = pg8_pk4_fp8((f32x4){s[12 * XS], s[13 * XS], s[14 * XS], s[15 * XS]} * WSCALE);
                    __builtin_nontemporal_store(o, (u32x4*)(dst + (size_t)n * 1024 + kc * 16)); }
            } else {
                bf16_t* dst = (bf16_t*)(p.ws + (it < I_WGU ? WS_WGU : WS_WD)) + drow * 1024 + k0;
#pragma unroll
                for (int i = 0; i < 4; ++i) { const int q = tid + NTHR * i, n = q >> 4, kc = q & 15; const LAS float* s = scr + (kc * 8) * XS + ((n + 8 * (kc >> 1)) & 127);
                    u32x4 o; o.x = pk2(s[0], s[XS]); o.y = pk2(s[2 * XS], s[3 * XS]); o.z = pk2(s[4 * XS], s[5 * XS]); o.w = pk2(s[6 * XS], s[7 * XS]);
                    *(u32x4*)(dst + (size_t)n * 1024 + kc * 8) = o; }
            }
            it = nx;
        }
        __syncthreads();
#undef P0_ISSUE
}
__device__ __forceinline__ void ph_prologue(const P& p, int wg, int nwg, int tid, LAS unsigned char* lds) {
    LAS float* scr = (LAS float*)lds;
    constexpr int I_MOD = 256, I_MISC = 7, I_FOLD = 64, I_WIN = 3 * 16, I_WQ = 5 * 6, I_WKV = 6 * 4, I_WOUT = 4 * 16;
    constexpr int NIT = I_MOD + I_MISC + I_FOLD + I_WIN + I_WQ + I_WKV + I_WOUT;
    for (int it = wg; it < NIT; it += nwg) {
        int r = it;
        if (r < I_MOD) { p0_mod_item(p, r, tid, scr); continue; } r -= I_MOD;
        if (r < I_MISC) { p0_misc_item(p, r, tid); continue; } r -= I_MISC;
        if (r < I_FOLD) { p0_fold_item(p, r >> 4, r & 15, tid, scr); continue; } r -= I_FOLD;
        if (r < I_WIN) { CmWin cm{p.in[10]}; p0_xpose_item(cm, 960, nullptr, (r & 15) * 64, (bf16_t*)(p.ws + WS_WIN), 1024, (r >> 4) * 256, tid, scr); continue; } r -= I_WIN;
        if (r < I_WQ) { CmPlain cm{p.in[13], 1152}; p0_xpose_item(cm, 1152, p.in[11], (r % 6) * 64, (bf16_t*)(p.ws + WS_WQ), 384, (r / 6) * 256, tid, scr); continue; } r -= I_WQ;
        if (r < I_WKV) { CmPlain cm{p.in[14], 1536}; p0_xpose_item(cm, 1536, p.in[12], (r & 3) * 64, (bf16_t*)(p.ws + WS_WKV), 256, (r >> 2) * 256, tid, scr); continue; } r -= I_WKV;
        if (r < I_WOUT) { CmPlain cm{p.in[16], 1024}; p0_xpose_item(cm, 1024, nullptr, (r & 15) * 64, (bf16_t*)(p.ws + WS_WOUT), 1024, (r >> 4) * 256, tid, scr); continue; } r -= I_WOUT;
    }
    p0_expert_items<true>(p, wg, nwg, nwg == NWG ? NEI_PREP : NEI, tid, scr, (unsigned*)(p.ws + WS_CTL) + 64);
}

template <int NR> __device__ __forceinline__ void modul_rows(const float* const (&rows)[NR], bf16_t* const (&outs)[NR], const f32x4 (&a)[4], const f32x4 (&sh)[4], int lane) {
    f32x4 v[NR][4];
#pragma unroll
    for (int r = 0; r < NR; ++r)
#pragma unroll
        for (int j = 0; j < 4; ++j) v[r][j] = __builtin_nontemporal_load((const f32x4*)(rows[r] + 4 * lane + 256 * j));
#pragma unroll
    for (int r = 0; r < NR; ++r) { float ss = 0.f;
#pragma unroll
        for (int j = 0; j < 4; ++j) ss += dot4(v[r][j], v[r][j]);
        const float rinv = rsqrtf(wave_sum(ss) * (1.f / D) + RMS_EPS);
#pragma unroll
        for (int j = 0; j < 4; ++j) { const f32x4 o = v[r][j] * rinv * a[j] + sh[j]; u32x2 w; w.x = pk2(o.x, o.y); w.y = pk2(o.z, o.w); *(u32x2*)(outs[r] + 4 * lane + 256 * j) = w; } }
}
__device__ __forceinline__ void ph_modulate(const P& p, int wg, int nwg, int tid) {
    const int lane = tid & 63, wave = tid >> 6;
    const float* x = p.in[0]; const float* ctx = p.in[2]; const float* gain = p.in[6];
    const float* MOD = (const float*)(p.ws + WS_MOD); bf16_t* HX = (bf16_t*)(p.ws + WS_HX);
    for (int ch = wg; ch < 256; ch += nwg) {
        f32x4 a[4], sh[4];
        { const int r = ch >> 7;
#pragma unroll
          for (int j = 0; j < 4; ++j) { const int c = 4 * lane + 256 * j; sh[j] = *(const f32x4*)(MOD + r * 6144 + c); a[j] = *(const f32x4*)(gain + c) * (*(const f32x4*)(MOD + r * 6144 + 1024 + c) + 1.f); } }
#pragma unroll
        for (int q = 0; q < 2; ++q) { const int m0 = ch * 64 + wave * 8 + q * 4;
            const float* const rows[4] = {x + (size_t)m0 * D, x + (size_t)(m0 + 1) * D, x + (size_t)(m0 + 2) * D, x + (size_t)(m0 + 3) * D};
            bf16_t* const outs[4] = {HX + (size_t)m0 * D, HX + (size_t)(m0 + 1) * D, HX + (size_t)(m0 + 2) * D, HX + (size_t)(m0 + 3) * D};
            modul_rows<4>(rows, outs, a, sh, lane); }
        if (wave == 7) {
#pragma unroll
            for (int j = 0; j < 4; ++j) { const int c = 4 * lane + 256 * j; sh[j] = *(const f32x4*)(MOD + 2 * 6144 + c); a[j] = *(const f32x4*)(gain + c) * (*(const f32x4*)(MOD + 2 * 6144 + 1024 + c) + 1.f); }
            const int c0 = ch * 2;
            const float* const rows[2] = {ctx + (size_t)c0 * D, ctx + (size_t)(c0 + 1) * D};
            bf16_t* const outs[2] = {HX + (size_t)(ML + c0) * D, HX + (size_t)(ML + c0 + 1) * D};
            modul_rows<2>(rows, outs, a, sh, lane); }
    }
}

template <int NR> __device__ __forceinline__ void row1_rows(const P& p, const int (&ms)[NR], int lane) {
    const bf16_t* PX = (const bf16_t*)(p.ws + WS_PX); float* RS = (float*)(p.ws + WS_RSTAT); bf16_t* KR = (bf16_t*)(p.ws + WS_KR);
    const float* ct = (const float*)(p.ws + WS_ROPE); const float* st = ct + 2048;
    u32x4 c0[NR], c1[NR];
#pragma unroll
    for (int r = 0; r < NR; ++r) { const bf16_t* pr = PX + (size_t)ms[r] * PXW; c0[r] = *(const u32x4*)(pr + 8 * lane); c1[r] = *(const u32x4*)(pr + 512 + 8 * (lane & 31)); }
#pragma unroll
    for (int r = 0; r < NR; ++r) { const int m = ms[r];
        float v[8]; v[0] = bflo(c0[r].x); v[1] = bfhi(c0[r].x); v[2] = bflo(c0[r].y); v[3] = bfhi(c0[r].y); v[4] = bflo(c0[r].z); v[5] = bfhi(c0[r].z); v[6] = bflo(c0[r].w); v[7] = bfhi(c0[r].w);
        float sq = 0.f; if (lane < 48) { for (int j = 0; j < 8; ++j) sq += v[j] * v[j]; }
        float skv = 0.f; if (lane < 32) { const float t0 = bflo(c1[r].x), t1 = bfhi(c1[r].x), t2 = bflo(c1[r].y), t3 = bfhi(c1[r].y), t4 = bflo(c1[r].z), t5 = bfhi(c1[r].z), t6 = bflo(c1[r].w), t7 = bfhi(c1[r].w);
            skv = (t0 * t0 + t1 * t1) + (t2 * t2 + t3 * t3) + (t4 * t4 + t5 * t5) + (t6 * t6 + t7 * t7); }
        const float rq = rsqrtf(wave_sum(sq) * (1.f / QL) + RMS_EPS), rkv = rsqrtf(wave_sum(skv) * (1.f / KVL) + RMS_EPS);
        if (lane == 0) { RS[2 * m] = rq; RS[2 * m + 1] = rkv; }
        if (lane >= 48 && lane < 56) {
            const int d0 = (lane - 48) * 8; int b, tt;
            if (m < ML) { b = m >> 13; tt = m & 8191; const int prow = tt >> 6, pcol = tt & 63;
#pragma unroll
                for (int q = 0; q < 4; ++q) { const int pi = (d0 >> 1) + q; const int pos = pi < 16 ? prow : pcol, j = pi & 15; const float c = ct[pos * 16 + j], s = st[pos * 16 + j];
                    const float e = v[2 * q], o = v[2 * q + 1]; v[2 * q] = e * c - o * s; v[2 * q + 1] = e * s + o * c; } }
            else { b = (m - ML) >> 8; tt = SEQ + ((m - ML) & 255); }
            u32x4 o; o.x = pk2(v[0], v[1]); o.y = pk2(v[2], v[3]); o.z = pk2(v[4], v[5]); o.w = pk2(v[6], v[7]);
            *(u32x4*)(KR + ((size_t)b * TK + tt) * DROPE + d0) = o;
        }
    }
}
__device__ __forceinline__ void ph_row1(const P& p, int wg, int nwg, int tid) {
    const int lane = tid & 63, wave = tid >> 6;
    for (int ch = wg; ch < 256; ch += nwg) {
        { const int m0 = ch * 64 + wave * 8; const int ms[8] = {m0, m0 + 1, m0 + 2, m0 + 3, m0 + 4, m0 + 5, m0 + 6, m0 + 7}; row1_rows<8>(p, ms, lane); }
        if (wave == 7) { const int ms[2] = {ML + ch * 2, ML + ch * 2 + 1}; row1_rows<2>(p, ms, lane); }
    }
}

__device__ __forceinline__ float half_max32(float v, int lane) {
    v = fmaxf(v, __builtin_bit_cast(float, __builtin_amdgcn_update_dpp(__builtin_bit_cast(int, v), __builtin_bit_cast(int, v), 0x111, 0xf, 0xf, false)));
    v = fmaxf(v, __builtin_bit_cast(float, __builtin_amdgcn_update_dpp(__builtin_bit_cast(int, v), __builtin_bit_cast(int, v), 0x112, 0xf, 0xf, false)));
    v = fmaxf(v, __builtin_bit_cast(float, __builtin_amdgcn_update_dpp(__builtin_bit_cast(int, v), __builtin_bit_cast(int, v), 0x114, 0xf, 0xf, false)));
    v = fmaxf(v, __builtin_bit_cast(float, __builtin_amdgcn_update_dpp(__builtin_bit_cast(int, v), __builtin_bit_cast(int, v), 0x118, 0xf, 0xf, false)));
    v = fmaxf(v, __builtin_bit_cast(float, __builtin_amdgcn_update_dpp(__builtin_bit_cast(int, v), __builtin_bit_cast(int, v), 0x142, 0xa, 0xf, false)));
    const float m0 = __builtin_bit_cast(float, __builtin_amdgcn_readlane(__builtin_bit_cast(int, v), 31)), m1 = __builtin_bit_cast(float, __builtin_amdgcn_readlane(__builtin_bit_cast(int, v), 63));
    return lane < 32 ? m0 : m1;
}
__device__ __forceinline__ void ph_row2(const P& p, int wg, int nwg, int tid, LAS unsigned char* lds) {
    const int lane = tid & 63, wave = tid >> 6;
    constexpr int HSTR = 2064;
    LAS unsigned char* Hhi = lds; LAS unsigned char* Hlo = lds + 32 * HSTR;
    LAS float* PL = (LAS float*)(lds + LDS_CTL + 4096);
    LAS int* hist = (LAS int*)(lds + LDS_CTL + 1024);
    const bf16_t* WRH = (const bf16_t*)(p.ws + WS_WRT); const bf16_t* WRL = WRH + 32768;
    const float* x = p.in[0]; const float* MOD = (const float*)(p.ws + WS_MOD); const float* npost = p.in[7]; const float* npre = p.in[8]; const float* br = p.in[18];
    const bf16_t* MIX = (const bf16_t*)(p.ws + WS_MIX); bf16_t* HX2 = (bf16_t*)(p.ws + WS_HX);
    int* TOPI = (int*)(p.ws + WS_TOPI); float* GATE = (float*)(p.ws + WS_GATE); int* CHCNT = (int*)(p.ws + WS_CHCNT);
    for (int ch = wg; ch < 256; ch += nwg) {
        if (tid < 32) hist[tid] = 0;
        const int b = (ch * 64) >> 13;
        f32x4 a1[4], a2[4], s2[4];
#pragma unroll
        for (int j = 0; j < 4; ++j) { const int c = 4 * lane + 256 * j;
            a1[j] = *(const f32x4*)(npost + c) * *(const f32x4*)(MOD + b * 6144 + 2048 + c);
            a2[j] = *(const f32x4*)(npre + c) * (*(const f32x4*)(MOD + b * 6144 + 4096 + c) + 1.f);
            s2[j] = *(const f32x4*)(MOD + b * 6144 + 3072 + c); }
        for (int batch = 0; batch < 2; ++batch) {
            u32x2 mw[4][4]; f32x4 xv[4][4];
#pragma unroll
            for (int i = 0; i < 4; ++i) { const int m = ch * 64 + batch * 32 + wave * 4 + i;
#pragma unroll
                for (int j = 0; j < 4; ++j) { mw[i][j] = *(const u32x2*)(MIX + (size_t)m * D + 4 * lane + 256 * j); xv[i][j] = __builtin_nontemporal_load((const f32x4*)(x + (size_t)m * D + 4 * lane + 256 * j)); } }
            const int fr = lane & 15, fq = lane >> 4, rb = (wave & 1) * 16, kq = wave >> 1;
            const bf16_t* bh = WRH + fr * 1024 + kq * 256 + fq * 8; const bf16_t* bl = WRL + fr * 1024 + kq * 256 + fq * 8;
#pragma unroll
            for (int i = 0; i < 4; ++i) {
                const int rl = wave * 4 + i, m = ch * 64 + batch * 32 + rl;
                f32x4 mx[4], h[4]; float ss = 0.f;
#pragma unroll
                for (int j = 0; j < 4; ++j) { const u32x2 w = mw[i][j]; mx[j] = (f32x4){bflo(w.x), bfhi(w.x), bflo(w.y), bfhi(w.y)}; ss += dot4(mx[j], mx[j]); }
                const float r1 = rsqrtf(wave_sum(ss) * (1.f / D) + RMS_EPS); float s2s = 0.f;
#pragma unroll
                for (int j = 0; j < 4; ++j) { h[j] = xv[i][j] + a1[j] * (mx[j] * r1); s2s += dot4(h[j], h[j]); }
                const float r2 = rsqrtf(wave_sum(s2s) * (1.f / D) + RMS_EPS);
#pragma unroll
                for (int j = 0; j < 4; ++j) { h[j] = h[j] * r2 * a2[j] + s2[j];
                    const unsigned h0 = f2bf(h[j].x), h1 = f2bf(h[j].y), h2 = f2bf(h[j].z), h3 = f2bf(h[j].w);
                    u32x2 wh; wh.x = h0 | (h1 << 16); wh.y = h2 | (h3 << 16);
                    u32x2 wl; wl.x = pk2(h[j].x - __uint_as_float(h0 << 16), h[j].y - __uint_as_float(h1 << 16)); wl.y = pk2(h[j].z - __uint_as_float(h2 << 16), h[j].w - __uint_as_float(h3 << 16));
                    if constexpr (MOE_FP8) *(unsigned*)((unsigned char*)HX2 + (size_t)m * D + 4 * lane + 256 * j) = pg8_pk4_fp8(h[j]);
                    else *(u32x2*)(HX2 + (size_t)m * D + 4 * lane + 256 * j) = wh;
                    *(LAS u32x2*)(Hhi + rl * HSTR + (4 * lane + 256 * j) * 2) = wh; *(LAS u32x2*)(Hlo + rl * HSTR + (4 * lane + 256 * j) * 2) = wl; }
            }
            bf16x8 Bh0[8], Bl0[8];
#pragma unroll
            for (int ks = 0; ks < 8; ++ks) { Bh0[ks] = *(const bf16x8*)(bh + ks * 32); Bl0[ks] = *(const bf16x8*)(bl + ks * 32); }
            __syncthreads();
            { f32x4 acc0 = {0.f, 0.f, 0.f, 0.f}, acc1 = {0.f, 0.f, 0.f, 0.f};
              bf16x8 Bh1[8], Bl1[8];
#pragma unroll
              for (int ks = 0; ks < 8; ++ks) { Bh1[ks] = *(const bf16x8*)(bh + 16 * 1024 + ks * 32); Bl1[ks] = *(const bf16x8*)(bl + 16 * 1024 + ks * 32); }
              const LAS unsigned char* ah = Hhi + (rb + fr) * HSTR + kq * 512 + fq * 16; const LAS unsigned char* al = Hlo + (rb + fr) * HSTR + kq * 512 + fq * 16;
#pragma unroll
              for (int ks = 0; ks < 8; ++ks) {
                  const bf16x8 Ah = *(const LAS bf16x8*)(ah + ks * 64), Al = *(const LAS bf16x8*)(al + ks * 64);
                  acc0 = __builtin_amdgcn_mfma_f32_16x16x32_bf16(Ah, Bh0[ks], acc0, 0, 0, 0); acc0 = __builtin_amdgcn_mfma_f32_16x16x32_bf16(Ah, Bl0[ks], acc0, 0, 0, 0); acc0 = __builtin_amdgcn_mfma_f32_16x16x32_bf16(Al, Bh0[ks], acc0, 0, 0, 0); }
#pragma unroll
              for (int ks = 0; ks < 8; ++ks) {
                  const bf16x8 Ah = *(const LAS bf16x8*)(ah + ks * 64), Al = *(const LAS bf16x8*)(al + ks * 64);
                  acc1 = __builtin_amdgcn_mfma_f32_16x16x32_bf16(Ah, Bh1[ks], acc1, 0, 0, 0); acc1 = __builtin_amdgcn_mfma_f32_16x16x32_bf16(Ah, Bl1[ks], acc1, 0, 0, 0); acc1 = __builtin_amdgcn_mfma_f32_16x16x32_bf16(Al, Bh1[ks], acc1, 0, 0, 0); }
#pragma unroll
              for (int r = 0; r < 4; ++r) { PL[(kq * 32 + rb + fq * 4 + r) * 32 + fr] = acc0[r]; PL[(kq * 32 + rb + fq * 4 + r) * 32 + 16 + fr] = acc1[r]; } }
            __syncthreads();
#pragma unroll
            for (int ps = 0; ps < 2; ++ps) {
                const int rl = wave * 4 + ps * 2 + (lane >> 5), e = lane & 31, m = ch * 64 + batch * 32 + rl;
                float v = ((PL[rl * 32 + e] + PL[(32 + rl) * 32 + e]) + (PL[(64 + rl) * 32 + e] + PL[(96 + rl) * 32 + e])) + br[e];
                int ti[4]; float tv[4];
#pragma unroll
                for (int k = 0; k < 4; ++k) { const float mx = half_max32(v, lane); const unsigned long long bal = __ballot(v == mx);
                    const unsigned hm = lane < 32 ? (unsigned)bal : (unsigned)(bal >> 32); const int idx = __ffs((int)hm) - 1;
                    ti[k] = idx; tv[k] = mx; if (e == idx) v = -3.0e38f; }
                const float e1 = __expf(tv[1] - tv[0]), e2 = __expf(tv[2] - tv[0]), e3 = __expf(tv[3] - tv[0]), inv = 1.f / (1.f + e1 + e2 + e3);
                if (e == 0) { *(int4*)(TOPI + 4 * m) = make_int4(ti[0], ti[1], ti[2], ti[3]); *(f32x4*)(GATE + 4 * m) = (f32x4){inv, e1 * inv, e2 * inv, e3 * inv};
                    atomicAdd((int*)&hist[ti[0]], 1); atomicAdd((int*)&hist[ti[1]], 1); atomicAdd((int*)&hist[ti[2]], 1); atomicAdd((int*)&hist[ti[3]], 1); }
            }
            __syncthreads();
        }
        if (tid < 32) CHCNT[ch * 32 + tid] = hist[tid];
        __syncthreads();
    }
}

__device__ __forceinline__ void ph_lists(const P& p, int wg, int nwg, int tid, LAS unsigned char* lds) {
    LAS int* ct = (LAS int*)lds;
    LAS int* part = ct + 8192;
    LAS int* tot = part + 512; LAS int* base = tot + 32; LAS int* off = base + 64; LAS int* tp = off + 32;
    const int* CHCNT = (const int*)(p.ws + WS_CHCNT); const int* TOPI = (const int*)(p.ws + WS_TOPI);
    int* TOKSLOT = (int*)(p.ws + WS_TOKSLOT); int* SLOTTOK = (int*)(p.ws + WS_SLOTTOK); int* TILEE = (int*)(p.ws + WS_TILEE);
    for (int i = tid; i < 8192; i += NTHR) ct[i] = CHCNT[i];
    __syncthreads();
    { const int e = tid & 31, pt = tid >> 5; int s = 0; for (int c = pt * 16; c < pt * 16 + 16; ++c) s += ct[c * 32 + e]; part[pt * 32 + e] = s; }
    __syncthreads();
    if (tid < 32) { int s = 0; for (int k = 0; k < 16; ++k) s += part[k * 32 + tid]; tot[tid] = s; }
    __syncthreads();
    if (tid == 0) { int run = 0; for (int e = 0; e < 32; ++e) { base[e] = run; run += ((tot[e] + 255) >> 8) << 8; } base[32] = run; }
    __syncthreads();
    for (int ch = wg; ch < 256; ch += nwg) {
        { const int e = tid & 31, pt = tid >> 5; int s = 0; for (int c = pt * 16; c < pt * 16 + 16 && c < ch; ++c) s += ct[c * 32 + e]; part[pt * 32 + e] = s; }
        if (tid < 256) tp[tid] = TOPI[ch * 256 + tid];
        __syncthreads();
        if (tid < 32) { int s = base[tid]; for (int k = 0; k < 16; ++k) s += part[k * 32 + tid]; off[tid] = s; }
        __syncthreads();
        if (tid < 256) { const int e = tp[tid]; int rank = 0; for (int q = 0; q < tid; ++q) rank += (tp[q] == e) ? 1 : 0;
            const int s = off[e] + rank; TOKSLOT[ch * 256 + tid] = s; SLOTTOK[s] = ch * 64 + (tid >> 2); }
        __syncthreads();
    }
    if (wg == 0) {
        if (tid < 32) { const int e = tid; for (int s = base[e] + tot[e]; s < base[e] + (((tot[e] + 255) >> 8) << 8); ++s) SLOTTOK[s] = 0;
            for (int t = base[e] >> 8; t < (base[e] >> 8) + ((tot[e] + 255) >> 8); ++t) TILEE[t] = e; }
        const int nt = base[32] >> 8;
        for (int t = nt + tid; t < MAXTILES; t += NTHR) TILEE[t] = -1;
        if (tid == 0) TILEE[400] = nt;
    }
}

__device__ __forceinline__ void ph_final(const P& p, int wg, int nwg, int tid) {
    const int lane = tid & 63, wave = tid >> 6;
    const float* x = p.in[0]; const float* MOD = (const float*)(p.ws + WS_MOD); const float* npost = p.in[7]; const float* nfpost = p.in[9];
    const bf16_t* MIX = (const bf16_t*)(p.ws + WS_MIX); const unsigned char* Y = (const unsigned char*)(p.ws + WS_Y);
    const int* TOKSLOT = (const int*)(p.ws + WS_TOKSLOT); const float* GATE = (const float*)(p.ws + WS_GATE);
    for (int ch = wg; ch < 256; ch += nwg) {
        const int b = (ch * 64) >> 13;
        f32x4 a1[4], a3[4];
#pragma unroll
        for (int j = 0; j < 4; ++j) { const int c = 4 * lane + 256 * j;
            a1[j] = *(const f32x4*)(npost + c) * *(const f32x4*)(MOD + b * 6144 + 2048 + c);
            a3[j] = *(const f32x4*)(nfpost + c) * *(const f32x4*)(MOD + b * 6144 + 5120 + c); }
        int4 sln[2]; f32x4 gtn[2];
#pragma unroll
        for (int q = 0; q < 2; ++q) { const int m = ch * 64 + wave * 8 + q; sln[q] = *(const int4*)(TOKSLOT + 4 * m); gtn[q] = *(const f32x4*)(GATE + 4 * m); }
#pragma unroll 1
        for (int i2 = 0; i2 < 8; i2 += 2) {
            const int4 sl[2] = {sln[0], sln[1]}; const f32x4 gt[2] = {gtn[0], gtn[1]};
            u32x2 mw[2][4]; unsigned yw[2][4][4]; f32x4 xv[2][4];
#pragma unroll
            for (int q = 0; q < 2; ++q) { const int m = ch * 64 + wave * 8 + i2 + q;
#pragma unroll
                for (int j = 0; j < 4; ++j) { const int c = 4 * lane + 256 * j;
                    mw[q][j] = __builtin_nontemporal_load((const u32x2*)(MIX + (size_t)m * D + c)); xv[q][j] = __builtin_nontemporal_load((const f32x4*)(x + (size_t)m * D + c));
                    yw[q][j][0] = __builtin_nontemporal_load((const unsigned*)(Y + (size_t)sl[q].x * D + c)); yw[q][j][1] = __builtin_nontemporal_load((const unsigned*)(Y + (size_t)sl[q].y * D + c));
                    yw[q][j][2] = __builtin_nontemporal_load((const unsigned*)(Y + (size_t)sl[q].z * D + c)); yw[q][j][3] = __builtin_nontemporal_load((const unsigned*)(Y + (size_t)sl[q].w * D + c)); } }
            if (i2 + 2 < 8) {
#pragma unroll
                for (int q = 0; q < 2; ++q) { const int m = ch * 64 + wave * 8 + i2 + 2 + q; sln[q] = *(const int4*)(TOKSLOT + 4 * m); gtn[q] = *(const f32x4*)(GATE + 4 * m); } }
#pragma unroll
            for (int q = 0; q < 2; ++q) { const int m = ch * 64 + wave * 8 + i2 + q; const f32x4 g = gt[q];
                f32x4 mx[4], y[4]; float ss = 0.f, sy = 0.f;
#pragma unroll
                for (int j = 0; j < 4; ++j) { const u32x2 w = mw[q][j]; mx[j] = (f32x4){bflo(w.x), bfhi(w.x), bflo(w.y), bfhi(w.y)}; ss += dot4(mx[j], mx[j]);
                    f32x4 t = fp8x4(yw[q][j][0]) * g.x; t += fp8x4(yw[q][j][1]) * g.y; t += fp8x4(yw[q][j][2]) * g.z; t += fp8x4(yw[q][j][3]) * g.w;
                    y[j] = t; sy += dot4(t, t); }
                const float r1 = rsqrtf(wave_sum(ss) * (1.f / D) + RMS_EPS), r3 = rsqrtf(wave_sum(sy) * (1.f / D) + RMS_EPS);
#pragma unroll
                for (int j = 0; j < 4; ++j) { const int c = 4 * lane + 256 * j;
                    const f32x4 x1 = xv[q][j] + a1[j] * (mx[j] * r1); __builtin_nontemporal_store(x1 + a3[j] * (y[j] * r3), (f32x4*)(p.out + (size_t)m * D + c)); } }
        }
    }
}

typedef float f32x2a __attribute__((ext_vector_type(2)));
__device__ __forceinline__ f32x4 act4p(f32x4 g, f32x4 u1) {
    f32x4 r;
#pragma unroll
    for (int i = 0; i < 4; i += 2) {
        const f32x2a gg = {fminf(g[i], 7.f), fminf(g[i + 1], 7.f)}; f32x2a e = gg * (f32x2a){-2.4554669595930156f, -2.4554669595930156f};
        e[0] = __builtin_amdgcn_exp2f(e[0]); e[1] = __builtin_amdgcn_exp2f(e[1]); e += (f32x2a){1.f, 1.f};
        const f32x2a rc = {__builtin_amdgcn_rcpf(e[0]), __builtin_amdgcn_rcpf(e[1])}, uu = {__builtin_amdgcn_fmed3f(u1[i], -6.f, 8.f), __builtin_amdgcn_fmed3f(u1[i + 1], -6.f, 8.f)};
        const f32x2a o = gg * rc * uu; r[i] = o[0]; r[i + 1] = o[1]; }
    return r;
}
__device__ __forceinline__ f32x4 act4(f32x4 g, f32x4 u) {
    f32x4 r;
#pragma unroll
    for (int i = 0; i < 4; ++i) { const float gg = fminf(g[i], 7.f), uu = fminf(fmaxf(u[i], -7.f), 7.f); r[i] = gg * __builtin_amdgcn_rcpf(1.f + __builtin_amdgcn_exp2f(-2.4554669595930156f * gg)) * (uu + 1.f); }
    return r;
}

namespace pg8 {
constexpr int BM = 256, BK = 64, HALF = 128, HTB = HALF * BK * 2, STAGE_BYTES = 8 * HTB, NXCD = 8, WGM = 8;
__device__ __forceinline__ int lds_byte(int r, int c) { const int st = (r >> 4) * 2 + (c >> 5), rr = r & 15, cc = c & 31, ob = rr * 64 + cc * 2; return st * 1024 + (ob ^ (((ob >> 9) & 1) << 5)); }
__device__ __forceinline__ void stage_rc(int b, int& R, int& C) { const int st = b / 1024, sb = b % 1024, swz = sb ^ (((sb >> 9) & 1) << 5); R = (st >> 1) * 16 + swz / 64; C = (st & 1) * 32 + (swz % 64) / 2; }
__device__ __forceinline__ int perm32(int rho) { const int n = rho >> 4, i = rho & 15; return 8 * (i >> 2) + 4 * n + (i & 3); }
struct GUnit { const char* B; int pm, pn, e, arow, li; };
typedef int i32x4v __attribute__((ext_vector_type(4)));
typedef int i32x8v __attribute__((ext_vector_type(8)));
template <class Epi, class Sched, bool FP8 = false>
__device__ __forceinline__ void gemm_phase(LAS unsigned char* lds, const int tid, const char* Abase, const int K, const Sched& S, const Epi& E) {
    const int wid = __builtin_amdgcn_readfirstlane(tid >> 6), lane = tid & 63, wr = wid >> 2, wc = wid & 3, fr = lane & 15, fq = lane >> 4;
    const int Kb = FP8 ? K : K * 2, nt = Kb / (BK * 2);
    unsigned voffB[2];
#pragma unroll
    for (int i = 0; i < 2; ++i) { int R, C; stage_rc(tid * 16 + i * 8192, R, C); const int Rb = (R & ~31) + perm32(R & 31); voffB[i] = (unsigned)(Rb * Kb + C * 2); }
    const size_t kstep = (size_t)(BK * 2);
    const size_t hstep = (size_t)HALF * Kb;
    const unsigned ldsw = (unsigned)wid * 1024u;
    constexpr int FC = FP8 ? 16 : 8, PSTR = FP8 ? 16 : 1024;
    const int aoff = lds_byte(wr * 64 + fr, fq * FC), boff = lds_byte(wc * 32 + fr, fq * FC);
#define PG8_SA(b, h) (((b) * 2 + (h)) * HTB)
#define PG8_SB(b, h) ((4 + (b) * 2 + (h)) * HTB)
#define PG8_STAGE_B(bufoff, gbase) do { _Pragma("unroll") for (int _i = 0; _i < 2; ++_i) \
        __builtin_amdgcn_global_load_lds((const unsigned*)((const char*)(gbase) + voffB[_i]), (LAS unsigned*)(lds + (bufoff) + ldsw + _i * 8192), 16, 0, 0); } while (0)
#define PG8_STAGE_A(bufoff, vo, koff) do { _Pragma("unroll") for (int _i = 0; _i < 2; ++_i) \
        __builtin_amdgcn_global_load_lds((const unsigned*)(Abase + (size_t)(vo)[_i] + (koff)), (LAS unsigned*)(lds + (bufoff) + ldsw + _i * 8192), 16, 0, 0); } while (0)
#define PG8_LDA(dst, b, h) do { _Pragma("unroll") for (int m = 0; m < 4; ++m) _Pragma("unroll") for (int k = 0; k < 2; ++k) dst[m][k] = *(const LAS bf16x8*)(lds + PG8_SA(b, h) + aoff + m * 2048 + k * PSTR); } while (0)
#define PG8_LDB(dst, b, h) do { _Pragma("unroll") for (int n = 0; n < 2; ++n) _Pragma("unroll") for (int k = 0; k < 2; ++k) dst[n][k] = *(const LAS bf16x8*)(lds + PG8_SB(b, h) + boff + n * 2048 + k * PSTR); } while (0)
#define PG8_CAT(x) __builtin_shufflevector(__builtin_bit_cast(i32x4v, (x)[0]), __builtin_bit_cast(i32x4v, (x)[1]), 0, 1, 2, 3, 4, 5, 6, 7)
#define PG8_MMA(ai, bj, At, Bt) do { __builtin_amdgcn_s_setprio(1); \
        if constexpr (FP8) { _Pragma("unroll") for (int m = 0; m < 4; ++m) _Pragma("unroll") for (int n = 0; n < 2; ++n) \
            acc[ai][bj][m][n] = __builtin_amdgcn_mfma_scale_f32_16x16x128_f8f6f4(PG8_CAT(Bt[n]), PG8_CAT(At[m]), acc[ai][bj][m][n], 0, 0, 0, 0x7F7F7F7F, 0, 0x7F7F7F7F); \
            _Pragma("unroll") for (int m = 0; m < 4; ++m) _Pragma("unroll") for (int n = 0; n < 2; ++n) asm volatile("" : "+v"(acc[ai][bj][m][n])); }   \
        else { _Pragma("unroll") for (int m = 0; m < 4; ++m) _Pragma("unroll") for (int n = 0; n < 2; ++n) _Pragma("unroll") for (int k = 0; k < 2; ++k) \
            acc[ai][bj][m][n] = __builtin_amdgcn_mfma_f32_16x16x32_bf16(Bt[n][k], At[m][k], acc[ai][bj][m][n], 0, 0, 0); } \
        __builtin_amdgcn_s_setprio(0); } while (0)
#define PG8_WAIT_V(n) asm volatile("s_waitcnt vmcnt(" #n ")" ::: "memory")
#define PG8_WAIT_L(n) asm volatile("s_waitcnt lgkmcnt(" #n ")" ::: "memory")
#define PG8_BAR __builtin_amdgcn_s_barrier()
#define PG8_SCHED __builtin_amdgcn_sched_barrier(0)
    GUnit cur, nxt; int ui = 0;
    if (!S.next(0, cur)) return;
    f32x4 acc[2][2][4][2];
#pragma unroll
    for (int a = 0; a < 2; ++a)
#pragma unroll
        for (int b = 0; b < 2; ++b)
#pragma unroll
            for (int m = 0; m < 4; ++m)
#pragma unroll
                for (int n = 0; n < 2; ++n) acc[a][b][m][n] = (f32x4){0.f, 0.f, 0.f, 0.f};
    bf16x8 At[4][2], B0[2][2], B1[2][2];
    unsigned cvo[2][2];
    S.aoffs(cur, tid, cvo);
    const char* cB = cur.B;
    PG8_STAGE_B(PG8_SB(0, 0), cB); PG8_STAGE_B(PG8_SB(0, 1), cB + hstep); PG8_STAGE_A(PG8_SA(0, 0), cvo[0], 0); PG8_STAGE_A(PG8_SA(0, 1), cvo[1], 0);
    if (wr == 1) PG8_BAR;
    PG8_WAIT_V(2); PG8_BAR;
    PG8_STAGE_B(PG8_SB(1, 0), cB + kstep); PG8_STAGE_A(PG8_SA(1, 0), cvo[0], kstep); PG8_STAGE_B(PG8_SB(1, 1), cB + hstep + kstep);
    PG8_WAIT_V(6); PG8_BAR;
    for (;;) {
        const bool has_next = S.next(ui + 1, nxt);
        const char* nB = has_next ? nxt.B : cB;
#pragma nounroll
        for (int t = 0; t < nt; t += 2) {
            const bool last = (t == nt - 2);
            const size_t k1 = (size_t)(t + 1) * kstep, k2 = last ? 0 : (size_t)(t + 2) * kstep, k3 = k2 + kstep;
            const char* b2 = last ? nB : cB + (size_t)(t + 2) * kstep; const char* b3 = b2 + kstep;
            PG8_LDB(B0, 0, 0); PG8_LDB(B1, 0, 1); PG8_SCHED; PG8_LDA(At, 0, 0); PG8_STAGE_A(PG8_SA(1, 1), cvo[1], k1);
            PG8_WAIT_V(8); PG8_WAIT_L(0); PG8_BAR; PG8_MMA(0, 0, At, B0); PG8_MMA(0, 1, At, B1); PG8_BAR; PG8_SCHED;
            if (last && has_next) S.aoffs(nxt, tid, cvo);
            PG8_LDA(At, 0, 1); PG8_STAGE_B(PG8_SB(0, 0), b2); PG8_STAGE_B(PG8_SB(0, 1), b2 + hstep); PG8_STAGE_A(PG8_SA(0, 0), cvo[0], k2);
            PG8_WAIT_V(8); PG8_WAIT_L(0); PG8_BAR; PG8_MMA(1, 0, At, B0); PG8_MMA(1, 1, At, B1); PG8_BAR; PG8_SCHED;
            PG8_LDB(B0, 1, 0); PG8_LDB(B1, 1, 1); PG8_SCHED; PG8_LDA(At, 1, 0); PG8_STAGE_A(PG8_SA(0, 1), cvo[1], k2);
            PG8_WAIT_V(8); PG8_WAIT_L(0); PG8_BAR; PG8_MMA(0, 0, At, B0); PG8_MMA(0, 1, At, B1); PG8_BAR; PG8_SCHED;
            PG8_LDA(At, 1, 1); PG8_STAGE_B(PG8_SB(1, 0), b3); PG8_STAGE_B(PG8_SB(1, 1), b3 + hstep); PG8_STAGE_A(PG8_SA(1, 0), cvo[0], k3);
            PG8_WAIT_V(8); PG8_WAIT_L(0); PG8_BAR; PG8_MMA(1, 0, At, B0); PG8_MMA(1, 1, At, B1); PG8_BAR; PG8_SCHED;
        }
        if (wr == 0) PG8_BAR;
        E(acc, cur, wr, wc, fr, fq);
        if (!has_next) break;
#pragma unroll
        for (int a = 0; a < 2; ++a)
#pragma unroll
            for (int b = 0; b < 2; ++b)
#pragma unroll
                for (int m = 0; m < 4; ++m)
#pragma unroll
                    for (int n = 0; n < 2; ++n) acc[a][b][m][n] = (f32x4){0.f, 0.f, 0.f, 0.f};
        cur = nxt; cB = nB; ++ui;
        if (wr == 1) PG8_BAR;
    }
    PG8_WAIT_V(0);
    PG8_BAR;
#undef PG8_SA
#undef PG8_SB
#undef PG8_STAGE_A
#undef PG8_STAGE_B
#undef PG8_LDA
#undef PG8_LDB
#undef PG8_MMA
#undef PG8_CAT
#undef PG8_WAIT_V
#undef PG8_WAIT_L
#undef PG8_BAR
#undef PG8_SCHED
}
struct DenseSched {
    int nM, nN, G, c, K, lda, acol0; const char* Bt;
    __device__ __forceinline__ bool next(int i, GUnit& u) const {
        const int nwg = nM * nN; const long L = (long)i * G + c; if (L >= nwg) return false;
        int wgid = (int)L; { const int q = nwg / NXCD, r = nwg % NXCD, xcd = wgid % NXCD, off = wgid / NXCD; wgid = (xcd < r ? xcd * (q + 1) : r * (q + 1) + (xcd - r) * q) + off; }
        const int nig = WGM * nN, gid = wgid / nig, fm = gid * WGM, gsz = (nM - fm) < WGM ? (nM - fm) : WGM;
        u.pm = fm + ((wgid % nig) % gsz); u.pn = (wgid % nig) / gsz; u.e = 0; u.arow = u.pm * BM; u.li = i; u.B = Bt + (size_t)u.pn * BM * K * 2; return true;
    }
    __device__ __forceinline__ void aoffs(const GUnit& u, int tid, unsigned (&vo)[2][2]) const {
#pragma unroll
        for (int i = 0; i < 2; ++i) { int R, C; stage_rc(tid * 16 + i * 8192, R, C);
#pragma unroll
            for (int h = 0; h < 2; ++h) vo[h][i] = (unsigned)((u.arow + R + 128 * h) * lda + acol0 + C) * 2u; }
    }
};
template <int NT, bool GATHER, bool FP8 = false> struct MoeSched {
    int G, c; const LAS int* tile; const LAS unsigned* lst; const char* W; int wrows;
    __device__ __forceinline__ bool next(int i, GUnit& u) const {
        constexpr int RPG = 32 / NT; const int L = i * G + c, x = L & 7, j = L >> 3, grp = j >> 5, jj = j & 31;
        const int rt = (grp * 8 + x) * RPG + (jj % RPG), pn = jj / RPG; if (rt >= tile[300]) return false;
        const int e = tile[rt]; u.pm = rt; u.pn = pn; u.e = e; u.arow = rt * BM; u.li = i; u.B = W + ((size_t)e * wrows + pn * BM) * (FP8 ? 1024 : 2048); return true;
    }
    __device__ __forceinline__ void aoffs(const GUnit& u, int tid, unsigned (&vo)[2][2]) const {
#pragma unroll
        for (int i = 0; i < 2; ++i) { int R, C; stage_rc(tid * 16 + i * 8192, R, C);
#pragma unroll
            for (int h = 0; h < 2; ++h) vo[h][i] = GATHER ? lst[u.li * 256 + R + 128 * h] + (unsigned)C * 2u : (unsigned)((u.arow + R + 128 * h) * (FP8 ? 1024 : 2048) + C * 2); }
    }
};
__device__ __forceinline__ u32x4 pack8(f32x4 a, f32x4 b) { u32x4 w; w.x = pk2(a.x, a.y); w.y = pk2(a.z, a.w); w.z = pk2(b.x, b.y); w.w = pk2(b.z, b.w); return w; }
#define PG8_EPI_LOOP _Pragma("unroll") for (int ai = 0; ai < 2; ++ai) _Pragma("unroll") for (int m = 0; m < 4; ++m)
struct EpiRowMajor { bf16_t* O; int ldo;
    __device__ __forceinline__ void operator()(const f32x4 (&acc)[2][2][4][2], const GUnit& u, int wr, int wc, int fr, int fq) const {
        PG8_EPI_LOOP { bf16_t* rp = O + (size_t)(u.arow + 128 * ai + 64 * wr + 16 * m + fr) * ldo + u.pn * BM + 32 * wc + 8 * fq;
#pragma unroll
            for (int bj = 0; bj < 2; ++bj) *(u32x4*)(rp + 128 * bj) = pack8(acc[ai][bj][m][0], acc[ai][bj][m][1]); }
    }
};
constexpr float QPRESCALE = 0.07216878364870322f * 1.4426950408889634f;
struct EpiQ { unsigned char* ws;
    __device__ __forceinline__ void operator()(const f32x4 (&acc)[2][2][4][2], const GUnit& u, int wr, int wc, int fr, int fq) const {
        const float* RS = (const float*)(ws + WS_RSTAT); const float* ct = (const float*)(ws + WS_ROPE); const float* st = ct + 2048; bf16_t* Q = (bf16_t*)(ws + WS_Q);
        PG8_EPI_LOOP { const int row = u.arow + 128 * ai + 64 * wr + 16 * m + fr; const float rinv = RS[2 * row] * QPRESCALE; const int b = row >> 13, t = row & 8191, prow = t >> 6, pcol = t & 63;
#pragma unroll
            for (int bj = 0; bj < 2; ++bj) { const int col = u.pn * BM + 128 * bj + 32 * wc + 8 * fq; if (col >= NH * DQK) continue;
                const int hd = col / DQK, d = col - hd * DQK; f32x4 v0 = acc[ai][bj][m][0] * rinv, v1 = acc[ai][bj][m][1] * rinv;
                if (d >= DNOPE) { const int pi = (d - DNOPE) >> 1, pos = pi < 16 ? prow : pcol, j = pi & 15; const f32x4 cs = *(const f32x4*)(ct + pos * 16 + j), sn = *(const f32x4*)(st + pos * 16 + j);
                    const f32x4 a = v0, c2 = v1; v0.x = a.x * cs.x - a.y * sn.x; v0.y = a.x * sn.x + a.y * cs.x; v0.z = a.z * cs.y - a.w * sn.y; v0.w = a.z * sn.y + a.w * cs.y;
                    v1.x = c2.x * cs.z - c2.y * sn.z; v1.y = c2.x * sn.z + c2.y * cs.z; v1.z = c2.z * cs.w - c2.w * sn.w; v1.w = c2.z * sn.w + c2.w * cs.w; }
                *(u32x4*)(Q + ((size_t)(b * NH + hd) * SEQ + t) * DQK + d) = pack8(v0, v1); }
            asm volatile("" ::: "memory"); }
    }
};
struct EpiKV { unsigned char* ws;
    __device__ __forceinline__ void operator()(const f32x4 (&acc)[2][2][4][2], const GUnit& u, int wr, int wc, int fr, int fq) const {
        const float* RS = (const float*)(ws + WS_RSTAT); bf16_t* KNp = (bf16_t*)(ws + WS_KN); bf16_t* Vp = (bf16_t*)(ws + WS_V);
        PG8_EPI_LOOP { const int row = u.arow + 128 * ai + 64 * wr + 16 * m + fr; const float rinv = RS[2 * row + 1]; int b, tt; if (row < ML) { b = row >> 13; tt = row & 8191; } else { b = (row - ML) >> 8; tt = SEQ + ((row - ML) & 255); }
            const size_t ro = ((size_t)(b * NH + u.pn) * TK + tt) * 128 + 32 * wc + 8 * fq;
            *(u32x4*)(KNp + ro) = pack8(acc[ai][0][m][0] * rinv, acc[ai][0][m][1] * rinv); *(u32x4*)(Vp + ro) = pack8(acc[ai][1][m][0] * rinv, acc[ai][1][m][1] * rinv);
            asm volatile("" ::: "memory"); }
    }
};
struct EpiAct { bf16_t* ACT; const float* bg; const float* bu;
    __device__ __forceinline__ void operator()(const f32x4 (&acc)[2][2][4][2], const GUnit& u, int wr, int wc, int fr, int fq) const {
        const int ac = u.pn * 128 + 32 * wc + 8 * fq; const float* pg = bg + u.e * 1024 + ac; const float* pu = bu + u.e * 1024 + ac;
        const f32x4 g0 = *(const f32x4*)pg, g1 = *(const f32x4*)(pg + 4), u0 = *(const f32x4*)pu, u1 = *(const f32x4*)(pu + 4);
        PG8_EPI_LOOP { const int slot = u.arow + 128 * ai + 64 * wr + 16 * m + fr;
            *(u32x4*)(ACT + (size_t)slot * 1024 + ac) = pack8(act4(acc[ai][0][m][0] + g0, acc[ai][1][m][0] + u0), act4(acc[ai][0][m][1] + g1, acc[ai][1][m][1] + u1)); }
    }
};
__device__ __forceinline__ unsigned pk4_fp8(f32x4 v) { int p = __builtin_amdgcn_cvt_pk_fp8_f32(v.x, v.y, 0, false); p = __builtin_amdgcn_cvt_pk_fp8_f32(v.z, v.w, p, true); return (unsigned)p; }
struct EpiAct8 { unsigned char* ACT; const float* bg; const float* bu; float sc;
    __device__ __forceinline__ void operator()(const f32x4 (&acc)[2][2][4][2], const GUnit& u, int wr, int wc, int fr, int fq) const {
        const int ac = u.pn * 128 + 32 * wc + 8 * fq; const float* pg = bg + u.e * 1024 + ac; const float* pu = bu + u.e * 1024 + ac;
        const f32x4 g0 = *(const f32x4*)pg, g1 = *(const f32x4*)(pg + 4), u0 = *(const f32x4*)pu + 1.f, u1 = *(const f32x4*)(pu + 4) + 1.f;
        PG8_EPI_LOOP { const int slot = u.arow + 128 * ai + 64 * wr + 16 * m + fr; u32x2 w;
            w.x = pk4_fp8(act4p(acc[ai][0][m][0] * sc + g0, acc[ai][1][m][0] * sc + u0)); w.y = pk4_fp8(act4p(acc[ai][0][m][1] * sc + g1, acc[ai][1][m][1] * sc + u1));
            *(u32x2*)(ACT + (size_t)slot * 1024 + ac) = w; }
    }
};
struct EpiY { bf16_t* Y; const float* bd; float sc;
    __device__ __forceinline__ void operator()(const f32x4 (&acc)[2][2][4][2], const GUnit& u, int wr, int wc, int fr, int fq) const {
        const int c0 = u.pn * BM + 32 * wc + 8 * fq; const float* pb = bd + u.e * 1024 + c0;
        const f32x4 b00 = *(const f32x4*)pb, b01 = *(const f32x4*)(pb + 4), b10 = *(const f32x4*)(pb + 128), b11 = *(const f32x4*)(pb + 132);
        PG8_EPI_LOOP { const int slot = u.arow + 128 * ai + 64 * wr + 16 * m + fr; bf16_t* rp = Y + (size_t)slot * 1024 + c0;
            *(u32x4*)rp = pack8(acc[ai][0][m][0] * sc + b00, acc[ai][0][m][1] * sc + b01); *(u32x4*)(rp + 128) = pack8(acc[ai][1][m][0] * sc + b10, acc[ai][1][m][1] * sc + b11); }
    }
};
struct EpiY8 { unsigned char* Y; const float* bd; float sc;
    __device__ __forceinline__ void operator()(const f32x4 (&acc)[2][2][4][2], const GUnit& u, int wr, int wc, int fr, int fq) const {
        const int c0 = u.pn * BM + 32 * wc + 8 * fq; const float* pb = bd + u.e * 1024 + c0;
        const f32x4 b00 = *(const f32x4*)pb, b01 = *(const f32x4*)(pb + 4), b10 = *(const f32x4*)(pb + 128), b11 = *(const f32x4*)(pb + 132);
        PG8_EPI_LOOP { const int slot = u.arow + 128 * ai + 64 * wr + 16 * m + fr; unsigned char* rp = Y + (size_t)slot * 1024 + c0; u32x2 w0, w1;
            w0.x = pk4_fp8(acc[ai][0][m][0] * sc + b00); w0.y = pk4_fp8(acc[ai][0][m][1] * sc + b01); w1.x = pk4_fp8(acc[ai][1][m][0] * sc + b10); w1.y = pk4_fp8(acc[ai][1][m][1] * sc + b11);
            *(u32x2*)rp = w0; *(u32x2*)(rp + 128) = w1; }
    }
};
#undef PG8_EPI_LOOP
}


namespace att {
typedef short s16x4 __attribute__((ext_vector_type(4)));
constexpr int NW = 8, QBLK = 32, KVBLK = 64, NTILE = 66, HALFKEYS = NTILE * KVBLK;
constexpr float SCALE = 0.07216878364870322f, THR = 8.f;
constexpr int SHM_V = KVBLK * 128 * 2, SHM_K = KVBLK * 128 * 2, SHM_R = KVBLK * 64 * 2;
__device__ __forceinline__ int crow(int r, int hi) { return (r & 3) + 8 * (r >> 2) + 4 * hi; }
__device__ __forceinline__ unsigned cvtpk(float lo, float hi) { return pk2(lo, hi); }
__device__ __forceinline__ int v_rd_base(int lane) { return ((lane & 3) << 3) | (((lane >> 2) & 3) << 6) | (((lane >> 4) & 1) << 5) | (((lane >> 5) & 1) << 8); }
constexpr int v_rd_off(int d0, int ks, int half) { return d0 * 512 + ks * 4096 + half * 2048; }
constexpr int SLOT_B = SHM_K + SHM_R + SHM_V, SL_K = 0, SL_R = SHM_K, SL_V = SHM_K + SHM_R, DMA_WS = 3 * SLOT_B, ATT_DMA_LDS = DMA_WS + NW * 64 * 4;
#define RSWZ(row, colB) ((row) * 128 + ((colB) ^ ((((row) >> 1) & 7) << 4)))
#define SBAR() __builtin_amdgcn_sched_barrier(0)
__device__ __forceinline__ float max3(float a, float b, float c) { return __builtin_elementwise_maximum(__builtin_elementwise_maximum(a, b), c); }
__device__ __forceinline__ float sm_max(const f32x16& p0, const f32x16& p1) {
  float a = max3(p0[0], p0[1], p0[2]), b = max3(p0[3], p0[4], p0[5]), c = max3(p1[0], p1[1], p1[2]), d = max3(p1[3], p1[4], p1[5]);
  a = max3(a, p0[6], p0[7]); b = max3(b, p0[8], p0[9]); c = max3(c, p1[6], p1[7]); d = max3(d, p1[8], p1[9]);
  a = max3(a, p0[10], p0[11]); b = max3(b, p0[12], p0[13]); c = max3(c, p1[10], p1[11]); d = max3(d, p1[12], p1[13]);
  a = max3(a, p0[14], p0[15]); c = max3(c, p1[14], p1[15]);
  float pmax = max3(a, b, max3(c, d, d));
  auto rr = __builtin_amdgcn_permlane32_swap(__float_as_uint(pmax), __float_as_uint(pmax), false, false);
  return max3(__uint_as_float(rr[0]), __uint_as_float(rr[1]), __uint_as_float(rr[1]));
}
__device__ __forceinline__ int kperm(int i) { const int a = i >> 3, h = (i >> 2) & 1, b = i & 3; return 16 * (a >> 1) + 8 * h + 4 * (a & 1) + b; }
__device__ __forceinline__ s16x4 trv(int a) { return __builtin_amdgcn_ds_read_tr16_b64_v4i16((LAS s16x4*)(uintptr_t)(unsigned)a); }
#define QK_LD(s, slot) do { if ((s) < 4) { f0[slot] = *(const LAS bf16x8*)(uintptr_t)(unsigned)(ka[(s)]); f1[slot] = *(const LAS bf16x8*)(uintptr_t)(unsigned)(ka[(s)] + 8192); } \
    else if ((s) < 8) { f0[slot] = *(const LAS bf16x8*)(uintptr_t)(unsigned)(kha[(s) - 4]); f1[slot] = *(const LAS bf16x8*)(uintptr_t)(unsigned)(kha[(s) - 4] + 8192); } \
    else { f0[slot] = *(const LAS bf16x8*)(uintptr_t)(unsigned)(ra[(s) - 8]); f1[slot] = *(const LAS bf16x8*)(uintptr_t)(unsigned)(ra[(s) - 8] + 4096); } } while (0)
#ifndef PP_KD
#define PP_KD 3
#endif
#ifndef PP_VD
#define PP_VD 6
#endif
constexpr int KD = PP_KD, KR_ = KD + 1, VD = PP_VD, VR_ = 16;
__device__ __forceinline__ void pp_qkt_head(bf16x8 (&f0)[KR_], bf16x8 (&f1)[KR_], const int (&kb)[4], const int (&rb)[4], int khd, int soff) {
  int ka[4], kha[4], ra[4];
#pragma unroll
  for (int i = 0; i < 4; ++i) { ka[i] = kb[i] + soff; kha[i] = ka[i] + khd; ra[i] = rb[i] + soff; }
#pragma unroll
  for (int s = 0; s < KD; ++s) QK_LD(s, s);
}
#define PV_LD(n) do { L[(n) & 15] = trv(vb + v_rd_off((n) & 3, (n) >> 2, 0)); H[(n) & 15] = trv(vb + v_rd_off((n) & 3, (n) >> 2, 1)); } while (0)
#define PV_MFMA(n) do { const bf16x8 pa_ = ((n) >> 2) == 0 ? pa0 : ((n) >> 2) == 1 ? pa1 : ((n) >> 2) == 2 ? pa2 : pa3; const s16x4 l_ = L[(n) & 15], h_ = H[(n) & 15]; \
    o[(n) & 3] = __builtin_amdgcn_mfma_f32_32x32x16_bf16(pa_, (bf16x8){l_[0], l_[1], l_[2], l_[3], h_[0], h_[1], h_[2], h_[3]}, o[(n) & 3], 0, 0, 0); } while (0)
template <bool PV>
__device__ __forceinline__ void pp_mphase(f32x16& p0, f32x16& p1, f32x16* o, bf16x8 (&f0)[KR_], bf16x8 (&f1)[KR_], const int (&kb)[4], int khd, const int (&rb)[4], int soff, int vb, const bf16x8* qr,
                                          bf16x8 pa0, bf16x8 pa1, bf16x8 pa2, bf16x8 pa3, const f32x16& minit) {
  int ka[4], kha[4], ra[4]; s16x4 L[VR_], H[VR_];
#pragma unroll
  for (int i = 0; i < 4; ++i) { ka[i] = kb[i] + soff; kha[i] = ka[i] + khd; ra[i] = rb[i] + soff; }
#pragma unroll
  for (int s = 0; s < 12; ++s) {
    if (s + KD < 12) QK_LD(s + KD, (s + KD) % KR_);
    else if (PV) { if (2 * (s + KD - 12) < VD) PV_LD(2 * (s + KD - 12)); if (2 * (s + KD - 12) + 1 < VD) PV_LD(2 * (s + KD - 12) + 1); }
    SBAR();
    p0 = __builtin_amdgcn_mfma_f32_32x32x16_bf16(f0[s % KR_], qr[s], s == 0 ? minit : p0, 0, 0, 0);
    p1 = __builtin_amdgcn_mfma_f32_32x32x16_bf16(f1[s % KR_], qr[s], s == 0 ? minit : p1, 0, 0, 0);
    SBAR(); }
  if (PV) {
#pragma unroll
    for (int n = 2 * KD; n < VD; ++n) PV_LD(n);
#pragma unroll
    for (int n = 0; n < 16; ++n) { if (n + VD < 16) PV_LD(n + VD); SBAR(); PV_MFMA(n); SBAR(); } }
}
__device__ __forceinline__ void pp_pv(f32x16* o, int vb, bf16x8 pa0, bf16x8 pa1, bf16x8 pa2, bf16x8 pa3) {
  s16x4 L[VR_], H[VR_];
#pragma unroll
  for (int n = 0; n < VD; ++n) PV_LD(n);
#pragma unroll
  for (int n = 0; n < 16; ++n) { if (n + VD < 16) PV_LD(n + VD); SBAR(); PV_MFMA(n); SBAR(); }
}
#undef PV_LD
#undef PV_MFMA
#undef QK_LD
typedef float f32x2p __attribute__((ext_vector_type(2)));
__device__ __forceinline__ bf16x8 pp_pack8(const f32x16& p, int b) {
  u32x4 w = {cvtpk(p[b], p[b + 1]), cvtpk(p[b + 2], p[b + 3]), cvtpk(p[b + 4], p[b + 5]), cvtpk(p[b + 6], p[b + 7])}; return *reinterpret_cast<bf16x8*>(&w); }
__device__ __forceinline__ void pp_expsum(f32x16& p0, f32x16& p1, float& l_reg, bf16x8& pa0, bf16x8& pa1, bf16x8& pa2, bf16x8& pa3) {
  f32x2p s0 = {0.f, 0.f}, s1 = {0.f, 0.f};
#pragma unroll
  for (int r = 0; r < 16; r += 2) { f32x2p v = {__builtin_amdgcn_exp2f(p0[r]), __builtin_amdgcn_exp2f(p0[r + 1])}; s0 += v; p0[r] = v[0]; p0[r + 1] = v[1]; }
#pragma unroll
  for (int r = 0; r < 16; r += 2) { f32x2p v = {__builtin_amdgcn_exp2f(p1[r]), __builtin_amdgcn_exp2f(p1[r + 1])}; s1 += v; p1[r] = v[0]; p1[r + 1] = v[1]; }
  s0 += s1; l_reg += s0[0] + s0[1];
  pa0 = pp_pack8(p0, 0); pa1 = pp_pack8(p0, 8); pa2 = pp_pack8(p1, 0); pa3 = pp_pack8(p1, 8);
}
template <int NTT, bool FULL>
__device__ __forceinline__ void attn_unit_pp(const bf16_t* __restrict__ Qb, const bf16_t* __restrict__ Kh, const bf16_t* __restrict__ Vh, const bf16_t* __restrict__ Rh,
                                             float* __restrict__ Op, float* __restrict__ MLp, LAS unsigned char* lds, const int tid) {
  const int wid = __builtin_amdgcn_readfirstlane(tid >> 6), lane = tid & 63, r32 = lane & 31, hi = lane >> 5;
  const bool grpB = wid >= 4;
  LAS float* wsx = (LAS float*)(lds + DMA_WS) + wid * 64; LAS float* al_l = wsx + 32;
  float l_reg = 0; f32x16 o[4] = {}, minit = {}; bf16x8 qr[12];
  unsigned ko[2], vo[2], ro;
#pragma unroll
  for (int i = 0; i < 2; ++i) { const int pc = 2 * wid + i;
    { const int row = 4 * pc + (lane >> 4), cl = (lane & 15) ^ (row & 15); ko[i] = (unsigned)(row * 128 + cl * 8) * 2u; }
    { const int s = pc * 64 + lane, sub = s >> 5, within = s & 31, kk = (sub >> 2) * 8 + (within >> 2), c = (sub & 3) * 32 + (within & 3) * 8;
      const int k = (kk & ~0xC) | ((kk & 4) << 1) | ((kk & 8) >> 1); vo[i] = (unsigned)(k * 128 + c) * 2u; } }
  { const int row = 8 * wid + (lane >> 3), cl = (lane & 7) ^ ((row >> 1) & 7); ro = (unsigned)(row * 64 + cl * 8) * 2u; }
#define DMA_KR(t, slot) do { const char* kt_ = (const char*)Kh + (size_t)(t) * (KVBLK * 256); const char* rt_ = (const char*)Rh + (size_t)(t) * (KVBLK * 128); const unsigned sb_ = (unsigned)lb + (unsigned)(slot) * SLOT_B; unsigned sv_; \
    asm volatile("s_mov_b32 %0, m0\n\ts_mov_b32 m0, %5\n\ts_nop 0\n\tglobal_load_lds_dwordx4 %1, %4\n\ts_mov_b32 m0, %6\n\ts_nop 0\n\tglobal_load_lds_dwordx4 %2, %4\n\ts_mov_b32 m0, %8\n\ts_nop 0\n\tglobal_load_lds_dwordx4 %3, %7\n\ts_mov_b32 m0, %0" \
                 : "=&s"(sv_) : "v"(ko[0]), "v"(ko[1]), "v"(ro), "s"(kt_), "s"(sb_ + SL_K + (2 * wid) * 1024), "s"(sb_ + SL_K + (2 * wid + 1) * 1024), "s"(rt_), "s"(sb_ + SL_R + wid * 1024) : "memory"); } while (0)
#define DMA_KR2(t, slot) do { const char* kt_ = (const char*)Kh + (size_t)(t) * (KVBLK * 256); const char* rt_ = (const char*)Rh + (size_t)(t) * (KVBLK * 128); const unsigned sb_ = (unsigned)lb + (unsigned)(slot) * SLOT_B; unsigned sv_; \
    asm volatile("s_mov_b32 %0, m0\n\ts_mov_b32 m0, %5\n\ts_nop 0\n\tglobal_load_lds_dwordx4 %1, %4\n\ts_mov_b32 m0, %6\n\ts_nop 0\n\tglobal_load_lds_dwordx4 %2, %4\n\ts_mov_b32 m0, %8\n\ts_nop 0\n\tglobal_load_lds_dwordx4 %3, %7\n\t" \
                 "s_mov_b32 m0, %10\n\ts_nop 0\n\tglobal_load_lds_dwordx4 %1, %9\n\ts_mov_b32 m0, %11\n\ts_nop 0\n\tglobal_load_lds_dwordx4 %2, %9\n\ts_mov_b32 m0, %13\n\ts_nop 0\n\tglobal_load_lds_dwordx4 %3, %12\n\ts_mov_b32 m0, %0" \
                 : "=&s"(sv_) : "v"(ko[0]), "v"(ko[1]), "v"(ro), "s"(kt_), "s"(sb_ + SL_K + (2 * wid) * 1024), "s"(sb_ + SL_K + (2 * wid + 1) * 1024), "s"(rt_), "s"(sb_ + SL_R + wid * 1024), \
                   "s"(kt_ + 8192), "s"(sb_ + SL_K + (2 * wid + 8) * 1024), "s"(sb_ + SL_K + (2 * wid + 9) * 1024), "s"(rt_ + 4096), "s"(sb_ + SL_R + (wid + 4) * 1024) : "memory"); } while (0)
#define DMA_V(t, slot) do { const char* vt_ = (const char*)Vh + (size_t)(t) * (KVBLK * 256); const unsigned sb_ = (unsigned)lb + (unsigned)(slot) * SLOT_B; unsigned sv_; \
    asm volatile("s_mov_b32 %0, m0\n\ts_mov_b32 m0, %4\n\ts_nop 0\n\tglobal_load_lds_dwordx4 %1, %3\n\ts_mov_b32 m0, %5\n\ts_nop 0\n\tglobal_load_lds_dwordx4 %2, %3\n\ts_mov_b32 m0, %0" \
                 : "=&s"(sv_) : "v"(vo[0]), "v"(vo[1]), "s"(vt_), "s"(sb_ + SL_V + (2 * wid) * 1024), "s"(sb_ + SL_V + (2 * wid + 1) * 1024) : "memory"); } while (0)
#define BAR() do { SBAR(); asm volatile("" ::: "memory"); __builtin_amdgcn_s_barrier(); asm volatile("" ::: "memory"); SBAR(); } while (0)
#define MBAR(n) do { SBAR(); asm volatile("s_waitcnt vmcnt(" #n ") lgkmcnt(0)" ::: "memory"); __builtin_amdgcn_s_barrier(); asm volatile("" ::: "memory"); SBAR(); } while (0)
#define RESC(a) do { if (__any((a) < 1.f)) { if (hi == 0) al_l[r32] = (a); asm volatile("s_waitcnt lgkmcnt(0)" ::: "memory"); \
    _Pragma("unroll") for (int d = 0; d < 4; ++d) _Pragma("unroll") for (int r = 0; r < 16; ++r) o[d][r] *= al_l[crow(r, hi)]; } } while (0)
#define VPHASE(FIRST) do { const float rel = sm_max(p0, p1); \
    if ((FIRST) || __any(rel > THR * 1.4426950408889634f)) { const float dl = (FIRST) ? rel : fmaxf(rel, 0.f), al = __builtin_amdgcn_exp2f(-dl); \
      _Pragma("unroll") for (int r = 0; r < 16; ++r) { p0[r] -= dl; p1[r] -= dl; minit[r] -= dl; }     \
      l_reg *= al; RESC(al); } \
    pp_expsum(p0, p1, l_reg, pa0, pa1, pa2, pa3); } while (0)
  constexpr int NT = NTT;
  const int lb = __builtin_amdgcn_readfirstlane((int)(uintptr_t)lds);
  DMA_KR(0, 0); DMA_KR(1, 1); DMA_V(0, 0);
  { const unsigned qo = (unsigned)((wid * QBLK + r32) * DQK + hi * 8) * 2u;
#pragma unroll
    for (int d0 = 0; d0 < 12; ++d0) qr[d0] = *reinterpret_cast<const bf16x8*>((const char*)Qb + qo + d0 * 32); }
  const int vbase = lb + SL_V + v_rd_base(lane);
  int kb[4], rb[4];
#pragma unroll
  for (int i = 0; i < 4; ++i) { const int cb = (i * 16 + hi * 8) * 2, kr = kperm(r32); kb[i] = lb + SL_K + kr * 256 + ((((2 * i + hi) ^ (kr & 7)) + 8 * ((kr >> 3) & 1)) << 4); rb[i] = lb + SL_R + RSWZ(kr, cb); }
  const int khd = ((kperm(r32) >> 3) & 1) ? -128 : 128;
  f32x16 p0, p1; bf16x8 pa0 = {}, pa1 = {}, pa2 = {}, pa3 = {};
  bf16x8 f0[KR_], f1[KR_];
  MBAR(0);
  if (grpB) BAR();
  pp_qkt_head(f0, f1, kb, rb, khd, 0); pp_mphase<false>(p0, p1, o, f0, f1, kb, khd, rb, 0, 0, qr, pa0, pa0, pa0, pa0, minit);
  MBAR(0);
  int sa = 0, sb = 1, sc = 2;
#pragma nounroll
  for (int t = 0; t + 1 < NT; ++t) {
    if (t + 2 < NT && !grpB) DMA_KR2(t + 2, sc);
    DMA_V(t + 1, sb);
    VPHASE(t == 0);
    pp_qkt_head(f0, f1, kb, rb, khd, sb * SLOT_B);
    BAR();
    pp_mphase<true>(p0, p1, o, f0, f1, kb, khd, rb, sb * SLOT_B, vbase + sa * SLOT_B, qr, pa0, pa1, pa2, pa3, minit);
    MBAR(0);
    { const int tmp = sa; sa = sb; sb = sc; sc = tmp; }
  }
  VPHASE(NT == 1);
  BAR();
  pp_pv(o, vbase + sa * SLOT_B, pa0, pa1, pa2, pa3);
  asm volatile("s_waitcnt vmcnt(0)" ::: "memory");
  if (!grpB) BAR();
  { auto rr = __builtin_amdgcn_permlane32_swap(__float_as_uint(l_reg), __float_as_uint(l_reg), false, false); l_reg = __uint_as_float(rr[0]) + __uint_as_float(rr[1]); }
  if constexpr (FULL) {
    if (hi == 0) wsx[r32] = l_reg; asm volatile("s_waitcnt lgkmcnt(0)" ::: "memory");
    const unsigned oo = (unsigned)((wid * QBLK + 4 * hi) * D + r32) * 2u;
#pragma unroll
    for (int r = 0; r < 16; ++r) { const float rl = __builtin_amdgcn_rcpf(wsx[crow(r, hi)]);
#pragma unroll
      for (int d0 = 0; d0 < 4; ++d0) *(bf16_t*)((char*)Op + oo + (unsigned)(((r & 3) + 8 * (r >> 2)) * D + d0 * 32) * 2u) = (bf16_t)f2bf(o[d0][r] * rl); }
  } else {
    if (hi == 0) { *(float2*)((char*)MLp + (unsigned)(wid * QBLK + r32) * 8u) = make_float2(-minit[0], l_reg); }
    const unsigned oo = (unsigned)((wid * QBLK + 4 * hi) * 128 + r32) * 4u;
#pragma unroll
    for (int r = 0; r < 16; ++r)
#pragma unroll
      for (int d0 = 0; d0 < 4; ++d0) *(float*)((char*)Op + oo + (unsigned)(((r & 3) + 8 * (r >> 2)) * 128 + d0 * 32) * 4u) = o[d0][r]; }
#undef DMA_KR
#undef DMA_KR2
#undef DMA_V
#undef BAR
#undef MBAR
#undef RESC
#undef VPHASE
}
#undef RSWZ
#undef SBAR
}
#ifndef ATTN_UNIT
#define ATTN_UNIT attn_unit_pp
#endif
__device__ __forceinline__ void ph_attn(const P& p, int wg, int nwg, LAS unsigned char* lds, const int wv) {
    unsigned char* ws = p.ws;
    { for (int L = wg; L < 256; L += nwg) { const int bh = L & 7, qb = (L >> 3) & 31, b = bh / NH, h = bh - b * NH;
        const int tid = fresh_tid(wv);
        __syncthreads();
        att::ATTN_UNIT<2 * att::NTILE, true>((const bf16_t*)(ws + WS_Q) + ((size_t)bh * SEQ + qb * 256) * DQK, (const bf16_t*)(ws + WS_KN) + (size_t)bh * TK * 128,
                   (const bf16_t*)(ws + WS_V) + (size_t)bh * TK * 128, (const bf16_t*)(ws + WS_KR) + (size_t)b * TK * 64,
                   (float*)((bf16_t*)(ws + WS_MIXA) + ((size_t)b * SEQ + qb * 256) * D + h * 128), nullptr, lds, tid); } }
    { for (int L = wg; L < 256; L += nwg) { const int x = L & 7, qb = (L >> 3) & 31, bh = 8 + (x >> 1), half = x & 1, b = bh / NH, key0 = half * att::HALFKEYS, pidx = ((bh - 8) * 32 + qb) * 2 + half;
        const int tid = fresh_tid(wv);
        __syncthreads();
        att::ATTN_UNIT<att::NTILE, false>((const bf16_t*)(ws + WS_Q) + ((size_t)bh * SEQ + qb * 256) * DQK, (const bf16_t*)(ws + WS_KN) + ((size_t)bh * TK + key0) * 128,
                   (const bf16_t*)(ws + WS_V) + ((size_t)bh * TK + key0) * 128, (const bf16_t*)(ws + WS_KR) + ((size_t)b * TK + key0) * 64,
                   (float*)(ws + WS_OPART) + (size_t)pidx * 32768, (float*)(ws + WS_OML) + (size_t)pidx * 512, lds, tid); } }
}
__device__ __forceinline__ void ph_acomb(const P& p, int wg, int nwg, int tid) {
    const int lane = tid & 63, gw = wg * 8 + (tid >> 6), ngw = nwg * 8; unsigned char* ws = p.ws;
    const float* OP = (const float*)(ws + WS_OPART); const float* OML = (const float*)(ws + WS_OML); bf16_t* MIXA = (bf16_t*)(ws + WS_MIXA);
    for (int rw = gw; rw < 4 * 32 * 256; rw += ngw) {
        const int pp = rw >> 8, r = rw & 255, bh = 8 + (pp >> 5), qb = pp & 31, b = bh / NH, h = bh - b * NH;
        const float2 ml1 = *(const float2*)(OML + ((size_t)(pp * 2) * 256 + r) * 2), ml2 = *(const float2*)(OML + ((size_t)(pp * 2 + 1) * 256 + r) * 2);
        typedef float f32x2v __attribute__((ext_vector_type(2)));
        const f32x2v o1 = __builtin_nontemporal_load((const f32x2v*)(OP + ((size_t)(pp * 2) * 256 + r) * 128 + 2 * lane)), o2 = __builtin_nontemporal_load((const f32x2v*)(OP + ((size_t)(pp * 2 + 1) * 256 + r) * 128 + 2 * lane));
        const float M = fmaxf(ml1.x, ml2.x), w1 = __builtin_amdgcn_exp2f(ml1.x - M), w2 = __builtin_amdgcn_exp2f(ml2.x - M), inv = 1.f / (ml1.y * w1 + ml2.y * w2);
        *(unsigned*)(MIXA + ((size_t)b * SEQ + qb * 256 + r) * D + h * 128 + 2 * lane) = pk2((o1.x * w1 + o2.x * w2) * inv, (o1.y * w1 + o2.y * w2) * inv);
    }
}

namespace fou {
typedef short s16x4 __attribute__((ext_vector_type(4)));
template <int OFF> __device__ __forceinline__ s16x4 tr_read(int vb) { s16x4 r; asm volatile("ds_read_b64_tr_b16 %0, %1 offset:%2" : "=&v"(r) : "v"(vb), "i"(OFF) : "memory"); return r; }
__device__ __forceinline__ int rd_base(int lane) { return ((lane & 3) << 3) | (((lane >> 2) & 3) << 6) | (((lane >> 4) & 1) << 5) | (((lane >> 5) & 1) << 8); }
__device__ __forceinline__ int img_off(int k, int c) { const int kk = (k & ~0xC) | ((k & 4) << 1) | ((k & 8) >> 1); return ((kk >> 3) * 2 + (c >> 5)) * 512 + ((kk & 7) * 32 + (c & 31)) * 2; }
#define FOU_PK(L, H) (bf16x8){L[0], L[1], L[2], L[3], H[0], H[1], H[2], H[3]}
template <int KS> __device__ __forceinline__ void a_step(f32x16& yr, f32x16& yi, int vb, const bf16x8 (&ar)[16], const bf16x8 (&ai)[16]) {
    const s16x4 l = tr_read<KS * 2048>(vb), h = tr_read<KS * 2048 + 1024>(vb);
    asm volatile("s_waitcnt lgkmcnt(0)" ::: "memory"); __builtin_amdgcn_sched_barrier(0);
    const bf16x8 bb = FOU_PK(l, h);
    yr = __builtin_amdgcn_mfma_f32_32x32x16_bf16(ar[KS], bb, yr, 0, 0, 0); yi = __builtin_amdgcn_mfma_f32_32x32x16_bf16(ai[KS], bb, yi, 0, 0, 0);
}
__device__ __forceinline__ void stage_a(unsigned char* ws, int bg, int n2, LAS unsigned char* lds, int tid) {
    const int b = bg >> 2, g = bg & 3, lane = tid & 63, w = tid >> 6, r32 = lane & 31, hi = lane >> 5;
    const bf16_t* PXb = (const bf16_t*)(ws + WS_PX) + (size_t)b * SEQ * PXW + 768 + g * 128;
#pragma unroll
    for (int i = 0; i < 4; ++i) { const int q = tid + NTHR * i, kk = q >> 3, jc = (q & 7) * 8, n1 = kk & 127, isq = kk >> 7;
        const bf16x8 v = __builtin_nontemporal_load((const bf16x8*)(PXb + (size_t)(64 * n1 + n2) * PXW + isq * 64 + jc)); *(LAS bf16x8*)(lds + img_off(kk, jc)) = v; }
    const int kb = w & 3, d0 = w >> 2;
    bf16x8 ar[16], ai[16];
    { const bf16_t* gar = (const bf16_t*)(ws + WS_GA) + (size_t)(kb * 32 + r32) * 256 + 8 * hi; const bf16_t* gai = gar + 128 * 256;
#pragma unroll
      for (int k = 0; k < 16; ++k) { ar[k] = *(const bf16x8*)(gar + k * 16); ai[k] = *(const bf16x8*)(gai + k * 16); } }
    __syncthreads();
    const int vb = (int)(uintptr_t)lds + rd_base(lane) + d0 * 512;
    f32x16 yr = {0}, yi = {0};
    a_step<0>(yr, yi, vb, ar, ai); a_step<1>(yr, yi, vb, ar, ai); a_step<2>(yr, yi, vb, ar, ai); a_step<3>(yr, yi, vb, ar, ai);
    a_step<4>(yr, yi, vb, ar, ai); a_step<5>(yr, yi, vb, ar, ai); a_step<6>(yr, yi, vb, ar, ai); a_step<7>(yr, yi, vb, ar, ai);
    a_step<8>(yr, yi, vb, ar, ai); a_step<9>(yr, yi, vb, ar, ai); a_step<10>(yr, yi, vb, ar, ai); a_step<11>(yr, yi, vb, ar, ai);
    a_step<12>(yr, yi, vb, ar, ai); a_step<13>(yr, yi, vb, ar, ai); a_step<14>(yr, yi, vb, ar, ai); a_step<15>(yr, yi, vb, ar, ai);
    const float2* tw = (const float2*)(ws + WS_FTAB); bf16_t* FT = (bf16_t*)(ws + WS_FT);
#pragma unroll
    for (int r = 0; r < 16; ++r) { const int k1 = kb * 32 + (r & 3) + 8 * (r >> 2) + 4 * hi; const float2 t = tw[(n2 * k1) & 8191];
        bf16_t* dst = FT + (((size_t)bg * 128 + k1) * 64 + n2) * 128 + d0 * 32 + r32;
        dst[0] = (bf16_t)f2bf(t.x * yr[r] + t.y * yi[r]); dst[64] = (bf16_t)f2bf(t.x * yi[r] - t.y * yr[r]); }
    __syncthreads();
}
template <int KS> __device__ __forceinline__ void b_step(f32x16 (&acc)[2][2], int vb, const bf16x8 (&g0)[8], const bf16x8 (&g1)[8]) {
    const s16x4 l0 = tr_read<KS * 2048>(vb), h0 = tr_read<KS * 2048 + 1024>(vb), l1 = tr_read<KS * 2048 + 512>(vb), h1 = tr_read<KS * 2048 + 1536>(vb);
    asm volatile("s_waitcnt lgkmcnt(0)" ::: "memory"); __builtin_amdgcn_sched_barrier(0);
    const bf16x8 b0 = FOU_PK(l0, h0), b1 = FOU_PK(l1, h1);
    acc[0][0] = __builtin_amdgcn_mfma_f32_32x32x16_bf16(g0[KS], b0, acc[0][0], 0, 0, 0); acc[0][1] = __builtin_amdgcn_mfma_f32_32x32x16_bf16(g0[KS], b1, acc[0][1], 0, 0, 0);
    acc[1][0] = __builtin_amdgcn_mfma_f32_32x32x16_bf16(g1[KS], b0, acc[1][0], 0, 0, 0); acc[1][1] = __builtin_amdgcn_mfma_f32_32x32x16_bf16(g1[KS], b1, acc[1][1], 0, 0, 0);
}
__device__ __forceinline__ void stage_b(unsigned char* ws, int bg, int k1base, LAS unsigned char* lds, int tid) {
    const int b = bg >> 2, g = bg & 3, lane = tid & 63, w = tid >> 6, r32 = lane & 31, hi = lane >> 5, k1 = k1base + w;
    const bf16_t* src = (const bf16_t*)(ws + WS_FT) + ((size_t)bg * 128 + k1) * 64 * 128;
    LAS unsigned char* my = lds + w * 16384;
#pragma unroll
    for (int i = 0; i < 16; ++i) { const int q = lane + 64 * i, kk = q >> 3, jc = (q & 7) * 8; const bf16x8 v = __builtin_nontemporal_load((const bf16x8*)(src + q * 8)); *(LAS bf16x8*)(my + img_off(kk, jc)) = v; }
    bf16x8 g0[8], g1[8];
    { const bf16_t* gb = (const bf16_t*)(ws + WS_GB) + (size_t)r32 * 128 + 8 * hi;
#pragma unroll
      for (int k = 0; k < 8; ++k) { g0[k] = *(const bf16x8*)(gb + k * 16); g1[k] = *(const bf16x8*)(gb + 32 * 128 + k * 16); } }
    asm volatile("s_waitcnt lgkmcnt(0)" ::: "memory"); __builtin_amdgcn_sched_barrier(0);
    const int vb = (int)(uintptr_t)my + rd_base(lane);
    f32x16 acc[2][2] = {};
    b_step<0>(acc, vb, g0, g1); b_step<1>(acc, vb, g0, g1); b_step<2>(acc, vb, g0, g1); b_step<3>(acc, vb, g0, g1); b_step<4>(acc, vb, g0, g1); b_step<5>(acc, vb, g0, g1); b_step<6>(acc, vb, g0, g1); b_step<7>(acc, vb, g0, g1);
    bf16_t* MIXA = (bf16_t*)(ws + WS_MIXA);
#pragma unroll
    for (int rb = 0; rb < 2; ++rb)
#pragma unroll
        for (int r = 0; r < 16; ++r) { const int k2 = rb * 32 + (r & 3) + 8 * (r >> 2) + 4 * hi; bf16_t* dst = MIXA + ((size_t)b * SEQ + k1 + 128 * k2) * D + 768 + g * 64 + r32;
            dst[0] = (bf16_t)f2bf(acc[rb][0][r]); dst[32] = (bf16_t)f2bf(acc[rb][1][r]); }
}
#undef FOU_PK
}


#define XB_TMO      128
#define XB_XCNT(j)  (256  + 64 * (j))
#define XB_XSUB(j)  (1280 + 64 * (j))
#define XB_XGEN(j)  (2304 + 64 * (j))
#define XB_TOP      3328
#define XB_TOPGEN   3392
#define XCD_BAR_WORDS 3456
#define XB_SPIN_CAP (1u << 18)
__device__ __forceinline__ unsigned xb_ld(unsigned* p)              { return __hip_atomic_load(p, __ATOMIC_RELAXED, __HIP_MEMORY_SCOPE_AGENT); }
__device__ __forceinline__ unsigned xb_add(unsigned* p, unsigned v) { return __hip_atomic_fetch_add(p, v, __ATOMIC_RELAXED, __HIP_MEMORY_SCOPE_AGENT); }
__device__ __forceinline__ unsigned xb_xcc_id() { return (unsigned)__builtin_amdgcn_s_getreg((3 << 11) | 20) & 0xFu; }
#define XB_SPIN(cond, bar) do { unsigned _sp = 0; while (cond) { __builtin_amdgcn_s_sleep(1); \
    if ((++_sp & 255u) == 0u) { if (xb_ld(&(bar)[XB_TMO])) break; if (_sp > XB_SPIN_CAP) { atomicAdd(&(bar)[XB_TMO], 1u); break; } } } } while (0)
struct XcdBarrier { unsigned* bar; unsigned x; volatile LAS unsigned* st; };
__device__ __forceinline__ XcdBarrier xcd_barrier_post(unsigned* bar, volatile LAS unsigned* st) {
    XcdBarrier b; b.bar = bar; b.x = xb_xcc_id(); b.st = st;
    if (threadIdx.x == 0) (void)xb_add(&bar[XB_XCNT(b.x)], 1u);
    return b;
}
__device__ __forceinline__ void xcd_barrier_complete(unsigned* bar, unsigned x, unsigned& nloc, unsigned& nx) {
    const unsigned G = gridDim.x * gridDim.y * gridDim.z;
    unsigned sum, cnt, mine, sp = 0u;
    for (;;) {
        sum = 0u; cnt = 0u; mine = 0u;
#pragma unroll
        for (unsigned j = 0; j < 16; ++j) { const unsigned c = xb_ld(&bar[XB_XCNT(j)]); sum += c; cnt += (c > 0u) ? 1u : 0u; mine = (j == x) ? c : mine; }
        if (sum == G) break;
        __builtin_amdgcn_s_sleep(1);
        if ((++sp & 255u) == 0u) { if (xb_ld(&bar[XB_TMO])) break; if (sp > XB_SPIN_CAP) { atomicAdd(&bar[XB_TMO], 1u); break; } }
    }
    nloc = mine > 0u ? mine : 1u; nx = cnt > 0u ? cnt : 1u;
}
__device__ __forceinline__ void xcd_barrier(const XcdBarrier& b) {
    asm volatile("s_waitcnt vmcnt(0)" ::: "memory");
    __syncthreads();
    if (threadIdx.x == 0) {
        unsigned* bar = b.bar;
        __builtin_amdgcn_s_waitcnt(0);
        unsigned nloc = b.st[0], nx = b.st[1];
        if (nloc == 0u) { xcd_barrier_complete(bar, b.x, nloc, nx); b.st[0] = nloc; b.st[1] = nx; }
        const unsigned old = xb_add(&bar[XB_XSUB(b.x)], 1u);
        const unsigned gen = old / nloc;
        if (old + 1u == (gen + 1u) * nloc) {
            __builtin_amdgcn_fence(__ATOMIC_RELEASE, "agent");
            asm volatile("s_waitcnt vmcnt(0)" ::: "memory");
            const unsigned og = xb_add(&bar[XB_TOP], 1u);
            const unsigned tg = og / nx;
            if (og + 1u == (tg + 1u) * nx) xb_add(&bar[XB_TOPGEN], 1u);
            else XB_SPIN(xb_ld(&bar[XB_TOPGEN]) == tg, bar);
            __builtin_amdgcn_fence(__ATOMIC_ACQUIRE, "agent");
            xb_add(&bar[XB_XGEN(b.x)], 1u);
            asm volatile("s_waitcnt vmcnt(0)" ::: "memory");
        } else {
            XB_SPIN(xb_ld(&bar[XB_XGEN(b.x)]) == gen, bar);
            __builtin_amdgcn_fence(__ATOMIC_ACQUIRE, "agent");
            asm volatile("s_waitcnt vmcnt(0)" ::: "memory");
        }
    }
    __syncthreads();
}

enum { PH_PREP = 0, PH_MODUL = 1, PH_INPROJ = 2, PH_ROW1 = 3, PH_QKV = 4, PH_ATTN = 5, PH_ACOMB = 6, PH_OUTPROJ = 7, PH_ROW2 = 8, PH_LIST = 9, PH_MOE1 = 10, PH_MOE2 = 11, PH_FINAL = 12, NPH = 13 };
__global__ void __launch_bounds__(NTHR, 2) mega(P p) {
    extern __shared__ __attribute__((aligned(16))) unsigned char lds_raw[];
    LAS unsigned char* lds = (LAS unsigned char*)lds_raw;
    const int wg = blockIdx.x, nwg = gridDim.x;
    const int lo = p.ph_lo, hi = p.ph_hi;
    int wv = __builtin_amdgcn_readfirstlane((int)(threadIdx.x >> 6)); asm volatile("" : "+s"(wv));
    if (threadIdx.x == 0) { ((volatile LAS unsigned*)(lds + LDS_CTL))[0] = 0u; ((volatile LAS unsigned*)(lds + LDS_CTL))[1] = 0u; }
    __syncthreads();
    XcdBarrier bar; bar.bar = (unsigned*)(p.ws + WS_CTL) + 4096; bar.x = 0; bar.st = (volatile LAS unsigned*)(lds + LDS_CTL);
    if (hi - lo > 1) bar = xcd_barrier_post((unsigned*)(p.ws + WS_CTL) + 4096, (volatile LAS unsigned*)(lds + LDS_CTL));
#define SEAM(k) do { if (lo <= (k) && (k) + 1 < hi) xcd_barrier(bar); } while (0)
#ifndef PHMASK
#define PHMASK 0xFFFF
#endif
#define IN(k) (((PHMASK >> (k)) & 1) && lo <= (k) && (k) < hi)
    unsigned char* ws = p.ws;
#ifndef REPMASK
#define REPMASK 0
#endif
#define PHASE(k, ...) do { if (IN(k)) { _Pragma("unroll") for (int rep_ = 0; rep_ < 1 + ((REPMASK >> (k)) & 1); ++rep_) { if (rep_) xcd_barrier(bar); __VA_ARGS__ } } SEAM(k); } while (0)
    PHASE(PH_PREP, ph_prologue(p, wg, nwg, fresh_tid(wv), lds););
    PHASE(PH_MODUL, ph_modulate(p, wg, nwg, fresh_tid(wv)););
    PHASE(PH_INPROJ, { const pg8::DenseSched S{MA / 256, PXW / 256, nwg, wg, D, D, 0, (const char*)(ws + WS_WIN)}; const pg8::EpiRowMajor E{(bf16_t*)(ws + WS_PX), PXW};
        pg8::gemm_phase(lds, fresh_tid(wv), (const char*)(ws + WS_HX), D, S, E);
        if (nwg == NWG && wg >= 74) p0_expert_items(p, NEI_PREP + (wg - 74), 182, NEI_PREP + FILL_IN, fresh_tid(wv), (LAS float*)lds); });
    PHASE(PH_ROW1, { ph_row1(p, wg, nwg, fresh_tid(wv));
        { const int tid = fresh_tid(wv); __syncthreads(); for (int u = wg; u < 512; u += nwg) fou::stage_a(ws, u >> 6, u & 63, lds, tid); } });
    PHASE(PH_QKV, {
        { const int tid = fresh_tid(wv); for (int u = (wg + nwg / 2) % nwg; u < 128; u += nwg) fou::stage_b(ws, u >> 4, (u & 15) * 8, lds, tid); __syncthreads(); }
        { const pg8::DenseSched S{ML / 256, 5, nwg, wg, QL, PXW, 0, (const char*)(ws + WS_WQ)}; const pg8::EpiQ E{ws}; pg8::gemm_phase(lds, fresh_tid(wv), (const char*)(ws + WS_PX), QL, S, E); }
        { const pg8::DenseSched S{MA / 256, 6, nwg, wg, KVL, PXW, 512, (const char*)(ws + WS_WKV)}; const pg8::EpiKV E{ws}; pg8::gemm_phase(lds, fresh_tid(wv), (const char*)(ws + WS_PX), KVL, S, E); }
        if (nwg == NWG && wg >= 64) { const int tid = fresh_tid(wv); constexpr int QB = NEI_PREP + FILL_IN;
            if (wg < 128) p0_expert_items(p, QB + (wg - 64), 64, QB + 128, tid, (LAS float*)lds);
            else if (wg < 140) p0_expert_items(p, QB + 128 + (wg - 128), 12, QB + 140, tid, (LAS float*)lds);
            else { p0_expert_items(p, QB + 140 + (wg - 140), 116, QB + 372, tid, (LAS float*)lds);
                   if (wg <= 220) p0_expert_items(p, QB + 372 + (wg - 140), 81, QB + 453, tid, (LAS float*)lds); } } });
    static_assert(NEI_PREP + FILL_IN + 453 == NEI, "filler shares");
    PHASE(PH_ATTN, ph_attn(p, wg, nwg, lds, wv););
    PHASE(PH_ACOMB, ph_acomb(p, wg, nwg, fresh_tid(wv)););
    PHASE(PH_OUTPROJ, { const pg8::DenseSched S{ML / 256, D / 256, nwg, wg, D, D, 0, (const char*)(ws + WS_WOUT)}; const pg8::EpiRowMajor E{(bf16_t*)(ws + WS_MIX), D};
        pg8::gemm_phase(lds, fresh_tid(wv), (const char*)(ws + WS_MIXA), D, S, E); });
    PHASE(PH_ROW2, ph_row2(p, wg, nwg, fresh_tid(wv), lds););
    PHASE(PH_LIST, ph_lists(p, wg, nwg, fresh_tid(wv), lds););
    PHASE(PH_MOE1, { const int tid = fresh_tid(wv);
        LAS int* tileL = (LAS int*)(lds + LDS_CTL + 2048); LAS unsigned* lstL = (LAS unsigned*)(lds + LDS_CTL + 4096);
        const int* TILEE = (const int*)(ws + WS_TILEE); const int* SLOTTOK = (const int*)(ws + WS_SLOTTOK);
        for (int i = tid; i < MAXTILES; i += NTHR) tileL[i] = TILEE[i];
        if (tid == 0) tileL[300] = TILEE[400];
        __syncthreads();
        const pg8::MoeSched<8, true, MOE_FP8> S{nwg, wg, tileL, lstL, (const char*)(ws + WS_WGU), 2048};
        { pg8::GUnit u; for (int i = 0; i < 16 && S.next(i, u); ++i) if (tid < 256) lstL[i * 256 + tid] = (unsigned)SLOTTOK[u.arow + tid] * (MOE_FP8 ? 1024u : 2048u); }
        __syncthreads();
        if constexpr (MOE_FP8) { const pg8::EpiAct8 E{ws + WS_ACT, p.in[20], p.in[22], 1.f / WSCALE}; pg8::gemm_phase<pg8::EpiAct8, pg8::MoeSched<8, true, MOE_FP8>, true>(lds, tid, (const char*)(ws + WS_HX), D, S, E); }
        else { const pg8::EpiAct E{(bf16_t*)(ws + WS_ACT), p.in[20], p.in[22]}; pg8::gemm_phase(lds, fresh_tid(wv), (const char*)(ws + WS_HX), D, S, E); } });
    PHASE(PH_MOE2, { const int tid = fresh_tid(wv);
        LAS int* tileL = (LAS int*)(lds + LDS_CTL + 2048); LAS unsigned* lstL = (LAS unsigned*)(lds + LDS_CTL + 4096);
        const int* TILEE = (const int*)(ws + WS_TILEE);
        for (int i = tid; i < MAXTILES; i += NTHR) tileL[i] = TILEE[i];
        if (tid == 0) tileL[300] = TILEE[400];
        __syncthreads();
        const pg8::MoeSched<4, false, MOE_FP8> S{nwg, wg, tileL, lstL, (const char*)(ws + WS_WD), 1024};
        const pg8::EpiY8 E{ws + WS_Y, p.in[24], MOE_FP8 ? 1.f / WSCALE : 1.f};
        pg8::gemm_phase<pg8::EpiY8, pg8::MoeSched<4, false, MOE_FP8>, MOE_FP8>(lds, tid, (const char*)(ws + WS_ACT), D, S, E); });
    PHASE(PH_FINAL, ph_final(p, wg, nwg, fresh_tid(wv)););
#undef PHASE
#undef IN
#undef SEAM
}

extern "C" void kernel_launch(void* const* d_in, const int* in_sizes, int n_in, void* d_out, int out_size, void* d_ws, size_t ws_size, hipStream_t stream) {
    static int ok = 0;
    if (ok == 0) {
        if (n_in != 25 || in_sizes[0] != ML * D || out_size != ML * D || ws_size < WS_END) { fprintf(stderr, "kernel_launch: unexpected shapes (n_in %d, in0 %d, out %d, ws %zu < %zu)\n", n_in, n_in > 0 ? in_sizes[0] : -1, out_size, ws_size, (size_t)WS_END); ok = -1; return; }
        if (hipFuncSetAttribute((const void*)mega, hipFuncAttributeMaxDynamicSharedMemorySize, LDS_BYTES) != hipSuccess) { fprintf(stderr, "kernel_launch: hipFuncSetAttribute failed\n"); ok = -1; return; }
        int dev = 0, cus = 0, per_cu = 0;
        if (hipGetDevice(&dev) != hipSuccess || hipDeviceGetAttribute(&cus, hipDeviceAttributeMultiprocessorCount, dev) != hipSuccess) { fprintf(stderr, "kernel_launch: device query failed\n"); ok = -1; return; }
        if (hipOccupancyMaxActiveBlocksPerMultiprocessor(&per_cu, (const void*)mega, NTHR, LDS_BYTES) != hipSuccess || per_cu < 1) { fprintf(stderr, "kernel_launch: occupancy query says %d blocks per CU\n", per_cu); (void)hipGetLastError(); }
        if (cus != NWG) fprintf(stderr, "kernel_launch: %d CUs (built for %d)\n", cus, NWG);
        ok = cus < NWG ? cus : NWG;
    }
    if (ok < 0) return;
    const int grid = ok;
    (void)hipMemsetAsync((char*)d_ws + WS_CTL, 0, CTL_BYTES, stream);
    P p{}; for (int i = 0; i < 25; ++i) p.in[i] = (const float*)d_in[i]; p.out = (float*)d_out; p.ws = (unsigned char*)d_ws;
#define MEGA(a, b) do { p.ph_lo = (a); p.ph_hi = (b); hipLaunchKernelGGL(mega, dim3(grid), dim3(NTHR), LDS_BYTES, stream, p); } while (0)
#ifdef MULTI_LAUNCH
    for (int ph = 0; ph < NPH; ++ph) MEGA(ph, ph + 1);
#else
    MEGA(0, NPH);
#endif
#undef MEGA
    const hipError_t le = hipPeekAtLastError();
    if (le != hipSuccess) fprintf(stderr, "kernel_launch: launch failed: %s\n", hipGetErrorName(le));
}
```

```cpp
#include <hip/hip_runtime.h>
#include <cstdint>
#include <cstdio>

#define GAS __attribute__((address_space(1)))
#define LAS __attribute__((address_space(3)))
typedef unsigned short bf16_t;
typedef short bf16x8 __attribute__((ext_vector_type(8)));
typedef float f32x4 __attribute__((ext_vector_type(4)));
typedef float f32x16 __attribute__((ext_vector_type(16)));
typedef unsigned u32x4 __attribute__((ext_vector_type(4)));
typedef unsigned u32x2 __attribute__((ext_vector_type(2)));

#ifndef ATT_QK8
#define ATT_QK8 1
#endif
constexpr int D = 1024, SEQ = 8192, CTXL = 256, NH = 6, DQK = 192, DNOPE = 128, DROPE = 64, DV = 128;
constexpr int QL = 384, KVL = 256;
constexpr int ML = 2 * SEQ, MC = 2 * CTXL, MA = ML + MC;
constexpr int TK = SEQ + CTXL;
constexpr int PXW = 1280;
constexpr int NE = 32, DFF = 1024;
constexpr int MAXTILES = 288, SLOTS = MAXTILES * 256;
constexpr float RMS_EPS = 1e-6f;
constexpr int NWG = 256, NTHR = 512;
#ifndef MOE_FP8_ON
#define MOE_FP8_ON 1
#endif
constexpr bool MOE_FP8 = MOE_FP8_ON;
constexpr float WSCALE = 32.f;

constexpr size_t KiB = 1024, MiB = 1024 * 1024;
constexpr size_t WS_CTL = 0, CTL_BYTES = 64 * KiB;
constexpr size_t WS_MOD = 1 * MiB;
constexpr size_t WS_ROPE = WS_MOD + 96 * KiB;
constexpr size_t WS_RSTAT = WS_ROPE + 16 * KiB;
constexpr size_t WS_TOPI = 1 * MiB + 256 * KiB;
constexpr size_t WS_GATE = WS_TOPI + 256 * KiB;
constexpr size_t WS_TOKSLOT = WS_GATE + 256 * KiB;
constexpr size_t WS_SLOTTOK = 2 * MiB;
constexpr size_t WS_CHCNT = WS_SLOTTOK + 320 * KiB;
constexpr size_t WS_TILEE = WS_CHCNT + 32 * KiB;
constexpr size_t WS_FTAB = WS_TILEE + 32 * KiB;
constexpr size_t WS_WRT = WS_FTAB + 64 * KiB;
constexpr size_t WS_GA = WS_WRT + 128 * KiB;
constexpr size_t WS_GB = WS_GA + 128 * KiB;
constexpr size_t WS_WIN = 4 * MiB;
constexpr size_t WS_WQ = 7 * MiB;
constexpr size_t WS_WKV = 8 * MiB;
constexpr size_t WS_WOUT = 9 * MiB;
constexpr size_t WS_WD = 16 * MiB;
constexpr size_t WS_WGU = 80 * MiB;
constexpr size_t WS_HX = 208 * MiB;
constexpr size_t WS_Y = 80 * MiB;
constexpr size_t WS_MIX = 242 * MiB;
constexpr size_t WS_ACT = 274 * MiB;
constexpr size_t WS_PX = 274 * MiB;
constexpr size_t WS_Q = 316 * MiB;
constexpr size_t WS_KN = 352 * MiB;
constexpr size_t WS_V = 377 * MiB;
constexpr size_t WS_KR = 402 * MiB;
constexpr size_t WS_FT = 405 * MiB;
constexpr size_t WS_MIXA = 421 * MiB;
constexpr size_t WS_OPART = 208 * MiB;
constexpr size_t WS_OML = 304 * MiB;
constexpr size_t WS_END = 453 * MiB;

constexpr int LDS_BYTES = 163840;
constexpr int LDS_CTL = 139264;

struct P { const float* in[25]; float* out; unsigned char* ws; int ph_lo, ph_hi; };

__device__ __forceinline__ unsigned f2bf(float f) { unsigned u = __float_as_uint(f); return (u + 0x7fffu + ((u >> 16) & 1u)) >> 16; }
__device__ __forceinline__ float bflo(unsigned w) { return __uint_as_float(w << 16); }
__device__ __forceinline__ float bfhi(unsigned w) { return __uint_as_float(w & 0xffff0000u); }
typedef __bf16 bf16x2c __attribute__((ext_vector_type(2)));
typedef float f32x2c __attribute__((ext_vector_type(2)));
__device__ __forceinline__ unsigned pk2(float lo, float hi) { const f32x2c v = {lo, hi}; return __builtin_bit_cast(unsigned, __builtin_convertvector(v, bf16x2c)); }
template <int CTRL, int RMASK, bool BC> __device__ __forceinline__ float dpp_mov(float v) { return __builtin_bit_cast(float, __builtin_amdgcn_update_dpp(0, __builtin_bit_cast(int, v), CTRL, RMASK, 0xf, BC)); }
__device__ __forceinline__ float wave_sum(float v) {
    v += dpp_mov<0x111, 0xf, true>(v); v += dpp_mov<0x112, 0xf, true>(v); v += dpp_mov<0x114, 0xf, true>(v); v += dpp_mov<0x118, 0xf, true>(v);
    v += dpp_mov<0x142, 0xa, false>(v); v += dpp_mov<0x143, 0xc, false>(v);
    return __builtin_bit_cast(float, __builtin_amdgcn_readlane(__builtin_bit_cast(int, v), 63));
}
__device__ __forceinline__ float wave_max(float v) {
#pragma unroll
    for (int o = 1; o < 64; o <<= 1) v = fmaxf(v, __shfl_xor(v, o));
    return v;
}
__device__ __forceinline__ int fresh_tid(int wv) { int t = (wv << 6) | (int)__builtin_amdgcn_mbcnt_hi(~0u, __builtin_amdgcn_mbcnt_lo(~0u, 0u)); asm volatile("" : "+v"(t)); return t; }
__device__ __forceinline__ unsigned pg8_pk4_fp8(f32x4 v) { int p = __builtin_amdgcn_cvt_pk_fp8_f32(v.x, v.y, 0, false); p = __builtin_amdgcn_cvt_pk_fp8_f32(v.z, v.w, p, true); return (unsigned)p; }
__device__ __forceinline__ f32x4 fp8x4(unsigned w) { const auto lo = __builtin_amdgcn_cvt_pk_f32_fp8((int)w, false), hi = __builtin_amdgcn_cvt_pk_f32_fp8((int)w, true); return (f32x4){lo[0], lo[1], hi[0], hi[1]}; }
__device__ __forceinline__ float dot4(f32x4 a, f32x4 b) { return (a.x * b.x + a.y * b.y) + (a.z * b.z + a.w * b.w); }

__device__ __forceinline__ void p0_mod_item(const P& p, int it, int tid, LAS float* scr) {
    LAS float* sl = scr;
    LAS float* part = scr + 3072;
    const float* c = p.in[1]; const float* cc = p.in[3]; const float* wm = p.in[4]; const float* bm = p.in[5];
    for (int i = tid; i < 3072; i += NTHR) { const int r = i >> 10, k = i & 1023; const float v = r < 2 ? c[r * 1024 + k] : cc[k]; sl[i] = v / (1.f + __expf(-v)); }
    __syncthreads();
    const int ks = tid >> 5, cidx = tid & 31, n0 = it * 24;
    if (cidx < 24) {
        float a0 = 0.f, a1 = 0.f, a2 = 0.f;
#pragma unroll 1
        for (int kq = 0; kq < 2; ++kq) { float wv[32];
#pragma unroll
            for (int k = 0; k < 32; ++k) wv[k] = __builtin_nontemporal_load(wm + (size_t)(ks * 64 + kq * 32 + k) * 6144 + n0 + cidx);
#pragma unroll
            for (int k = 0; k < 32; ++k) { const float w = wv[k]; const int kk = ks * 64 + kq * 32 + k; a0 += sl[kk] * w; a1 += sl[1024 + kk] * w; a2 += sl[2048 + kk] * w; } }
        part[(ks * 3 + 0) * 24 + cidx] = a0; part[(ks * 3 + 1) * 24 + cidx] = a1; part[(ks * 3 + 2) * 24 + cidx] = a2;
    }
    __syncthreads();
    if (tid < 72) { const int r = tid / 24, cx = tid % 24; float s = bm[n0 + cx];
        for (int k = 0; k < 16; ++k) s += part[(k * 3 + r) * 24 + cx];
        ((float*)(p.ws + WS_MOD))[r * 6144 + n0 + cx] = s; }
    __syncthreads();
}
__device__ __forceinline__ void p0_misc_item(const P& p, int r, int tid) {
    const double TWO_PI = 6.283185307179586476925;
    if (r == 0) {
        float* ct = (float*)(p.ws + WS_ROPE); float* st = ct + 2048;
        for (int i = tid; i < 2048; i += NTHR) { const int pos = i >> 4, j = i & 15; const double inv = pow(10000.0, -(2.0 * j) / 32.0); const double a = (double)pos * inv; ct[i] = (float)cos(a); st[i] = (float)sin(a); }
        const float* wr = p.in[17]; bf16_t* wrh = (bf16_t*)(p.ws + WS_WRT); bf16_t* wrl = wrh + 32768;
        for (int i = tid; i < 32768; i += NTHR) { const int k = i >> 5, e = i & 31; const float w = wr[i]; const unsigned hb = f2bf(w); wrh[e * 1024 + k] = (bf16_t)hb; wrl[e * 1024 + k] = (bf16_t)f2bf(w - __uint_as_float(hb << 16)); }
    } else if (r == 1) {
        for (int i = tid; i < 8192; i += NTHR) { const double a = TWO_PI * i / 8192.0; ((float2*)(p.ws + WS_FTAB))[i] = make_float2((float)cos(a), (float)sin(a)); }
    } else if (r < 6) {
        bf16_t* GA = (bf16_t*)(p.ws + WS_GA);
        for (int i = tid; i < 64 * 256; i += NTHR) { const int row = (r - 2) * 64 + (i >> 8), kk = i & 255, c = row >> 7, k1 = row & 127, n1 = kk & 127, isq = kk >> 7;
            const double a = TWO_PI * ((n1 * k1) & 127) / 128.0; const double cs = cos(a), sn = sin(a);
            const double v = c == 0 ? (isq ? -sn : cs) : (isq ? -cs : -sn); GA[row * 256 + kk] = (bf16_t)f2bf((float)v); }
    } else {
        bf16_t* GB = (bf16_t*)(p.ws + WS_GB);
        for (int i = tid; i < 64 * 128; i += NTHR) { const int k2 = i >> 7, kk = i & 127, n2 = kk >> 1, c = kk & 1; const double a = TWO_PI * ((k2 * n2) & 63) / 64.0;
            GB[i] = (bf16_t)f2bf((float)(c ? sin(a) : cos(a))); }
    }
}
template <class CM>
__device__ __forceinline__ void p0_xpose_item(const CM& cm, int ldn, const float* gain, int k0, bf16_t* dst, int Kd, int nd0, int tid, LAS float* scr) {
    f32x4 v[8];
#pragma unroll
    for (int i = 0; i < 8; ++i) { const int q = tid + NTHR * i, k = q >> 6, n = (q & 63) * 4; const float* sp = cm(nd0 + n);
        v[i] = sp ? *(const f32x4*)(sp + (size_t)(k0 + k) * ldn) : (f32x4){0.f, 0.f, 0.f, 0.f}; }
#pragma unroll
    for (int i = 0; i < 8; ++i) { const int q = tid + NTHR * i, k = q >> 6, n = (q & 63) * 4; const float g = gain ? gain[k0 + k] : 1.f;
        LAS float* d = scr + k * 257 + n; d[0] = v[i].x * g; d[1] = v[i].y * g; d[2] = v[i].z * g; d[3] = v[i].w * g; }
    __syncthreads();
#pragma unroll
    for (int i = 0; i < 4; ++i) { const int q = tid + NTHR * i, n = q >> 3, kc = q & 7; const LAS float* s = scr + (kc * 8) * 257 + n;
        u32x4 o; o.x = pk2(s[0], s[257]); o.y = pk2(s[2 * 257], s[3 * 257]); o.z = pk2(s[4 * 257], s[5 * 257]); o.w = pk2(s[6 * 257], s[7 * 257]);
        *(u32x4*)(dst + (size_t)(nd0 + n) * Kd + k0 + kc * 8) = o; }
    __syncthreads();
}
struct CmWin { const float* w; __device__ const float* operator()(int n) const { return n < 384 ? w + 256 + n : (n < 448 ? w + 896 + (n - 384) : (n < 512 ? nullptr : w + 640 + (n - 512))); } };
struct CmPlain { const float* w; int nmax; __device__ const float* operator()(int n) const { return n < nmax ? w + n : nullptr; } };
struct CmGU { const float* g; const float* u; int pn; __device__ const float* operator()(int n) const { const int j = n & 255; return j < 128 ? g + 128 * pn + j : u + 128 * pn + (j - 128); } };
__device__ __forceinline__ void p0_fold_item(const P& p, int g, int kb, int tid, LAS float* scr) {
    LAS float* Mg = scr;
    LAS float* wb = scr + 8192;
    LAS float* cs = scr + 8192 + 4160;
    const float* wf = p.in[15] + g * 4096; const float* win = p.in[10];
    if (tid < 64) { const double a = 6.283185307179586476925 * tid / 64.0; cs[tid] = (float)cos(a); cs[64 + tid] = (float)sin(a); }
    __syncthreads();
    const float sinv = 1.0f / 724.0773439350246f;
    for (int i = 0; i < 16; ++i) { const int e = tid + NTHR * i, c = e >> 7, jj = e & 127, j = jj & 63, isq = jj >> 6; float s = 0.f;
        for (int m = 0; m < 64; ++m) s += cs[isq * 64 + ((m * c) & 63)] * wf[m * 64 + j];
        Mg[c * 128 + jj] = s * sinv; }
    for (int i = 0; i < 8; ++i) { const int e = tid + NTHR * i, k = e >> 6, c = e & 63; wb[k * 65 + c] = win[(size_t)(kb * 64 + k) * 960 + g * 64 + c]; }
    __syncthreads();
    const int jj = tid >> 2, kq = tid & 3; float acc[16];
#pragma unroll
    for (int i = 0; i < 16; ++i) acc[i] = 0.f;
    for (int c = 0; c < 64; ++c) { const float mv = Mg[c * 128 + jj];
#pragma unroll
        for (int i = 0; i < 16; ++i) acc[i] += wb[(kq * 16 + i) * 65 + c] * mv; }
    bf16_t* dst = (bf16_t*)(p.ws + WS_WIN) + (size_t)(768 + g * 128 + jj) * 1024 + kb * 64 + kq * 16;
    u32x4 o0, o1; o0.x = pk2(acc[0], acc[1]); o0.y = pk2(acc[2], acc[3]); o0.z = pk2(acc[4], acc[5]); o0.w = pk2(acc[6], acc[7]);
    o1.x = pk2(acc[8], acc[9]); o1.y = pk2(acc[10], acc[11]); o1.z = pk2(acc[12], acc[13]); o1.w = pk2(acc[14], acc[15]);
    *(u32x4*)dst = o0; *(u32x4*)(dst + 8) = o1;
    __syncthreads();
}
constexpr int I_WGU = 32 * 8 * 2 * 8, I_WD = 32 * 8 * 8, NEI = I_WGU + I_WD;
constexpr int FILL_IN = 182 * 4, FILL_Q = 128 + 12 + 232 + 81, NEI_PREP = NEI - FILL_IN - FILL_Q;
template <bool DYN = false>
__device__ __forceinline__ void p0_expert_items(const P& p, int first, int step, int end, int tid, LAS float* scr, unsigned* ctr = nullptr) {
        constexpr int XS = 129;
        f32x4 v[8];
#define P0_ISSUE(r_) do { const int r = (r_); const float* s0; int k0; \
            if (r < I_WGU) { const int e = r >> 7, t = (r >> 3) & 15, pn = t >> 1, hf = t & 1; k0 = (r & 7) * 128; s0 = (hf ? p.in[21] : p.in[19]) + (size_t)e * 1048576 + 128 * pn; } \
            else { const int q = r - I_WGU, e = q >> 6, nb = (q >> 3) & 7; k0 = (q & 7) * 128; s0 = p.in[23] + (size_t)e * 1048576 + nb * 128; } \
            _Pragma("unroll") for (int i = 0; i < 8; ++i) { const int q = tid + NTHR * i, k = q >> 5, n = (q & 31) * 4; v[i] = __builtin_nontemporal_load((const f32x4*)(s0 + (size_t)(k0 + k) * 1024 + n)); } } while (0)
        int it = first; LAS float* const scr0 = scr; int par = 0;
        LAS int* const nxw = (LAS int*)((LAS unsigned char*)scr0 + LDS_CTL + 128); unsigned pend = 0;
        if constexpr (DYN) { if (tid == 0) { nxw[0] = (int)__hip_atomic_fetch_add(ctr, 1u, __ATOMIC_RELAXED, __HIP_MEMORY_SCOPE_AGENT); pend = __hip_atomic_fetch_add(ctr, 1u, __ATOMIC_RELAXED, __HIP_MEMORY_SCOPE_AGENT); }
            __syncthreads(); it = nxw[0]; __syncthreads(); }
        if (it < end) P0_ISSUE(it);
        for (; it < end; par ^= 1) {
            int nx = it + step;
            scr = scr0 + par * (128 * XS);
#pragma unroll
            for (int i = 0; i < 8; ++i) { const int q = tid + NTHR * i, k = q >> 5, n = (q & 31) * 4; LAS float* d = scr + k * XS + ((n + 8 * (k >> 4)) & 127); d[0] = v[i].x; d[1] = v[i].y; d[2] = v[i].z; d[3] = v[i].w; }
            if constexpr (DYN) { if (tid == 0) { nxw[par] = (int)pend; pend = __hip_atomic_fetch_add(ctr, 1u, __ATOMIC_RELAXED, __HIP_MEMORY_SCOPE_AGENT); } }
            __syncthreads();
            if constexpr (DYN) nx = nxw[par];
            if (nx < end) P0_ISSUE(nx);
            size_t drow; int k0;
            if (it < I_WGU) { const int e = it >> 7, t = (it >> 3) & 15, pn = t >> 1, hf = t & 1; k0 = (it & 7) * 128; drow = (size_t)e * 2048 + pn * 256 + hf * 128; }
            else { const int q = it - I_WGU, e = q >> 6, nb = (q >> 3) & 7; k0 = (q & 7) * 128; drow = (size_t)e * 1024 + nb * 128; }
            if constexpr (MOE_FP8) {
                unsigned char* dst = (unsigned char*)(p.ws + (it < I_WGU ? WS_WGU : WS_WD)) + drow * 1024 + k0;
#pragma unroll
                for (int i = 0; i < 2; ++i) { const int q = tid + NTHR * i, n = q >> 3, kc = q & 7; const LAS float* s = scr + (kc * 16) * XS + ((n + 8 * kc) & 127); u32x4 o;
                    o.x = pg8_pk4_fp8((f32x4){s[0], s[XS], s[2 * XS], s[3 * XS]} * WSCALE); o.y = pg8_pk4_fp8((f32x4){s[4 * XS], s[5 * XS], s[6 * XS], s[7 * XS]} * WSCALE);
                    o.z = pg8_pk4_fp8((f32x4){s[8 * XS], s[9 * XS], s[10 * XS], s[11 * XS]} * WSCALE); o.w = pg8_pk4_fp8((f32x4){s[12 * XS], s[13 * XS], s[14 * XS], s[15 * XS]} * WSCALE);
                    __builtin_nontemporal_store(o, (u32x4*)(dst + (size_t)n * 1024 + kc * 16)); }
            } else {
                bf16_t* dst = (bf16_t*)(p.ws + (it < I_WGU ? WS_WGU : WS_WD)) + drow * 1024 + k0;
#pragma unroll
                for (int i = 0; i < 4; ++i) { const int q = tid + NTHR * i, n = q >> 4, kc = q & 15; const LAS float* s = scr + (kc * 8) * XS + ((n + 8 * (kc >> 1)) & 127);
                    u32x4 o; o.x = pk2(s[0], s[XS]); o.y = pk2(s[2 * XS], s[3 * XS]); o.z = pk2(s[4 * XS], s[5 * XS]); o.w = pk2(s[6 * XS], s[7 * XS]);
                    *(u32x4*)(dst + (size_t)n * 1024 + kc * 8) = o; }
            }
            it = nx;
        }
        __syncthreads();
#undef P0_ISSUE
}
__device__ __forceinline__ void ph_prologue(const P& p, int wg, int nwg, int tid, LAS unsigned char* lds) {
    LAS float* scr = (LAS float*)lds;
    constexpr int I_MOD = 256, I_MISC = 7, I_FOLD = 64, I_WIN = 3 * 16, I_WQ = 5 * 6, I_WKV = 6 * 4, I_WOUT = 4 * 16;
    constexpr int NIT = I_MOD + I_MISC + I_FOLD + I_WIN + I_WQ + I_WKV + I_WOUT;
    for (int it = wg; it < NIT; it += nwg) {
        int r = it;
        if (r < I_MOD) { p0_mod_item(p, r, tid, scr); continue; } r -= I_MOD;
        if (r < I_MISC) { p0_misc_item(p, r, tid); continue; } r -= I_MISC;
        if (r < I_FOLD) { p0_fold_item(p, r >> 4, r & 15, tid, scr); continue; } r -= I_FOLD;
        if (r < I_WIN) { CmWin cm{p.in[10]}; p0_xpose_item(cm, 960, nullptr, (r & 15) * 64, (bf16_t*)(p.ws + WS_WIN), 1024, (r >> 4) * 256, tid, scr); continue; } r -= I_WIN;
        if (r < I_WQ) { CmPlain cm{p.in[13], 1152}; p0_xpose_item(cm, 1152, p.in[11], (r % 6) * 64, (bf16_t*)(p.ws + WS_WQ), 384, (r / 6) * 256, tid, scr); continue; } r -= I_WQ;
        if (r < I_WKV) { CmPlain cm{p.in[14], 1536}; p0_xpose_item(cm, 1536, p.in[12], (r & 3) * 64, (bf16_t*)(p.ws + WS_WKV), 256, (r >> 2) * 256, tid, scr); continue; } r -= I_WKV;
        if (r < I_WOUT) { CmPlain cm{p.in[16], 1024}; p0_xpose_item(cm, 1024, nullptr, (r & 15) * 64, (bf16_t*)(p.ws + WS_WOUT), 1024, (r >> 4) * 256, tid, scr); continue; } r -= I_WOUT;
    }
    p0_expert_items<true>(p, wg, nwg, nwg == NWG ? NEI_PREP : NEI, tid, scr, (unsigned*)(p.ws + WS_CTL) + 64);
}

template <int NR> __device__ __forceinline__ void modul_rows(const float* const (&rows)[NR], bf16_t* const (&outs)[NR], const f32x4 (&a)[4], const f32x4 (&sh)[4], int lane) {
    f32x4 v[NR][4];
#pragma unroll
    for (int r = 0; r < NR; ++r)
#pragma unroll
        for (int j = 0; j < 4; ++j) v[r][j] = __builtin_nontemporal_load((const f32x4*)(rows[r] + 4 * lane + 256 * j));
#pragma unroll
    for (int r = 0; r < NR; ++r) { float ss = 0.f;
#pragma unroll
        for (int j = 0; j < 4; ++j) ss += dot4(v[r][j], v[r][j]);
        const float rinv = rsqrtf(wave_sum(ss) * (1.f / D) + RMS_EPS);
#pragma unroll
        for (int j = 0; j < 4; ++j) { const f32x4 o = v[r][j] * rinv * a[j] + sh[j]; u32x2 w; w.x = pk2(o.x, o.y); w.y = pk2(o.z, o.w); *(u32x2*)(outs[r] + 4 * lane + 256 * j) = w; } }
}
__device__ __forceinline__ void ph_modulate(const P& p, int wg, int nwg, int tid) {
    const int lane = tid & 63, wave = tid >> 6;
    const float* x = p.in[0]; const float* ctx = p.in[2]; const float* gain = p.in[6];
    const float* MOD = (const float*)(p.ws + WS_MOD); bf16_t* HX = (bf16_t*)(p.ws + WS_HX);
    for (int ch = wg; ch < 256; ch += nwg) {
        f32x4 a[4], sh[4];
        { const int r = ch >> 7;
#pragma unroll
          for (int j = 0; j < 4; ++j) { const int c = 4 * lane + 256 * j; sh[j] = *(const f32x4*)(MOD + r * 6144 + c); a[j] = *(const f32x4*)(gain + c) * (*(const f32x4*)(MOD + r * 6144 + 1024 + c) + 1.f); } }
#pragma unroll
        for (int q = 0; q < 2; ++q) { const int m0 = ch * 64 + wave * 8 + q * 4;
            const float* const rows[4] = {x + (size_t)m0 * D, x + (size_t)(m0 + 1) * D, x + (size_t)(m0 + 2) * D, x + (size_t)(m0 + 3) * D};
            bf16_t* const outs[4] = {HX + (size_t)m0 * D, HX + (size_t)(m0 + 1) * D, HX + (size_t)(m0 + 2) * D, HX + (size_t)(m0 + 3) * D};
            modul_rows<4>(rows, outs, a, sh, lane); }
        if (wave == 7) {
#pragma unroll
            for (int j = 0; j < 4; ++j) { const int c = 4 * lane + 256 * j; sh[j] = *(const f32x4*)(MOD + 2 * 6144 + c); a[j] = *(const f32x4*)(gain + c) * (*(const f32x4*)(MOD + 2 * 6144 + 1024 + c) + 1.f); }
            const int c0 = ch * 2;
            const float* const rows[2] = {ctx + (size_t)c0 * D, ctx + (size_t)(c0 + 1) * D};
            bf16_t* const outs[2] = {HX + (size_t)(ML + c0) * D, HX + (size_t)(ML + c0 + 1) * D};
            modul_rows<2>(rows, outs, a, sh, lane); }
    }
}

template <int NR> __device__ __forceinline__ void row1_rows(const P& p, const int (&ms)[NR], int lane) {
    const bf16_t* PX = (const bf16_t*)(p.ws + WS_PX); float* RS = (float*)(p.ws + WS_RSTAT); bf16_t* KR = (bf16_t*)(p.ws + WS_KR);
    const float* ct = (const float*)(p.ws + WS_ROPE); const float* st = ct + 2048;
    u32x4 c0[NR], c1[NR];
#pragma unroll
    for (int r = 0; r < NR; ++r) { const bf16_t* pr = PX + (size_t)ms[r] * PXW; c0[r] = *(const u32x4*)(pr + 8 * lane); c1[r] = *(const u32x4*)(pr + 512 + 8 * (lane & 31)); }
#pragma unroll
    for (int r = 0; r < NR; ++r) { const int m = ms[r];
        float v[8]; v[0] = bflo(c0[r].x); v[1] = bfhi(c0[r].x); v[2] = bflo(c0[r].y); v[3] = bfhi(c0[r].y); v[4] = bflo(c0[r].z); v[5] = bfhi(c0[r].z); v[6] = bflo(c0[r].w); v[7] = bfhi(c0[r].w);
        float sq = 0.f; if (lane < 48) { for (int j = 0; j < 8; ++j) sq += v[j] * v[j]; }
        float skv = 0.f; if (lane < 32) { const float t0 = bflo(c1[r].x), t1 = bfhi(c1[r].x), t2 = bflo(c1[r].y), t3 = bfhi(c1[r].y), t4 = bflo(c1[r].z), t5 = bfhi(c1[r].z), t6 = bflo(c1[r].w), t7 = bfhi(c1[r].w);
            skv = (t0 * t0 + t1 * t1) + (t2 * t2 + t3 * t3) + (t4 * t4 + t5 * t5) + (t6 * t6 + t7 * t7); }
        const float rq = rsqrtf(wave_sum(sq) * (1.f / QL) + RMS_EPS), rkv = rsqrtf(wave_sum(skv) * (1.f / KVL) + RMS_EPS);
        if (lane == 0) { RS[2 * m] = rq; RS[2 * m + 1] = rkv; }
        if (lane >= 48 && lane < 56) {
            const int d0 = (lane - 48) * 8; int b, tt;
            if (m < ML) { b = m >> 13; tt = m & 8191; const int prow = tt >> 6, pcol = tt & 63;
#pragma unroll
                for (int q = 0; q < 4; ++q) { const int pi = (d0 >> 1) + q; const int pos = pi < 16 ? prow : pcol, j = pi & 15; const float c = ct[pos * 16 + j], s = st[pos * 16 + j];
                    const float e = v[2 * q], o = v[2 * q + 1]; v[2 * q] = e * c - o * s; v[2 * q + 1] = e * s + o * c; } }
            else { b = (m - ML) >> 8; tt = SEQ + ((m - ML) & 255); }
            u32x4 o; o.x = pk2(v[0], v[1]); o.y = pk2(v[2], v[3]); o.z = pk2(v[4], v[5]); o.w = pk2(v[6], v[7]);
            if constexpr (ATT_QK8) { u32x2 w8; w8.x = pg8_pk4_fp8((f32x4){v[0], v[1], v[2], v[3]}); w8.y = pg8_pk4_fp8((f32x4){v[4], v[5], v[6], v[7]}); *(u32x2*)((unsigned char*)KR + ((size_t)b * TK + tt) * DROPE + d0) = w8; }
            else *(u32x4*)(KR + ((size_t)b * TK + tt) * DROPE + d0) = o;
        }
    }
}
__device__ __forceinline__ void ph_row1(const P& p, int wg, int nwg, int tid) {
    const int lane = tid & 63, wave = tid >> 6;
    for (int ch = wg; ch < 256; ch += nwg) {
        { const int m0 = ch * 64 + wave * 8; const int ms[8] = {m0, m0 + 1, m0 + 2, m0 + 3, m0 + 4, m0 + 5, m0 + 6, m0 + 7}; row1_rows<8>(p, ms, lane); }
        if (wave == 7) { const int ms[2] = {ML + ch * 2, ML + ch * 2 + 1}; row1_rows<2>(p, ms, lane); }
    }
}

__device__ __forceinline__ float half_max32(float v, int lane) {
    v = fmaxf(v, __builtin_bit_cast(float, __builtin_amdgcn_update_dpp(__builtin_bit_cast(int, v), __builtin_bit_cast(int, v), 0x111, 0xf, 0xf, false)));
    v = fmaxf(v, __builtin_bit_cast(float, __builtin_amdgcn_update_dpp(__builtin_bit_cast(int, v), __builtin_bit_cast(int, v), 0x112, 0xf, 0xf, false)));
    v = fmaxf(v, __builtin_bit_cast(float, __builtin_amdgcn_update_dpp(__builtin_bit_cast(int, v), __builtin_bit_cast(int, v), 0x114, 0xf, 0xf, false)));
    v = fmaxf(v, __builtin_bit_cast(float, __builtin_amdgcn_update_dpp(__builtin_bit_cast(int, v), __builtin_bit_cast(int, v), 0x118, 0xf, 0xf, false)));
    v = fmaxf(v, __builtin_bit_cast(float, __builtin_amdgcn_update_dpp(__builtin_bit_cast(int, v), __builtin_bit_cast(int, v), 0x142, 0xa, 0xf, false)));
    const float m0 = __builtin_bit_cast(float, __builtin_amdgcn_readlane(__builtin_bit_cast(int, v), 31)), m1 = __builtin_bit_cast(float, __builtin_amdgcn_readlane(__builtin_bit_cast(int, v), 63));
    return lane < 32 ? m0 : m1;
}
__device__ __forceinline__ void ph_row2(const P& p, int wg, int nwg, int tid, LAS unsigned char* lds) {
    const int lane = tid & 63, wave = tid >> 6;
    constexpr int HSTR = 2064;
    LAS unsigned char* Hhi = lds; LAS unsigned char* Hlo = lds + 32 * HSTR;
    LAS float* PL = (LAS float*)(lds + LDS_CTL + 4096);
    LAS int* hist = (LAS int*)(lds + LDS_CTL + 1024);
    const bf16_t* WRH = (const bf16_t*)(p.ws + WS_WRT); const bf16_t* WRL = WRH + 32768;
    const float* x = p.in[0]; const float* MOD = (const float*)(p.ws + WS_MOD); const float* npost = p.in[7]; const float* npre = p.in[8]; const float* br = p.in[18];
    const bf16_t* MIX = (const bf16_t*)(p.ws + WS_MIX); bf16_t* HX2 = (bf16_t*)(p.ws + WS_HX);
    int* TOPI = (int*)(p.ws + WS_TOPI); float* GATE = (float*)(p.ws + WS_GATE); int* CHCNT = (int*)(p.ws + WS_CHCNT);
    for (int ch = wg; ch < 256; ch += nwg) {
        if (tid < 32) hist[tid] = 0;
        const int b = (ch * 64) >> 13;
        f32x4 a1[4], a2[4], s2[4];
#pragma unroll
        for (int j = 0; j < 4; ++j) { const int c = 4 * lane + 256 * j;
            a1[j] = *(const f32x4*)(npost + c) * *(const f32x4*)(MOD + b * 6144 + 2048 + c);
            a2[j] = *(const f32x4*)(npre + c) * (*(const f32x4*)(MOD + b * 6144 + 4096 + c) + 1.f);
            s2[j] = *(const f32x4*)(MOD + b * 6144 + 3072 + c); }
        for (int batch = 0; batch < 2; ++batch) {
            u32x2 mw[4][4]; f32x4 xv[4][4];
#pragma unroll
            for (int i = 0; i < 4; ++i) { const int m = ch * 64 + batch * 32 + wave * 4 + i;
#pragma unroll
                for (int j = 0; j < 4; ++j) { mw[i][j] = *(const u32x2*)(MIX + (size_t)m * D + 4 * lane + 256 * j); xv[i][j] = __builtin_nontemporal_load((const f32x4*)(x + (size_t)m * D + 4 * lane + 256 * j)); } }
            const int fr = lane & 15, fq = lane >> 4, rb = (wave & 1) * 16, kq = wave >> 1;
            const bf16_t* bh = WRH + fr * 1024 + kq * 256 + fq * 8; const bf16_t* bl = WRL + fr * 1024 + kq * 256 + fq * 8;
#pragma unroll
            for (int i = 0; i < 4; ++i) {
                const int rl = wave * 4 + i, m = ch * 64 + batch * 32 + rl;
                f32x4 mx[4], h[4]; float ss = 0.f;
#pragma unroll
                for (int j = 0; j < 4; ++j) { const u32x2 w = mw[i][j]; mx[j] = (f32x4){bflo(w.x), bfhi(w.x), bflo(w.y), bfhi(w.y)}; ss += dot4(mx[j], mx[j]); }
                const float r1 = rsqrtf(wave_sum(ss) * (1.f / D) + RMS_EPS); float s2s = 0.f;
#pragma unroll
                for (int j = 0; j < 4; ++j) { h[j] = xv[i][j] + a1[j] * (mx[j] * r1); s2s += dot4(h[j], h[j]); }
                const float r2 = rsqrtf(wave_sum(s2s) * (1.f / D) + RMS_EPS);
#pragma unroll
                for (int j = 0; j < 4; ++j) { h[j] = h[j] * r2 * a2[j] + s2[j];
                    const unsigned h0 = f2bf(h[j].x), h1 = f2bf(h[j].y), h2 = f2bf(h[j].z), h3 = f2bf(h[j].w);
                    u32x2 wh; wh.x = h0 | (h1 << 16); wh.y = h2 | (h3 << 16);
                    u32x2 wl; wl.x = pk2(h[j].x - __uint_as_float(h0 << 16), h[j].y - __uint_as_float(h1 << 16)); wl.y = pk2(h[j].z - __uint_as_float(h2 << 16), h[j].w - __uint_as_float(h3 << 16));
                    if constexpr (MOE_FP8) *(unsigned*)((unsigned char*)HX2 + (size_t)m * D + 4 * lane + 256 * j) = pg8_pk4_fp8(h[j]);
                    else *(u32x2*)(HX2 + (size_t)m * D + 4 * lane + 256 * j) = wh;
                    *(LAS u32x2*)(Hhi + rl * HSTR + (4 * lane + 256 * j) * 2) = wh; *(LAS u32x2*)(Hlo + rl * HSTR + (4 * lane + 256 * j) * 2) = wl; }
            }
            bf16x8 Bh0[8], Bl0[8];
#pragma unroll
            for (int ks = 0; ks < 8; ++ks) { Bh0[ks] = *(const bf16x8*)(bh + ks * 32); Bl0[ks] = *(const bf16x8*)(bl + ks * 32); }
            __syncthreads();
            { f32x4 acc0 = {0.f, 0.f, 0.f, 0.f}, acc1 = {0.f, 0.f, 0.f, 0.f};
              bf16x8 Bh1[8], Bl1[8];
#pragma unroll
              for (int ks = 0; ks < 8; ++ks) { Bh1[ks] = *(const bf16x8*)(bh + 16 * 1024 + ks * 32); Bl1[ks] = *(const bf16x8*)(bl + 16 * 1024 + ks * 32); }
              const LAS unsigned char* ah = Hhi + (rb + fr) * HSTR + kq * 512 + fq * 16; const LAS unsigned char* al = Hlo + (rb + fr) * HSTR + kq * 512 + fq * 16;
#pragma unroll
              for (int ks = 0; ks < 8; ++ks) {
                  const bf16x8 Ah = *(const LAS bf16x8*)(ah + ks * 64), Al = *(const LAS bf16x8*)(al + ks * 64);
                  acc0 = __builtin_amdgcn_mfma_f32_16x16x32_bf16(Ah, Bh0[ks], acc0, 0, 0, 0); acc0 = __builtin_amdgcn_mfma_f32_16x16x32_bf16(Ah, Bl0[ks], acc0, 0, 0, 0); acc0 = __builtin_amdgcn_mfma_f32_16x16x32_bf16(Al, Bh0[ks], acc0, 0, 0, 0); }
#pragma unroll
              for (int ks = 0; ks < 8; ++ks) {
                  const bf16x8 Ah = *(const LAS bf16x8*)(ah + ks * 64), Al = *(const LAS bf16x8*)(al + ks * 64);
                  acc1 = __builtin_amdgcn_mfma_f32_16x16x32_bf16(Ah, Bh1[ks], acc1, 0, 0, 0); acc1 = __builtin_amdgcn_mfma_f32_16x16x32_bf16(Ah, Bl1[ks], acc1, 0, 0, 0); acc1 = __builtin_amdgcn_mfma_f32_16x16x32_bf16(Al, Bh1[ks], acc1, 0, 0, 0); }
#pragma unroll
              for (int r = 0; r < 4; ++r) { PL[(kq * 32 + rb + fq * 4 + r) * 32 + fr] = acc0[r]; PL[(kq * 32 + rb + fq * 4 + r) * 32 + 16 + fr] = acc1[r]; } }
            __syncthreads();
#pragma unroll
            for (int ps = 0; ps < 2; ++ps) {
                const int rl = wave * 4 + ps * 2 + (lane >> 5), e = lane & 31, m = ch * 64 + batch * 32 + rl;
                float v = ((PL[rl * 32 + e] + PL[(32 + rl) * 32 + e]) + (PL[(64 + rl) * 32 + e] + PL[(96 + rl) * 32 + e])) + br[e];
                int ti[4]; float tv[4];
#pragma unroll
                for (int k = 0; k < 4; ++k) { const float mx = half_max32(v, lane); const unsigned long long bal = __ballot(v == mx);
                    const unsigned hm = lane < 32 ? (unsigned)bal : (unsigned)(bal >> 32); const int idx = __ffs((int)hm) - 1;
                    ti[k] = idx; tv[k] = mx; if (e == idx) v = -3.0e38f; }
                const float e1 = __expf(tv[1] - tv[0]), e2 = __expf(tv[2] - tv[0]), e3 = __expf(tv[3] - tv[0]), inv = 1.f / (1.f + e1 + e2 + e3);
                if (e == 0) { *(int4*)(TOPI + 4 * m) = make_int4(ti[0], ti[1], ti[2], ti[3]); *(f32x4*)(GATE + 4 * m) = (f32x4){inv, e1 * inv, e2 * inv, e3 * inv};
                    atomicAdd((int*)&hist[ti[0]], 1); atomicAdd((int*)&hist[ti[1]], 1); atomicAdd((int*)&hist[ti[2]], 1); atomicAdd((int*)&hist[ti[3]], 1); }
            }
            __syncthreads();
        }
        if (tid < 32) CHCNT[ch * 32 + tid] = hist[tid];
        __syncthreads();
    }
}

__device__ __forceinline__ void ph_lists(const P& p, int wg, int nwg, int tid, LAS unsigned char* lds) {
    LAS int* ct = (LAS int*)lds;
    LAS int* part = ct + 8192;
    LAS int* tot = part + 512; LAS int* base = tot + 32; LAS int* off = base + 64; LAS int* tp = off + 32;
    const int* CHCNT = (const int*)(p.ws + WS_CHCNT); const int* TOPI = (const int*)(p.ws + WS_TOPI);
    int* TOKSLOT = (int*)(p.ws + WS_TOKSLOT); int* SLOTTOK = (int*)(p.ws + WS_SLOTTOK); int* TILEE = (int*)(p.ws + WS_TILEE);
    for (int i = tid; i < 8192; i += NTHR) ct[i] = CHCNT[i];
    __syncthreads();
    { const int e = tid & 31, pt = tid >> 5; int s = 0; for (int c = pt * 16; c < pt * 16 + 16; ++c) s += ct[c * 32 + e]; part[pt * 32 + e] = s; }
    __syncthreads();
    if (tid < 32) { int s = 0; for (int k = 0; k < 16; ++k) s += part[k * 32 + tid]; tot[tid] = s; }
    __syncthreads();
    if (tid == 0) { int run = 0; for (int e = 0; e < 32; ++e) { base[e] = run; run += ((tot[e] + 255) >> 8) << 8; } base[32] = run; }
    __syncthreads();
    for (int ch = wg; ch < 256; ch += nwg) {
        { const int e = tid & 31, pt = tid >> 5; int s = 0; for (int c = pt * 16; c < pt * 16 + 16 && c < ch; ++c) s += ct[c * 32 + e]; part[pt * 32 + e] = s; }
        if (tid < 256) tp[tid] = TOPI[ch * 256 + tid];
        __syncthreads();
        if (tid < 32) { int s = base[tid]; for (int k = 0; k < 16; ++k) s += part[k * 32 + tid]; off[tid] = s; }
        __syncthreads();
        if (tid < 256) { const int e = tp[tid]; int rank = 0; for (int q = 0; q < tid; ++q) rank += (tp[q] == e) ? 1 : 0;
            const int s = off[e] + rank; TOKSLOT[ch * 256 + tid] = s; SLOTTOK[s] = ch * 64 + (tid >> 2); }
        __syncthreads();
    }
    if (wg == 0) {
        if (tid < 32) { const int e = tid; for (int s = base[e] + tot[e]; s < base[e] + (((tot[e] + 255) >> 8) << 8); ++s) SLOTTOK[s] = 0;
            for (int t = base[e] >> 8; t < (base[e] >> 8) + ((tot[e] + 255) >> 8); ++t) TILEE[t] = e; }
        const int nt = base[32] >> 8;
        for (int t = nt + tid; t < MAXTILES; t += NTHR) TILEE[t] = -1;
        if (tid == 0) TILEE[400] = nt;
    }
}

__device__ __forceinline__ void ph_final(const P& p, int wg, int nwg, int tid) {
    const int lane = tid & 63, wave = tid >> 6;
    const float* x = p.in[0]; const float* MOD = (const float*)(p.ws + WS_MOD); const float* npost = p.in[7]; const float* nfpost = p.in[9];
    const bf16_t* MIX = (const bf16_t*)(p.ws + WS_MIX); const unsigned char* Y = (const unsigned char*)(p.ws + WS_Y);
    const int* TOKSLOT = (const int*)(p.ws + WS_TOKSLOT); const float* GATE = (const float*)(p.ws + WS_GATE);
    for (int ch = wg; ch < 256; ch += nwg) {
        const int b = (ch * 64) >> 13;
        f32x4 a1[4], a3[4];
#pragma unroll
        for (int j = 0; j < 4; ++j) { const int c = 4 * lane + 256 * j;
            a1[j] = *(const f32x4*)(npost + c) * *(const f32x4*)(MOD + b * 6144 + 2048 + c);
            a3[j] = *(const f32x4*)(nfpost + c) * *(const f32x4*)(MOD + b * 6144 + 5120 + c); }
        int4 sln[2]; f32x4 gtn[2];
#pragma unroll
        for (int q = 0; q < 2; ++q) { const int m = ch * 64 + wave * 8 + q; sln[q] = *(const int4*)(TOKSLOT + 4 * m); gtn[q] = *(const f32x4*)(GATE + 4 * m); }
#pragma unroll 1
        for (int i2 = 0; i2 < 8; i2 += 2) {
            const int4 sl[2] = {sln[0], sln[1]}; const f32x4 gt[2] = {gtn[0], gtn[1]};
            u32x2 mw[2][4]; unsigned yw[2][4][4]; f32x4 xv[2][4];
#pragma unroll
            for (int q = 0; q < 2; ++q) { const int m = ch * 64 + wave * 8 + i2 + q;
#pragma unroll
                for (int j = 0; j < 4; ++j) { const int c = 4 * lane + 256 * j;
                    mw[q][j] = __builtin_nontemporal_load((const u32x2*)(MIX + (size_t)m * D + c)); xv[q][j] = __builtin_nontemporal_load((const f32x4*)(x + (size_t)m * D + c));
                    yw[q][j][0] = __builtin_nontemporal_load((const unsigned*)(Y + (size_t)sl[q].x * D + c)); yw[q][j][1] = __builtin_nontemporal_load((const unsigned*)(Y + (size_t)sl[q].y * D + c));
                    yw[q][j][2] = __builtin_nontemporal_load((const unsigned*)(Y + (size_t)sl[q].z * D + c)); yw[q][j][3] = __builtin_nontemporal_load((const unsigned*)(Y + (size_t)sl[q].w * D + c)); } }
            if (i2 + 2 < 8) {
#pragma unroll
                for (int q = 0; q < 2; ++q) { const int m = ch * 64 + wave * 8 + i2 + 2 + q; sln[q] = *(const int4*)(TOKSLOT + 4 * m); gtn[q] = *(const f32x4*)(GATE + 4 * m); } }
#pragma unroll
            for (int q = 0; q < 2; ++q) { const int m = ch * 64 + wave * 8 + i2 + q; const f32x4 g = gt[q];
                f32x4 mx[4], y[4]; float ss = 0.f, sy = 0.f;
#pragma unroll
                for (int j = 0; j < 4; ++j) { const u32x2 w = mw[q][j]; mx[j] = (f32x4){bflo(w.x), bfhi(w.x), bflo(w.y), bfhi(w.y)}; ss += dot4(mx[j], mx[j]);
                    f32x4 t = fp8x4(yw[q][j][0]) * g.x; t += fp8x4(yw[q][j][1]) * g.y; t += fp8x4(yw[q][j][2]) * g.z; t += fp8x4(yw[q][j][3]) * g.w;
                    y[j] = t; sy += dot4(t, t); }
                const float r1 = rsqrtf(wave_sum(ss) * (1.f / D) + RMS_EPS), r3 = rsqrtf(wave_sum(sy) * (1.f / D) + RMS_EPS);
#pragma unroll
                for (int j = 0; j < 4; ++j) { const int c = 4 * lane + 256 * j;
                    const f32x4 x1 = xv[q][j] + a1[j] * (mx[j] * r1); __builtin_nontemporal_store(x1 + a3[j] * (y[j] * r3), (f32x4*)(p.out + (size_t)m * D + c)); } }
        }
    }
}

typedef float f32x2a __attribute__((ext_vector_type(2)));
__device__ __forceinline__ f32x4 act4p(f32x4 g, f32x4 u1) {
    f32x4 r;
#pragma unroll
    for (int i = 0; i < 4; i += 2) {
        const f32x2a gg = {fminf(g[i], 7.f), fminf(g[i + 1], 7.f)}; f32x2a e = gg * (f32x2a){-2.4554669595930156f, -2.4554669595930156f};
        e[0] = __builtin_amdgcn_exp2f(e[0]); e[1] = __builtin_amdgcn_exp2f(e[1]); e += (f32x2a){1.f, 1.f};
        const f32x2a rc = {__builtin_amdgcn_rcpf(e[0]), __builtin_amdgcn_rcpf(e[1])}, uu = {__builtin_amdgcn_fmed3f(u1[i], -6.f, 8.f), __builtin_amdgcn_fmed3f(u1[i + 1], -6.f, 8.f)};
        const f32x2a o = gg * rc * uu; r[i] = o[0]; r[i + 1] = o[1]; }
    return r;
}
__device__ __forceinline__ f32x4 act4(f32x4 g, f32x4 u) {
    f32x4 r;
#pragma unroll
    for (int i = 0; i < 4; ++i) { const float gg = fminf(g[i], 7.f), uu = fminf(fmaxf(u[i], -7.f), 7.f); r[i] = gg * __builtin_amdgcn_rcpf(1.f + __builtin_amdgcn_exp2f(-2.4554669595930156f * gg)) * (uu + 1.f); }
    return r;
}

namespace pg8 {
constexpr int BM = 256, BK = 64, HALF = 128, HTB = HALF * BK * 2, STAGE_BYTES = 8 * HTB, NXCD = 8, WGM = 8;
__device__ __forceinline__ int lds_byte(int r, int c) { const int st = (r >> 4) * 2 + (c >> 5), rr = r & 15, cc = c & 31, ob = rr * 64 + cc * 2; return st * 1024 + (ob ^ (((ob >> 9) & 1) << 5)); }
__device__ __forceinline__ void stage_rc(int b, int& R, int& C) { const int st = b / 1024, sb = b % 1024, swz = sb ^ (((sb >> 9) & 1) << 5); R = (st >> 1) * 16 + swz / 64; C = (st & 1) * 32 + (swz % 64) / 2; }
__device__ __forceinline__ int perm32(int rho) { const int n = rho >> 4, i = rho & 15; return 8 * (i >> 2) + 4 * n + (i & 3); }
struct GUnit { const char* B; int pm, pn, e, arow, li; };
typedef int i32x4v __attribute__((ext_vector_type(4)));
typedef int i32x8v __attribute__((ext_vector_type(8)));
template <class Epi, class Sched, bool FP8 = false>
__device__ __forceinline__ void gemm_phase(LAS unsigned char* lds, const int tid, const char* Abase, const int K, const Sched& S, const Epi& E) {
    const int wid = __builtin_amdgcn_readfirstlane(tid >> 6), lane = tid & 63, wr = wid >> 2, wc = wid & 3, fr = lane & 15, fq = lane >> 4;
    const int Kb = FP8 ? K : K * 2, nt = Kb / (BK * 2);
    unsigned voffB[2];
#pragma unroll
    for (int i = 0; i < 2; ++i) { int R, C; stage_rc(tid * 16 + i * 8192, R, C); const int Rb = (R & ~31) + perm32(R & 31); voffB[i] = (unsigned)(Rb * Kb + C * 2); }
    const size_t kstep = (size_t)(BK * 2);
    const size_t hstep = (size_t)HALF * Kb;
    const unsigned ldsw = (unsigned)wid * 1024u;
    constexpr int FC = FP8 ? 16 : 8, PSTR = FP8 ? 16 : 1024;
    const int aoff = lds_byte(wr * 64 + fr, fq * FC), boff = lds_byte(wc * 32 + fr, fq * FC);
#define PG8_SA(b, h) (((b) * 2 + (h)) * HTB)
#define PG8_SB(b, h) ((4 + (b) * 2 + (h)) * HTB)
#define PG8_STAGE_B(bufoff, gbase) do { _Pragma("unroll") for (int _i = 0; _i < 2; ++_i) \
        __builtin_amdgcn_global_load_lds((const unsigned*)((const char*)(gbase) + voffB[_i]), (LAS unsigned*)(lds + (bufoff) + ldsw + _i * 8192), 16, 0, 0); } while (0)
#define PG8_STAGE_A(bufoff, vo, koff) do { _Pragma("unroll") for (int _i = 0; _i < 2; ++_i) \
        __builtin_amdgcn_global_load_lds((const unsigned*)(Abase + (size_t)(vo)[_i] + (koff)), (LAS unsigned*)(lds + (bufoff) + ldsw + _i * 8192), 16, 0, 0); } while (0)
#define PG8_LDA(dst, b, h) do { _Pragma("unroll") for (int m = 0; m < 4; ++m) _Pragma("unroll") for (int k = 0; k < 2; ++k) dst[m][k] = *(const LAS bf16x8*)(lds + PG8_SA(b, h) + aoff + m * 2048 + k * PSTR); } while (0)
#define PG8_LDB(dst, b, h) do { _Pragma("unroll") for (int n = 0; n < 2; ++n) _Pragma("unroll") for (int k = 0; k < 2; ++k) dst[n][k] = *(const LAS bf16x8*)(lds + PG8_SB(b, h) + boff + n * 2048 + k * PSTR); } while (0)
#define PG8_CAT(x) __builtin_shufflevector(__builtin_bit_cast(i32x4v, (x)[0]), __builtin_bit_cast(i32x4v, (x)[1]), 0, 1, 2, 3, 4, 5, 6, 7)
#define PG8_MMA(ai, bj, At, Bt) do { __builtin_amdgcn_s_setprio(1); \
        if constexpr (FP8) { _Pragma("unroll") for (int m = 0; m < 4; ++m) _Pragma("unroll") for (int n = 0; n < 2; ++n) \
            acc[ai][bj][m][n] = __builtin_amdgcn_mfma_scale_f32_16x16x128_f8f6f4(PG8_CAT(Bt[n]), PG8_CAT(At[m]), acc[ai][bj][m][n], 0, 0, 0, 0x7F7F7F7F, 0, 0x7F7F7F7F); \
            _Pragma("unroll") for (int m = 0; m < 4; ++m) _Pragma("unroll") for (int n = 0; n < 2; ++n) asm volatile("" : "+v"(acc[ai][bj][m][n])); }   \
        else { _Pragma("unroll") for (int m = 0; m < 4; ++m) _Pragma("unroll") for (int n = 0; n < 2; ++n) _Pragma("unroll") for (int k = 0; k < 2; ++k) \
            acc[ai][bj][m][n] = __builtin_amdgcn_mfma_f32_16x16x32_bf16(Bt[n][k], At[m][k], acc[ai][bj][m][n], 0, 0, 0); } \
        __builtin_amdgcn_s_setprio(0); } while (0)
#define PG8_WAIT_V(n) asm volatile("s_waitcnt vmcnt(" #n ")" ::: "memory")
#define PG8_WAIT_L(n) asm volatile("s_waitcnt lgkmcnt(" #n ")" ::: "memory")
#define PG8_BAR __builtin_amdgcn_s_barrier()
#define PG8_SCHED __builtin_amdgcn_sched_barrier(0)
    GUnit cur, nxt; int ui = 0;
    if (!S.next(0, cur)) return;
    f32x4 acc[2][2][4][2];
#pragma unroll
    for (int a = 0; a < 2; ++a)
#pragma unroll
        for (int b = 0; b < 2; ++b)
#pragma unroll
            for (int m = 0; m < 4; ++m)
#pragma unroll
                for (int n = 0; n < 2; ++n) acc[a][b][m][n] = (f32x4){0.f, 0.f, 0.f, 0.f};
    bf16x8 At[4][2], B0[2][2], B1[2][2];
    unsigned cvo[2][2];
    S.aoffs(cur, tid, cvo);
    const char* cB = cur.B;
    PG8_STAGE_B(PG8_SB(0, 0), cB); PG8_STAGE_B(PG8_SB(0, 1), cB + hstep); PG8_STAGE_A(PG8_SA(0, 0), cvo[0], 0); PG8_STAGE_A(PG8_SA(0, 1), cvo[1], 0);
    if (wr == 1) PG8_BAR;
    PG8_WAIT_V(2); PG8_BAR;
    PG8_STAGE_B(PG8_SB(1, 0), cB + kstep); PG8_STAGE_A(PG8_SA(1, 0), cvo[0], kstep); PG8_STAGE_B(PG8_SB(1, 1), cB + hstep + kstep);
    PG8_WAIT_V(6); PG8_BAR;
    for (;;) {
        const bool has_next = S.next(ui + 1, nxt);
        const char* nB = has_next ? nxt.B : cB;
#pragma nounroll
        for (int t = 0; t < nt; t += 2) {
            const bool last = (t == nt - 2);
            const size_t k1 = (size_t)(t + 1) * kstep, k2 = last ? 0 : (size_t)(t + 2) * kstep, k3 = k2 + kstep;
            const char* b2 = last ? nB : cB + (size_t)(t + 2) * kstep; const char* b3 = b2 + kstep;
            PG8_LDB(B0, 0, 0); PG8_LDB(B1, 0, 1); PG8_SCHED; PG8_LDA(At, 0, 0); PG8_STAGE_A(PG8_SA(1, 1), cvo[1], k1);
            PG8_WAIT_V(8); PG8_WAIT_L(0); PG8_BAR; PG8_MMA(0, 0, At, B0); PG8_MMA(0, 1, At, B1); PG8_BAR; PG8_SCHED;
            if (last && has_next) S.aoffs(nxt, tid, cvo);
            PG8_LDA(At, 0, 1); PG8_STAGE_B(PG8_SB(0, 0), b2); PG8_STAGE_B(PG8_SB(0, 1), b2 + hstep); PG8_STAGE_A(PG8_SA(0, 0), cvo[0], k2);
            PG8_WAIT_V(8); PG8_WAIT_L(0); PG8_BAR; PG8_MMA(1, 0, At, B0); PG8_MMA(1, 1, At, B1); PG8_BAR; PG8_SCHED;
            PG8_LDB(B0, 1, 0); PG8_LDB(B1, 1, 1); PG8_SCHED; PG8_LDA(At, 1, 0); PG8_STAGE_A(PG8_SA(0, 1), cvo[1], k2);
            PG8_WAIT_V(8); PG8_WAIT_L(0); PG8_BAR; PG8_MMA(0, 0, At, B0); PG8_MMA(0, 1, At, B1); PG8_BAR; PG8_SCHED;
            PG8_LDA(At, 1, 1); PG8_STAGE_B(PG8_SB(1, 0), b3); PG8_STAGE_B(PG8_SB(1, 1), b3 + hstep); PG8_STAGE_A(PG8_SA(1, 0), cvo[0], k3);
            PG8_WAIT_V(8); PG8_WAIT_L(0); PG8_BAR; PG8_MMA(1, 0, At, B0); PG8_MMA(1, 1, At, B1); PG8_BAR; PG8_SCHED;
        }
        if (wr == 0) PG8_BAR;
        E(acc, cur, wr, wc, fr, fq);
        if (!has_next) break;
#pragma unroll
        for (int a = 0; a < 2; ++a)
#pragma unroll
            for (int b = 0; b < 2; ++b)
#pragma unroll
                for (int m = 0; m < 4; ++m)
#pragma unroll
                    for (int n = 0; n < 2; ++n) acc[a][b][m][n] = (f32x4){0.f, 0.f, 0.f, 0.f};
        cur = nxt; cB = nB; ++ui;
        if (wr == 1) PG8_BAR;
    }
    PG8_WAIT_V(0);
    PG8_BAR;
#undef PG8_SA
#undef PG8_SB
#undef PG8_STAGE_A
#undef PG8_STAGE_B
#undef PG8_LDA
#undef PG8_LDB
#undef PG8_MMA
#undef PG8_CAT
#undef PG8_WAIT_V
#undef PG8_WAIT_L
#undef PG8_BAR
#undef PG8_SCHED
}
struct DenseSched {
    int nM, nN, G, c, K, lda, acol0; const char* Bt;
    __device__ __forceinline__ bool next(int i, GUnit& u) const {
        const int nwg = nM * nN; const long L = (long)i * G + c; if (L >= nwg) return false;
        int wgid = (int)L; { const int q = nwg / NXCD, r = nwg % NXCD, xcd = wgid % NXCD, off = wgid / NXCD; wgid = (xcd < r ? xcd * (q + 1) : r * (q + 1) + (xcd - r) * q) + off; }
        const int nig = WGM * nN, gid = wgid / nig, fm = gid * WGM, gsz = (nM - fm) < WGM ? (nM - fm) : WGM;
        u.pm = fm + ((wgid % nig) % gsz); u.pn = (wgid % nig) / gsz; u.e = 0; u.arow = u.pm * BM; u.li = i; u.B = Bt + (size_t)u.pn * BM * K * 2; return true;
    }
    __device__ __forceinline__ void aoffs(const GUnit& u, int tid, unsigned (&vo)[2][2]) const {
#pragma unroll
        for (int i = 0; i < 2; ++i) { int R, C; stage_rc(tid * 16 + i * 8192, R, C);
#pragma unroll
            for (int h = 0; h < 2; ++h) vo[h][i] = (unsigned)((u.arow + R + 128 * h) * lda + acol0 + C) * 2u; }
    }
};
template <int NT, bool GATHER, bool FP8 = false> struct MoeSched {
    int G, c; const LAS int* tile; const LAS unsigned* lst; const char* W; int wrows;
    __device__ __forceinline__ bool next(int i, GUnit& u) const {
        constexpr int RPG = 32 / NT; const int L = i * G + c, x = L & 7, j = L >> 3, grp = j >> 5, jj = j & 31;
        const int rt = (grp * 8 + x) * RPG + (jj % RPG), pn = jj / RPG; if (rt >= tile[300]) return false;
        const int e = tile[rt]; u.pm = rt; u.pn = pn; u.e = e; u.arow = rt * BM; u.li = i; u.B = W + ((size_t)e * wrows + pn * BM) * (FP8 ? 1024 : 2048); return true;
    }
    __device__ __forceinline__ void aoffs(const GUnit& u, int tid, unsigned (&vo)[2][2]) const {
#pragma unroll
        for (int i = 0; i < 2; ++i) { int R, C; stage_rc(tid * 16 + i * 8192, R, C);
#pragma unroll
            for (int h = 0; h < 2; ++h) vo[h][i] = GATHER ? lst[u.li * 256 + R + 128 * h] + (unsigned)C * 2u : (unsigned)((u.arow + R + 128 * h) * (FP8 ? 1024 : 2048) + C * 2); }
    }
};
__device__ __forceinline__ u32x4 pack8(f32x4 a, f32x4 b) { u32x4 w; w.x = pk2(a.x, a.y); w.y = pk2(a.z, a.w); w.z = pk2(b.x, b.y); w.w = pk2(b.z, b.w); return w; }
#define PG8_EPI_LOOP _Pragma("unroll") for (int ai = 0; ai < 2; ++ai) _Pragma("unroll") for (int m = 0; m < 4; ++m)
struct EpiRowMajor { bf16_t* O; int ldo;
    __device__ __forceinline__ void operator()(const f32x4 (&acc)[2][2][4][2], const GUnit& u, int wr, int wc, int fr, int fq) const {
        PG8_EPI_LOOP { bf16_t* rp = O + (size_t)(u.arow + 128 * ai + 64 * wr + 16 * m + fr) * ldo + u.pn * BM + 32 * wc + 8 * fq;
#pragma unroll
            for (int bj = 0; bj < 2; ++bj) *(u32x4*)(rp + 128 * bj) = pack8(acc[ai][bj][m][0], acc[ai][bj][m][1]); }
    }
};
constexpr float QPRESCALE = 0.07216878364870322f * 1.4426950408889634f;
struct EpiQ { unsigned char* ws;
    __device__ __forceinline__ void operator()(const f32x4 (&acc)[2][2][4][2], const GUnit& u, int wr, int wc, int fr, int fq) const {
        const float* RS = (const float*)(ws + WS_RSTAT); const float* ct = (const float*)(ws + WS_ROPE); const float* st = ct + 2048; bf16_t* Q = (bf16_t*)(ws + WS_Q);
        PG8_EPI_LOOP { const int row = u.arow + 128 * ai + 64 * wr + 16 * m + fr; const float rinv = RS[2 * row] * (ATT_QK8 ? QPRESCALE * 16.f : QPRESCALE); const int b = row >> 13, t = row & 8191, prow = t >> 6, pcol = t & 63;
#pragma unroll
            for (int bj = 0; bj < 2; ++bj) { const int col = u.pn * BM + 128 * bj + 32 * wc + 8 * fq; if (col >= NH * DQK) continue;
                const int hd = col / DQK, d = col - hd * DQK; f32x4 v0 = acc[ai][bj][m][0] * rinv, v1 = acc[ai][bj][m][1] * rinv;
                if (d >= DNOPE) { const int pi = (d - DNOPE) >> 1, pos = pi < 16 ? prow : pcol, j = pi & 15; const f32x4 cs = *(const f32x4*)(ct + pos * 16 + j), sn = *(const f32x4*)(st + pos * 16 + j);
                    const f32x4 a = v0, c2 = v1; v0.x = a.x * cs.x - a.y * sn.x; v0.y = a.x * sn.x + a.y * cs.x; v0.z = a.z * cs.y - a.w * sn.y; v0.w = a.z * sn.y + a.w * cs.y;
                    v1.x = c2.x * cs.z - c2.y * sn.z; v1.y = c2.x * sn.z + c2.y * cs.z; v1.z = c2.z * cs.w - c2.w * sn.w; v1.w = c2.z * sn.w + c2.w * cs.w; }
                if constexpr (ATT_QK8) { u32x2 w8; w8.x = pg8_pk4_fp8(v0); w8.y = pg8_pk4_fp8(v1); *(u32x2*)((unsigned char*)Q + ((size_t)(b * NH + hd) * SEQ + t) * DQK + d) = w8; }
                else *(u32x4*)(Q + ((size_t)(b * NH + hd) * SEQ + t) * DQK + d) = pack8(v0, v1); }
            asm volatile("" ::: "memory"); }
    }
};
struct EpiKV { unsigned char* ws;
    __device__ __forceinline__ void operator()(const f32x4 (&acc)[2][2][4][2], const GUnit& u, int wr, int wc, int fr, int fq) const {
        const float* RS = (const float*)(ws + WS_RSTAT); bf16_t* KNp = (bf16_t*)(ws + WS_KN); bf16_t* Vp = (bf16_t*)(ws + WS_V);
        PG8_EPI_LOOP { const int row = u.arow + 128 * ai + 64 * wr + 16 * m + fr; const float rinv = RS[2 * row + 1]; int b, tt; if (row < ML) { b = row >> 13; tt = row & 8191; } else { b = (row - ML) >> 8; tt = SEQ + ((row - ML) & 255); }
            const size_t ro = ((size_t)(b * NH + u.pn) * TK + tt) * 128 + 32 * wc + 8 * fq;
            if constexpr (ATT_QK8) { u32x2 w8; w8.x = pg8_pk4_fp8(acc[ai][0][m][0] * rinv); w8.y = pg8_pk4_fp8(acc[ai][0][m][1] * rinv); *(u32x2*)((unsigned char*)KNp + ro) = w8; }
            else *(u32x4*)(KNp + ro) = pack8(acc[ai][0][m][0] * rinv, acc[ai][0][m][1] * rinv);
            *(u32x4*)(Vp + ro) = pack8(acc[ai][1][m][0] * rinv, acc[ai][1][m][1] * rinv);
            asm volatile("" ::: "memory"); }
    }
};
struct EpiAct { bf16_t* ACT; const float* bg; const float* bu;
    __device__ __forceinline__ void operator()(const f32x4 (&acc)[2][2][4][2], const GUnit& u, int wr, int wc, int fr, int fq) const {
        const int ac = u.pn * 128 + 32 * wc + 8 * fq; const float* pg = bg + u.e * 1024 + ac; const float* pu = bu + u.e * 1024 + ac;
        const f32x4 g0 = *(const f32x4*)pg, g1 = *(const f32x4*)(pg + 4), u0 = *(const f32x4*)pu, u1 = *(const f32x4*)(pu + 4);
        PG8_EPI_LOOP { const int slot = u.arow + 128 * ai + 64 * wr + 16 * m + fr;
            *(u32x4*)(ACT + (size_t)slot * 1024 + ac) = pack8(act4(acc[ai][0][m][0] + g0, acc[ai][1][m][0] + u0), act4(acc[ai][0][m][1] + g1, acc[ai][1][m][1] + u1)); }
    }
};
__device__ __forceinline__ unsigned pk4_fp8(f32x4 v) { int p = __builtin_amdgcn_cvt_pk_fp8_f32(v.x, v.y, 0, false); p = __builtin_amdgcn_cvt_pk_fp8_f32(v.z, v.w, p, true); return (unsigned)p; }
struct EpiAct8 { unsigned char* ACT; const float* bg; const float* bu; float sc;
    __device__ __forceinline__ void operator()(const f32x4 (&acc)[2][2][4][2], const GUnit& u, int wr, int wc, int fr, int fq) const {
        const int ac = u.pn * 128 + 32 * wc + 8 * fq; const float* pg = bg + u.e * 1024 + ac; const float* pu = bu + u.e * 1024 + ac;
        const f32x4 g0 = *(const f32x4*)pg, g1 = *(const f32x4*)(pg + 4), u0 = *(const f32x4*)pu + 1.f, u1 = *(const f32x4*)(pu + 4) + 1.f;
        PG8_EPI_LOOP { const int slot = u.arow + 128 * ai + 64 * wr + 16 * m + fr; u32x2 w;
            w.x = pk4_fp8(act4p(acc[ai][0][m][0] * sc + g0, acc[ai][1][m][0] * sc + u0)); w.y = pk4_fp8(act4p(acc[ai][0][m][1] * sc + g1, acc[ai][1][m][1] * sc + u1));
            *(u32x2*)(ACT + (size_t)slot * 1024 + ac) = w; }
    }
};
struct EpiY { bf16_t* Y; const float* bd; float sc;
    __device__ __forceinline__ void operator()(const f32x4 (&acc)[2][2][4][2], const GUnit& u, int wr, int wc, int fr, int fq) const {
        const int c0 = u.pn * BM + 32 * wc + 8 * fq; const float* pb = bd + u.e * 1024 + c0;
        const f32x4 b00 = *(const f32x4*)pb, b01 = *(const f32x4*)(pb + 4), b10 = *(const f32x4*)(pb + 128), b11 = *(const f32x4*)(pb + 132);
        PG8_EPI_LOOP { const int slot = u.arow + 128 * ai + 64 * wr + 16 * m + fr; bf16_t* rp = Y + (size_t)slot * 1024 + c0;
            *(u32x4*)rp = pack8(acc[ai][0][m][0] * sc + b00, acc[ai][0][m][1] * sc + b01); *(u32x4*)(rp + 128) = pack8(acc[ai][1][m][0] * sc + b10, acc[ai][1][m][1] * sc + b11); }
    }
};
struct EpiY8 { unsigned char* Y; const float* bd; float sc;
    __device__ __forceinline__ void operator()(const f32x4 (&acc)[2][2][4][2], const GUnit& u, int wr, int wc, int fr, int fq) const {
        const int c0 = u.pn * BM + 32 * wc + 8 * fq; const float* pb = bd + u.e * 1024 + c0;
        const f32x4 b00 = *(const f32x4*)pb, b01 = *(const f32x4*)(pb + 4), b10 = *(const f32x4*)(pb + 128), b11 = *(const f32x4*)(pb + 132);
        PG8_EPI_LOOP { const int slot = u.arow + 128 * ai + 64 * wr + 16 * m + fr; unsigned char* rp = Y + (size_t)slot * 1024 + c0; u32x2 w0, w1;
            w0.x = pk4_fp8(acc[ai][0][m][0] * sc + b00); w0.y = pk4_fp8(acc[ai][0][m][1] * sc + b01); w1.x = pk4_fp8(acc[ai][1][m][0] * sc + b10); w1.y = pk4_fp8(acc[ai][1][m][1] * sc + b11);
            *(u32x2*)rp = w0; *(u32x2*)(rp + 128) = w1; }
    }
};
#undef PG8_EPI_LOOP
}


namespace att {
typedef short s16x4 __attribute__((ext_vector_type(4)));
constexpr int NW = 8, QBLK = 32, KVBLK = 64, NTILE = 66, HALFKEYS = NTILE * KVBLK;
constexpr float SCALE = 0.07216878364870322f, THR = 8.f;
constexpr int SHM_V = KVBLK * 128 * 2, SHM_K = KVBLK * 128 * (ATT_QK8 ? 1 : 2), SHM_R = KVBLK * 64 * (ATT_QK8 ? 1 : 2);
__device__ __forceinline__ int crow(int r, int hi) { return (r & 3) + 8 * (r >> 2) + 4 * hi; }
__device__ __forceinline__ unsigned cvtpk(float lo, float hi) { return pk2(lo, hi); }
__device__ __forceinline__ int v_rd_base(int lane) { return ((lane & 3) << 3) | (((lane >> 2) & 3) << 6) | (((lane >> 4) & 1) << 5) | (((lane >> 5) & 1) << 8); }
constexpr int v_rd_off(int d0, int ks, int half) { return d0 * 512 + ks * 4096 + half * 2048; }
constexpr int SLOT_B = SHM_K + SHM_R + SHM_V, SL_K = 0, SL_R = SHM_K, SL_V = SHM_K + SHM_R, DMA_WS = 3 * SLOT_B, ATT_DMA_LDS = DMA_WS + NW * 64 * 4;
#define RSWZ(row, colB) ((row) * 128 + ((colB) ^ ((((row) >> 1) & 7) << 4)))
#define SBAR() __builtin_amdgcn_sched_barrier(0)
__device__ __forceinline__ float max3(float a, float b, float c) { return __builtin_elementwise_maximum(__builtin_elementwise_maximum(a, b), c); }
__device__ __forceinline__ float sm_max(const f32x16& p0, const f32x16& p1) {
  float a = max3(p0[0], p0[1], p0[2]), b = max3(p0[3], p0[4], p0[5]), c = max3(p1[0], p1[1], p1[2]), d = max3(p1[3], p1[4], p1[5]);
  a = max3(a, p0[6], p0[7]); b = max3(b, p0[8], p0[9]); c = max3(c, p1[6], p1[7]); d = max3(d, p1[8], p1[9]);
  a = max3(a, p0[10], p0[11]); b = max3(b, p0[12], p0[13]); c = max3(c, p1[10], p1[11]); d = max3(d, p1[12], p1[13]);
  a = max3(a, p0[14], p0[15]); c = max3(c, p1[14], p1[15]);
  float pmax = max3(a, b, max3(c, d, d));
  auto rr = __builtin_amdgcn_permlane32_swap(__float_as_uint(pmax), __float_as_uint(pmax), false, false);
  return max3(__uint_as_float(rr[0]), __uint_as_float(rr[1]), __uint_as_float(rr[1]));
}
__device__ __forceinline__ int kperm(int i) { const int a = i >> 3, h = (i >> 2) & 1, b = i & 3; return 16 * (a >> 1) + 8 * h + 4 * (a & 1) + b; }
__device__ __forceinline__ s16x4 trv(int a) { return __builtin_amdgcn_ds_read_tr16_b64_v4i16((LAS s16x4*)(uintptr_t)(unsigned)a); }
#define QK_LD(s, slot) do { if ((s) < 4) { f0[slot] = *(const LAS bf16x8*)(uintptr_t)(unsigned)(ka[(s)]); f1[slot] = *(const LAS bf16x8*)(uintptr_t)(unsigned)(ka[(s)] + 8192); } \
    else if ((s) < 8) { f0[slot] = *(const LAS bf16x8*)(uintptr_t)(unsigned)(kha[(s) - 4]); f1[slot] = *(const LAS bf16x8*)(uintptr_t)(unsigned)(kha[(s) - 4] + 8192); } \
    else { f0[slot] = *(const LAS bf16x8*)(uintptr_t)(unsigned)(ra[(s) - 8]); f1[slot] = *(const LAS bf16x8*)(uintptr_t)(unsigned)(ra[(s) - 8] + 4096); } } while (0)
#ifndef PP_KD
#define PP_KD 3
#endif
#ifndef PP_VD
#define PP_VD 6
#endif
constexpr int KD = PP_KD, KR_ = KD + 1, VD = PP_VD, VR_ = 16;
__device__ __forceinline__ void pp_qkt_head(bf16x8 (&f0)[KR_], bf16x8 (&f1)[KR_], const int (&kb)[4], const int (&rb)[4], int khd, int soff) {
  int ka[4], kha[4], ra[4];
#pragma unroll
  for (int i = 0; i < 4; ++i) { ka[i] = kb[i] + soff; kha[i] = ka[i] + khd; ra[i] = rb[i] + soff; }
#pragma unroll
  for (int s = 0; s < KD; ++s) QK_LD(s, s);
}
#define PV_LD(n) do { L[(n) & 15] = trv(vb + v_rd_off((n) & 3, (n) >> 2, 0)); H[(n) & 15] = trv(vb + v_rd_off((n) & 3, (n) >> 2, 1)); } while (0)
#define PV_MFMA(n) do { const bf16x8 pa_ = ((n) >> 2) == 0 ? pa0 : ((n) >> 2) == 1 ? pa1 : ((n) >> 2) == 2 ? pa2 : pa3; const s16x4 l_ = L[(n) & 15], h_ = H[(n) & 15]; \
    o[(n) & 3] = __builtin_amdgcn_mfma_f32_32x32x16_bf16(pa_, (bf16x8){l_[0], l_[1], l_[2], l_[3], h_[0], h_[1], h_[2], h_[3]}, o[(n) & 3], 0, 0, 0); } while (0)
template <bool PV>
__device__ __forceinline__ void pp_mphase(f32x16& p0, f32x16& p1, f32x16* o, bf16x8 (&f0)[KR_], bf16x8 (&f1)[KR_], const int (&kb)[4], int khd, const int (&rb)[4], int soff, int vb, const bf16x8* qr,
                                          bf16x8 pa0, bf16x8 pa1, bf16x8 pa2, bf16x8 pa3, const f32x16& minit) {
  int ka[4], kha[4], ra[4]; s16x4 L[VR_], H[VR_];
#pragma unroll
  for (int i = 0; i < 4; ++i) { ka[i] = kb[i] + soff; kha[i] = ka[i] + khd; ra[i] = rb[i] + soff; }
#pragma unroll
  for (int s = 0; s < 12; ++s) {
    if (s + KD < 12) QK_LD(s + KD, (s + KD) % KR_);
    else if (PV) { if (2 * (s + KD - 12) < VD) PV_LD(2 * (s + KD - 12)); if (2 * (s + KD - 12) + 1 < VD) PV_LD(2 * (s + KD - 12) + 1); }
    SBAR();
    p0 = __builtin_amdgcn_mfma_f32_32x32x16_bf16(f0[s % KR_], qr[s], s == 0 ? minit : p0, 0, 0, 0);
    p1 = __builtin_amdgcn_mfma_f32_32x32x16_bf16(f1[s % KR_], qr[s], s == 0 ? minit : p1, 0, 0, 0);
    SBAR(); }
  if (PV) {
#pragma unroll
    for (int n = 2 * KD; n < VD; ++n) PV_LD(n);
#pragma unroll
    for (int n = 0; n < 16; ++n) { if (n + VD < 16) PV_LD(n + VD); SBAR(); PV_MFMA(n); SBAR(); } }
}
__device__ __forceinline__ void pp_pv(f32x16* o, int vb, bf16x8 pa0, bf16x8 pa1, bf16x8 pa2, bf16x8 pa3) {
  s16x4 L[VR_], H[VR_];
#pragma unroll
  for (int n = 0; n < VD; ++n) PV_LD(n);
#pragma unroll
  for (int n = 0; n < 16; ++n) { if (n + VD < 16) PV_LD(n + VD); SBAR(); PV_MFMA(n); SBAR(); }
}
#undef QK_LD
#if ATT_QK8
typedef int i32x4q __attribute__((ext_vector_type(4)));
typedef int i32x8q __attribute__((ext_vector_type(8)));
#define Q8_CAT(a, b) __builtin_shufflevector((a), (b), 0, 1, 2, 3, 4, 5, 6, 7)
#define Q8_LD(s, slot) do { const int a0_ = (s) < 2 ? kq[2 * (s)] : rq[0], a1_ = (s) < 2 ? kq[2 * (s) + 1] : rq[1]; constexpr int b1_ = (s) < 2 ? 32 * 128 : 32 * 64; \
    g0[slot] = Q8_CAT(*(const LAS i32x4q*)(uintptr_t)(unsigned)(a0_ + soff), *(const LAS i32x4q*)(uintptr_t)(unsigned)(a1_ + soff)); \
    g1[slot] = Q8_CAT(*(const LAS i32x4q*)(uintptr_t)(unsigned)(a0_ + soff + b1_), *(const LAS i32x4q*)(uintptr_t)(unsigned)(a1_ + soff + b1_)); } while (0)
__device__ __forceinline__ void pp8_head(i32x8q (&g0)[3], i32x8q (&g1)[3], const int (&kq)[4], const int (&rq)[2], int soff) { Q8_LD(0, 0); Q8_LD(1, 1); }
template <bool PV>
__device__ __forceinline__ void pp8_mphase(f32x16& p0, f32x16& p1, f32x16* o, i32x8q (&g0)[3], i32x8q (&g1)[3], const int (&kq)[4], const int (&rq)[2], int soff, int vb, const i32x8q (&qf)[3],
                                           bf16x8 pa0, bf16x8 pa1, bf16x8 pa2, bf16x8 pa3, const f32x16& minit) {
  s16x4 L[VR_], H[VR_];
#pragma unroll
  for (int s = 0; s < 3; ++s) {
    if (s == 0) Q8_LD(2, 2);
    else if (PV) { PV_LD(3 * (s - 1)); PV_LD(3 * (s - 1) + 1); PV_LD(3 * (s - 1) + 2); }
    SBAR();
    p0 = __builtin_amdgcn_mfma_scale_f32_32x32x64_f8f6f4(g0[s], qf[s], s == 0 ? minit : p0, 0, 0, 0, 0x7F7F7F7F, 0, 0x7B7B7B7B);
    p1 = __builtin_amdgcn_mfma_scale_f32_32x32x64_f8f6f4(g1[s], qf[s], s == 0 ? minit : p1, 0, 0, 0, 0x7F7F7F7F, 0, 0x7B7B7B7B);
    SBAR(); }
  if (PV) {
#pragma unroll
    for (int n = 0; n < 16; ++n) { if (n + VD < 16) PV_LD(n + VD); SBAR(); PV_MFMA(n); SBAR(); } }
}
#undef Q8_LD
#endif
#undef PV_LD
#undef PV_MFMA
typedef float f32x2p __attribute__((ext_vector_type(2)));
__device__ __forceinline__ bf16x8 pp_pack8(const f32x16& p, int b) {
  u32x4 w = {cvtpk(p[b], p[b + 1]), cvtpk(p[b + 2], p[b + 3]), cvtpk(p[b + 4], p[b + 5]), cvtpk(p[b + 6], p[b + 7])}; return *reinterpret_cast<bf16x8*>(&w); }
__device__ __forceinline__ void pp_expsum(f32x16& p0, f32x16& p1, float& l_reg, bf16x8& pa0, bf16x8& pa1, bf16x8& pa2, bf16x8& pa3) {
  f32x2p s0 = {0.f, 0.f}, s1 = {0.f, 0.f};
#pragma unroll
  for (int r = 0; r < 16; r += 2) { f32x2p v = {__builtin_amdgcn_exp2f(p0[r]), __builtin_amdgcn_exp2f(p0[r + 1])}; s0 += v; p0[r] = v[0]; p0[r + 1] = v[1]; }
#pragma unroll
  for (int r = 0; r < 16; r += 2) { f32x2p v = {__builtin_amdgcn_exp2f(p1[r]), __builtin_amdgcn_exp2f(p1[r + 1])}; s1 += v; p1[r] = v[0]; p1[r + 1] = v[1]; }
  s0 += s1; l_reg += s0[0] + s0[1];
  pa0 = pp_pack8(p0, 0); pa1 = pp_pack8(p0, 8); pa2 = pp_pack8(p1, 0); pa3 = pp_pack8(p1, 8);
}
template <int NTT, bool FULL>
__device__ __forceinline__ void attn_unit_pp(const bf16_t* __restrict__ Qb, const bf16_t* __restrict__ Kh, const bf16_t* __restrict__ Vh, const bf16_t* __restrict__ Rh,
                                             float* __restrict__ Op, float* __restrict__ MLp, LAS unsigned char* lds, const int tid) {
  const int wid = __builtin_amdgcn_readfirstlane(tid >> 6), lane = tid & 63, r32 = lane & 31, hi = lane >> 5;
  const bool grpB = wid >= 4;
  LAS float* wsx = (LAS float*)(lds + DMA_WS) + wid * 64; LAS float* al_l = wsx + 32;
  float l_reg = 0; f32x16 o[4] = {}, minit = {};
#if ATT_QK8
  i32x8q qf[3];
#else
  bf16x8 qr[12];
#endif
  unsigned ko[2], vo[2], ro;
#pragma unroll
  for (int i = 0; i < 2; ++i) { const int pc = 2 * wid + i;
    { const int s = pc * 64 + lane, sub = s >> 5, within = s & 31, kk = (sub >> 2) * 8 + (within >> 2), c = (sub & 3) * 32 + (within & 3) * 8;
      const int k = (kk & ~0xC) | ((kk & 4) << 1) | ((kk & 8) >> 1); vo[i] = (unsigned)(k * 128 + c) * 2u; } }
#if ATT_QK8
  { const int row = 8 * wid + (lane >> 3), c = (lane & 7) ^ ((row >> 1) & 7); ko[0] = (unsigned)(row * 128 + c * 16); ko[1] = 0; }
  { const int row = 16 * (wid & 3) + (lane >> 2), c = (lane & 3) ^ ((row >> 2) & 3); ro = (unsigned)(row * 64 + c * 16); }
#else
#pragma unroll
  for (int i = 0; i < 2; ++i) { const int pc = 2 * wid + i;
    { const int row = 4 * pc + (lane >> 4), cl = (lane & 15) ^ (row & 15); ko[i] = (unsigned)(row * 128 + cl * 8) * 2u; } }
  { const int row = 8 * wid + (lane >> 3), cl = (lane & 7) ^ ((row >> 1) & 7); ro = (unsigned)(row * 64 + cl * 8) * 2u; }
#endif
#if ATT_QK8
#define GL1(voff, sbase, l) do { unsigned sv_; asm volatile("s_mov_b32 %0, m0\n\ts_mov_b32 m0, %3\n\ts_nop 0\n\tglobal_load_lds_dwordx4 %1, %2\n\ts_mov_b32 m0, %0" : "=&s"(sv_) : "v"(voff), "s"(sbase), "s"(l) : "memory"); } while (0)
#define DMA_KR(t, slot) do { const char* kt_ = (const char*)Kh + (size_t)(t) * (KVBLK * 128); const char* rt_ = (const char*)Rh + (size_t)(t) * (KVBLK * 64); const unsigned sb_ = (unsigned)lb + (unsigned)(slot) * SLOT_B; \
    GL1(ko[0], kt_, sb_ + SL_K + wid * 1024); if (wid < 4) GL1(ro, rt_, sb_ + SL_R + wid * 1024); } while (0)
#define DMA_KR2(t, slot) do { const char* kt_ = (const char*)Kh + (size_t)(t) * (KVBLK * 128); const char* rt_ = (const char*)Rh + (size_t)(t) * (KVBLK * 64); const unsigned sb_ = (unsigned)lb + (unsigned)(slot) * SLOT_B; \
    GL1(ko[0], kt_, sb_ + SL_K + wid * 1024); GL1(ko[0], kt_ + 4096, sb_ + SL_K + (wid + 4) * 1024); GL1(ro, rt_, sb_ + SL_R + wid * 1024); } while (0)
#else
#define DMA_KR(t, slot) do { const char* kt_ = (const char*)Kh + (size_t)(t) * (KVBLK * 256); const char* rt_ = (const char*)Rh + (size_t)(t) * (KVBLK * 128); const unsigned sb_ = (unsigned)lb + (unsigned)(slot) * SLOT_B; unsigned sv_; \
    asm volatile("s_mov_b32 %0, m0\n\ts_mov_b32 m0, %5\n\ts_nop 0\n\tglobal_load_lds_dwordx4 %1, %4\n\ts_mov_b32 m0, %6\n\ts_nop 0\n\tglobal_load_lds_dwordx4 %2, %4\n\ts_mov_b32 m0, %8\n\ts_nop 0\n\tglobal_load_lds_dwordx4 %3, %7\n\ts_mov_b32 m0, %0" \
                 : "=&s"(sv_) : "v"(ko[0]), "v"(ko[1]), "v"(ro), "s"(kt_), "s"(sb_ + SL_K + (2 * wid) * 1024), "s"(sb_ + SL_K + (2 * wid + 1) * 1024), "s"(rt_), "s"(sb_ + SL_R + wid * 1024) : "memory"); } while (0)
#define DMA_KR2(t, slot) do { const char* kt_ = (const char*)Kh + (size_t)(t) * (KVBLK * 256); const char* rt_ = (const char*)Rh + (size_t)(t) * (KVBLK * 128); const unsigned sb_ = (unsigned)lb + (unsigned)(slot) * SLOT_B; unsigned sv_; \
    asm volatile("s_mov_b32 %0, m0\n\ts_mov_b32 m0, %5\n\ts_nop 0\n\tglobal_load_lds_dwordx4 %1, %4\n\ts_mov_b32 m0, %6\n\ts_nop 0\n\tglobal_load_lds_dwordx4 %2, %4\n\ts_mov_b32 m0, %8\n\ts_nop 0\n\tglobal_load_lds_dwordx4 %3, %7\n\t" \
                 "s_mov_b32 m0, %10\n\ts_nop 0\n\tglobal_load_lds_dwordx4 %1, %9\n\ts_mov_b32 m0, %11\n\ts_nop 0\n\tglobal_load_lds_dwordx4 %2, %9\n\ts_mov_b32 m0, %13\n\ts_nop 0\n\tglobal_load_lds_dwordx4 %3, %12\n\ts_mov_b32 m0, %0" \
                 : "=&s"(sv_) : "v"(ko[0]), "v"(ko[1]), "v"(ro), "s"(kt_), "s"(sb_ + SL_K + (2 * wid) * 1024), "s"(sb_ + SL_K + (2 * wid + 1) * 1024), "s"(rt_), "s"(sb_ + SL_R + wid * 1024), \
                   "s"(kt_ + 8192), "s"(sb_ + SL_K + (2 * wid + 8) * 1024), "s"(sb_ + SL_K + (2 * wid + 9) * 1024), "s"(rt_ + 4096), "s"(sb_ + SL_R + (wid + 4) * 1024) : "memory"); } while (0)
#endif
#define DMA_V(t, slot) do { const char* vt_ = (const char*)Vh + (size_t)(t) * (KVBLK * 256); const unsigned sb_ = (unsigned)lb + (unsigned)(slot) * SLOT_B; unsigned sv_; \
    asm volatile("s_mov_b32 %0, m0\n\ts_mov_b32 m0, %4\n\ts_nop 0\n\tglobal_load_lds_dwordx4 %1, %3\n\ts_mov_b32 m0, %5\n\ts_nop 0\n\tglobal_load_lds_dwordx4 %2, %3\n\ts_mov_b32 m0, %0" \
                 : "=&s"(sv_) : "v"(vo[0]), "v"(vo[1]), "s"(vt_), "s"(sb_ + SL_V + (2 * wid) * 1024), "s"(sb_ + SL_V + (2 * wid + 1) * 1024) : "memory"); } while (0)
#define BAR() do { SBAR(); asm volatile("" ::: "memory"); __builtin_amdgcn_s_barrier(); asm volatile("" ::: "memory"); SBAR(); } while (0)
#define MBAR(n) do { SBAR(); asm volatile("s_waitcnt vmcnt(" #n ") lgkmcnt(0)" ::: "memory"); __builtin_amdgcn_s_barrier(); asm volatile("" ::: "memory"); SBAR(); } while (0)
#define RESC(a) do { if (__any((a) < 1.f)) { if (hi == 0) al_l[r32] = (a); asm volatile("s_waitcnt lgkmcnt(0)" ::: "memory"); \
    _Pragma("unroll") for (int d = 0; d < 4; ++d) _Pragma("unroll") for (int r = 0; r < 16; ++r) o[d][r] *= al_l[crow(r, hi)]; } } while (0)
#define VPHASE(FIRST) do { const float rel = sm_max(p0, p1); \
    if ((FIRST) || __any(rel > THR * 1.4426950408889634f)) { const float dl = (FIRST) ? rel : fmaxf(rel, 0.f), al = __builtin_amdgcn_exp2f(-dl); \
      _Pragma("unroll") for (int r = 0; r < 16; ++r) { p0[r] -= dl; p1[r] -= dl; minit[r] -= dl; }     \
      l_reg *= al; RESC(al); } \
    pp_expsum(p0, p1, l_reg, pa0, pa1, pa2, pa3); } while (0)
  constexpr int NT = NTT;
  const int lb = __builtin_amdgcn_readfirstlane((int)(uintptr_t)lds);
  DMA_KR(0, 0); DMA_KR(1, 1); DMA_V(0, 0);
#if ATT_QK8
  { const char* qp = (const char*)Qb + (unsigned)((wid * QBLK + r32) * DQK + hi * 16);
#pragma unroll
    for (int j = 0; j < 3; ++j) qf[j] = Q8_CAT(*reinterpret_cast<const i32x4q*>(qp + 64 * j), *reinterpret_cast<const i32x4q*>(qp + 64 * j + 32)); }
  const int vbase = lb + SL_V + v_rd_base(lane);
  int kq[4], rq[2];
  { const int kr = kperm(r32);
#pragma unroll
    for (int i = 0; i < 4; ++i) kq[i] = lb + SL_K + kr * 128 + ((((i >> 1) * 4 + (i & 1) * 2 + hi) ^ ((kr >> 1) & 7)) << 4);
#pragma unroll
    for (int i = 0; i < 2; ++i) rq[i] = lb + SL_R + kr * 64 + (((i * 2 + hi) ^ ((kr >> 2) & 3)) << 4); }
  i32x8q g0[3], g1[3];
#else
  { const unsigned qo = (unsigned)((wid * QBLK + r32) * DQK + hi * 8) * 2u;
#pragma unroll
    for (int d0 = 0; d0 < 12; ++d0) qr[d0] = *reinterpret_cast<const bf16x8*>((const char*)Qb + qo + d0 * 32); }
  const int vbase = lb + SL_V + v_rd_base(lane);
  int kb[4], rb[4];
#pragma unroll
  for (int i = 0; i < 4; ++i) { const int cb = (i * 16 + hi * 8) * 2, kr = kperm(r32); kb[i] = lb + SL_K + kr * 256 + ((((2 * i + hi) ^ (kr & 7)) + 8 * ((kr >> 3) & 1)) << 4); rb[i] = lb + SL_R + RSWZ(kr, cb); }
  const int khd = ((kperm(r32) >> 3) & 1) ? -128 : 128;
  bf16x8 f0[KR_], f1[KR_];
#endif
  f32x16 p0, p1; bf16x8 pa0 = {}, pa1 = {}, pa2 = {}, pa3 = {};
  MBAR(0);
  if (grpB) BAR();
#if ATT_QK8
  pp8_head(g0, g1, kq, rq, 0); pp8_mphase<false>(p0, p1, o, g0, g1, kq, rq, 0, 0, qf, pa0, pa0, pa0, pa0, minit);
#else
  pp_qkt_head(f0, f1, kb, rb, khd, 0); pp_mphase<false>(p0, p1, o, f0, f1, kb, khd, rb, 0, 0, qr, pa0, pa0, pa0, pa0, minit);
#endif
  MBAR(0);
  int sa = 0, sb = 1, sc = 2;
#pragma nounroll
  for (int t = 0; t + 1 < NT; ++t) {
    if (t + 2 < NT && !grpB) DMA_KR2(t + 2, sc);
    DMA_V(t + 1, sb);
    VPHASE(t == 0);
#if ATT_QK8
    pp8_head(g0, g1, kq, rq, sb * SLOT_B);
#else
    pp_qkt_head(f0, f1, kb, rb, khd, sb * SLOT_B);
#endif
    BAR();
#if ATT_QK8
    pp8_mphase<true>(p0, p1, o, g0, g1, kq, rq, sb * SLOT_B, vbase + sa * SLOT_B, qf, pa0, pa1, pa2, pa3, minit);
#else
    pp_mphase<true>(p0, p1, o, f0, f1, kb, khd, rb, sb * SLOT_B, vbase + sa * SLOT_B, qr, pa0, pa1, pa2, pa3, minit);
#endif
    MBAR(0);
    { const int tmp = sa; sa = sb; sb = sc; sc = tmp; }
  }
  VPHASE(NT == 1);
  BAR();
  pp_pv(o, vbase + sa * SLOT_B, pa0, pa1, pa2, pa3);
  asm volatile("s_waitcnt vmcnt(0)" ::: "memory");
  if (!grpB) BAR();
  { auto rr = __builtin_amdgcn_permlane32_swap(__float_as_uint(l_reg), __float_as_uint(l_reg), false, false); l_reg = __uint_as_float(rr[0]) + __uint_as_float(rr[1]); }
  if constexpr (FULL) {
    if (hi == 0) wsx[r32] = l_reg; asm volatile("s_waitcnt lgkmcnt(0)" ::: "memory");
    const unsigned oo = (unsigned)((wid * QBLK + 4 * hi) * D + r32) * 2u;
#pragma unroll
    for (int r = 0; r < 16; ++r) { const float rl = __builtin_amdgcn_rcpf(wsx[crow(r, hi)]);
#pragma unroll
      for (int d0 = 0; d0 < 4; ++d0) *(bf16_t*)((char*)Op + oo + (unsigned)(((r & 3) + 8 * (r >> 2)) * D + d0 * 32) * 2u) = (bf16_t)f2bf(o[d0][r] * rl); }
  } else {
    if (hi == 0) { *(float2*)((char*)MLp + (unsigned)(wid * QBLK + r32) * 8u) = make_float2(-minit[0], l_reg); }
    const unsigned oo = (unsigned)((wid * QBLK + 4 * hi) * 128 + r32) * 4u;
#pragma unroll
    for (int r = 0; r < 16; ++r)
#pragma unroll
      for (int d0 = 0; d0 < 4; ++d0) *(float*)((char*)Op + oo + (unsigned)(((r & 3) + 8 * (r >> 2)) * 128 + d0 * 32) * 4u) = o[d0][r]; }
#undef DMA_KR
#undef DMA_KR2
#ifdef GL1
#undef GL1
#endif
#undef DMA_V
#undef BAR
#undef MBAR
#undef RESC
#undef VPHASE
}
#undef RSWZ
#undef SBAR
}
#ifndef ATTN_UNIT
#define ATTN_UNIT attn_unit_pp
#endif
constexpr size_t QKB = ATT_QK8 ? 1 : 2;
__device__ __forceinline__ void ph_attn(const P& p, int wg, int nwg, LAS unsigned char* lds, const int wv) {
    unsigned char* ws = p.ws;
    { for (int L = wg; L < 256; L += nwg) { const int bh = L & 7, qb = (L >> 3) & 31, b = bh / NH, h = bh - b * NH;
        const int tid = fresh_tid(wv);
        __syncthreads();
        att::ATTN_UNIT<2 * att::NTILE, true>((const bf16_t*)(ws + WS_Q + ((size_t)bh * SEQ + qb * 256) * DQK * QKB), (const bf16_t*)(ws + WS_KN + (size_t)bh * TK * 128 * QKB),
                   (const bf16_t*)(ws + WS_V) + (size_t)bh * TK * 128, (const bf16_t*)(ws + WS_KR + (size_t)b * TK * 64 * QKB),
                   (float*)((bf16_t*)(ws + WS_MIXA) + ((size_t)b * SEQ + qb * 256) * D + h * 128), nullptr, lds, tid); } }
    { for (int L = wg; L < 256; L += nwg) { const int x = L & 7, qb = (L >> 3) & 31, bh = 8 + (x >> 1), half = x & 1, b = bh / NH, key0 = half * att::HALFKEYS, pidx = ((bh - 8) * 32 + qb) * 2 + half;
        const int tid = fresh_tid(wv);
        __syncthreads();
        att::ATTN_UNIT<att::NTILE, false>((const bf16_t*)(ws + WS_Q + ((size_t)bh * SEQ + qb * 256) * DQK * QKB), (const bf16_t*)(ws + WS_KN + ((size_t)bh * TK + key0) * 128 * QKB),
                   (const bf16_t*)(ws + WS_V) + ((size_t)bh * TK + key0) * 128, (const bf16_t*)(ws + WS_KR + ((size_t)b * TK + key0) * 64 * QKB),
                   (float*)(ws + WS_OPART) + (size_t)pidx * 32768, (float*)(ws + WS_OML) + (size_t)pidx * 512, lds, tid); } }
}
__device__ __forceinline__ void ph_acomb(const P& p, int wg, int nwg, int tid) {
    const int lane = tid & 63, gw = wg * 8 + (tid >> 6), ngw = nwg * 8; unsigned char* ws = p.ws;
    const float* OP = (const float*)(ws + WS_OPART); const float* OML = (const float*)(ws + WS_OML); bf16_t* MIXA = (bf16_t*)(ws + WS_MIXA);
    for (int rw = gw; rw < 4 * 32 * 256; rw += ngw) {
        const int pp = rw >> 8, r = rw & 255, bh = 8 + (pp >> 5), qb = pp & 31, b = bh / NH, h = bh - b * NH;
        const float2 ml1 = *(const float2*)(OML + ((size_t)(pp * 2) * 256 + r) * 2), ml2 = *(const float2*)(OML + ((size_t)(pp * 2 + 1) * 256 + r) * 2);
        typedef float f32x2v __attribute__((ext_vector_type(2)));
        const f32x2v o1 = __builtin_nontemporal_load((const f32x2v*)(OP + ((size_t)(pp * 2) * 256 + r) * 128 + 2 * lane)), o2 = __builtin_nontemporal_load((const f32x2v*)(OP + ((size_t)(pp * 2 + 1) * 256 + r) * 128 + 2 * lane));
        const float M = fmaxf(ml1.x, ml2.x), w1 = __builtin_amdgcn_exp2f(ml1.x - M), w2 = __builtin_amdgcn_exp2f(ml2.x - M), inv = 1.f / (ml1.y * w1 + ml2.y * w2);
        *(unsigned*)(MIXA + ((size_t)b * SEQ + qb * 256 + r) * D + h * 128 + 2 * lane) = pk2((o1.x * w1 + o2.x * w2) * inv, (o1.y * w1 + o2.y * w2) * inv);
    }
}

namespace fou {
typedef short s16x4 __attribute__((ext_vector_type(4)));
template <int OFF> __device__ __forceinline__ s16x4 tr_read(int vb) { s16x4 r; asm volatile("ds_read_b64_tr_b16 %0, %1 offset:%2" : "=&v"(r) : "v"(vb), "i"(OFF) : "memory"); return r; }
__device__ __forceinline__ int rd_base(int lane) { return ((lane & 3) << 3) | (((lane >> 2) & 3) << 6) | (((lane >> 4) & 1) << 5) | (((lane >> 5) & 1) << 8); }
__device__ __forceinline__ int img_off(int k, int c) { const int kk = (k & ~0xC) | ((k & 4) << 1) | ((k & 8) >> 1); return ((kk >> 3) * 2 + (c >> 5)) * 512 + ((kk & 7) * 32 + (c & 31)) * 2; }
#define FOU_PK(L, H) (bf16x8){L[0], L[1], L[2], L[3], H[0], H[1], H[2], H[3]}
template <int KS> __device__ __forceinline__ void a_step(f32x16& yr, f32x16& yi, int vb, const bf16x8 (&ar)[16], const bf16x8 (&ai)[16]) {
    const s16x4 l = tr_read<KS * 2048>(vb), h = tr_read<KS * 2048 + 1024>(vb);
    asm volatile("s_waitcnt lgkmcnt(0)" ::: "memory"); __builtin_amdgcn_sched_barrier(0);
    const bf16x8 bb = FOU_PK(l, h);
    yr = __builtin_amdgcn_mfma_f32_32x32x16_bf16(ar[KS], bb, yr, 0, 0, 0); yi = __builtin_amdgcn_mfma_f32_32x32x16_bf16(ai[KS], bb, yi, 0, 0, 0);
}
__device__ __forceinline__ void stage_a(unsigned char* ws, int bg, int n2, LAS unsigned char* lds, int tid) {
    const int b = bg >> 2, g = bg & 3, lane = tid & 63, w = tid >> 6, r32 = lane & 31, hi = lane >> 5;
    const bf16_t* PXb = (const bf16_t*)(ws + WS_PX) + (size_t)b * SEQ * PXW + 768 + g * 128;
#pragma unroll
    for (int i = 0; i < 4; ++i) { const int q = tid + NTHR * i, kk = q >> 3, jc = (q & 7) * 8, n1 = kk & 127, isq = kk >> 7;
        const bf16x8 v = __builtin_nontemporal_load((const bf16x8*)(PXb + (size_t)(64 * n1 + n2) * PXW + isq * 64 + jc)); *(LAS bf16x8*)(lds + img_off(kk, jc)) = v; }
    const int kb = w & 3, d0 = w >> 2;
    bf16x8 ar[16], ai[16];
    { const bf16_t* gar = (const bf16_t*)(ws + WS_GA) + (size_t)(kb * 32 + r32) * 256 + 8 * hi; const bf16_t* gai = gar + 128 * 256;
#pragma unroll
      for (int k = 0; k < 16; ++k) { ar[k] = *(const bf16x8*)(gar + k * 16); ai[k] = *(const bf16x8*)(gai + k * 16); } }
    __syncthreads();
    const int vb = (int)(uintptr_t)lds + rd_base(lane) + d0 * 512;
    f32x16 yr = {0}, yi = {0};
    a_step<0>(yr, yi, vb, ar, ai); a_step<1>(yr, yi, vb, ar, ai); a_step<2>(yr, yi, vb, ar, ai); a_step<3>(yr, yi, vb, ar, ai);
    a_step<4>(yr, yi, vb, ar, ai); a_step<5>(yr, yi, vb, ar, ai); a_step<6>(yr, yi, vb, ar, ai); a_step<7>(yr, yi, vb, ar, ai);
    a_step<8>(yr, yi, vb, ar, ai); a_step<9>(yr, yi, vb, ar, ai); a_step<10>(yr, yi, vb, ar, ai); a_step<11>(yr, yi, vb, ar, ai);
    a_step<12>(yr, yi, vb, ar, ai); a_step<13>(yr, yi, vb, ar, ai); a_step<14>(yr, yi, vb, ar, ai); a_step<15>(yr, yi, vb, ar, ai);
    const float2* tw = (const float2*)(ws + WS_FTAB); bf16_t* FT = (bf16_t*)(ws + WS_FT);
#pragma unroll
    for (int r = 0; r < 16; ++r) { const int k1 = kb * 32 + (r & 3) + 8 * (r >> 2) + 4 * hi; const float2 t = tw[(n2 * k1) & 8191];
        bf16_t* dst = FT + (((size_t)bg * 128 + k1) * 64 + n2) * 128 + d0 * 32 + r32;
        dst[0] = (bf16_t)f2bf(t.x * yr[r] + t.y * yi[r]); dst[64] = (bf16_t)f2bf(t.x * yi[r] - t.y * yr[r]); }
    __syncthreads();
}
template <int KS> __device__ __forceinline__ void b_step(f32x16 (&acc)[2][2], int vb, const bf16x8 (&g0)[8], const bf16x8 (&g1)[8]) {
    const s16x4 l0 = tr_read<KS * 2048>(vb), h0 = tr_read<KS * 2048 + 1024>(vb), l1 = tr_read<KS * 2048 + 512>(vb), h1 = tr_read<KS * 2048 + 1536>(vb);
    asm volatile("s_waitcnt lgkmcnt(0)" ::: "memory"); __builtin_amdgcn_sched_barrier(0);
    const bf16x8 b0 = FOU_PK(l0, h0), b1 = FOU_PK(l1, h1);
    acc[0][0] = __builtin_amdgcn_mfma_f32_32x32x16_bf16(g0[KS], b0, acc[0][0], 0, 0, 0); acc[0][1] = __builtin_amdgcn_mfma_f32_32x32x16_bf16(g0[KS], b1, acc[0][1], 0, 0, 0);
    acc[1][0] = __builtin_amdgcn_mfma_f32_32x32x16_bf16(g1[KS], b0, acc[1][0], 0, 0, 0); acc[1][1] = __builtin_amdgcn_mfma_f32_32x32x16_bf16(g1[KS], b1, acc[1][1], 0, 0, 0);
}
__device__ __forceinline__ void stage_b(unsigned char* ws, int bg, int k1base, LAS unsigned char* lds, int tid) {
    const int b = bg >> 2, g = bg & 3, lane = tid & 63, w = tid >> 6, r32 = lane & 31, hi = lane >> 5, k1 = k1base + w;
    const bf16_t* src = (const bf16_t*)(ws + WS_FT) + ((size_t)bg * 128 + k1) * 64 * 128;
    LAS unsigned char* my = lds + w * 16384;
#pragma unroll
    for (int i = 0; i < 16; ++i) { const int q = lane + 64 * i, kk = q >> 3, jc = (q & 7) * 8; const bf16x8 v = __builtin_nontemporal_load((const bf16x8*)(src + q * 8)); *(LAS bf16x8*)(my + img_off(kk, jc)) = v; }
    bf16x8 g0[8], g1[8];
    { const bf16_t* gb = (const bf16_t*)(ws + WS_GB) + (size_t)r32 * 128 + 8 * hi;
#pragma unroll
      for (int k = 0; k < 8; ++k) { g0[k] = *(const bf16x8*)(gb + k * 16); g1[k] = *(const bf16x8*)(gb + 32 * 128 + k * 16); } }
    asm volatile("s_waitcnt lgkmcnt(0)" ::: "memory"); __builtin_amdgcn_sched_barrier(0);
    const int vb = (int)(uintptr_t)my + rd_base(lane);
    f32x16 acc[2][2] = {};
    b_step<0>(acc, vb, g0, g1); b_step<1>(acc, vb, g0, g1); b_step<2>(acc, vb, g0, g1); b_step<3>(acc, vb, g0, g1); b_step<4>(acc, vb, g0, g1); b_step<5>(acc, vb, g0, g1); b_step<6>(acc, vb, g0, g1); b_step<7>(acc, vb, g0, g1);
    bf16_t* MIXA = (bf16_t*)(ws + WS_MIXA);
#pragma unroll
    for (int rb = 0; rb < 2; ++rb)
#pragma unroll
        for (int r = 0; r < 16; ++r) { const int k2 = rb * 32 + (r & 3) + 8 * (r >> 2) + 4 * hi; bf16_t* dst = MIXA + ((size_t)b * SEQ + k1 + 128 * k2) * D + 768 + g * 64 + r32;
            dst[0] = (bf16_t)f2bf(acc[rb][0][r]); dst[32] = (bf16_t)f2bf(acc[rb][1][r]); }
}
#undef FOU_PK
}


#define XB_TMO      128
#define XB_XCNT(j)  (256  + 64 * (j))
#define XB_XSUB(j)  (1280 + 64 * (j))
#define XB_XGEN(j)  (2304 + 64 * (j))
#define XB_TOP      3328
#define XB_TOPGEN   3392
#define XCD_BAR_WORDS 3456
#define XB_SPIN_CAP (1u << 18)
__device__ __forceinline__ unsigned xb_ld(unsigned* p)              { return __hip_atomic_load(p, __ATOMIC_RELAXED, __HIP_MEMORY_SCOPE_AGENT); }
__device__ __forceinline__ unsigned xb_add(unsigned* p, unsigned v) { return __hip_atomic_fetch_add(p, v, __ATOMIC_RELAXED, __HIP_MEMORY_SCOPE_AGENT); }
__device__ __forceinline__ unsigned xb_xcc_id() { return (unsigned)__builtin_amdgcn_s_getreg((3 << 11) | 20) & 0xFu; }
#define XB_SPIN(cond, bar) do { unsigned _sp = 0; while (cond) { __builtin_amdgcn_s_sleep(1); \
    if ((++_sp & 255u) == 0u) { if (xb_ld(&(bar)[XB_TMO])) break; if (_sp > XB_SPIN_CAP) { atomicAdd(&(bar)[XB_TMO], 1u); break; } } } } while (0)
struct XcdBarrier { unsigned* bar; unsigned x; volatile LAS unsigned* st; };
__device__ __forceinline__ XcdBarrier xcd_barrier_post(unsigned* bar, volatile LAS unsigned* st) {
    XcdBarrier b; b.bar = bar; b.x = xb_xcc_id(); b.st = st;
    if (threadIdx.x == 0) (void)xb_add(&bar[XB_XCNT(b.x)], 1u);
    return b;
}
__device__ __forceinline__ void xcd_barrier_complete(unsigned* bar, unsigned x, unsigned& nloc, unsigned& nx) {
    const unsigned G = gridDim.x * gridDim.y * gridDim.z;
    unsigned sum, cnt, mine, sp = 0u;
    for (;;) {
        sum = 0u; cnt = 0u; mine = 0u;
#pragma unroll
        for (unsigned j = 0; j < 16; ++j) { const unsigned c = xb_ld(&bar[XB_XCNT(j)]); sum += c; cnt += (c > 0u) ? 1u : 0u; mine = (j == x) ? c : mine; }
        if (sum == G) break;
        __builtin_amdgcn_s_sleep(1);
        if ((++sp & 255u) == 0u) { if (xb_ld(&bar[XB_TMO])) break; if (sp > XB_SPIN_CAP) { atomicAdd(&bar[XB_TMO], 1u); break; } }
    }
    nloc = mine > 0u ? mine : 1u; nx = cnt > 0u ? cnt : 1u;
}
__device__ __forceinline__ void xcd_barrier(const XcdBarrier& b) {
    asm volatile("s_waitcnt vmcnt(0)" ::: "memory");
    __syncthreads();
    if (threadIdx.x == 0) {
        unsigned* bar = b.bar;
        __builtin_amdgcn_s_waitcnt(0);
        unsigned nloc = b.st[0], nx = b.st[1];
        if (nloc == 0u) { xcd_barrier_complete(bar, b.x, nloc, nx); b.st[0] = nloc; b.st[1] = nx; }
        const unsigned old = xb_add(&bar[XB_XSUB(b.x)], 1u);
        const unsigned gen = old / nloc;
        if (old + 1u == (gen + 1u) * nloc) {
            __builtin_amdgcn_fence(__ATOMIC_RELEASE, "agent");
            asm volatile("s_waitcnt vmcnt(0)" ::: "memory");
            const unsigned og = xb_add(&bar[XB_TOP], 1u);
            const unsigned tg = og / nx;
            if (og + 1u == (tg + 1u) * nx) xb_add(&bar[XB_TOPGEN], 1u);
            else XB_SPIN(xb_ld(&bar[XB_TOPGEN]) == tg, bar);
            __builtin_amdgcn_fence(__ATOMIC_ACQUIRE, "agent");
            xb_add(&bar[XB_XGEN(b.x)], 1u);
            asm volatile("s_waitcnt vmcnt(0)" ::: "memory");
        } else {
            XB_SPIN(xb_ld(&bar[XB_XGEN(b.x)]) == gen, bar);
            __builtin_amdgcn_fence(__ATOMIC_ACQUIRE, "agent");
            asm volatile("s_waitcnt vmcnt(0)" ::: "memory");
        }
    }
    __syncthreads();
}

enum { PH_PREP = 0, PH_MODUL = 1, PH_INPROJ = 2, PH_ROW1 = 3, PH_QKV = 4, PH_ATTN = 5, PH_ACOMB = 6, PH_OUTPROJ = 7, PH_ROW2 = 8, PH_LIST = 9, PH_MOE1 = 10, PH_MOE2 = 11, PH_FINAL = 12, NPH = 13 };
__global__ void __launch_bounds__(NTHR, 2) mega(P p) {
    extern __shared__ __attribute__((aligned(16))) unsigned char lds_raw[];
    LAS unsigned char* lds = (LAS unsigned char*)lds_raw;
    const int wg = blockIdx.x, nwg = gridDim.x;
    const int lo = p.ph_lo, hi = p.ph_hi;
    int wv = __builtin_amdgcn_readfirstlane((int)(threadIdx.x >> 6)); asm volatile("" : "+s"(wv));
    if (threadIdx.x == 0) { ((volatile LAS unsigned*)(lds + LDS_CTL))[0] = 0u; ((volatile LAS unsigned*)(lds + LDS_CTL))[1] = 0u; }
    __syncthreads();
    XcdBarrier bar; bar.bar = (unsigned*)(p.ws + WS_CTL) + 4096; bar.x = 0; bar.st = (volatile LAS unsigned*)(lds + LDS_CTL);
    if (hi - lo > 1) bar = xcd_barrier_post((unsigned*)(p.ws + WS_CTL) + 4096, (volatile LAS unsigned*)(lds + LDS_CTL));
#define SEAM(k) do { if (lo <= (k) && (k) + 1 < hi) xcd_barrier(bar); } while (0)
#ifndef PHMASK
#define PHMASK 0xFFFF
#endif
#define IN(k) (((PHMASK >> (k)) & 1) && lo <= (k) && (k) < hi)
    unsigned char* ws = p.ws;
#ifndef REPMASK
#define REPMASK 0
#endif
#define PHASE(k, ...) do { if (IN(k)) { _Pragma("unroll") for (int rep_ = 0; rep_ < 1 + ((REPMASK >> (k)) & 1); ++rep_) { if (rep_) xcd_barrier(bar); __VA_ARGS__ } } SEAM(k); } while (0)
    PHASE(PH_PREP, ph_prologue(p, wg, nwg, fresh_tid(wv), lds););
    PHASE(PH_MODUL, ph_modulate(p, wg, nwg, fresh_tid(wv)););
    PHASE(PH_INPROJ, { const pg8::DenseSched S{MA / 256, PXW / 256, nwg, wg, D, D, 0, (const char*)(ws + WS_WIN)}; const pg8::EpiRowMajor E{(bf16_t*)(ws + WS_PX), PXW};
        pg8::gemm_phase(lds, fresh_tid(wv), (const char*)(ws + WS_HX), D, S, E);
        if (nwg == NWG && wg >= 74) p0_expert_items(p, NEI_PREP + (wg - 74), 182, NEI_PREP + FILL_IN, fresh_tid(wv), (LAS float*)lds); });
    PHASE(PH_ROW1, { ph_row1(p, wg, nwg, fresh_tid(wv));
        { const int tid = fresh_tid(wv); __syncthreads(); for (int u = wg; u < 512; u += nwg) fou::stage_a(ws, u >> 6, u & 63, lds, tid); } });
    PHASE(PH_QKV, {
        { const int tid = fresh_tid(wv); for (int u = (wg + nwg / 2) % nwg; u < 128; u += nwg) fou::stage_b(ws, u >> 4, (u & 15) * 8, lds, tid); __syncthreads(); }
        { const pg8::DenseSched S{ML / 256, 5, nwg, wg, QL, PXW, 0, (const char*)(ws + WS_WQ)}; const pg8::EpiQ E{ws}; pg8::gemm_phase(lds, fresh_tid(wv), (const char*)(ws + WS_PX), QL, S, E); }
        { const pg8::DenseSched S{MA / 256, 6, nwg, wg, KVL, PXW, 512, (const char*)(ws + WS_WKV)}; const pg8::EpiKV E{ws}; pg8::gemm_phase(lds, fresh_tid(wv), (const char*)(ws + WS_PX), KVL, S, E); }
        if (nwg == NWG && wg >= 64) { const int tid = fresh_tid(wv); constexpr int QB = NEI_PREP + FILL_IN;
            if (wg < 128) p0_expert_items(p, QB + (wg - 64), 64, QB + 128, tid, (LAS float*)lds);
            else if (wg < 140) p0_expert_items(p, QB + 128 + (wg - 128), 12, QB + 140, tid, (LAS float*)lds);
            else { p0_expert_items(p, QB + 140 + (wg - 140), 116, QB + 372, tid, (LAS float*)lds);
                   if (wg <= 220) p0_expert_items(p, QB + 372 + (wg - 140), 81, QB + 453, tid, (LAS float*)lds); } } });
    static_assert(NEI_PREP + FILL_IN + 453 == NEI, "filler shares");
    PHASE(PH_ATTN, ph_attn(p, wg, nwg, lds, wv););
    PHASE(PH_ACOMB, ph_acomb(p, wg, nwg, fresh_tid(wv)););
    PHASE(PH_OUTPROJ, { const pg8::DenseSched S{ML / 256, D / 256, nwg, wg, D, D, 0, (const char*)(ws + WS_WOUT)}; const pg8::EpiRowMajor E{(bf16_t*)(ws + WS_MIX), D};
        pg8::gemm_phase(lds, fresh_tid(wv), (const char*)(ws + WS_MIXA), D, S, E); });
    PHASE(PH_ROW2, ph_row2(p, wg, nwg, fresh_tid(wv), lds););
    PHASE(PH_LIST, ph_lists(p, wg, nwg, fresh_tid(wv), lds););
    PHASE(PH_MOE1, { const int tid = fresh_tid(wv);
        LAS int* tileL = (LAS int*)(lds + LDS_CTL + 2048); LAS unsigned* lstL = (LAS unsigned*)(lds + LDS_CTL + 4096);
        const int* TILEE = (const int*)(ws + WS_TILEE); const int* SLOTTOK = (const int*)(ws + WS_SLOTTOK);
        for (int i = tid; i < MAXTILES; i += NTHR) tileL[i] = TILEE[i];
        if (tid == 0) tileL[300] = TILEE[400];
        __syncthreads();
        const pg8::MoeSched<8, true, MOE_FP8> S{nwg, wg, tileL, lstL, (const char*)(ws + WS_WGU), 2048};
        { pg8::GUnit u; for (int i = 0; i < 16 && S.next(i, u); ++i) if (tid < 256) lstL[i * 256 + tid] = (unsigned)SLOTTOK[u.arow + tid] * (MOE_FP8 ? 1024u : 2048u); }
        __syncthreads();
        if constexpr (MOE_FP8) { const pg8::EpiAct8 E{ws + WS_ACT, p.in[20], p.in[22], 1.f / WSCALE}; pg8::gemm_phase<pg8::EpiAct8, pg8::MoeSched<8, true, MOE_FP8>, true>(lds, tid, (const char*)(ws + WS_HX), D, S, E); }
        else { const pg8::EpiAct E{(bf16_t*)(ws + WS_ACT), p.in[20], p.in[22]}; pg8::gemm_phase(lds, fresh_tid(wv), (const char*)(ws + WS_HX), D, S, E); } });
    PHASE(PH_MOE2, { const int tid = fresh_tid(wv);
        LAS int* tileL = (LAS int*)(lds + LDS_CTL + 2048); LAS unsigned* lstL = (LAS unsigned*)(lds + LDS_CTL + 4096);
        const int* TILEE = (const int*)(ws + WS_TILEE);
        for (int i = tid; i < MAXTILES; i += NTHR) tileL[i] = TILEE[i];
        if (tid == 0) tileL[300] = TILEE[400];
        __syncthreads();
        const pg8::MoeSched<4, false, MOE_FP8> S{nwg, wg, tileL, lstL, (const char*)(ws + WS_WD), 1024};
        const pg8::EpiY8 E{ws + WS_Y, p.in[24], MOE_FP8 ? 1.f / WSCALE : 1.f};
        pg8::gemm_phase<pg8::EpiY8, pg8::MoeSched<4, false, MOE_FP8>, MOE_FP8>(lds, tid, (const char*)(ws + WS_ACT), D, S, E); });
    PHASE(PH_FINAL, ph_final(p, wg, nwg, fresh_tid(wv)););
#undef PHASE
#undef IN
#undef SEAM
}

extern "C" void kernel_launch(void* const* d_in, const int* in_sizes, int n_in, void* d_out, int out_size, void* d_ws, size_t ws_size, hipStream_t stream) {
    static int ok = 0;
    if (ok == 0) {
        if (n_in != 25 || in_sizes[0] != ML * D || out_size != ML * D || ws_size < WS_END) { fprintf(stderr, "kernel_launch: unexpected shapes (n_in %d, in0 %d, out %d, ws %zu < %zu)\n", n_in, n_in > 0 ? in_sizes[0] : -1, out_size, ws_size, (size_t)WS_END); ok = -1; return; }
        if (hipFuncSetAttribute((const void*)mega, hipFuncAttributeMaxDynamicSharedMemorySize, LDS_BYTES) != hipSuccess) { fprintf(stderr, "kernel_launch: hipFuncSetAttribute failed\n"); ok = -1; return; }
        int dev = 0, cus = 0, per_cu = 0;
        if (hipGetDevice(&dev) != hipSuccess || hipDeviceGetAttribute(&cus, hipDeviceAttributeMultiprocessorCount, dev) != hipSuccess) { fprintf(stderr, "kernel_launch: device query failed\n"); ok = -1; return; }
        if (hipOccupancyMaxActiveBlocksPerMultiprocessor(&per_cu, (const void*)mega, NTHR, LDS_BYTES) != hipSuccess || per_cu < 1) { fprintf(stderr, "kernel_launch: occupancy query says %d blocks per CU\n", per_cu); (void)hipGetLastError(); }
        if (cus != NWG) fprintf(stderr, "kernel_launch: %d CUs (built for %d)\n", cus, NWG);
        ok = cus < NWG ? cus : NWG;
    }
    if (ok < 0) return;
    const int grid = ok;
    (void)hipMemsetAsync((char*)d_ws + WS_CTL, 0, CTL_BYTES, stream);
    P p{}; for (int i = 0; i < 25; ++i) p.in[i] = (const float*)d_in[i]; p.out = (float*)d_out; p.ws = (unsigned char*)d_ws;
#define MEGA(a, b) do { p.ph_lo = (a); p.ph_hi = (b); hipLaunchKernelGGL(mega, dim3(grid), dim3(NTHR), LDS_BYTES, stream, p); } while (0)
#ifdef MULTI_LAUNCH
    for (int ph = 0; ph < NPH; ++ph) MEGA(ph, ph + 1);
#else
    MEGA(0, NPH);
#endif
#undef MEGA
    const hipError_t le = hipPeekAtLastError();
    if (le != hipSuccess) fprintf(stderr, "kernel_launch: launch failed: %s\n", hipGetErrorName(le));
}
```

```cpp
#include <hip/hip_runtime.h>
#include <cstdint>
#include <cstdio>

#define GAS __attribute__((address_space(1)))
#define LAS __attribute__((address_space(3)))
typedef unsigned short bf16_t;
typedef short bf16x8 __attribute__((ext_vector_type(8)));
typedef float f32x4 __attribute__((ext_vector_type(4)));
typedef float f32x16 __attribute__((ext_vector_type(16)));
typedef unsigned u32x4 __attribute__((ext_vector_type(4)));
typedef unsigned u32x2 __attribute__((ext_vector_type(2)));

#ifndef ATT_PV8
#define ATT_PV8 1
#endif
#ifndef ATT_QK8
#define ATT_QK8 1
#endif
constexpr int D = 1024, SEQ = 8192, CTXL = 256, NH = 6, DQK = 192, DNOPE = 128, DROPE = 64, DV = 128;
constexpr int QL = 384, KVL = 256;
constexpr int ML = 2 * SEQ, MC = 2 * CTXL, MA = ML + MC;
constexpr int TK = SEQ + CTXL;
constexpr int PXW = 1280;
constexpr int NE = 32, DFF = 1024;
constexpr int MAXTILES = 288, SLOTS = MAXTILES * 256;
constexpr float RMS_EPS = 1e-6f;
constexpr int NWG = 256, NTHR = 512;
#ifndef MOE_FP8_ON
#define MOE_FP8_ON 1
#endif
constexpr bool MOE_FP8 = MOE_FP8_ON;
constexpr float WSCALE = 32.f;

constexpr size_t KiB = 1024, MiB = 1024 * 1024;
constexpr size_t WS_CTL = 0, CTL_BYTES = 64 * KiB;
constexpr size_t WS_MOD = 1 * MiB;
constexpr size_t WS_ROPE = WS_MOD + 96 * KiB;
constexpr size_t WS_RSTAT = WS_ROPE + 16 * KiB;
constexpr size_t WS_TOPI = 1 * MiB + 256 * KiB;
constexpr size_t WS_GATE = WS_TOPI + 256 * KiB;
constexpr size_t WS_TOKSLOT = WS_GATE + 256 * KiB;
constexpr size_t WS_SLOTTOK = 2 * MiB;
constexpr size_t WS_CHCNT = WS_SLOTTOK + 320 * KiB;
constexpr size_t WS_TILEE = WS_CHCNT + 32 * KiB;
constexpr size_t WS_FTAB = WS_TILEE + 32 * KiB;
constexpr size_t WS_WRT = WS_FTAB + 64 * KiB;
constexpr size_t WS_GA = WS_WRT + 128 * KiB;
constexpr size_t WS_GB = WS_GA + 128 * KiB;
constexpr size_t WS_WIN = 4 * MiB;
constexpr size_t WS_WQ = 7 * MiB;
constexpr size_t WS_WKV = 8 * MiB;
constexpr size_t WS_WOUT = 9 * MiB;
constexpr size_t WS_WD = 16 * MiB;
constexpr size_t WS_WGU = 80 * MiB;
constexpr size_t WS_HX = 208 * MiB;
constexpr size_t WS_Y = 80 * MiB;
constexpr size_t WS_MIX = 242 * MiB;
constexpr size_t WS_ACT = 274 * MiB;
constexpr size_t WS_PX = 274 * MiB;
constexpr size_t WS_Q = 316 * MiB;
constexpr size_t WS_KN = 352 * MiB;
constexpr size_t WS_V = 377 * MiB;
constexpr size_t WS_KR = 402 * MiB;
constexpr size_t WS_FT = 405 * MiB;
constexpr size_t WS_MIXA = 421 * MiB;
constexpr size_t WS_OPART = 208 * MiB;
constexpr size_t WS_OML = 304 * MiB;
constexpr size_t WS_END = 453 * MiB;

constexpr int LDS_BYTES = 163840;
constexpr int LDS_CTL = 139264;

struct P { const float* in[25]; float* out; unsigned char* ws; int ph_lo, ph_hi; };

__device__ __forceinline__ unsigned f2bf(float f) { unsigned u = __float_as_uint(f); return (u + 0x7fffu + ((u >> 16) & 1u)) >> 16; }
__device__ __forceinline__ float bflo(unsigned w) { return __uint_as_float(w << 16); }
__device__ __forceinline__ float bfhi(unsigned w) { return __uint_as_float(w & 0xffff0000u); }
typedef __bf16 bf16x2c __attribute__((ext_vector_type(2)));
typedef float f32x2c __attribute__((ext_vector_type(2)));
__device__ __forceinline__ unsigned pk2(float lo, float hi) { const f32x2c v = {lo, hi}; return __builtin_bit_cast(unsigned, __builtin_convertvector(v, bf16x2c)); }
template <int CTRL, int RMASK, bool BC> __device__ __forceinline__ float dpp_mov(float v) { return __builtin_bit_cast(float, __builtin_amdgcn_update_dpp(0, __builtin_bit_cast(int, v), CTRL, RMASK, 0xf, BC)); }
__device__ __forceinline__ float wave_sum(float v) {
    v += dpp_mov<0x111, 0xf, true>(v); v += dpp_mov<0x112, 0xf, true>(v); v += dpp_mov<0x114, 0xf, true>(v); v += dpp_mov<0x118, 0xf, true>(v);
    v += dpp_mov<0x142, 0xa, false>(v); v += dpp_mov<0x143, 0xc, false>(v);
    return __builtin_bit_cast(float, __builtin_amdgcn_readlane(__builtin_bit_cast(int, v), 63));
}
__device__ __forceinline__ float wave_max(float v) {
#pragma unroll
    for (int o = 1; o < 64; o <<= 1) v = fmaxf(v, __shfl_xor(v, o));
    return v;
}
__device__ __forceinline__ int fresh_tid(int wv) { int t = (wv << 6) | (int)__builtin_amdgcn_mbcnt_hi(~0u, __builtin_amdgcn_mbcnt_lo(~0u, 0u)); asm volatile("" : "+v"(t)); return t; }
__device__ __forceinline__ unsigned pg8_pk4_fp8(f32x4 v) { int p = __builtin_amdgcn_cvt_pk_fp8_f32(v.x, v.y, 0, false); p = __builtin_amdgcn_cvt_pk_fp8_f32(v.z, v.w, p, true); return (unsigned)p; }
__device__ __forceinline__ f32x4 fp8x4(unsigned w) { const auto lo = __builtin_amdgcn_cvt_pk_f32_fp8((int)w, false), hi = __builtin_amdgcn_cvt_pk_f32_fp8((int)w, true); return (f32x4){lo[0], lo[1], hi[0], hi[1]}; }
__device__ __forceinline__ float dot4(f32x4 a, f32x4 b) { return (a.x * b.x + a.y * b.y) + (a.z * b.z + a.w * b.w); }

__device__ __forceinline__ void p0_mod_item(const P& p, int it, int tid, LAS float* scr) {
    LAS float* sl = scr;
    LAS float* part = scr + 3072;
    const float* c = p.in[1]; const float* cc = p.in[3]; const float* wm = p.in[4]; const float* bm = p.in[5];
    for (int i = tid; i < 3072; i += NTHR) { const int r = i >> 10, k = i & 1023; const float v = r < 2 ? c[r * 1024 + k] : cc[k]; sl[i] = v / (1.f + __expf(-v)); }
    __syncthreads();
    const int ks = tid >> 5, cidx = tid & 31, n0 = it * 24;
    if (cidx < 24) {
        float a0 = 0.f, a1 = 0.f, a2 = 0.f;
#pragma unroll 1
        for (int kq = 0; kq < 2; ++kq) { float wv[32];
#pragma unroll
            for (int k = 0; k < 32; ++k) wv[k] = __builtin_nontemporal_load(wm + (size_t)(ks * 64 + kq * 32 + k) * 6144 + n0 + cidx);
#pragma unroll
            for (int k = 0; k < 32; ++k) { const float w = wv[k]; const int kk = ks * 64 + kq * 32 + k; a0 += sl[kk] * w; a1 += sl[1024 + kk] * w; a2 += sl[2048 + kk] * w; } }
        part[(ks * 3 + 0) * 24 + cidx] = a0; part[(ks * 3 + 1) * 24 + cidx] = a1; part[(ks * 3 + 2) * 24 + cidx] = a2;
    }
    __syncthreads();
    if (tid < 72) { const int r = tid / 24, cx = tid % 24; float s = bm[n0 + cx];
        for (int k = 0; k < 16; ++k) s += part[(k * 3 + r) * 24 + cx];
        ((float*)(p.ws + WS_MOD))[r * 6144 + n0 + cx] = s; }
    __syncthreads();
}
__device__ __forceinline__ void p0_misc_item(const P& p, int r, int tid) {
    const double TWO_PI = 6.283185307179586476925;
    if (r == 0) {
        float* ct = (float*)(p.ws + WS_ROPE); float* st = ct + 2048;
        for (int i = tid; i < 2048; i += NTHR) { const int pos = i >> 4, j = i & 15; const double inv = pow(10000.0, -(2.0 * j) / 32.0); const double a = (double)pos * inv; ct[i] = (float)cos(a); st[i] = (float)sin(a); }
        const float* wr = p.in[17]; bf16_t* wrh = (bf16_t*)(p.ws + WS_WRT); bf16_t* wrl = wrh + 32768;
        for (int i = tid; i < 32768; i += NTHR) { const int k = i >> 5, e = i & 31; const float w = wr[i]; const unsigned hb = f2bf(w); wrh[e * 1024 + k] = (bf16_t)hb; wrl[e * 1024 + k] = (bf16_t)f2bf(w - __uint_as_float(hb << 16)); }
    } else if (r == 1) {
        for (int i = tid; i < 8192; i += NTHR) { const double a = TWO_PI * i / 8192.0; ((float2*)(p.ws + WS_FTAB))[i] = make_float2((float)cos(a), (float)sin(a)); }
    } else if (r < 6) {
        bf16_t* GA = (bf16_t*)(p.ws + WS_GA);
        for (int i = tid; i < 64 * 256; i += NTHR) { const int row = (r - 2) * 64 + (i >> 8), kk = i & 255, c = row >> 7, k1 = row & 127, n1 = kk & 127, isq = kk >> 7;
            const double a = TWO_PI * ((n1 * k1) & 127) / 128.0; const double cs = cos(a), sn = sin(a);
            const double v = c == 0 ? (isq ? -sn : cs) : (isq ? -cs : -sn); GA[row * 256 + kk] = (bf16_t)f2bf((float)v); }
    } else {
        bf16_t* GB = (bf16_t*)(p.ws + WS_GB);
        for (int i = tid; i < 64 * 128; i += NTHR) { const int k2 = i >> 7, kk = i & 127, n2 = kk >> 1, c = kk & 1; const double a = TWO_PI * ((k2 * n2) & 63) / 64.0;
            GB[i] = (bf16_t)f2bf((float)(c ? sin(a) : cos(a))); }
    }
}
template <class CM>
__device__ __forceinline__ void p0_xpose_item(const CM& cm, int ldn, const float* gain, int k0, bf16_t* dst, int Kd, int nd0, int tid, LAS float* scr) {
    f32x4 v[8];
#pragma unroll
    for (int i = 0; i < 8; ++i) { const int q = tid + NTHR * i, k = q >> 6, n = (q & 63) * 4; const float* sp = cm(nd0 + n);
        v[i] = sp ? *(const f32x4*)(sp + (size_t)(k0 + k) * ldn) : (f32x4){0.f, 0.f, 0.f, 0.f}; }
#pragma unroll
    for (int i = 0; i < 8; ++i) { const int q = tid + NTHR * i, k = q >> 6, n = (q & 63) * 4; const float g = gain ? gain[k0 + k] : 1.f;
        LAS float* d = scr + k * 257 + n; d[0] = v[i].x * g; d[1] = v[i].y * g; d[2] = v[i].z * g; d[3] = v[i].w * g; }
    __syncthreads();
#pragma unroll
    for (int i = 0; i < 4; ++i) { const int q = tid + NTHR * i, n = q >> 3, kc = q & 7; const LAS float* s = scr + (kc * 8) * 257 + n;
        u32x4 o; o.x = pk2(s[0], s[257]); o.y = pk2(s[2 * 257], s[3 * 257]); o.z = pk2(s[4 * 257], s[5 * 257]); o.w = pk2(s[6 * 257], s[7 * 257]);
        *(u32x4*)(dst + (size_t)(nd0 + n) * Kd + k0 + kc * 8) = o; }
    __syncthreads();
}
struct CmWin { const float* w; __device__ const float* operator()(int n) const { return n < 384 ? w + 256 + n : (n < 448 ? w + 896 + (n - 384) : (n < 512 ? nullptr : w + 640 + (n - 512))); } };
struct CmPlain { const float* w; int nmax; __device__ const float* operator()(int n) const { return n < nmax ? w + n : nullptr; } };
struct CmGU { const float* g; const float* u; int pn; __device__ const float* operator()(int n) const { const int j = n & 255; return j < 128 ? g + 128 * pn + j : u + 128 * pn + (j - 128); } };
__device__ __forceinline__ void p0_fold_item(const P& p, int g, int kb, int tid, LAS float* scr) {
    LAS float* Mg = scr;
    LAS float* wb = scr + 8192;
    LAS float* cs = scr + 8192 + 4160;
    const float* wf = p.in[15] + g * 4096; const float* win = p.in[10];
    if (tid < 64) { const double a = 6.283185307179586476925 * tid / 64.0; cs[tid] = (float)cos(a); cs[64 + tid] = (float)sin(a); }
    __syncthreads();
    const float sinv = 1.0f / 724.0773439350246f;
    for (int i = 0; i < 16; ++i) { const int e = tid + NTHR * i, c = e >> 7, jj = e & 127, j = jj & 63, isq = jj >> 6; float s = 0.f;
        for (int m = 0; m < 64; ++m) s += cs[isq * 64 + ((m * c) & 63)] * wf[m * 64 + j];
        Mg[c * 128 + jj] = s * sinv; }
    for (int i = 0; i < 8; ++i) { const int e = tid + NTHR * i, k = e >> 6, c = e & 63; wb[k * 65 + c] = win[(size_t)(kb * 64 + k) * 960 + g * 64 + c]; }
    __syncthreads();
    const int jj = tid >> 2, kq = tid & 3; float acc[16];
#pragma unroll
    for (int i = 0; i < 16; ++i) acc[i] = 0.f;
    for (int c = 0; c < 64; ++c) { const float mv = Mg[c * 128 + jj];
#pragma unroll
        for (int i = 0; i < 16; ++i) acc[i] += wb[(kq * 16 + i) * 65 + c] * mv; }
    bf16_t* dst = (bf16_t*)(p.ws + WS_WIN) + (size_t)(768 + g * 128 + jj) * 1024 + kb * 64 + kq * 16;
    u32x4 o0, o1; o0.x = pk2(acc[0], acc[1]); o0.y = pk2(acc[2], acc[3]); o0.z = pk2(acc[4], acc[5]); o0.w = pk2(acc[6], acc[7]);
    o1.x = pk2(acc[8], acc[9]); o1.y = pk2(acc[10], acc[11]); o1.z = pk2(acc[12], acc[13]); o1.w = pk2(acc[14], acc[15]);
    *(u32x4*)dst = o0; *(u32x4*)(dst + 8) = o1;
    __syncthreads();
}
constexpr int I_WGU = 32 * 8 * 2 * 8, I_WD = 32 * 8 * 8, NEI = I_WGU + I_WD;
constexpr int FILL_IN = 182 * 4, FILL_Q = 128 + 12 + 232 + 81, NEI_PREP = NEI - FILL_IN - FILL_Q;
template <bool DYN = false>
__device__ __forceinline__ void p0_expert_items(const P& p, int first, int step, int end, int tid, LAS float* scr, unsigned* ctr = nullptr) {
        constexpr int XS = 129;
        f32x4 v[8];
#define P0_ISSUE(r_) do { const int r = (r_); const float* s0; int k0; \
            if (r < I_WGU) { const int e = r >> 7, t = (r >> 3) & 15, pn = t >> 1, hf = t & 1; k0 = (r & 7) * 128; s0 = (hf ? p.in[21] : p.in[19]) + (size_t)e * 1048576 + 128 * pn; } \
            else { const int q = r - I_WGU, e = q >> 6, nb = (q >> 3) & 7; k0 = (q & 7) * 128; s0 = p.in[23] + (size_t)e * 1048576 + nb * 128; } \
            _Pragma("unroll") for (int i = 0; i < 8; ++i) { const int q = tid + NTHR * i, k = q >> 5, n = (q & 31) * 4; v[i] = __builtin_nontemporal_load((const f32x4*)(s0 + (size_t)(k0 + k) * 1024 + n)); } } while (0)
        int it = first; LAS float* const scr0 = scr; int par = 0;
        LAS int* const nxw = (LAS int*)((LAS unsigned char*)scr0 + LDS_CTL + 128); unsigned pend = 0;
        if constexpr (DYN) { if (tid == 0) { nxw[0] = (int)__hip_atomic_fetch_add(ctr, 1u, __ATOMIC_RELAXED, __HIP_MEMORY_SCOPE_AGENT); pend = __hip_atomic_fetch_add(ctr, 1u, __ATOMIC_RELAXED, __HIP_MEMORY_SCOPE_AGENT); }
            __syncthreads(); it = nxw[0]; __syncthreads(); }
        if (it < end) P0_ISSUE(it);
        for (; it < end; par ^= 1) {
            int nx = it + step;
            scr = scr0 + par * (128 * XS);
#pragma unroll
            for (int i = 0; i < 8; ++i) { const int q = tid + NTHR * i, k = q >> 5, n = (q & 31) * 4; LAS float* d = scr + k * XS + ((n + 8 * (k >> 4)) & 127); d[0] = v[i].x; d[1] = v[i].y; d[2] = v[i].z; d[3] = v[i].w; }
            if constexpr (DYN) { if (tid == 0) { nxw[par] = (int)pend; pend = __hip_atomic_fetch_add(ctr, 1u, __ATOMIC_RELAXED, __HIP_MEMORY_SCOPE_AGENT); } }
            __syncthreads();
            if constexpr (DYN) nx = nxw[par];
            if (nx < end) P0_ISSUE(nx);
            size_t drow; int k0;
            if (it < I_WGU) { const int e = it >> 7, t = (it >> 3) & 15, pn = t >> 1, hf = t & 1; k0 = (it & 7) * 128; drow = (size_t)e * 2048 + pn * 256 + hf * 128; }
            else { const int q = it - I_WGU, e = q >> 6, nb = (q >> 3) & 7; k0 = (q & 7) * 128; drow = (size_t)e * 1024 + nb * 128; }
            if constexpr (MOE_FP8) {
                unsigned char* dst = (unsigned char*)(p.ws + (it < I_WGU ? WS_WGU : WS_WD)) + drow * 1024 + k0;
#pragma unroll
                for (int i = 0; i < 2; ++i) { const int q = tid + NTHR * i, n = q >> 3, kc = q & 7; const LAS float* s = scr + (kc * 16) * XS + ((n + 8 * kc) & 127); u32x4 o;
                    o.x = pg8_pk4_fp8((f32x4){s[0], s[XS], s[2 * XS], s[3 * XS]} * WSCALE); o.y = pg8_pk4_fp8((f32x4){s[4 * XS], s[5 * XS], s[6 * XS], s[7 * XS]} * WSCALE);
                    o.z = pg8_pk4_fp8((f32x4){s[8 * XS], s[9 * XS], s[10 * XS], s[11 * XS]} * WSCALE); o.w = pg8_pk4_fp8((f32x4){s[12 * XS], s[13 * XS], s[14 * XS], s[15 * XS]} * WSCALE);
                    __builtin_nontemporal_store(o, (u32x4*)(dst + (size_t)n * 1024 + kc * 16)); }
            } else {
                bf16_t* dst = (bf16_t*)(p.ws + (it < I_WGU ? WS_WGU : WS_WD)) + drow * 1024 + k0;
#pragma unroll
                for (int i = 0; i < 4; ++i) { const int q = tid + NTHR * i, n = q >> 4, kc = q & 15; const LAS float* s = scr + (kc * 8) * XS + ((n + 8 * (kc >> 1)) & 127);
                    u32x4 o; o.x = pk2(s[0], s[XS]); o.y = pk2(s[2 * XS], s[3 * XS]); o.z = pk2(s[4 * XS], s[5 * XS]); o.w = pk2(s[6 * XS], s[7 * XS]);
                    *(u32x4*)(dst + (size_t)n * 1024 + kc * 8) = o; }
            }
            it = nx;
        }
        __syncthreads();
#undef P0_ISSUE
}
__device__ __forceinline__ void ph_prologue(const P& p, int wg, int nwg, int tid, LAS unsigned char* lds) {
    LAS float* scr = (LAS float*)lds;
    constexpr int I_MOD = 256, I_MISC = 7, I_FOLD = 64, I_WIN = 3 * 16, I_WQ = 5 * 6, I_WKV = 6 * 4, I_WOUT = 4 * 16;
    constexpr int NIT = I_MOD + I_MISC + I_FOLD + I_WIN + I_WQ + I_WKV + I_WOUT;
    for (int it = wg; it < NIT; it += nwg) {
        int r = it;
        if (r < I_MOD) { p0_mod_item(p, r, tid, scr); continue; } r -= I_MOD;
        if (r < I_MISC) { p0_misc_item(p, r, tid); continue; } r -= I_MISC;
        if (r < I_FOLD) { p0_fold_item(p, r >> 4, r & 15, tid, scr); continue; } r -= I_FOLD;
        if (r < I_WIN) { CmWin cm{p.in[10]}; p0_xpose_item(cm, 960, nullptr, (r & 15) * 64, (bf16_t*)(p.ws + WS_WIN), 1024, (r >> 4) * 256, tid, scr); continue; } r -= I_WIN;
        if (r < I_WQ) { CmPlain cm{p.in[13], 1152}; p0_xpose_item(cm, 1152, p.in[11], (r % 6) * 64, (bf16_t*)(p.ws + WS_WQ), 384, (r / 6) * 256, tid, scr); continue; } r -= I_WQ;
        if (r < I_WKV) { CmPlain cm{p.in[14], 1536}; p0_xpose_item(cm, 1536, p.in[12], (r & 3) * 64, (bf16_t*)(p.ws + WS_WKV), 256, (r >> 2) * 256, tid, scr); continue; } r -= I_WKV;
        if (r < I_WOUT) { CmPlain cm{p.in[16], 1024}; p0_xpose_item(cm, 1024, nullptr, (r & 15) * 64, (bf16_t*)(p.ws + WS_WOUT), 1024, (r >> 4) * 256, tid, scr); continue; } r -= I_WOUT;
    }
    p0_expert_items<true>(p, wg, nwg, nwg == NWG ? NEI_PREP : NEI, tid, scr, (unsigned*)(p.ws + WS_CTL) + 64);
}

template <int NR> __device__ __forceinline__ void modul_rows(const float* const (&rows)[NR], bf16_t* const (&outs)[NR], const f32x4 (&a)[4], const f32x4 (&sh)[4], int lane) {
    f32x4 v[NR][4];
#pragma unroll
    for (int r = 0; r < NR; ++r)
#pragma unroll
        for (int j = 0; j < 4; ++j) v[r][j] = __builtin_nontemporal_load((const f32x4*)(rows[r] + 4 * lane + 256 * j));
#pragma unroll
    for (int r = 0; r < NR; ++r) { float ss = 0.f;
#pragma unroll
        for (int j = 0; j < 4; ++j) ss += dot4(v[r][j], v[r][j]);
        const float rinv = rsqrtf(wave_sum(ss) * (1.f / D) + RMS_EPS);
#pragma unroll
        for (int j = 0; j < 4; ++j) { const f32x4 o = v[r][j] * rinv * a[j] + sh[j]; u32x2 w; w.x = pk2(o.x, o.y); w.y = pk2(o.z, o.w); *(u32x2*)(outs[r] + 4 * lane + 256 * j) = w; } }
}
__device__ __forceinline__ void ph_modulate(const P& p, int wg, int nwg, int tid) {
    const int lane = tid & 63, wave = tid >> 6;
    const float* x = p.in[0]; const float* ctx = p.in[2]; const float* gain = p.in[6];
    const float* MOD = (const float*)(p.ws + WS_MOD); bf16_t* HX = (bf16_t*)(p.ws + WS_HX);
    for (int ch = wg; ch < 256; ch += nwg) {
        f32x4 a[4], sh[4];
        { const int r = ch >> 7;
#pragma unroll
          for (int j = 0; j < 4; ++j) { const int c = 4 * lane + 256 * j; sh[j] = *(const f32x4*)(MOD + r * 6144 + c); a[j] = *(const f32x4*)(gain + c) * (*(const f32x4*)(MOD + r * 6144 + 1024 + c) + 1.f); } }
#pragma unroll
        for (int q = 0; q < 2; ++q) { const int m0 = ch * 64 + wave * 8 + q * 4;
            const float* const rows[4] = {x + (size_t)m0 * D, x + (size_t)(m0 + 1) * D, x + (size_t)(m0 + 2) * D, x + (size_t)(m0 + 3) * D};
            bf16_t* const outs[4] = {HX + (size_t)m0 * D, HX + (size_t)(m0 + 1) * D, HX + (size_t)(m0 + 2) * D, HX + (size_t)(m0 + 3) * D};
            modul_rows<4>(rows, outs, a, sh, lane); }
        if (wave == 7) {
#pragma unroll
            for (int j = 0; j < 4; ++j) { const int c = 4 * lane + 256 * j; sh[j] = *(const f32x4*)(MOD + 2 * 6144 + c); a[j] = *(const f32x4*)(gain + c) * (*(const f32x4*)(MOD + 2 * 6144 + 1024 + c) + 1.f); }
            const int c0 = ch * 2;
            const float* const rows[2] = {ctx + (size_t)c0 * D, ctx + (size_t)(c0 + 1) * D};
            bf16_t* const outs[2] = {HX + (size_t)(ML + c0) * D, HX + (size_t)(ML + c0 + 1) * D};
            modul_rows<2>(rows, outs, a, sh, lane); }
    }
}

template <int NR> __device__ __forceinline__ void row1_rows(const P& p, const int (&ms)[NR], int lane) {
    const bf16_t* PX = (const bf16_t*)(p.ws + WS_PX); float* RS = (float*)(p.ws + WS_RSTAT); bf16_t* KR = (bf16_t*)(p.ws + WS_KR);
    const float* ct = (const float*)(p.ws + WS_ROPE); const float* st = ct + 2048;
    u32x4 c0[NR], c1[NR];
#pragma unroll
    for (int r = 0; r < NR; ++r) { const bf16_t* pr = PX + (size_t)ms[r] * PXW; c0[r] = *(const u32x4*)(pr + 8 * lane); c1[r] = *(const u32x4*)(pr + 512 + 8 * (lane & 31)); }
#pragma unroll
    for (int r = 0; r < NR; ++r) { const int m = ms[r];
        float v[8]; v[0] = bflo(c0[r].x); v[1] = bfhi(c0[r].x); v[2] = bflo(c0[r].y); v[3] = bfhi(c0[r].y); v[4] = bflo(c0[r].z); v[5] = bfhi(c0[r].z); v[6] = bflo(c0[r].w); v[7] = bfhi(c0[r].w);
        float sq = 0.f; if (lane < 48) { for (int j = 0; j < 8; ++j) sq += v[j] * v[j]; }
        float skv = 0.f; if (lane < 32) { const float t0 = bflo(c1[r].x), t1 = bfhi(c1[r].x), t2 = bflo(c1[r].y), t3 = bfhi(c1[r].y), t4 = bflo(c1[r].z), t5 = bfhi(c1[r].z), t6 = bflo(c1[r].w), t7 = bfhi(c1[r].w);
            skv = (t0 * t0 + t1 * t1) + (t2 * t2 + t3 * t3) + (t4 * t4 + t5 * t5) + (t6 * t6 + t7 * t7); }
        const float rq = rsqrtf(wave_sum(sq) * (1.f / QL) + RMS_EPS), rkv = rsqrtf(wave_sum(skv) * (1.f / KVL) + RMS_EPS);
        if (lane == 0) { RS[2 * m] = rq; RS[2 * m + 1] = rkv; }
        if (lane >= 48 && lane < 56) {
            const int d0 = (lane - 48) * 8; int b, tt;
            if (m < ML) { b = m >> 13; tt = m & 8191; const int prow = tt >> 6, pcol = tt & 63;
#pragma unroll
                for (int q = 0; q < 4; ++q) { const int pi = (d0 >> 1) + q; const int pos = pi < 16 ? prow : pcol, j = pi & 15; const float c = ct[pos * 16 + j], s = st[pos * 16 + j];
                    const float e = v[2 * q], o = v[2 * q + 1]; v[2 * q] = e * c - o * s; v[2 * q + 1] = e * s + o * c; } }
            else { b = (m - ML) >> 8; tt = SEQ + ((m - ML) & 255); }
            u32x4 o; o.x = pk2(v[0], v[1]); o.y = pk2(v[2], v[3]); o.z = pk2(v[4], v[5]); o.w = pk2(v[6], v[7]);
            if constexpr (ATT_QK8) { u32x2 w8; w8.x = pg8_pk4_fp8((f32x4){v[0], v[1], v[2], v[3]}); w8.y = pg8_pk4_fp8((f32x4){v[4], v[5], v[6], v[7]}); *(u32x2*)((unsigned char*)KR + ((size_t)b * TK + tt) * DROPE + d0) = w8; }
            else *(u32x4*)(KR + ((size_t)b * TK + tt) * DROPE + d0) = o;
        }
    }
}
__device__ __forceinline__ void ph_row1(const P& p, int wg, int nwg, int tid) {
    const int lane = tid & 63, wave = tid >> 6;
    for (int ch = wg; ch < 256; ch += nwg) {
        { const int m0 = ch * 64 + wave * 8; const int ms[8] = {m0, m0 + 1, m0 + 2, m0 + 3, m0 + 4, m0 + 5, m0 + 6, m0 + 7}; row1_rows<8>(p, ms, lane); }
        if (wave == 7) { const int ms[2] = {ML + ch * 2, ML + ch * 2 + 1}; row1_rows<2>(p, ms, lane); }
    }
}

__device__ __forceinline__ float half_max32(float v, int lane) {
    v = fmaxf(v, __builtin_bit_cast(float, __builtin_amdgcn_update_dpp(__builtin_bit_cast(int, v), __builtin_bit_cast(int, v), 0x111, 0xf, 0xf, false)));
    v = fmaxf(v, __builtin_bit_cast(float, __builtin_amdgcn_update_dpp(__builtin_bit_cast(int, v), __builtin_bit_cast(int, v), 0x112, 0xf, 0xf, false)));
    v = fmaxf(v, __builtin_bit_cast(float, __builtin_amdgcn_update_dpp(__builtin_bit_cast(int, v), __builtin_bit_cast(int, v), 0x114, 0xf, 0xf, false)));
    v = fmaxf(v, __builtin_bit_cast(float, __builtin_amdgcn_update_dpp(__builtin_bit_cast(int, v), __builtin_bit_cast(int, v), 0x118, 0xf, 0xf, false)));
    v = fmaxf(v, __builtin_bit_cast(float, __builtin_amdgcn_update_dpp(__builtin_bit_cast(int, v), __builtin_bit_cast(int, v), 0x142, 0xa, 0xf, false)));
    const float m0 = __builtin_bit_cast(float, __builtin_amdgcn_readlane(__builtin_bit_cast(int, v), 31)), m1 = __builtin_bit_cast(float, __builtin_amdgcn_readlane(__builtin_bit_cast(int, v), 63));
    return lane < 32 ? m0 : m1;
}
__device__ __forceinline__ void ph_row2(const P& p, int wg, int nwg, int tid, LAS unsigned char* lds) {
    const int lane = tid & 63, wave = tid >> 6;
    constexpr int HSTR = 2064;
    LAS unsigned char* Hhi = lds; LAS unsigned char* Hlo = lds + 32 * HSTR;
    LAS float* PL = (LAS float*)(lds + LDS_CTL + 4096);
    LAS int* hist = (LAS int*)(lds + LDS_CTL + 1024);
    const bf16_t* WRH = (const bf16_t*)(p.ws + WS_WRT); const bf16_t* WRL = WRH + 32768;
    const float* x = p.in[0]; const float* MOD = (const float*)(p.ws + WS_MOD); const float* npost = p.in[7]; const float* npre = p.in[8]; const float* br = p.in[18];
    const bf16_t* MIX = (const bf16_t*)(p.ws + WS_MIX); bf16_t* HX2 = (bf16_t*)(p.ws + WS_HX);
    int* TOPI = (int*)(p.ws + WS_TOPI); float* GATE = (float*)(p.ws + WS_GATE); int* CHCNT = (int*)(p.ws + WS_CHCNT);
    for (int ch = wg; ch < 256; ch += nwg) {
        if (tid < 32) hist[tid] = 0;
        const int b = (ch * 64) >> 13;
        f32x4 a1[4], a2[4], s2[4];
#pragma unroll
        for (int j = 0; j < 4; ++j) { const int c = 4 * lane + 256 * j;
            a1[j] = *(const f32x4*)(npost + c) * *(const f32x4*)(MOD + b * 6144 + 2048 + c);
            a2[j] = *(const f32x4*)(npre + c) * (*(const f32x4*)(MOD + b * 6144 + 4096 + c) + 1.f);
            s2[j] = *(const f32x4*)(MOD + b * 6144 + 3072 + c); }
        for (int batch = 0; batch < 2; ++batch) {
            u32x2 mw[4][4]; f32x4 xv[4][4];
#pragma unroll
            for (int i = 0; i < 4; ++i) { const int m = ch * 64 + batch * 32 + wave * 4 + i;
#pragma unroll
                for (int j = 0; j < 4; ++j) { mw[i][j] = *(const u32x2*)(MIX + (size_t)m * D + 4 * lane + 256 * j); xv[i][j] = __builtin_nontemporal_load((const f32x4*)(x + (size_t)m * D + 4 * lane + 256 * j)); } }
            const int fr = lane & 15, fq = lane >> 4, rb = (wave & 1) * 16, kq = wave >> 1;
            const bf16_t* bh = WRH + fr * 1024 + kq * 256 + fq * 8; const bf16_t* bl = WRL + fr * 1024 + kq * 256 + fq * 8;
#pragma unroll
            for (int i = 0; i < 4; ++i) {
                const int rl = wave * 4 + i, m = ch * 64 + batch * 32 + rl;
                f32x4 mx[4], h[4]; float ss = 0.f;
#pragma unroll
                for (int j = 0; j < 4; ++j) { const u32x2 w = mw[i][j]; mx[j] = (f32x4){bflo(w.x), bfhi(w.x), bflo(w.y), bfhi(w.y)}; ss += dot4(mx[j], mx[j]); }
                const float r1 = rsqrtf(wave_sum(ss) * (1.f / D) + RMS_EPS); float s2s = 0.f;
#pragma unroll
                for (int j = 0; j < 4; ++j) { h[j] = xv[i][j] + a1[j] * (mx[j] * r1); s2s += dot4(h[j], h[j]); }
                const float r2 = rsqrtf(wave_sum(s2s) * (1.f / D) + RMS_EPS);
#pragma unroll
                for (int j = 0; j < 4; ++j) { h[j] = h[j] * r2 * a2[j] + s2[j];
                    const unsigned h0 = f2bf(h[j].x), h1 = f2bf(h[j].y), h2 = f2bf(h[j].z), h3 = f2bf(h[j].w);
                    u32x2 wh; wh.x = h0 | (h1 << 16); wh.y = h2 | (h3 << 16);
                    u32x2 wl; wl.x = pk2(h[j].x - __uint_as_float(h0 << 16), h[j].y - __uint_as_float(h1 << 16)); wl.y = pk2(h[j].z - __uint_as_float(h2 << 16), h[j].w - __uint_as_float(h3 << 16));
                    if constexpr (MOE_FP8) *(unsigned*)((unsigned char*)HX2 + (size_t)m * D + 4 * lane + 256 * j) = pg8_pk4_fp8(h[j]);
                    else *(u32x2*)(HX2 + (size_t)m * D + 4 * lane + 256 * j) = wh;
                    *(LAS u32x2*)(Hhi + rl * HSTR + (4 * lane + 256 * j) * 2) = wh; *(LAS u32x2*)(Hlo + rl * HSTR + (4 * lane + 256 * j) * 2) = wl; }
            }
            bf16x8 Bh0[8], Bl0[8];
#pragma unroll
            for (int ks = 0; ks < 8; ++ks) { Bh0[ks] = *(const bf16x8*)(bh + ks * 32); Bl0[ks] = *(const bf16x8*)(bl + ks * 32); }
            __syncthreads();
            { f32x4 acc0 = {0.f, 0.f, 0.f, 0.f}, acc1 = {0.f, 0.f, 0.f, 0.f};
              bf16x8 Bh1[8], Bl1[8];
#pragma unroll
              for (int ks = 0; ks < 8; ++ks) { Bh1[ks] = *(const bf16x8*)(bh + 16 * 1024 + ks * 32); Bl1[ks] = *(const bf16x8*)(bl + 16 * 1024 + ks * 32); }
              const LAS unsigned char* ah = Hhi + (rb + fr) * HSTR + kq * 512 + fq * 16; const LAS unsigned char* al = Hlo + (rb + fr) * HSTR + kq * 512 + fq * 16;
#pragma unroll
              for (int ks = 0; ks < 8; ++ks) {
                  const bf16x8 Ah = *(const LAS bf16x8*)(ah + ks * 64), Al = *(const LAS bf16x8*)(al + ks * 64);
                  acc0 = __builtin_amdgcn_mfma_f32_16x16x32_bf16(Ah, Bh0[ks], acc0, 0, 0, 0); acc0 = __builtin_amdgcn_mfma_f32_16x16x32_bf16(Ah, Bl0[ks], acc0, 0, 0, 0); acc0 = __builtin_amdgcn_mfma_f32_16x16x32_bf16(Al, Bh0[ks], acc0, 0, 0, 0); }
#pragma unroll
              for (int ks = 0; ks < 8; ++ks) {
                  const bf16x8 Ah = *(const LAS bf16x8*)(ah + ks * 64), Al = *(const LAS bf16x8*)(al + ks * 64);
                  acc1 = __builtin_amdgcn_mfma_f32_16x16x32_bf16(Ah, Bh1[ks], acc1, 0, 0, 0); acc1 = __builtin_amdgcn_mfma_f32_16x16x32_bf16(Ah, Bl1[ks], acc1, 0, 0, 0); acc1 = __builtin_amdgcn_mfma_f32_16x16x32_bf16(Al, Bh1[ks], acc1, 0, 0, 0); }
#pragma unroll
              for (int r = 0; r < 4; ++r) { PL[(kq * 32 + rb + fq * 4 + r) * 32 + fr] = acc0[r]; PL[(kq * 32 + rb + fq * 4 + r) * 32 + 16 + fr] = acc1[r]; } }
            __syncthreads();
#pragma unroll
            for (int ps = 0; ps < 2; ++ps) {
                const int rl = wave * 4 + ps * 2 + (lane >> 5), e = lane & 31, m = ch * 64 + batch * 32 + rl;
                float v = ((PL[rl * 32 + e] + PL[(32 + rl) * 32 + e]) + (PL[(64 + rl) * 32 + e] + PL[(96 + rl) * 32 + e])) + br[e];
                int ti[4]; float tv[4];
#pragma unroll
                for (int k = 0; k < 4; ++k) { const float mx = half_max32(v, lane); const unsigned long long bal = __ballot(v == mx);
                    const unsigned hm = lane < 32 ? (unsigned)bal : (unsigned)(bal >> 32); const int idx = __ffs((int)hm) - 1;
                    ti[k] = idx; tv[k] = mx; if (e == idx) v = -3.0e38f; }
                const float e1 = __expf(tv[1] - tv[0]), e2 = __expf(tv[2] - tv[0]), e3 = __expf(tv[3] - tv[0]), inv = 1.f / (1.f + e1 + e2 + e3);
                if (e == 0) { *(int4*)(TOPI + 4 * m) = make_int4(ti[0], ti[1], ti[2], ti[3]); *(f32x4*)(GATE + 4 * m) = (f32x4){inv, e1 * inv, e2 * inv, e3 * inv};
                    atomicAdd((int*)&hist[ti[0]], 1); atomicAdd((int*)&hist[ti[1]], 1); atomicAdd((int*)&hist[ti[2]], 1); atomicAdd((int*)&hist[ti[3]], 1); }
            }
            __syncthreads();
        }
        if (tid < 32) CHCNT[ch * 32 + tid] = hist[tid];
        __syncthreads();
    }
}

__device__ __forceinline__ void ph_lists(const P& p, int wg, int nwg, int tid, LAS unsigned char* lds) {
    LAS int* ct = (LAS int*)lds;
    LAS int* part = ct + 8192;
    LAS int* tot = part + 512; LAS int* base = tot + 32; LAS int* off = base + 64; LAS int* tp = off + 32;
    const int* CHCNT = (const int*)(p.ws + WS_CHCNT); const int* TOPI = (const int*)(p.ws + WS_TOPI);
    int* TOKSLOT = (int*)(p.ws + WS_TOKSLOT); int* SLOTTOK = (int*)(p.ws + WS_SLOTTOK); int* TILEE = (int*)(p.ws + WS_TILEE);
    for (int i = tid; i < 8192; i += NTHR) ct[i] = CHCNT[i];
    __syncthreads();
    { const int e = tid & 31, pt = tid >> 5; int s = 0; for (int c = pt * 16; c < pt * 16 + 16; ++c) s += ct[c * 32 + e]; part[pt * 32 + e] = s; }
    __syncthreads();
    if (tid < 32) { int s = 0; for (int k = 0; k < 16; ++k) s += part[k * 32 + tid]; tot[tid] = s; }
    __syncthreads();
    if (tid == 0) { int run = 0; for (int e = 0; e < 32; ++e) { base[e] = run; run += ((tot[e] + 255) >> 8) << 8; } base[32] = run; }
    __syncthreads();
    for (int ch = wg; ch < 256; ch += nwg) {
        { const int e = tid & 31, pt = tid >> 5; int s = 0; for (int c = pt * 16; c < pt * 16 + 16 && c < ch; ++c) s += ct[c * 32 + e]; part[pt * 32 + e] = s; }
        if (tid < 256) tp[tid] = TOPI[ch * 256 + tid];
        __syncthreads();
        if (tid < 32) { int s = base[tid]; for (int k = 0; k < 16; ++k) s += part[k * 32 + tid]; off[tid] = s; }
        __syncthreads();
        if (tid < 256) { const int e = tp[tid]; int rank = 0; for (int q = 0; q < tid; ++q) rank += (tp[q] == e) ? 1 : 0;
            const int s = off[e] + rank; TOKSLOT[ch * 256 + tid] = s; SLOTTOK[s] = ch * 64 + (tid >> 2); }
        __syncthreads();
    }
    if (wg == 0) {
        if (tid < 32) { const int e = tid; for (int s = base[e] + tot[e]; s < base[e] + (((tot[e] + 255) >> 8) << 8); ++s) SLOTTOK[s] = 0;
            for (int t = base[e] >> 8; t < (base[e] >> 8) + ((tot[e] + 255) >> 8); ++t) TILEE[t] = e; }
        const int nt = base[32] >> 8;
        for (int t = nt + tid; t < MAXTILES; t += NTHR) TILEE[t] = -1;
        if (tid == 0) TILEE[400] = nt;
    }
}

__device__ __forceinline__ void ph_final(const P& p, int wg, int nwg, int tid) {
    const int lane = tid & 63, wave = tid >> 6;
    const float* x = p.in[0]; const float* MOD = (const float*)(p.ws + WS_MOD); const float* npost = p.in[7]; const float* nfpost = p.in[9];
    const bf16_t* MIX = (const bf16_t*)(p.ws + WS_MIX); const unsigned char* Y = (const unsigned char*)(p.ws + WS_Y);
    const int* TOKSLOT = (const int*)(p.ws + WS_TOKSLOT); const float* GATE = (const float*)(p.ws + WS_GATE);
    for (int ch = wg; ch < 256; ch += nwg) {
        const int b = (ch * 64) >> 13;
        f32x4 a1[4], a3[4];
#pragma unroll
        for (int j = 0; j < 4; ++j) { const int c = 4 * lane + 256 * j;
            a1[j] = *(const f32x4*)(npost + c) * *(const f32x4*)(MOD + b * 6144 + 2048 + c);
            a3[j] = *(const f32x4*)(nfpost + c) * *(const f32x4*)(MOD + b * 6144 + 5120 + c); }
        int4 sln[2]; f32x4 gtn[2];
#pragma unroll
        for (int q = 0; q < 2; ++q) { const int m = ch * 64 + wave * 8 + q; sln[q] = *(const int4*)(TOKSLOT + 4 * m); gtn[q] = *(const f32x4*)(GATE + 4 * m); }
#pragma unroll 1
        for (int i2 = 0; i2 < 8; i2 += 2) {
            const int4 sl[2] = {sln[0], sln[1]}; const f32x4 gt[2] = {gtn[0], gtn[1]};
            u32x2 mw[2][4]; unsigned yw[2][4][4]; f32x4 xv[2][4];
#pragma unroll
            for (int q = 0; q < 2; ++q) { const int m = ch * 64 + wave * 8 + i2 + q;
#pragma unroll
                for (int j = 0; j < 4; ++j) { const int c = 4 * lane + 256 * j;
                    mw[q][j] = __builtin_nontemporal_load((const u32x2*)(MIX + (size_t)m * D + c)); xv[q][j] = __builtin_nontemporal_load((const f32x4*)(x + (size_t)m * D + c));
                    yw[q][j][0] = __builtin_nontemporal_load((const unsigned*)(Y + (size_t)sl[q].x * D + c)); yw[q][j][1] = __builtin_nontemporal_load((const unsigned*)(Y + (size_t)sl[q].y * D + c));
                    yw[q][j][2] = __builtin_nontemporal_load((const unsigned*)(Y + (size_t)sl[q].z * D + c)); yw[q][j][3] = __builtin_nontemporal_load((const unsigned*)(Y + (size_t)sl[q].w * D + c)); } }
            if (i2 + 2 < 8) {
#pragma unroll
                for (int q = 0; q < 2; ++q) { const int m = ch * 64 + wave * 8 + i2 + 2 + q; sln[q] = *(const int4*)(TOKSLOT + 4 * m); gtn[q] = *(const f32x4*)(GATE + 4 * m); } }
#pragma unroll
            for (int q = 0; q < 2; ++q) { const int m = ch * 64 + wave * 8 + i2 + q; const f32x4 g = gt[q];
                f32x4 mx[4], y[4]; float ss = 0.f, sy = 0.f;
#pragma unroll
                for (int j = 0; j < 4; ++j) { const u32x2 w = mw[q][j]; mx[j] = (f32x4){bflo(w.x), bfhi(w.x), bflo(w.y), bfhi(w.y)}; ss += dot4(mx[j], mx[j]);
                    f32x4 t = fp8x4(yw[q][j][0]) * g.x; t += fp8x4(yw[q][j][1]) * g.y; t += fp8x4(yw[q][j][2]) * g.z; t += fp8x4(yw[q][j][3]) * g.w;
                    y[j] = t; sy += dot4(t, t); }
                const float r1 = rsqrtf(wave_sum(ss) * (1.f / D) + RMS_EPS), r3 = rsqrtf(wave_sum(sy) * (1.f / D) + RMS_EPS);
#pragma unroll
                for (int j = 0; j < 4; ++j) { const int c = 4 * lane + 256 * j;
                    const f32x4 x1 = xv[q][j] + a1[j] * (mx[j] * r1); __builtin_nontemporal_store(x1 + a3[j] * (y[j] * r3), (f32x4*)(p.out + (size_t)m * D + c)); } }
        }
    }
}

typedef float f32x2a __attribute__((ext_vector_type(2)));
__device__ __forceinline__ f32x4 act4p(f32x4 g, f32x4 u1) {
    f32x4 r;
#pragma unroll
    for (int i = 0; i < 4; i += 2) {
        const f32x2a gg = {fminf(g[i], 7.f), fminf(g[i + 1], 7.f)}; f32x2a e = gg * (f32x2a){-2.4554669595930156f, -2.4554669595930156f};
        e[0] = __builtin_amdgcn_exp2f(e[0]); e[1] = __builtin_amdgcn_exp2f(e[1]); e += (f32x2a){1.f, 1.f};
        const f32x2a rc = {__builtin_amdgcn_rcpf(e[0]), __builtin_amdgcn_rcpf(e[1])}, uu = {__builtin_amdgcn_fmed3f(u1[i], -6.f, 8.f), __builtin_amdgcn_fmed3f(u1[i + 1], -6.f, 8.f)};
        const f32x2a o = gg * rc * uu; r[i] = o[0]; r[i + 1] = o[1]; }
    return r;
}
__device__ __forceinline__ f32x4 act4(f32x4 g, f32x4 u) {
    f32x4 r;
#pragma unroll
    for (int i = 0; i < 4; ++i) { const float gg = fminf(g[i], 7.f), uu = fminf(fmaxf(u[i], -7.f), 7.f); r[i] = gg * __builtin_amdgcn_rcpf(1.f + __builtin_amdgcn_exp2f(-2.4554669595930156f * gg)) * (uu + 1.f); }
    return r;
}

namespace pg8 {
constexpr int BM = 256, BK = 64, HALF = 128, HTB = HALF * BK * 2, STAGE_BYTES = 8 * HTB, NXCD = 8, WGM = 8;
__device__ __forceinline__ int lds_byte(int r, int c) { const int st = (r >> 4) * 2 + (c >> 5), rr = r & 15, cc = c & 31, ob = rr * 64 + cc * 2; return st * 1024 + (ob ^ (((ob >> 9) & 1) << 5)); }
__device__ __forceinline__ void stage_rc(int b, int& R, int& C) { const int st = b / 1024, sb = b % 1024, swz = sb ^ (((sb >> 9) & 1) << 5); R = (st >> 1) * 16 + swz / 64; C = (st & 1) * 32 + (swz % 64) / 2; }
__device__ __forceinline__ int perm32(int rho) { const int n = rho >> 4, i = rho & 15; return 8 * (i >> 2) + 4 * n + (i & 3); }
struct GUnit { const char* B; int pm, pn, e, arow, li; };
typedef int i32x4v __attribute__((ext_vector_type(4)));
typedef int i32x8v __attribute__((ext_vector_type(8)));
template <class Epi, class Sched, bool FP8 = false>
__device__ __forceinline__ void gemm_phase(LAS unsigned char* lds, const int tid, const char* Abase, const int K, const Sched& S, const Epi& E) {
    const int wid = __builtin_amdgcn_readfirstlane(tid >> 6), lane = tid & 63, wr = wid >> 2, wc = wid & 3, fr = lane & 15, fq = lane >> 4;
    const int Kb = FP8 ? K : K * 2, nt = Kb / (BK * 2);
    unsigned voffB[2];
#pragma unroll
    for (int i = 0; i < 2; ++i) { int R, C; stage_rc(tid * 16 + i * 8192, R, C); const int Rb = (R & ~31) + perm32(R & 31); voffB[i] = (unsigned)(Rb * Kb + C * 2); }
    const size_t kstep = (size_t)(BK * 2);
    const size_t hstep = (size_t)HALF * Kb;
    const unsigned ldsw = (unsigned)wid * 1024u;
    constexpr int FC = FP8 ? 16 : 8, PSTR = FP8 ? 16 : 1024;
    const int aoff = lds_byte(wr * 64 + fr, fq * FC), boff = lds_byte(wc * 32 + fr, fq * FC);
#define PG8_SA(b, h) (((b) * 2 + (h)) * HTB)
#define PG8_SB(b, h) ((4 + (b) * 2 + (h)) * HTB)
#define PG8_STAGE_B(bufoff, gbase) do { _Pragma("unroll") for (int _i = 0; _i < 2; ++_i) \
        __builtin_amdgcn_global_load_lds((const unsigned*)((const char*)(gbase) + voffB[_i]), (LAS unsigned*)(lds + (bufoff) + ldsw + _i * 8192), 16, 0, 0); } while (0)
#define PG8_STAGE_A(bufoff, vo, koff) do { _Pragma("unroll") for (int _i = 0; _i < 2; ++_i) \
        __builtin_amdgcn_global_load_lds((const unsigned*)(Abase + (size_t)(vo)[_i] + (koff)), (LAS unsigned*)(lds + (bufoff) + ldsw + _i * 8192), 16, 0, 0); } while (0)
#define PG8_LDA(dst, b, h) do { _Pragma("unroll") for (int m = 0; m < 4; ++m) _Pragma("unroll") for (int k = 0; k < 2; ++k) dst[m][k] = *(const LAS bf16x8*)(lds + PG8_SA(b, h) + aoff + m * 2048 + k * PSTR); } while (0)
#define PG8_LDB(dst, b, h) do { _Pragma("unroll") for (int n = 0; n < 2; ++n) _Pragma("unroll") for (int k = 0; k < 2; ++k) dst[n][k] = *(const LAS bf16x8*)(lds + PG8_SB(b, h) + boff + n * 2048 + k * PSTR); } while (0)
#define PG8_CAT(x) __builtin_shufflevector(__builtin_bit_cast(i32x4v, (x)[0]), __builtin_bit_cast(i32x4v, (x)[1]), 0, 1, 2, 3, 4, 5, 6, 7)
#define PG8_MMA(ai, bj, At, Bt) do { __builtin_amdgcn_s_setprio(1); \
        if constexpr (FP8) { _Pragma("unroll") for (int m = 0; m < 4; ++m) _Pragma("unroll") for (int n = 0; n < 2; ++n) \
            acc[ai][bj][m][n] = __builtin_amdgcn_mfma_scale_f32_16x16x128_f8f6f4(PG8_CAT(Bt[n]), PG8_CAT(At[m]), acc[ai][bj][m][n], 0, 0, 0, 0x7F7F7F7F, 0, 0x7F7F7F7F); \
            _Pragma("unroll") for (int m = 0; m < 4; ++m) _Pragma("unroll") for (int n = 0; n < 2; ++n) asm volatile("" : "+v"(acc[ai][bj][m][n])); }   \
        else { _Pragma("unroll") for (int m = 0; m < 4; ++m) _Pragma("unroll") for (int n = 0; n < 2; ++n) _Pragma("unroll") for (int k = 0; k < 2; ++k) \
            acc[ai][bj][m][n] = __builtin_amdgcn_mfma_f32_16x16x32_bf16(Bt[n][k], At[m][k], acc[ai][bj][m][n], 0, 0, 0); } \
        __builtin_amdgcn_s_setprio(0); } while (0)
#define PG8_WAIT_V(n) asm volatile("s_waitcnt vmcnt(" #n ")" ::: "memory")
#define PG8_WAIT_L(n) asm volatile("s_waitcnt lgkmcnt(" #n ")" ::: "memory")
#define PG8_BAR __builtin_amdgcn_s_barrier()
#define PG8_SCHED __builtin_amdgcn_sched_barrier(0)
    GUnit cur, nxt; int ui = 0;
    if (!S.next(0, cur)) return;
    f32x4 acc[2][2][4][2];
#pragma unroll
    for (int a = 0; a < 2; ++a)
#pragma unroll
        for (int b = 0; b < 2; ++b)
#pragma unroll
            for (int m = 0; m < 4; ++m)
#pragma unroll
                for (int n = 0; n < 2; ++n) acc[a][b][m][n] = (f32x4){0.f, 0.f, 0.f, 0.f};
    bf16x8 At[4][2], B0[2][2], B1[2][2];
    unsigned cvo[2][2];
    S.aoffs(cur, tid, cvo);
    const char* cB = cur.B;
    PG8_STAGE_B(PG8_SB(0, 0), cB); PG8_STAGE_B(PG8_SB(0, 1), cB + hstep); PG8_STAGE_A(PG8_SA(0, 0), cvo[0], 0); PG8_STAGE_A(PG8_SA(0, 1), cvo[1], 0);
    if (wr == 1) PG8_BAR;
    PG8_WAIT_V(2); PG8_BAR;
    PG8_STAGE_B(PG8_SB(1, 0), cB + kstep); PG8_STAGE_A(PG8_SA(1, 0), cvo[0], kstep); PG8_STAGE_B(PG8_SB(1, 1), cB + hstep + kstep);
    PG8_WAIT_V(6); PG8_BAR;
    for (;;) {
        const bool has_next = S.next(ui + 1, nxt);
        const char* nB = has_next ? nxt.B : cB;
#pragma nounroll
        for (int t = 0; t < nt; t += 2) {
            const bool last = (t == nt - 2);
            const size_t k1 = (size_t)(t + 1) * kstep, k2 = last ? 0 : (size_t)(t + 2) * kstep, k3 = k2 + kstep;
            const char* b2 = last ? nB : cB + (size_t)(t + 2) * kstep; const char* b3 = b2 + kstep;
            PG8_LDB(B0, 0, 0); PG8_LDB(B1, 0, 1); PG8_SCHED; PG8_LDA(At, 0, 0); PG8_STAGE_A(PG8_SA(1, 1), cvo[1], k1);
            PG8_WAIT_V(8); PG8_WAIT_L(0); PG8_BAR; PG8_MMA(0, 0, At, B0); PG8_MMA(0, 1, At, B1); PG8_BAR; PG8_SCHED;
            if (last && has_next) S.aoffs(nxt, tid, cvo);
            PG8_LDA(At, 0, 1); PG8_STAGE_B(PG8_SB(0, 0), b2); PG8_STAGE_B(PG8_SB(0, 1), b2 + hstep); PG8_STAGE_A(PG8_SA(0, 0), cvo[0], k2);
            PG8_WAIT_V(8); PG8_WAIT_L(0); PG8_BAR; PG8_MMA(1, 0, At, B0); PG8_MMA(1, 1, At, B1); PG8_BAR; PG8_SCHED;
            PG8_LDB(B0, 1, 0); PG8_LDB(B1, 1, 1); PG8_SCHED; PG8_LDA(At, 1, 0); PG8_STAGE_A(PG8_SA(0, 1), cvo[1], k2);
            PG8_WAIT_V(8); PG8_WAIT_L(0); PG8_BAR; PG8_MMA(0, 0, At, B0); PG8_MMA(0, 1, At, B1); PG8_BAR; PG8_SCHED;
            PG8_LDA(At, 1, 1); PG8_STAGE_B(PG8_SB(1, 0), b3); PG8_STAGE_B(PG8_SB(1, 1), b3 + hstep); PG8_STAGE_A(PG8_SA(1, 0), cvo[0], k3);
            PG8_WAIT_V(8); PG8_WAIT_L(0); PG8_BAR; PG8_MMA(1, 0, At, B0); PG8_MMA(1, 1, At, B1); PG8_BAR; PG8_SCHED;
        }
        if (wr == 0) PG8_BAR;
        E(acc, cur, wr, wc, fr, fq);
        if (!has_next) break;
#pragma unroll
        for (int a = 0; a < 2; ++a)
#pragma unroll
            for (int b = 0; b < 2; ++b)
#pragma unroll
                for (int m = 0; m < 4; ++m)
#pragma unroll
                    for (int n = 0; n < 2; ++n) acc[a][b][m][n] = (f32x4){0.f, 0.f, 0.f, 0.f};
        cur = nxt; cB = nB; ++ui;
        if (wr == 1) PG8_BAR;
    }
    PG8_WAIT_V(0);
    PG8_BAR;
#undef PG8_SA
#undef PG8_SB
#undef PG8_STAGE_A
#undef PG8_STAGE_B
#undef PG8_LDA
#undef PG8_LDB
#undef PG8_MMA
#undef PG8_CAT
#undef PG8_WAIT_V
#undef PG8_WAIT_L
#undef PG8_BAR
#undef PG8_SCHED
}
struct DenseSched {
    int nM, nN, G, c, K, lda, acol0; const char* Bt;
    __device__ __forceinline__ bool next(int i, GUnit& u) const {
        const int nwg = nM * nN; const long L = (long)i * G + c; if (L >= nwg) return false;
        int wgid = (int)L; { const int q = nwg / NXCD, r = nwg % NXCD, xcd = wgid % NXCD, off = wgid / NXCD; wgid = (xcd < r ? xcd * (q + 1) : r * (q + 1) + (xcd - r) * q) + off; }
        const int nig = WGM * nN, gid = wgid / nig, fm = gid * WGM, gsz = (nM - fm) < WGM ? (nM - fm) : WGM;
        u.pm = fm + ((wgid % nig) % gsz); u.pn = (wgid % nig) / gsz; u.e = 0; u.arow = u.pm * BM; u.li = i; u.B = Bt + (size_t)u.pn * BM * K * 2; return true;
    }
    __device__ __forceinline__ void aoffs(const GUnit& u, int tid, unsigned (&vo)[2][2]) const {
#pragma unroll
        for (int i = 0; i < 2; ++i) { int R, C; stage_rc(tid * 16 + i * 8192, R, C);
#pragma unroll
            for (int h = 0; h < 2; ++h) vo[h][i] = (unsigned)((u.arow + R + 128 * h) * lda + acol0 + C) * 2u; }
    }
};
template <int NT, bool GATHER, bool FP8 = false> struct MoeSched {
    int G, c; const LAS int* tile; const LAS unsigned* lst; const char* W; int wrows;
    __device__ __forceinline__ bool next(int i, GUnit& u) const {
        constexpr int RPG = 32 / NT; const int L = i * G + c, x = L & 7, j = L >> 3, grp = j >> 5, jj = j & 31;
        const int rt = (grp * 8 + x) * RPG + (jj % RPG), pn = jj / RPG; if (rt >= tile[300]) return false;
        const int e = tile[rt]; u.pm = rt; u.pn = pn; u.e = e; u.arow = rt * BM; u.li = i; u.B = W + ((size_t)e * wrows + pn * BM) * (FP8 ? 1024 : 2048); return true;
    }
    __device__ __forceinline__ void aoffs(const GUnit& u, int tid, unsigned (&vo)[2][2]) const {
#pragma unroll
        for (int i = 0; i < 2; ++i) { int R, C; stage_rc(tid * 16 + i * 8192, R, C);
#pragma unroll
            for (int h = 0; h < 2; ++h) vo[h][i] = GATHER ? lst[u.li * 256 + R + 128 * h] + (unsigned)C * 2u : (unsigned)((u.arow + R + 128 * h) * (FP8 ? 1024 : 2048) + C * 2); }
    }
};
__device__ __forceinline__ u32x4 pack8(f32x4 a, f32x4 b) { u32x4 w; w.x = pk2(a.x, a.y); w.y = pk2(a.z, a.w); w.z = pk2(b.x, b.y); w.w = pk2(b.z, b.w); return w; }
#define PG8_EPI_LOOP _Pragma("unroll") for (int ai = 0; ai < 2; ++ai) _Pragma("unroll") for (int m = 0; m < 4; ++m)
struct EpiRowMajor { bf16_t* O; int ldo;
    __device__ __forceinline__ void operator()(const f32x4 (&acc)[2][2][4][2], const GUnit& u, int wr, int wc, int fr, int fq) const {
        PG8_EPI_LOOP { bf16_t* rp = O + (size_t)(u.arow + 128 * ai + 64 * wr + 16 * m + fr) * ldo + u.pn * BM + 32 * wc + 8 * fq;
#pragma unroll
            for (int bj = 0; bj < 2; ++bj) *(u32x4*)(rp + 128 * bj) = pack8(acc[ai][bj][m][0], acc[ai][bj][m][1]); }
    }
};
constexpr float QPRESCALE = 0.07216878364870322f * 1.4426950408889634f;
struct EpiQ { unsigned char* ws;
    __device__ __forceinline__ void operator()(const f32x4 (&acc)[2][2][4][2], const GUnit& u, int wr, int wc, int fr, int fq) const {
        const float* RS = (const float*)(ws + WS_RSTAT); const float* ct = (const float*)(ws + WS_ROPE); const float* st = ct + 2048; bf16_t* Q = (bf16_t*)(ws + WS_Q);
        PG8_EPI_LOOP { const int row = u.arow + 128 * ai + 64 * wr + 16 * m + fr; const float rinv = RS[2 * row] * (ATT_QK8 ? QPRESCALE * 16.f : QPRESCALE); const int b = row >> 13, t = row & 8191, prow = t >> 6, pcol = t & 63;
#pragma unroll
            for (int bj = 0; bj < 2; ++bj) { const int col = u.pn * BM + 128 * bj + 32 * wc + 8 * fq; if (col >= NH * DQK) continue;
                const int hd = col / DQK, d = col - hd * DQK; f32x4 v0 = acc[ai][bj][m][0] * rinv, v1 = acc[ai][bj][m][1] * rinv;
                if (d >= DNOPE) { const int pi = (d - DNOPE) >> 1, pos = pi < 16 ? prow : pcol, j = pi & 15; const f32x4 cs = *(const f32x4*)(ct + pos * 16 + j), sn = *(const f32x4*)(st + pos * 16 + j);
                    const f32x4 a = v0, c2 = v1; v0.x = a.x * cs.x - a.y * sn.x; v0.y = a.x * sn.x + a.y * cs.x; v0.z = a.z * cs.y - a.w * sn.y; v0.w = a.z * sn.y + a.w * cs.y;
                    v1.x = c2.x * cs.z - c2.y * sn.z; v1.y = c2.x * sn.z + c2.y * cs.z; v1.z = c2.z * cs.w - c2.w * sn.w; v1.w = c2.z * sn.w + c2.w * cs.w; }
                if constexpr (ATT_QK8) { u32x2 w8; w8.x = pg8_pk4_fp8(v0); w8.y = pg8_pk4_fp8(v1); *(u32x2*)((unsigned char*)Q + ((size_t)(b * NH + hd) * SEQ + t) * DQK + d) = w8; }
                else *(u32x4*)(Q + ((size_t)(b * NH + hd) * SEQ + t) * DQK + d) = pack8(v0, v1); }
            asm volatile("" ::: "memory"); }
    }
};
struct EpiKV { unsigned char* ws;
    __device__ __forceinline__ void operator()(const f32x4 (&acc)[2][2][4][2], const GUnit& u, int wr, int wc, int fr, int fq) const {
        const float* RS = (const float*)(ws + WS_RSTAT); bf16_t* KNp = (bf16_t*)(ws + WS_KN); bf16_t* Vp = (bf16_t*)(ws + WS_V);
        PG8_EPI_LOOP { const int row = u.arow + 128 * ai + 64 * wr + 16 * m + fr; const float rinv = RS[2 * row + 1]; int b, tt; if (row < ML) { b = row >> 13; tt = row & 8191; } else { b = (row - ML) >> 8; tt = SEQ + ((row - ML) & 255); }
            const size_t ro = ((size_t)(b * NH + u.pn) * TK + tt) * 128 + 32 * wc + 8 * fq;
            if constexpr (ATT_QK8) { u32x2 w8; w8.x = pg8_pk4_fp8(acc[ai][0][m][0] * rinv); w8.y = pg8_pk4_fp8(acc[ai][0][m][1] * rinv); *(u32x2*)((unsigned char*)KNp + ro) = w8; }
            else *(u32x4*)(KNp + ro) = pack8(acc[ai][0][m][0] * rinv, acc[ai][0][m][1] * rinv);
            if constexpr (ATT_PV8) { u32x2 w8; w8.x = pg8_pk4_fp8(acc[ai][1][m][0] * rinv); w8.y = pg8_pk4_fp8(acc[ai][1][m][1] * rinv); *(u32x2*)((unsigned char*)Vp + ro) = w8; }
            else *(u32x4*)(Vp + ro) = pack8(acc[ai][1][m][0] * rinv, acc[ai][1][m][1] * rinv);
            asm volatile("" ::: "memory"); }
    }
};
struct EpiAct { bf16_t* ACT; const float* bg; const float* bu;
    __device__ __forceinline__ void operator()(const f32x4 (&acc)[2][2][4][2], const GUnit& u, int wr, int wc, int fr, int fq) const {
        const int ac = u.pn * 128 + 32 * wc + 8 * fq; const float* pg = bg + u.e * 1024 + ac; const float* pu = bu + u.e * 1024 + ac;
        const f32x4 g0 = *(const f32x4*)pg, g1 = *(const f32x4*)(pg + 4), u0 = *(const f32x4*)pu, u1 = *(const f32x4*)(pu + 4);
        PG8_EPI_LOOP { const int slot = u.arow + 128 * ai + 64 * wr + 16 * m + fr;
            *(u32x4*)(ACT + (size_t)slot * 1024 + ac) = pack8(act4(acc[ai][0][m][0] + g0, acc[ai][1][m][0] + u0), act4(acc[ai][0][m][1] + g1, acc[ai][1][m][1] + u1)); }
    }
};
__device__ __forceinline__ unsigned pk4_fp8(f32x4 v) { int p = __builtin_amdgcn_cvt_pk_fp8_f32(v.x, v.y, 0, false); p = __builtin_amdgcn_cvt_pk_fp8_f32(v.z, v.w, p, true); return (unsigned)p; }
struct EpiAct8 { unsigned char* ACT; const float* bg; const float* bu; float sc;
    __device__ __forceinline__ void operator()(const f32x4 (&acc)[2][2][4][2], const GUnit& u, int wr, int wc, int fr, int fq) const {
        const int ac = u.pn * 128 + 32 * wc + 8 * fq; const float* pg = bg + u.e * 1024 + ac; const float* pu = bu + u.e * 1024 + ac;
        const f32x4 g0 = *(const f32x4*)pg, g1 = *(const f32x4*)(pg + 4), u0 = *(const f32x4*)pu + 1.f, u1 = *(const f32x4*)(pu + 4) + 1.f;
        PG8_EPI_LOOP { const int slot = u.arow + 128 * ai + 64 * wr + 16 * m + fr; u32x2 w;
            w.x = pk4_fp8(act4p(acc[ai][0][m][0] * sc + g0, acc[ai][1][m][0] * sc + u0)); w.y = pk4_fp8(act4p(acc[ai][0][m][1] * sc + g1, acc[ai][1][m][1] * sc + u1));
            *(u32x2*)(ACT + (size_t)slot * 1024 + ac) = w; }
    }
};
struct EpiY { bf16_t* Y; const float* bd; float sc;
    __device__ __forceinline__ void operator()(const f32x4 (&acc)[2][2][4][2], const GUnit& u, int wr, int wc, int fr, int fq) const {
        const int c0 = u.pn * BM + 32 * wc + 8 * fq; const float* pb = bd + u.e * 1024 + c0;
        const f32x4 b00 = *(const f32x4*)pb, b01 = *(const f32x4*)(pb + 4), b10 = *(const f32x4*)(pb + 128), b11 = *(const f32x4*)(pb + 132);
        PG8_EPI_LOOP { const int slot = u.arow + 128 * ai + 64 * wr + 16 * m + fr; bf16_t* rp = Y + (size_t)slot * 1024 + c0;
            *(u32x4*)rp = pack8(acc[ai][0][m][0] * sc + b00, acc[ai][0][m][1] * sc + b01); *(u32x4*)(rp + 128) = pack8(acc[ai][1][m][0] * sc + b10, acc[ai][1][m][1] * sc + b11); }
    }
};
struct EpiY8 { unsigned char* Y; const float* bd; float sc;
    __device__ __forceinline__ void operator()(const f32x4 (&acc)[2][2][4][2], const GUnit& u, int wr, int wc, int fr, int fq) const {
        const int c0 = u.pn * BM + 32 * wc + 8 * fq; const float* pb = bd + u.e * 1024 + c0;
        const f32x4 b00 = *(const f32x4*)pb, b01 = *(const f32x4*)(pb + 4), b10 = *(const f32x4*)(pb + 128), b11 = *(const f32x4*)(pb + 132);
        PG8_EPI_LOOP { const int slot = u.arow + 128 * ai + 64 * wr + 16 * m + fr; unsigned char* rp = Y + (size_t)slot * 1024 + c0; u32x2 w0, w1;
            w0.x = pk4_fp8(acc[ai][0][m][0] * sc + b00); w0.y = pk4_fp8(acc[ai][0][m][1] * sc + b01); w1.x = pk4_fp8(acc[ai][1][m][0] * sc + b10); w1.y = pk4_fp8(acc[ai][1][m][1] * sc + b11);
            *(u32x2*)rp = w0; *(u32x2*)(rp + 128) = w1; }
    }
};
#undef PG8_EPI_LOOP
}


namespace att {
typedef short s16x4 __attribute__((ext_vector_type(4)));
constexpr int NW = 8, QBLK = 32, KVBLK = 64, NTILE = 66, HALFKEYS = NTILE * KVBLK;
constexpr float SCALE = 0.07216878364870322f, THR = 8.f;
constexpr int SHM_V = KVBLK * 128 * (ATT_PV8 ? 1 : 2), SHM_K = KVBLK * 128 * (ATT_QK8 ? 1 : 2), SHM_R = KVBLK * 64 * (ATT_QK8 ? 1 : 2);
__device__ __forceinline__ int crow(int r, int hi) { return (r & 3) + 8 * (r >> 2) + 4 * hi; }
__device__ __forceinline__ unsigned cvtpk(float lo, float hi) { return pk2(lo, hi); }
__device__ __forceinline__ int v_rd_base(int lane) { return ((lane & 3) << 3) | (((lane >> 2) & 3) << 6) | (((lane >> 4) & 1) << 5) | (((lane >> 5) & 1) << 8); }
constexpr int v_rd_off(int d0, int ks, int half) { return d0 * 512 + ks * 4096 + half * 2048; }
constexpr int SLOT_B = SHM_K + SHM_R + SHM_V, SL_K = 0, SL_R = SHM_K, SL_V = SHM_K + SHM_R, DMA_WS = 3 * SLOT_B, ATT_DMA_LDS = DMA_WS + NW * 64 * 4;
#define RSWZ(row, colB) ((row) * 128 + ((colB) ^ ((((row) >> 1) & 7) << 4)))
#define SBAR() __builtin_amdgcn_sched_barrier(0)
__device__ __forceinline__ float max3(float a, float b, float c) { return __builtin_elementwise_maximum(__builtin_elementwise_maximum(a, b), c); }
__device__ __forceinline__ float sm_max(const f32x16& p0, const f32x16& p1) {
  float a = max3(p0[0], p0[1], p0[2]), b = max3(p0[3], p0[4], p0[5]), c = max3(p1[0], p1[1], p1[2]), d = max3(p1[3], p1[4], p1[5]);
  a = max3(a, p0[6], p0[7]); b = max3(b, p0[8], p0[9]); c = max3(c, p1[6], p1[7]); d = max3(d, p1[8], p1[9]);
  a = max3(a, p0[10], p0[11]); b = max3(b, p0[12], p0[13]); c = max3(c, p1[10], p1[11]); d = max3(d, p1[12], p1[13]);
  a = max3(a, p0[14], p0[15]); c = max3(c, p1[14], p1[15]);
  float pmax = max3(a, b, max3(c, d, d));
  auto rr = __builtin_amdgcn_permlane32_swap(__float_as_uint(pmax), __float_as_uint(pmax), false, false);
  return max3(__uint_as_float(rr[0]), __uint_as_float(rr[1]), __uint_as_float(rr[1]));
}
#if ATT_PV8
__device__ __forceinline__ int kperm(int i) { return 16 * ((i >> 2) & 1) + 4 * (i >> 3) + (i & 3); }
#else
__device__ __forceinline__ int kperm(int i) { const int a = i >> 3, h = (i >> 2) & 1, b = i & 3; return 16 * (a >> 1) + 8 * h + 4 * (a & 1) + b; }
#endif
__device__ __forceinline__ s16x4 trv(int a) { return __builtin_amdgcn_ds_read_tr16_b64_v4i16((LAS s16x4*)(uintptr_t)(unsigned)a); }
#define QK_LD(s, slot) do { if ((s) < 4) { f0[slot] = *(const LAS bf16x8*)(uintptr_t)(unsigned)(ka[(s)]); f1[slot] = *(const LAS bf16x8*)(uintptr_t)(unsigned)(ka[(s)] + 8192); } \
    else if ((s) < 8) { f0[slot] = *(const LAS bf16x8*)(uintptr_t)(unsigned)(kha[(s) - 4]); f1[slot] = *(const LAS bf16x8*)(uintptr_t)(unsigned)(kha[(s) - 4] + 8192); } \
    else { f0[slot] = *(const LAS bf16x8*)(uintptr_t)(unsigned)(ra[(s) - 8]); f1[slot] = *(const LAS bf16x8*)(uintptr_t)(unsigned)(ra[(s) - 8] + 4096); } } while (0)
#ifndef PP_KD
#define PP_KD 3
#endif
#ifndef PP_VD
#define PP_VD 6
#endif
constexpr int KD = PP_KD, KR_ = KD + 1, VD = PP_VD, VR_ = 16;
__device__ __forceinline__ void pp_qkt_head(bf16x8 (&f0)[KR_], bf16x8 (&f1)[KR_], const int (&kb)[4], const int (&rb)[4], int khd, int soff) {
  int ka[4], kha[4], ra[4];
#pragma unroll
  for (int i = 0; i < 4; ++i) { ka[i] = kb[i] + soff; kha[i] = ka[i] + khd; ra[i] = rb[i] + soff; }
#pragma unroll
  for (int s = 0; s < KD; ++s) QK_LD(s, s);
}
#define PV_LD(n) do { L[(n) & 15] = trv(vb + v_rd_off((n) & 3, (n) >> 2, 0)); H[(n) & 15] = trv(vb + v_rd_off((n) & 3, (n) >> 2, 1)); } while (0)
#define PV_MFMA(n) do { const bf16x8 pa_ = ((n) >> 2) == 0 ? pa0 : ((n) >> 2) == 1 ? pa1 : ((n) >> 2) == 2 ? pa2 : pa3; const s16x4 l_ = L[(n) & 15], h_ = H[(n) & 15]; \
    o[(n) & 3] = __builtin_amdgcn_mfma_f32_32x32x16_bf16(pa_, (bf16x8){l_[0], l_[1], l_[2], l_[3], h_[0], h_[1], h_[2], h_[3]}, o[(n) & 3], 0, 0, 0); } while (0)
template <bool PV>
__device__ __forceinline__ void pp_mphase(f32x16& p0, f32x16& p1, f32x16* o, bf16x8 (&f0)[KR_], bf16x8 (&f1)[KR_], const int (&kb)[4], int khd, const int (&rb)[4], int soff, int vb, const bf16x8* qr,
                                          bf16x8 pa0, bf16x8 pa1, bf16x8 pa2, bf16x8 pa3, const f32x16& minit) {
  int ka[4], kha[4], ra[4]; s16x4 L[VR_], H[VR_];
#pragma unroll
  for (int i = 0; i < 4; ++i) { ka[i] = kb[i] + soff; kha[i] = ka[i] + khd; ra[i] = rb[i] + soff; }
#pragma unroll
  for (int s = 0; s < 12; ++s) {
    if (s + KD < 12) QK_LD(s + KD, (s + KD) % KR_);
    else if (PV) { if (2 * (s + KD - 12) < VD) PV_LD(2 * (s + KD - 12)); if (2 * (s + KD - 12) + 1 < VD) PV_LD(2 * (s + KD - 12) + 1); }
    SBAR();
    p0 = __builtin_amdgcn_mfma_f32_32x32x16_bf16(f0[s % KR_], qr[s], s == 0 ? minit : p0, 0, 0, 0);
    p1 = __builtin_amdgcn_mfma_f32_32x32x16_bf16(f1[s % KR_], qr[s], s == 0 ? minit : p1, 0, 0, 0);
    SBAR(); }
  if (PV) {
#pragma unroll
    for (int n = 2 * KD; n < VD; ++n) PV_LD(n);
#pragma unroll
    for (int n = 0; n < 16; ++n) { if (n + VD < 16) PV_LD(n + VD); SBAR(); PV_MFMA(n); SBAR(); } }
}
__device__ __forceinline__ void pp_pv(f32x16* o, int vb, bf16x8 pa0, bf16x8 pa1, bf16x8 pa2, bf16x8 pa3) {
  s16x4 L[VR_], H[VR_];
#pragma unroll
  for (int n = 0; n < VD; ++n) PV_LD(n);
#pragma unroll
  for (int n = 0; n < 16; ++n) { if (n + VD < 16) PV_LD(n + VD); SBAR(); PV_MFMA(n); SBAR(); }
}
#undef QK_LD
#if ATT_QK8
typedef int i32x4q __attribute__((ext_vector_type(4)));
typedef int i32x8q __attribute__((ext_vector_type(8)));
#define Q8_CAT(a, b) __builtin_shufflevector((a), (b), 0, 1, 2, 3, 4, 5, 6, 7)
#define Q8_LD(s, slot) do { const int a0_ = (s) < 2 ? kq[2 * (s)] : rq[0], a1_ = (s) < 2 ? kq[2 * (s) + 1] : rq[1]; constexpr int b1_ = (s) < 2 ? 32 * 128 : 32 * 64; \
    g0[slot] = Q8_CAT(*(const LAS i32x4q*)(uintptr_t)(unsigned)(a0_ + soff), *(const LAS i32x4q*)(uintptr_t)(unsigned)(a1_ + soff)); \
    g1[slot] = Q8_CAT(*(const LAS i32x4q*)(uintptr_t)(unsigned)(a0_ + soff + b1_), *(const LAS i32x4q*)(uintptr_t)(unsigned)(a1_ + soff + b1_)); } while (0)
typedef int i32x2q __attribute__((ext_vector_type(2)));
__device__ __forceinline__ i32x2q trv8(int a) { return __builtin_amdgcn_ds_read_tr8_b64_v2i32((LAS i32x2q*)(uintptr_t)(unsigned)a); }
#define PV8_LD(db) do { const int a_ = vb8[db] + voff; const i32x2q t0_ = trv8(a_), t1_ = trv8(a_ + 1024), t2_ = trv8(a_ + 4096), t3_ = trv8(a_ + 5120); \
    vf[db] = (i32x8q){t0_[0], t0_[1], t1_[0], t1_[1], t2_[0], t2_[1], t3_[0], t3_[1]}; } while (0)
__device__ __forceinline__ void pp8_head(i32x8q (&g0)[3], i32x8q (&g1)[3], const int (&kq)[4], const int (&rq)[2], int soff) { Q8_LD(0, 0); Q8_LD(1, 1); }
template <bool PV>
#if ATT_PV8
#define PP8_VARG const int (&vb8)[4], int voff
#else
#define PP8_VARG int vb
#endif
__device__ __forceinline__ void pp8_mphase(f32x16& p0, f32x16& p1, f32x16* o, i32x8q (&g0)[3], i32x8q (&g1)[3], const int (&kq)[4], const int (&rq)[2], int soff, PP8_VARG, const i32x8q (&qf)[3],
                                           bf16x8 pa0, bf16x8 pa1, bf16x8 pa2, bf16x8 pa3, const f32x16& minit) {
#if ATT_PV8
  i32x8q vf[4];
#else
  s16x4 L[VR_], H[VR_];
#endif
#pragma unroll
  for (int s = 0; s < 3; ++s) {
    if (s == 0) Q8_LD(2, 2);
#if ATT_PV8
    else if (PV) { PV8_LD(2 * (s - 1)); PV8_LD(2 * (s - 1) + 1); }
#else
    else if (PV) { PV_LD(3 * (s - 1)); PV_LD(3 * (s - 1) + 1); PV_LD(3 * (s - 1) + 2); }
#endif
    SBAR();
    p0 = __builtin_amdgcn_mfma_scale_f32_32x32x64_f8f6f4(g0[s], qf[s], s == 0 ? minit : p0, 0, 0, 0, 0x7F7F7F7F, 0, 0x7B7B7B7B);
    p1 = __builtin_amdgcn_mfma_scale_f32_32x32x64_f8f6f4(g1[s], qf[s], s == 0 ? minit : p1, 0, 0, 0, 0x7F7F7F7F, 0, 0x7B7B7B7B);
    SBAR(); }
  if (PV) {
#if ATT_PV8
    const i32x8q p8 = Q8_CAT(__builtin_bit_cast(i32x4q, pa0), __builtin_bit_cast(i32x4q, pa1));
#pragma unroll
    for (int db = 0; db < 4; ++db) { SBAR(); o[db] = __builtin_amdgcn_mfma_scale_f32_32x32x64_f8f6f4(p8, vf[db], o[db], 0, 0, 0, 0x7F7F7F7F, 0, 0x7F7F7F7F); SBAR(); }
#else
#pragma unroll
    for (int n = 0; n < 16; ++n) { if (n + VD < 16) PV_LD(n + VD); SBAR(); PV_MFMA(n); SBAR(); }
#endif
  }
}
#if ATT_PV8
__device__ __forceinline__ void pp_pv8(f32x16* o, const int (&vb8)[4], int voff, bf16x8 pa0, bf16x8 pa1) {
  i32x8q vf[4];
#pragma unroll
  for (int db = 0; db < 4; ++db) PV8_LD(db);
  const i32x8q p8 = Q8_CAT(__builtin_bit_cast(i32x4q, pa0), __builtin_bit_cast(i32x4q, pa1));
#pragma unroll
  for (int db = 0; db < 4; ++db) o[db] = __builtin_amdgcn_mfma_scale_f32_32x32x64_f8f6f4(p8, vf[db], o[db], 0, 0, 0, 0x7F7F7F7F, 0, 0x7F7F7F7F);
}
#endif
#undef Q8_LD
#undef PV8_LD
#endif
#undef PV_LD
#undef PV_MFMA
typedef float f32x2p __attribute__((ext_vector_type(2)));
__device__ __forceinline__ bf16x8 pp_pack8(const f32x16& p, int b) {
  u32x4 w = {cvtpk(p[b], p[b + 1]), cvtpk(p[b + 2], p[b + 3]), cvtpk(p[b + 4], p[b + 5]), cvtpk(p[b + 6], p[b + 7])}; return *reinterpret_cast<bf16x8*>(&w); }
__device__ __forceinline__ void pp_expsum(f32x16& p0, f32x16& p1, float& l_reg, bf16x8& pa0, bf16x8& pa1, bf16x8& pa2, bf16x8& pa3) {
  f32x2p s0 = {0.f, 0.f}, s1 = {0.f, 0.f};
#pragma unroll
  for (int r = 0; r < 16; r += 2) { f32x2p v = {__builtin_amdgcn_exp2f(p0[r]), __builtin_amdgcn_exp2f(p0[r + 1])}; s0 += v; p0[r] = v[0]; p0[r + 1] = v[1]; }
#pragma unroll
  for (int r = 0; r < 16; r += 2) { f32x2p v = {__builtin_amdgcn_exp2f(p1[r]), __builtin_amdgcn_exp2f(p1[r + 1])}; s1 += v; p1[r] = v[0]; p1[r + 1] = v[1]; }
  s0 += s1; l_reg += s0[0] + s0[1];
#if ATT_PV8
  { u32x4 w0, w1;
    w0.x = pg8_pk4_fp8((f32x4){p0[0], p0[1], p0[2], p0[3]}); w0.y = pg8_pk4_fp8((f32x4){p0[4], p0[5], p0[6], p0[7]}); w0.z = pg8_pk4_fp8((f32x4){p0[8], p0[9], p0[10], p0[11]}); w0.w = pg8_pk4_fp8((f32x4){p0[12], p0[13], p0[14], p0[15]});
    w1.x = pg8_pk4_fp8((f32x4){p1[0], p1[1], p1[2], p1[3]}); w1.y = pg8_pk4_fp8((f32x4){p1[4], p1[5], p1[6], p1[7]}); w1.z = pg8_pk4_fp8((f32x4){p1[8], p1[9], p1[10], p1[11]}); w1.w = pg8_pk4_fp8((f32x4){p1[12], p1[13], p1[14], p1[15]});
    pa0 = *reinterpret_cast<bf16x8*>(&w0); pa1 = *reinterpret_cast<bf16x8*>(&w1); }
#else
  pa0 = pp_pack8(p0, 0); pa1 = pp_pack8(p0, 8); pa2 = pp_pack8(p1, 0); pa3 = pp_pack8(p1, 8);
#endif
}
template <int NTT, bool FULL>
__device__ __forceinline__ void attn_unit_pp(const bf16_t* __restrict__ Qb, const bf16_t* __restrict__ Kh, const bf16_t* __restrict__ Vh, const bf16_t* __restrict__ Rh,
                                             float* __restrict__ Op, float* __restrict__ MLp, LAS unsigned char* lds, const int tid) {
  const int wid = __builtin_amdgcn_readfirstlane(tid >> 6), lane = tid & 63, r32 = lane & 31, hi = lane >> 5;
  const bool grpB = wid >= 4;
  LAS float* wsx = (LAS float*)(lds + DMA_WS) + wid * 64; LAS float* al_l = wsx + 32;
  float l_reg = 0; f32x16 o[4] = {}, minit = {};
#if ATT_QK8
  i32x8q qf[3];
#else
  bf16x8 qr[12];
#endif
  unsigned ko[2], vo[2], ro;
#if ATT_PV8
  { const int row = 8 * wid + (lane >> 3), cp = lane & 7, c = (((cp >> 1) ^ ((row >> 1) & 3)) << 1) | (cp & 1); vo[0] = (unsigned)(row * 128 + c * 16); vo[1] = 0; }
#else
#pragma unroll
  for (int i = 0; i < 2; ++i) { const int pc = 2 * wid + i;
    { const int s = pc * 64 + lane, sub = s >> 5, within = s & 31, kk = (sub >> 2) * 8 + (within >> 2), c = (sub & 3) * 32 + (within & 3) * 8;
      const int k = (kk & ~0xC) | ((kk & 4) << 1) | ((kk & 8) >> 1); vo[i] = (unsigned)(k * 128 + c) * 2u; } }
#endif
#if ATT_QK8
  { const int row = 8 * wid + (lane >> 3), c = (lane & 7) ^ ((row >> 1) & 7); ko[0] = (unsigned)(row * 128 + c * 16); ko[1] = 0; }
  { const int row = 16 * (wid & 3) + (lane >> 2), c = (lane & 3) ^ ((row >> 2) & 3); ro = (unsigned)(row * 64 + c * 16); }
#else
#pragma unroll
  for (int i = 0; i < 2; ++i) { const int pc = 2 * wid + i;
    { const int row = 4 * pc + (lane >> 4), cl = (lane & 15) ^ (row & 15); ko[i] = (unsigned)(row * 128 + cl * 8) * 2u; } }
  { const int row = 8 * wid + (lane >> 3), cl = (lane & 7) ^ ((row >> 1) & 7); ro = (unsigned)(row * 64 + cl * 8) * 2u; }
#endif
#if ATT_QK8
#define GL1(voff, sbase, l) do { unsigned sv_; asm volatile("s_mov_b32 %0, m0\n\ts_mov_b32 m0, %3\n\ts_nop 0\n\tglobal_load_lds_dwordx4 %1, %2\n\ts_mov_b32 m0, %0" : "=&s"(sv_) : "v"(voff), "s"(sbase), "s"(l) : "memory"); } while (0)
#define DMA_KR(t, slot) do { const char* kt_ = (const char*)Kh + (size_t)(t) * (KVBLK * 128); const char* rt_ = (const char*)Rh + (size_t)(t) * (KVBLK * 64); const unsigned sb_ = (unsigned)lb + (unsigned)(slot) * SLOT_B; \
    GL1(ko[0], kt_, sb_ + SL_K + wid * 1024); if (wid < 4) GL1(ro, rt_, sb_ + SL_R + wid * 1024); } while (0)
#define DMA_KR2(t, slot) do { const char* kt_ = (const char*)Kh + (size_t)(t) * (KVBLK * 128); const char* rt_ = (const char*)Rh + (size_t)(t) * (KVBLK * 64); const unsigned sb_ = (unsigned)lb + (unsigned)(slot) * SLOT_B; \
    GL1(ko[0], kt_, sb_ + SL_K + wid * 1024); GL1(ko[0], kt_ + 4096, sb_ + SL_K + (wid + 4) * 1024); GL1(ro, rt_, sb_ + SL_R + wid * 1024); } while (0)
#else
#define DMA_KR(t, slot) do { const char* kt_ = (const char*)Kh + (size_t)(t) * (KVBLK * 256); const char* rt_ = (const char*)Rh + (size_t)(t) * (KVBLK * 128); const unsigned sb_ = (unsigned)lb + (unsigned)(slot) * SLOT_B; unsigned sv_; \
    asm volatile("s_mov_b32 %0, m0\n\ts_mov_b32 m0, %5\n\ts_nop 0\n\tglobal_load_lds_dwordx4 %1, %4\n\ts_mov_b32 m0, %6\n\ts_nop 0\n\tglobal_load_lds_dwordx4 %2, %4\n\ts_mov_b32 m0, %8\n\ts_nop 0\n\tglobal_load_lds_dwordx4 %3, %7\n\ts_mov_b32 m0, %0" \
                 : "=&s"(sv_) : "v"(ko[0]), "v"(ko[1]), "v"(ro), "s"(kt_), "s"(sb_ + SL_K + (2 * wid) * 1024), "s"(sb_ + SL_K + (2 * wid + 1) * 1024), "s"(rt_), "s"(sb_ + SL_R + wid * 1024) : "memory"); } while (0)
#define DMA_KR2(t, slot) do { const char* kt_ = (const char*)Kh + (size_t)(t) * (KVBLK * 256); const char* rt_ = (const char*)Rh + (size_t)(t) * (KVBLK * 128); const unsigned sb_ = (unsigned)lb + (unsigned)(slot) * SLOT_B; unsigned sv_; \
    asm volatile("s_mov_b32 %0, m0\n\ts_mov_b32 m0, %5\n\ts_nop 0\n\tglobal_load_lds_dwordx4 %1, %4\n\ts_mov_b32 m0, %6\n\ts_nop 0\n\tglobal_load_lds_dwordx4 %2, %4\n\ts_mov_b32 m0, %8\n\ts_nop 0\n\tglobal_load_lds_dwordx4 %3, %7\n\t" \
                 "s_mov_b32 m0, %10\n\ts_nop 0\n\tglobal_load_lds_dwordx4 %1, %9\n\ts_mov_b32 m0, %11\n\ts_nop 0\n\tglobal_load_lds_dwordx4 %2, %9\n\ts_mov_b32 m0, %13\n\ts_nop 0\n\tglobal_load_lds_dwordx4 %3, %12\n\ts_mov_b32 m0, %0" \
                 : "=&s"(sv_) : "v"(ko[0]), "v"(ko[1]), "v"(ro), "s"(kt_), "s"(sb_ + SL_K + (2 * wid) * 1024), "s"(sb_ + SL_K + (2 * wid + 1) * 1024), "s"(rt_), "s"(sb_ + SL_R + wid * 1024), \
                   "s"(kt_ + 8192), "s"(sb_ + SL_K + (2 * wid + 8) * 1024), "s"(sb_ + SL_K + (2 * wid + 9) * 1024), "s"(rt_ + 4096), "s"(sb_ + SL_R + (wid + 4) * 1024) : "memory"); } while (0)
#endif
#if ATT_PV8
#define DMA_V(t, slot) do { const char* vt_ = (const char*)Vh + (size_t)(t) * (KVBLK * 128); const unsigned sb_ = (unsigned)lb + (unsigned)(slot) * SLOT_B; GL1(vo[0], vt_, sb_ + SL_V + wid * 1024); } while (0)
#else
#define DMA_V(t, slot) do { const char* vt_ = (const char*)Vh + (size_t)(t) * (KVBLK * 256); const unsigned sb_ = (unsigned)lb + (unsigned)(slot) * SLOT_B; unsigned sv_; \
    asm volatile("s_mov_b32 %0, m0\n\ts_mov_b32 m0, %4\n\ts_nop 0\n\tglobal_load_lds_dwordx4 %1, %3\n\ts_mov_b32 m0, %5\n\ts_nop 0\n\tglobal_load_lds_dwordx4 %2, %3\n\ts_mov_b32 m0, %0" \
                 : "=&s"(sv_) : "v"(vo[0]), "v"(vo[1]), "s"(vt_), "s"(sb_ + SL_V + (2 * wid) * 1024), "s"(sb_ + SL_V + (2 * wid + 1) * 1024) : "memory"); } while (0)
#endif
#define BAR() do { SBAR(); asm volatile("" ::: "memory"); __builtin_amdgcn_s_barrier(); asm volatile("" ::: "memory"); SBAR(); } while (0)
#define MBAR(n) do { SBAR(); asm volatile("s_waitcnt vmcnt(" #n ") lgkmcnt(0)" ::: "memory"); __builtin_amdgcn_s_barrier(); asm volatile("" ::: "memory"); SBAR(); } while (0)
#define RESC(a) do { if (__any((a) < 1.f)) { if (hi == 0) al_l[r32] = (a); asm volatile("s_waitcnt lgkmcnt(0)" ::: "memory"); \
    _Pragma("unroll") for (int d = 0; d < 4; ++d) _Pragma("unroll") for (int r = 0; r < 16; ++r) o[d][r] *= al_l[crow(r, hi)]; } } while (0)
#define VPHASE(FIRST) do { const float rel = sm_max(p0, p1); \
    if ((FIRST) || __any(rel > (ATT_PV8 ? 8.75f : THR * 1.4426950408889634f))) { const float dl = ((FIRST) ? rel : fmaxf(rel, 0.f)) - (ATT_PV8 ? 4.f : 0.f), al = __builtin_amdgcn_exp2f(-dl);     \
      _Pragma("unroll") for (int r = 0; r < 16; ++r) { p0[r] -= dl; p1[r] -= dl; minit[r] -= dl; }     \
      l_reg *= al; RESC(al); } \
    pp_expsum(p0, p1, l_reg, pa0, pa1, pa2, pa3); } while (0)
  constexpr int NT = NTT;
  const int lb = __builtin_amdgcn_readfirstlane((int)(uintptr_t)lds);
  DMA_KR(0, 0); DMA_KR(1, 1); DMA_V(0, 0);
#if ATT_QK8
  { const char* qp = (const char*)Qb + (unsigned)((wid * QBLK + r32) * DQK + hi * 16);
#pragma unroll
    for (int j = 0; j < 3; ++j) qf[j] = Q8_CAT(*reinterpret_cast<const i32x4q*>(qp + 64 * j), *reinterpret_cast<const i32x4q*>(qp + 64 * j + 32)); }
#if ATT_PV8
  int vb8[4];
#pragma unroll
  for (int db = 0; db < 4; ++db) { const int i16 = lane & 15; vb8[db] = lb + SL_V + (16 * hi + (i16 >> 1)) * 128 + ((db ^ ((i16 >> 2) & 3)) * 32) + 16 * ((lane >> 4) & 1) + 8 * (i16 & 1); }
#else
  const int vbase = lb + SL_V + v_rd_base(lane);
#endif
  int kq[4], rq[2];
  { const int kr = kperm(r32);
#pragma unroll
    for (int i = 0; i < 4; ++i) kq[i] = lb + SL_K + kr * 128 + ((((i >> 1) * 4 + (i & 1) * 2 + hi) ^ ((kr >> 1) & 7)) << 4);
#pragma unroll
    for (int i = 0; i < 2; ++i) rq[i] = lb + SL_R + kr * 64 + (((i * 2 + hi) ^ ((kr >> 2) & 3)) << 4); }
  i32x8q g0[3], g1[3];
#else
  { const unsigned qo = (unsigned)((wid * QBLK + r32) * DQK + hi * 8) * 2u;
#pragma unroll
    for (int d0 = 0; d0 < 12; ++d0) qr[d0] = *reinterpret_cast<const bf16x8*>((const char*)Qb + qo + d0 * 32); }
  const int vbase = lb + SL_V + v_rd_base(lane);
  int kb[4], rb[4];
#pragma unroll
  for (int i = 0; i < 4; ++i) { const int cb = (i * 16 + hi * 8) * 2, kr = kperm(r32); kb[i] = lb + SL_K + kr * 256 + ((((2 * i + hi) ^ (kr & 7)) + 8 * ((kr >> 3) & 1)) << 4); rb[i] = lb + SL_R + RSWZ(kr, cb); }
  const int khd = ((kperm(r32) >> 3) & 1) ? -128 : 128;
  bf16x8 f0[KR_], f1[KR_];
#endif
  f32x16 p0, p1; bf16x8 pa0 = {}, pa1 = {}, pa2 = {}, pa3 = {};
  MBAR(0);
  if (grpB) BAR();
#if ATT_QK8
#if ATT_PV8
  pp8_head(g0, g1, kq, rq, 0); pp8_mphase<false>(p0, p1, o, g0, g1, kq, rq, 0, vb8, 0, qf, pa0, pa0, pa0, pa0, minit);
#else
  pp8_head(g0, g1, kq, rq, 0); pp8_mphase<false>(p0, p1, o, g0, g1, kq, rq, 0, 0, qf, pa0, pa0, pa0, pa0, minit);
#endif
#else
  pp_qkt_head(f0, f1, kb, rb, khd, 0); pp_mphase<false>(p0, p1, o, f0, f1, kb, khd, rb, 0, 0, qr, pa0, pa0, pa0, pa0, minit);
#endif
  MBAR(0);
  int sa = 0, sb = 1, sc = 2;
#pragma nounroll
  for (int t = 0; t + 1 < NT; ++t) {
    if (t + 2 < NT && !grpB) DMA_KR2(t + 2, sc);
    DMA_V(t + 1, sb);
    VPHASE(t == 0);
#if ATT_QK8
    pp8_head(g0, g1, kq, rq, sb * SLOT_B);
#else
    pp_qkt_head(f0, f1, kb, rb, khd, sb * SLOT_B);
#endif
    BAR();
#if ATT_QK8
#if ATT_PV8
    pp8_mphase<true>(p0, p1, o, g0, g1, kq, rq, sb * SLOT_B, vb8, sa * SLOT_B, qf, pa0, pa1, pa2, pa3, minit);
#else
    pp8_mphase<true>(p0, p1, o, g0, g1, kq, rq, sb * SLOT_B, vbase + sa * SLOT_B, qf, pa0, pa1, pa2, pa3, minit);
#endif
#else
    pp_mphase<true>(p0, p1, o, f0, f1, kb, khd, rb, sb * SLOT_B, vbase + sa * SLOT_B, qr, pa0, pa1, pa2, pa3, minit);
#endif
    MBAR(0);
    { const int tmp = sa; sa = sb; sb = sc; sc = tmp; }
  }
  VPHASE(NT == 1);
  BAR();
#if ATT_PV8
  pp_pv8(o, vb8, sa * SLOT_B, pa0, pa1);
#else
  pp_pv(o, vbase + sa * SLOT_B, pa0, pa1, pa2, pa3);
#endif
  asm volatile("s_waitcnt vmcnt(0)" ::: "memory");
  if (!grpB) BAR();
  { auto rr = __builtin_amdgcn_permlane32_swap(__float_as_uint(l_reg), __float_as_uint(l_reg), false, false); l_reg = __uint_as_float(rr[0]) + __uint_as_float(rr[1]); }
  if constexpr (FULL) {
    if (hi == 0) wsx[r32] = l_reg; asm volatile("s_waitcnt lgkmcnt(0)" ::: "memory");
    const unsigned oo = (unsigned)((wid * QBLK + 4 * hi) * D + r32) * 2u;
#pragma unroll
    for (int r = 0; r < 16; ++r) { const float rl = __builtin_amdgcn_rcpf(wsx[crow(r, hi)]);
#pragma unroll
      for (int d0 = 0; d0 < 4; ++d0) *(bf16_t*)((char*)Op + oo + (unsigned)(((r & 3) + 8 * (r >> 2)) * D + d0 * 32) * 2u) = (bf16_t)f2bf(o[d0][r] * rl); }
  } else {
    if (hi == 0) { *(float2*)((char*)MLp + (unsigned)(wid * QBLK + r32) * 8u) = make_float2(-minit[0], l_reg); }
    const unsigned oo = (unsigned)((wid * QBLK + 4 * hi) * 128 + r32) * 4u;
#pragma unroll
    for (int r = 0; r < 16; ++r)
#pragma unroll
      for (int d0 = 0; d0 < 4; ++d0) *(float*)((char*)Op + oo + (unsigned)(((r & 3) + 8 * (r >> 2)) * 128 + d0 * 32) * 4u) = o[d0][r]; }
#undef DMA_KR
#undef DMA_KR2
#ifdef GL1
#undef GL1
#endif
#undef DMA_V
#undef BAR
#undef MBAR
#undef RESC
#undef VPHASE
}
#undef RSWZ
#undef SBAR
}
#ifndef ATTN_UNIT
#define ATTN_UNIT attn_unit_pp
#endif
constexpr size_t QKB = ATT_QK8 ? 1 : 2, PVB = ATT_PV8 ? 1 : 2;
__device__ __forceinline__ void ph_attn(const P& p, int wg, int nwg, LAS unsigned char* lds, const int wv) {
    unsigned char* ws = p.ws;
    { for (int L = wg; L < 256; L += nwg) { const int bh = L & 7, qb = (L >> 3) & 31, b = bh / NH, h = bh - b * NH;
        const int tid = fresh_tid(wv);
        __syncthreads();
        att::ATTN_UNIT<2 * att::NTILE, true>((const bf16_t*)(ws + WS_Q + ((size_t)bh * SEQ + qb * 256) * DQK * QKB), (const bf16_t*)(ws + WS_KN + (size_t)bh * TK * 128 * QKB),
                   (const bf16_t*)(ws + WS_V + (size_t)bh * TK * 128 * PVB), (const bf16_t*)(ws + WS_KR + (size_t)b * TK * 64 * QKB),
                   (float*)((bf16_t*)(ws + WS_MIXA) + ((size_t)b * SEQ + qb * 256) * D + h * 128), nullptr, lds, tid); } }
    { for (int L = wg; L < 256; L += nwg) { const int x = L & 7, qb = (L >> 3) & 31, bh = 8 + (x >> 1), half = x & 1, b = bh / NH, key0 = half * att::HALFKEYS, pidx = ((bh - 8) * 32 + qb) * 2 + half;
        const int tid = fresh_tid(wv);
        __syncthreads();
        att::ATTN_UNIT<att::NTILE, false>((const bf16_t*)(ws + WS_Q + ((size_t)bh * SEQ + qb * 256) * DQK * QKB), (const bf16_t*)(ws + WS_KN + ((size_t)bh * TK + key0) * 128 * QKB),
                   (const bf16_t*)(ws + WS_V + ((size_t)bh * TK + key0) * 128 * PVB), (const bf16_t*)(ws + WS_KR + ((size_t)b * TK + key0) * 64 * QKB),
                   (float*)(ws + WS_OPART) + (size_t)pidx * 32768, (float*)(ws + WS_OML) + (size_t)pidx * 512, lds, tid); } }
}
__device__ __forceinline__ void ph_acomb(const P& p, int wg, int nwg, int tid) {
    const int lane = tid & 63, gw = wg * 8 + (tid >> 6), ngw = nwg * 8; unsigned char* ws = p.ws;
    const float* OP = (const float*)(ws + WS_OPART); const float* OML = (const float*)(ws + WS_OML); bf16_t* MIXA = (bf16_t*)(ws + WS_MIXA);
    for (int rw = gw; rw < 4 * 32 * 256; rw += ngw) {
        const int pp = rw >> 8, r = rw & 255, bh = 8 + (pp >> 5), qb = pp & 31, b = bh / NH, h = bh - b * NH;
        const float2 ml1 = *(const float2*)(OML + ((size_t)(pp * 2) * 256 + r) * 2), ml2 = *(const float2*)(OML + ((size_t)(pp * 2 + 1) * 256 + r) * 2);
        typedef float f32x2v __attribute__((ext_vector_type(2)));
        const f32x2v o1 = __builtin_nontemporal_load((const f32x2v*)(OP + ((size_t)(pp * 2) * 256 + r) * 128 + 2 * lane)), o2 = __builtin_nontemporal_load((const f32x2v*)(OP + ((size_t)(pp * 2 + 1) * 256 + r) * 128 + 2 * lane));
        const float M = fmaxf(ml1.x, ml2.x), w1 = __builtin_amdgcn_exp2f(ml1.x - M), w2 = __builtin_amdgcn_exp2f(ml2.x - M), inv = 1.f / (ml1.y * w1 + ml2.y * w2);
        *(unsigned*)(MIXA + ((size_t)b * SEQ + qb * 256 + r) * D + h * 128 + 2 * lane) = pk2((o1.x * w1 + o2.x * w2) * inv, (o1.y * w1 + o2.y * w2) * inv);
    }
}

namespace fou {
typedef short s16x4 __attribute__((ext_vector_type(4)));
template <int OFF> __device__ __forceinline__ s16x4 tr_read(int vb) { s16x4 r; asm volatile("ds_read_b64_tr_b16 %0, %1 offset:%2" : "=&v"(r) : "v"(vb), "i"(OFF) : "memory"); return r; }
__device__ __forceinline__ int rd_base(int lane) { return ((lane & 3) << 3) | (((lane >> 2) & 3) << 6) | (((lane >> 4) & 1) << 5) | (((lane >> 5) & 1) << 8); }
__device__ __forceinline__ int img_off(int k, int c) { const int kk = (k & ~0xC) | ((k & 4) << 1) | ((k & 8) >> 1); return ((kk >> 3) * 2 + (c >> 5)) * 512 + ((kk & 7) * 32 + (c & 31)) * 2; }
#define FOU_PK(L, H) (bf16x8){L[0], L[1], L[2], L[3], H[0], H[1], H[2], H[3]}
template <int KS> __device__ __forceinline__ void a_step(f32x16& yr, f32x16& yi, int vb, const bf16x8 (&ar)[16], const bf16x8 (&ai)[16]) {
    const s16x4 l = tr_read<KS * 2048>(vb), h = tr_read<KS * 2048 + 1024>(vb);
    asm volatile("s_waitcnt lgkmcnt(0)" ::: "memory"); __builtin_amdgcn_sched_barrier(0);
    const bf16x8 bb = FOU_PK(l, h);
    yr = __builtin_amdgcn_mfma_f32_32x32x16_bf16(ar[KS], bb, yr, 0, 0, 0); yi = __builtin_amdgcn_mfma_f32_32x32x16_bf16(ai[KS], bb, yi, 0, 0, 0);
}
__device__ __forceinline__ void stage_a(unsigned char* ws, int bg, int n2, LAS unsigned char* lds, int tid) {
    const int b = bg >> 2, g = bg & 3, lane = tid & 63, w = tid >> 6, r32 = lane & 31, hi = lane >> 5;
    const bf16_t* PXb = (const bf16_t*)(ws + WS_PX) + (size_t)b * SEQ * PXW + 768 + g * 128;
#pragma unroll
    for (int i = 0; i < 4; ++i) { const int q = tid + NTHR * i, kk = q >> 3, jc = (q & 7) * 8, n1 = kk & 127, isq = kk >> 7;
        const bf16x8 v = __builtin_nontemporal_load((const bf16x8*)(PXb + (size_t)(64 * n1 + n2) * PXW + isq * 64 + jc)); *(LAS bf16x8*)(lds + img_off(kk, jc)) = v; }
    const int kb = w & 3, d0 = w >> 2;
    bf16x8 ar[16], ai[16];
    { const bf16_t* gar = (const bf16_t*)(ws + WS_GA) + (size_t)(kb * 32 + r32) * 256 + 8 * hi; const bf16_t* gai = gar + 128 * 256;
#pragma unroll
      for (int k = 0; k < 16; ++k) { ar[k] = *(const bf16x8*)(gar + k * 16); ai[k] = *(const bf16x8*)(gai + k * 16); } }
    __syncthreads();
    const int vb = (int)(uintptr_t)lds + rd_base(lane) + d0 * 512;
    f32x16 yr = {0}, yi = {0};
    a_step<0>(yr, yi, vb, ar, ai); a_step<1>(yr, yi, vb, ar, ai); a_step<2>(yr, yi, vb, ar, ai); a_step<3>(yr, yi, vb, ar, ai);
    a_step<4>(yr, yi, vb, ar, ai); a_step<5>(yr, yi, vb, ar, ai); a_step<6>(yr, yi, vb, ar, ai); a_step<7>(yr, yi, vb, ar, ai);
    a_step<8>(yr, yi, vb, ar, ai); a_step<9>(yr, yi, vb, ar, ai); a_step<10>(yr, yi, vb, ar, ai); a_step<11>(yr, yi, vb, ar, ai);
    a_step<12>(yr, yi, vb, ar, ai); a_step<13>(yr, yi, vb, ar, ai); a_step<14>(yr, yi, vb, ar, ai); a_step<15>(yr, yi, vb, ar, ai);
    const float2* tw = (const float2*)(ws + WS_FTAB); bf16_t* FT = (bf16_t*)(ws + WS_FT);
#pragma unroll
    for (int r = 0; r < 16; ++r) { const int k1 = kb * 32 + (r & 3) + 8 * (r >> 2) + 4 * hi; const float2 t = tw[(n2 * k1) & 8191];
        bf16_t* dst = FT + (((size_t)bg * 128 + k1) * 64 + n2) * 128 + d0 * 32 + r32;
        dst[0] = (bf16_t)f2bf(t.x * yr[r] + t.y * yi[r]); dst[64] = (bf16_t)f2bf(t.x * yi[r] - t.y * yr[r]); }
    __syncthreads();
}
template <int KS> __device__ __forceinline__ void b_step(f32x16 (&acc)[2][2], int vb, const bf16x8 (&g0)[8], const bf16x8 (&g1)[8]) {
    const s16x4 l0 = tr_read<KS * 2048>(vb), h0 = tr_read<KS * 2048 + 1024>(vb), l1 = tr_read<KS * 2048 + 512>(vb), h1 = tr_read<KS * 2048 + 1536>(vb);
    asm volatile("s_waitcnt lgkmcnt(0)" ::: "memory"); __builtin_amdgcn_sched_barrier(0);
    const bf16x8 b0 = FOU_PK(l0, h0), b1 = FOU_PK(l1, h1);
    acc[0][0] = __builtin_amdgcn_mfma_f32_32x32x16_bf16(g0[KS], b0, acc[0][0], 0, 0, 0); acc[0][1] = __builtin_amdgcn_mfma_f32_32x32x16_bf16(g0[KS], b1, acc[0][1], 0, 0, 0);
    acc[1][0] = __builtin_amdgcn_mfma_f32_32x32x16_bf16(g1[KS], b0, acc[1][0], 0, 0, 0); acc[1][1] = __builtin_amdgcn_mfma_f32_32x32x16_bf16(g1[KS], b1, acc[1][1], 0, 0, 0);
}
__device__ __forceinline__ void stage_b(unsigned char* ws, int bg, int k1base, LAS unsigned char* lds, int tid) {
    const int b = bg >> 2, g = bg & 3, lane = tid & 63, w = tid >> 6, r32 = lane & 31, hi = lane >> 5, k1 = k1base + w;
    const bf16_t* src = (const bf16_t*)(ws + WS_FT) + ((size_t)bg * 128 + k1) * 64 * 128;
    LAS unsigned char* my = lds + w * 16384;
#pragma unroll
    for (int i = 0; i < 16; ++i) { const int q = lane + 64 * i, kk = q >> 3, jc = (q & 7) * 8; const bf16x8 v = __builtin_nontemporal_load((const bf16x8*)(src + q * 8)); *(LAS bf16x8*)(my + img_off(kk, jc)) = v; }
    bf16x8 g0[8], g1[8];
    { const bf16_t* gb = (const bf16_t*)(ws + WS_GB) + (size_t)r32 * 128 + 8 * hi;
#pragma unroll
      for (int k = 0; k < 8; ++k) { g0[k] = *(const bf16x8*)(gb + k * 16); g1[k] = *(const bf16x8*)(gb + 32 * 128 + k * 16); } }
    asm volatile("s_waitcnt lgkmcnt(0)" ::: "memory"); __builtin_amdgcn_sched_barrier(0);
    const int vb = (int)(uintptr_t)my + rd_base(lane);
    f32x16 acc[2][2] = {};
    b_step<0>(acc, vb, g0, g1); b_step<1>(acc, vb, g0, g1); b_step<2>(acc, vb, g0, g1); b_step<3>(acc, vb, g0, g1); b_step<4>(acc, vb, g0, g1); b_step<5>(acc, vb, g0, g1); b_step<6>(acc, vb, g0, g1); b_step<7>(acc, vb, g0, g1);
    bf16_t* MIXA = (bf16_t*)(ws + WS_MIXA);
#pragma unroll
    for (int rb = 0; rb < 2; ++rb)
#pragma unroll
        for (int r = 0; r < 16; ++r) { const int k2 = rb * 32 + (r & 3) + 8 * (r >> 2) + 4 * hi; bf16_t* dst = MIXA + ((size_t)b * SEQ + k1 + 128 * k2) * D + 768 + g * 64 + r32;
            dst[0] = (bf16_t)f2bf(acc[rb][0][r]); dst[32] = (bf16_t)f2bf(acc[rb][1][r]); }
}
#undef FOU_PK
}


#define XB_TMO      128
#define XB_XCNT(j)  (256  + 64 * (j))
#define XB_XSUB(j)  (1280 + 64 * (j))
#define XB_XGEN(j)  (2304 + 64 * (j))
#define XB_TOP      3328
#define XB_TOPGEN   3392
#define XCD_BAR_WORDS 3456
#define XB_SPIN_CAP (1u << 18)
__device__ __forceinline__ unsigned xb_ld(unsigned* p)              { return __hip_atomic_load(p, __ATOMIC_RELAXED, __HIP_MEMORY_SCOPE_AGENT); }
__device__ __forceinline__ unsigned xb_add(unsigned* p, unsigned v) { return __hip_atomic_fetch_add(p, v, __ATOMIC_RELAXED, __HIP_MEMORY_SCOPE_AGENT); }
__device__ __forceinline__ unsigned xb_xcc_id() { return (unsigned)__builtin_amdgcn_s_getreg((3 << 11) | 20) & 0xFu; }
#define XB_SPIN(cond, bar) do { unsigned _sp = 0; while (cond) { __builtin_amdgcn_s_sleep(1); \
    if ((++_sp & 255u) == 0u) { if (xb_ld(&(bar)[XB_TMO])) break; if (_sp > XB_SPIN_CAP) { atomicAdd(&(bar)[XB_TMO], 1u); break; } } } } while (0)
struct XcdBarrier { unsigned* bar; unsigned x; volatile LAS unsigned* st; };
__device__ __forceinline__ XcdBarrier xcd_barrier_post(unsigned* bar, volatile LAS unsigned* st) {
    XcdBarrier b; b.bar = bar; b.x = xb_xcc_id(); b.st = st;
    if (threadIdx.x == 0) (void)xb_add(&bar[XB_XCNT(b.x)], 1u);
    return b;
}
__device__ __forceinline__ void xcd_barrier_complete(unsigned* bar, unsigned x, unsigned& nloc, unsigned& nx) {
    const unsigned G = gridDim.x * gridDim.y * gridDim.z;
    unsigned sum, cnt, mine, sp = 0u;
    for (;;) {
        sum = 0u; cnt = 0u; mine = 0u;
#pragma unroll
        for (unsigned j = 0; j < 16; ++j) { const unsigned c = xb_ld(&bar[XB_XCNT(j)]); sum += c; cnt += (c > 0u) ? 1u : 0u; mine = (j == x) ? c : mine; }
        if (sum == G) break;
        __builtin_amdgcn_s_sleep(1);
        if ((++sp & 255u) == 0u) { if (xb_ld(&bar[XB_TMO])) break; if (sp > XB_SPIN_CAP) { atomicAdd(&bar[XB_TMO], 1u); break; } }
    }
    nloc = mine > 0u ? mine : 1u; nx = cnt > 0u ? cnt : 1u;
}
__device__ __forceinline__ void xcd_barrier(const XcdBarrier& b) {
    asm volatile("s_waitcnt vmcnt(0)" ::: "memory");
    __syncthreads();
    if (threadIdx.x == 0) {
        unsigned* bar = b.bar;
        __builtin_amdgcn_s_waitcnt(0);
        unsigned nloc = b.st[0], nx = b.st[1];
        if (nloc == 0u) { xcd_barrier_complete(bar, b.x, nloc, nx); b.st[0] = nloc; b.st[1] = nx; }
        const unsigned old = xb_add(&bar[XB_XSUB(b.x)], 1u);
        const unsigned gen = old / nloc;
        if (old + 1u == (gen + 1u) * nloc) {
            __builtin_amdgcn_fence(__ATOMIC_RELEASE, "agent");
            asm volatile("s_waitcnt vmcnt(0)" ::: "memory");
            const unsigned og = xb_add(&bar[XB_TOP], 1u);
            const unsigned tg = og / nx;
            if (og + 1u == (tg + 1u) * nx) xb_add(&bar[XB_TOPGEN], 1u);
            else XB_SPIN(xb_ld(&bar[XB_TOPGEN]) == tg, bar);
            __builtin_amdgcn_fence(__ATOMIC_ACQUIRE, "agent");
            xb_add(&bar[XB_XGEN(b.x)], 1u);
            asm volatile("s_waitcnt vmcnt(0)" ::: "memory");
        } else {
            XB_SPIN(xb_ld(&bar[XB_XGEN(b.x)]) == gen, bar);
            __builtin_amdgcn_fence(__ATOMIC_ACQUIRE, "agent");
            asm volatile("s_waitcnt vmcnt(0)" ::: "memory");
        }
    }
    __syncthreads();
}

enum { PH_PREP = 0, PH_MODUL = 1, PH_INPROJ = 2, PH_ROW1 = 3, PH_QKV = 4, PH_ATTN = 5, PH_ACOMB = 6, PH_OUTPROJ = 7, PH_ROW2 = 8, PH_LIST = 9, PH_MOE1 = 10, PH_MOE2 = 11, PH_FINAL = 12, NPH = 13 };
__global__ void __launch_bounds__(NTHR, 2) mega(P p) {
    extern __shared__ __attribute__((aligned(16))) unsigned char lds_raw[];
    LAS unsigned char* lds = (LAS unsigned char*)lds_raw;
    const int wg = blockIdx.x, nwg = gridDim.x;
    const int lo = p.ph_lo, hi = p.ph_hi;
    int wv = __builtin_amdgcn_readfirstlane((int)(threadIdx.x >> 6)); asm volatile("" : "+s"(wv));
    if (threadIdx.x == 0) { ((volatile LAS unsigned*)(lds + LDS_CTL))[0] = 0u; ((volatile LAS unsigned*)(lds + LDS_CTL))[1] = 0u; }
    __syncthreads();
    XcdBarrier bar; bar.bar = (unsigned*)(p.ws + WS_CTL) + 4096; bar.x = 0; bar.st = (volatile LAS unsigned*)(lds + LDS_CTL);
    if (hi - lo > 1) bar = xcd_barrier_post((unsigned*)(p.ws + WS_CTL) + 4096, (volatile LAS unsigned*)(lds + LDS_CTL));
#define SEAM(k) do { if (lo <= (k) && (k) + 1 < hi) xcd_barrier(bar); } while (0)
#ifndef PHMASK
#define PHMASK 0xFFFF
#endif
#define IN(k) (((PHMASK >> (k)) & 1) && lo <= (k) && (k) < hi)
    unsigned char* ws = p.ws;
#ifndef REPMASK
#define REPMASK 0
#endif
#define PHASE(k, ...) do { if (IN(k)) { _Pragma("unroll") for (int rep_ = 0; rep_ < 1 + ((REPMASK >> (k)) & 1); ++rep_) { if (rep_) xcd_barrier(bar); __VA_ARGS__ } } SEAM(k); } while (0)
    PHASE(PH_PREP, ph_prologue(p, wg, nwg, fresh_tid(wv), lds););
    PHASE(PH_MODUL, ph_modulate(p, wg, nwg, fresh_tid(wv)););
    PHASE(PH_INPROJ, { const pg8::DenseSched S{MA / 256, PXW / 256, nwg, wg, D, D, 0, (const char*)(ws + WS_WIN)}; const pg8::EpiRowMajor E{(bf16_t*)(ws + WS_PX), PXW};
        pg8::gemm_phase(lds, fresh_tid(wv), (const char*)(ws + WS_HX), D, S, E);
        if (nwg == NWG && wg >= 74) p0_expert_items(p, NEI_PREP + (wg - 74), 182, NEI_PREP + FILL_IN, fresh_tid(wv), (LAS float*)lds); });
    PHASE(PH_ROW1, { ph_row1(p, wg, nwg, fresh_tid(wv));
        { const int tid = fresh_tid(wv); __syncthreads(); for (int u = wg; u < 512; u += nwg) fou::stage_a(ws, u >> 6, u & 63, lds, tid); } });
    PHASE(PH_QKV, {
        { const int tid = fresh_tid(wv); for (int u = (wg + nwg / 2) % nwg; u < 128; u += nwg) fou::stage_b(ws, u >> 4, (u & 15) * 8, lds, tid); __syncthreads(); }
        { const pg8::DenseSched S{ML / 256, 5, nwg, wg, QL, PXW, 0, (const char*)(ws + WS_WQ)}; const pg8::EpiQ E{ws}; pg8::gemm_phase(lds, fresh_tid(wv), (const char*)(ws + WS_PX), QL, S, E); }
        { const pg8::DenseSched S{MA / 256, 6, nwg, wg, KVL, PXW, 512, (const char*)(ws + WS_WKV)}; const pg8::EpiKV E{ws}; pg8::gemm_phase(lds, fresh_tid(wv), (const char*)(ws + WS_PX), KVL, S, E); }
        if (nwg == NWG && wg >= 64) { const int tid = fresh_tid(wv); constexpr int QB = NEI_PREP + FILL_IN;
            if (wg < 128) p0_expert_items(p, QB + (wg - 64), 64, QB + 128, tid, (LAS float*)lds);
            else if (wg < 140) p0_expert_items(p, QB + 128 + (wg - 128), 12, QB + 140, tid, (LAS float*)lds);
            else { p0_expert_items(p, QB + 140 + (wg - 140), 116, QB + 372, tid, (LAS float*)lds);
                   if (wg <= 220) p0_expert_items(p, QB + 372 + (wg - 140), 81, QB + 453, tid, (LAS float*)lds); } } });
    static_assert(NEI_PREP + FILL_IN + 453 == NEI, "filler shares");
    PHASE(PH_ATTN, ph_attn(p, wg, nwg, lds, wv););
    PHASE(PH_ACOMB, ph_acomb(p, wg, nwg, fresh_tid(wv)););
    PHASE(PH_OUTPROJ, { const pg8::DenseSched S{ML / 256, D / 256, nwg, wg, D, D, 0, (const char*)(ws + WS_WOUT)}; const pg8::EpiRowMajor E{(bf16_t*)(ws + WS_MIX), D};
        pg8::gemm_phase(lds, fresh_tid(wv), (const char*)(ws + WS_MIXA), D, S, E); });
    PHASE(PH_ROW2, ph_row2(p, wg, nwg, fresh_tid(wv), lds););
    PHASE(PH_LIST, ph_lists(p, wg, nwg, fresh_tid(wv), lds););
    PHASE(PH_MOE1, { const int tid = fresh_tid(wv);
        LAS int* tileL = (LAS int*)(lds + LDS_CTL + 2048); LAS unsigned* lstL = (LAS unsigned*)(lds + LDS_CTL + 4096);
        const int* TILEE = (const int*)(ws + WS_TILEE); const int* SLOTTOK = (const int*)(ws + WS_SLOTTOK);
        for (int i = tid; i < MAXTILES; i += NTHR) tileL[i] = TILEE[i];
        if (tid == 0) tileL[300] = TILEE[400];
        __syncthreads();
        const pg8::MoeSched<8, true, MOE_FP8> S{nwg, wg, tileL, lstL, (const char*)(ws + WS_WGU), 2048};
        { pg8::GUnit u; for (int i = 0; i < 16 && S.next(i, u); ++i) if (tid < 256) lstL[i * 256 + tid] = (unsigned)SLOTTOK[u.arow + tid] * (MOE_FP8 ? 1024u : 2048u); }
        __syncthreads();
        if constexpr (MOE_FP8) { const pg8::EpiAct8 E{ws + WS_ACT, p.in[20], p.in[22], 1.f / WSCALE}; pg8::gemm_phase<pg8::EpiAct8, pg8::MoeSched<8, true, MOE_FP8>, true>(lds, tid, (const char*)(ws + WS_HX), D, S, E); }
        else { const pg8::EpiAct E{(bf16_t*)(ws + WS_ACT), p.in[20], p.in[22]}; pg8::gemm_phase(lds, fresh_tid(wv), (const char*)(ws + WS_HX), D, S, E); } });
    PHASE(PH_MOE2, { const int tid = fresh_tid(wv);
        LAS int* tileL = (LAS int*)(lds + LDS_CTL + 2048); LAS unsigned* lstL = (LAS unsigned*)(lds + LDS_CTL + 4096);
        const int* TILEE = (const int*)(ws + WS_TILEE);
        for (int i = tid; i < MAXTILES; i += NTHR) tileL[i] = TILEE[i];
        if (tid == 0) tileL[300] = TILEE[400];
        __syncthreads();
        const pg8::MoeSched<4, false, MOE_FP8> S{nwg, wg, tileL, lstL, (const char*)(ws + WS_WD), 1024};
        const pg8::EpiY8 E{ws + WS_Y, p.in[24], MOE_FP8 ? 1.f / WSCALE : 1.f};
        pg8::gemm_phase<pg8::EpiY8, pg8::MoeSched<4, false, MOE_FP8>, MOE_FP8>(lds, tid, (const char*)(ws + WS_ACT), D, S, E); });
    PHASE(PH_FINAL, ph_final(p, wg, nwg, fresh_tid(wv)););
#undef PHASE
#undef IN
#undef SEAM
}

extern "C" void kernel_launch(void* const* d_in, const int* in_sizes, int n_in, void* d_out, int out_size, void* d_ws, size_t ws_size, hipStream_t stream) {
    static int ok = 0;
    if (ok == 0) {
        if (n_in != 25 || in_sizes[0] != ML * D || out_size != ML * D || ws_size < WS_END) { fprintf(stderr, "kernel_launch: unexpected shapes (n_in %d, in0 %d, out %d, ws %zu < %zu)\n", n_in, n_in > 0 ? in_sizes[0] : -1, out_size, ws_size, (size_t)WS_END); ok = -1; return; }
        if (hipFuncSetAttribute((const void*)mega, hipFuncAttributeMaxDynamicSharedMemorySize, LDS_BYTES) != hipSuccess) { fprintf(stderr, "kernel_launch: hipFuncSetAttribute failed\n"); ok = -1; return; }
        int dev = 0, cus = 0, per_cu = 0;
        if (hipGetDevice(&dev) != hipSuccess || hipDeviceGetAttribute(&cus, hipDeviceAttributeMultiprocessorCount, dev) != hipSuccess) { fprintf(stderr, "kernel_launch: device query failed\n"); ok = -1; return; }
        if (hipOccupancyMaxActiveBlocksPerMultiprocessor(&per_cu, (const void*)mega, NTHR, LDS_BYTES) != hipSuccess || per_cu < 1) { fprintf(stderr, "kernel_launch: occupancy query says %d blocks per CU\n", per_cu); (void)hipGetLastError(); }
        if (cus != NWG) fprintf(stderr, "kernel_launch: %d CUs (built for %d)\n", cus, NWG);
        ok = cus < NWG ? cus : NWG;
    }
    if (ok < 0) return;
    const int grid = ok;
    (void)hipMemsetAsync((char*)d_ws + WS_CTL, 0, CTL_BYTES, stream);
    P p{}; for (int i = 0; i < 25; ++i) p.in[i] = (const float*)d_in[i]; p.out = (float*)d_out; p.ws = (unsigned char*)d_ws;
#define MEGA(a, b) do { p.ph_lo = (a); p.ph_hi = (b); hipLaunchKernelGGL(mega, dim3(grid), dim3(NTHR), LDS_BYTES, stream, p); } while (0)
#ifdef MULTI_LAUNCH
    for (int ph = 0; ph < NPH; ++ph) MEGA(ph, ph + 1);
#else
    MEGA(0, NPH);
#endif
#undef MEGA
    const hipError_t le = hipPeekAtLastError();
    if (le != hipSuccess) fprintf(stderr, "kernel_launch: launch failed: %s\n", hipGetErrorName(le));
}
```

```cpp
#include <hip/hip_runtime.h>
#include <cstdint>
#include <cstdio>

#define GAS __attribute__((address_space(1)))
#define LAS __attribute__((address_space(3)))
typedef unsigned short bf16_t;
typedef short bf16x8 __attribute__((ext_vector_type(8)));
typedef float f32x4 __attribute__((ext_vector_type(4)));
typedef float f32x16 __attribute__((ext_vector_type(16)));
typedef unsigned u32x4 __attribute__((ext_vector_type(4)));
typedef unsigned u32x2 __attribute__((ext_vector_type(2)));

#ifndef ATT_PV8
#define ATT_PV8 1
#endif
#ifndef ATT_QK8
#define ATT_QK8 1
#endif
constexpr int D = 1024, SEQ = 8192, CTXL = 256, NH = 6, DQK = 192, DNOPE = 128, DROPE = 64, DV = 128;
constexpr int QL = 384, KVL = 256;
constexpr int ML = 2 * SEQ, MC = 2 * CTXL, MA = ML + MC;
constexpr int TK = SEQ + CTXL;
constexpr int PXW = 1280;
constexpr int NE = 32, DFF = 1024;
constexpr int MAXTILES = 288, SLOTS = MAXTILES * 256;
constexpr float RMS_EPS = 1e-6f;
constexpr int NWG = 256, NTHR = 512;
#ifndef MOE_FP8_ON
#define MOE_FP8_ON 1
#endif
constexpr bool MOE_FP8 = MOE_FP8_ON;
constexpr float WSCALE = 32.f;

constexpr size_t KiB = 1024, MiB = 1024 * 1024;
constexpr size_t WS_CTL = 0, CTL_BYTES = 64 * KiB;
constexpr size_t WS_MOD = 1 * MiB;
constexpr size_t WS_ROPE = WS_MOD + 96 * KiB;
constexpr size_t WS_RSTAT = WS_ROPE + 16 * KiB;
constexpr size_t WS_TOPI = 1 * MiB + 256 * KiB;
constexpr size_t WS_GATE = WS_TOPI + 256 * KiB;
constexpr size_t WS_TOKSLOT = WS_GATE + 256 * KiB;
constexpr size_t WS_SLOTTOK = 2 * MiB;
constexpr size_t WS_CHCNT = WS_SLOTTOK + 320 * KiB;
constexpr size_t WS_TILEE = WS_CHCNT + 32 * KiB;
constexpr size_t WS_FTAB = WS_TILEE + 32 * KiB;
constexpr size_t WS_WRT = WS_FTAB + 64 * KiB;
constexpr size_t WS_GA = WS_WRT + 128 * KiB;
constexpr size_t WS_GB = WS_GA + 128 * KiB;
constexpr size_t WS_WIN = 4 * MiB;
constexpr size_t WS_WQ = 7 * MiB;
constexpr size_t WS_WKV = 8 * MiB;
constexpr size_t WS_WOUT = 9 * MiB;
constexpr size_t WS_WD = 16 * MiB;
constexpr size_t WS_WGU = 80 * MiB;
constexpr size_t WS_HX = 208 * MiB;
constexpr size_t WS_Y = 80 * MiB;
constexpr size_t WS_MIX = 242 * MiB;
constexpr size_t WS_ACT = 274 * MiB;
constexpr size_t WS_PX = 274 * MiB;
constexpr size_t WS_Q = 316 * MiB;
constexpr size_t WS_KN = 352 * MiB;
constexpr size_t WS_V = 377 * MiB;
constexpr size_t WS_KR = 402 * MiB;
constexpr size_t WS_FT = 405 * MiB;
constexpr size_t WS_MIXA = 421 * MiB;
constexpr size_t WS_OPART = 208 * MiB;
constexpr size_t WS_OML = 304 * MiB;
constexpr size_t WS_END = 453 * MiB;

constexpr int LDS_BYTES = 163840;
constexpr int LDS_CTL = 139264;

struct P { const float* in[25]; float* out; unsigned char* ws; int ph_lo, ph_hi; };

__device__ __forceinline__ unsigned f2bf(float f) { unsigned u = __float_as_uint(f); return (u + 0x7fffu + ((u >> 16) & 1u)) >> 16; }
__device__ __forceinline__ float bflo(unsigned w) { return __uint_as_float(w << 16); }
__device__ __forceinline__ float bfhi(unsigned w) { return __uint_as_float(w & 0xffff0000u); }
typedef __bf16 bf16x2c __attribute__((ext_vector_type(2)));
typedef float f32x2c __attribute__((ext_vector_type(2)));
__device__ __forceinline__ unsigned pk2(float lo, float hi) { const f32x2c v = {lo, hi}; return __builtin_bit_cast(unsigned, __builtin_convertvector(v, bf16x2c)); }
template <int CTRL, int RMASK, bool BC> __device__ __forceinline__ float dpp_mov(float v) { return __builtin_bit_cast(float, __builtin_amdgcn_update_dpp(0, __builtin_bit_cast(int, v), CTRL, RMASK, 0xf, BC)); }
__device__ __forceinline__ float wave_sum(float v) {
    v += dpp_mov<0x111, 0xf, true>(v); v += dpp_mov<0x112, 0xf, true>(v); v += dpp_mov<0x114, 0xf, true>(v); v += dpp_mov<0x118, 0xf, true>(v);
    v += dpp_mov<0x142, 0xa, false>(v); v += dpp_mov<0x143, 0xc, false>(v);
    return __builtin_bit_cast(float, __builtin_amdgcn_readlane(__builtin_bit_cast(int, v), 63));
}
__device__ __forceinline__ float wave_max(float v) {
#pragma unroll
    for (int o = 1; o < 64; o <<= 1) v = fmaxf(v, __shfl_xor(v, o));
    return v;
}
__device__ __forceinline__ int fresh_tid(int wv) { int t = (wv << 6) | (int)__builtin_amdgcn_mbcnt_hi(~0u, __builtin_amdgcn_mbcnt_lo(~0u, 0u)); asm volatile("" : "+v"(t)); return t; }
__device__ __forceinline__ unsigned pg8_pk4_fp8(f32x4 v) { int p = __builtin_amdgcn_cvt_pk_fp8_f32(v.x, v.y, 0, false); p = __builtin_amdgcn_cvt_pk_fp8_f32(v.z, v.w, p, true); return (unsigned)p; }
__device__ __forceinline__ f32x4 fp8x4(unsigned w) { const auto lo = __builtin_amdgcn_cvt_pk_f32_fp8((int)w, false), hi = __builtin_amdgcn_cvt_pk_f32_fp8((int)w, true); return (f32x4){lo[0], lo[1], hi[0], hi[1]}; }
__device__ __forceinline__ float dot4(f32x4 a, f32x4 b) { return (a.x * b.x + a.y * b.y) + (a.z * b.z + a.w * b.w); }

__device__ __forceinline__ void p0_mod_item(const P& p, int it, int tid, LAS float* scr) {
    LAS float* sl = scr;
    LAS float* part = scr + 3072;
    const float* c = p.in[1]; const float* cc = p.in[3]; const float* wm = p.in[4]; const float* bm = p.in[5];
    for (int i = tid; i < 3072; i += NTHR) { const int r = i >> 10, k = i & 1023; const float v = r < 2 ? c[r * 1024 + k] : cc[k]; sl[i] = v / (1.f + __expf(-v)); }
    __syncthreads();
    const int ks = tid >> 5, cidx = tid & 31, n0 = it * 24;
    if (cidx < 24) {
        float a0 = 0.f, a1 = 0.f, a2 = 0.f;
#pragma unroll 1
        for (int kq = 0; kq < 2; ++kq) { float wv[32];
#pragma unroll
            for (int k = 0; k < 32; ++k) wv[k] = __builtin_nontemporal_load(wm + (size_t)(ks * 64 + kq * 32 + k) * 6144 + n0 + cidx);
#pragma unroll
            for (int k = 0; k < 32; ++k) { const float w = wv[k]; const int kk = ks * 64 + kq * 32 + k; a0 += sl[kk] * w; a1 += sl[1024 + kk] * w; a2 += sl[2048 + kk] * w; } }
        part[(ks * 3 + 0) * 24 + cidx] = a0; part[(ks * 3 + 1) * 24 + cidx] = a1; part[(ks * 3 + 2) * 24 + cidx] = a2;
    }
    __syncthreads();
    if (tid < 72) { const int r = tid / 24, cx = tid % 24; float s = bm[n0 + cx];
        for (int k = 0; k < 16; ++k) s += part[(k * 3 + r) * 24 + cx];
        ((float*)(p.ws + WS_MOD))[r * 6144 + n0 + cx] = s; }
    __syncthreads();
}
__device__ __forceinline__ void p0_misc_item(const P& p, int r, int tid) {
    const double TWO_PI = 6.283185307179586476925;
    if (r == 0) {
        float* ct = (float*)(p.ws + WS_ROPE); float* st = ct + 2048;
        for (int i = tid; i < 2048; i += NTHR) { const int pos = i >> 4, j = i & 15; const double inv = pow(10000.0, -(2.0 * j) / 32.0); const double a = (double)pos * inv; ct[i] = (float)cos(a); st[i] = (float)sin(a); }
        const float* wr = p.in[17]; bf16_t* wrh = (bf16_t*)(p.ws + WS_WRT); bf16_t* wrl = wrh + 32768;
        for (int i = tid; i < 32768; i += NTHR) { const int k = i >> 5, e = i & 31; const float w = wr[i]; const unsigned hb = f2bf(w); wrh[e * 1024 + k] = (bf16_t)hb; wrl[e * 1024 + k] = (bf16_t)f2bf(w - __uint_as_float(hb << 16)); }
    } else if (r == 1) {
        for (int i = tid; i < 8192; i += NTHR) { const double a = TWO_PI * i / 8192.0; ((float2*)(p.ws + WS_FTAB))[i] = make_float2((float)cos(a), (float)sin(a)); }
    } else if (r < 6) {
        bf16_t* GA = (bf16_t*)(p.ws + WS_GA);
        for (int i = tid; i < 64 * 256; i += NTHR) { const int row = (r - 2) * 64 + (i >> 8), kk = i & 255, c = row >> 7, k1 = row & 127, n1 = kk & 127, isq = kk >> 7;
            const double a = TWO_PI * ((n1 * k1) & 127) / 128.0; const double cs = cos(a), sn = sin(a);
            const double v = c == 0 ? (isq ? -sn : cs) : (isq ? -cs : -sn); GA[row * 256 + kk] = (bf16_t)f2bf((float)v); }
    } else {
        bf16_t* GB = (bf16_t*)(p.ws + WS_GB);
        for (int i = tid; i < 64 * 128; i += NTHR) { const int k2 = i >> 7, kk = i & 127, n2 = kk >> 1, c = kk & 1; const double a = TWO_PI * ((k2 * n2) & 63) / 64.0;
            GB[i] = (bf16_t)f2bf((float)(c ? sin(a) : cos(a))); }
    }
}
template <class CM>
__device__ __forceinline__ void p0_xpose_item(const CM& cm, int ldn, const float* gain, int k0, bf16_t* dst, int Kd, int nd0, int tid, LAS float* scr) {
    f32x4 v[8];
#pragma unroll
    for (int i = 0; i < 8; ++i) { const int q = tid + NTHR * i, k = q >> 6, n = (q & 63) * 4; const float* sp = cm(nd0 + n);
        v[i] = sp ? *(const f32x4*)(sp + (size_t)(k0 + k) * ldn) : (f32x4){0.f, 0.f, 0.f, 0.f}; }
#pragma unroll
    for (int i = 0; i < 8; ++i) { const int q = tid + NTHR * i, k = q >> 6, n = (q & 63) * 4; const float g = gain ? gain[k0 + k] : 1.f;
        LAS float* d = scr + k * 257 + n; d[0] = v[i].x * g; d[1] = v[i].y * g; d[2] = v[i].z * g; d[3] = v[i].w * g; }
    __syncthreads();
#pragma unroll
    for (int i = 0; i < 4; ++i) { const int q = tid + NTHR * i, n = q >> 3, kc = q & 7; const LAS float* s = scr + (kc * 8) * 257 + n;
        u32x4 o; o.x = pk2(s[0], s[257]); o.y = pk2(s[2 * 257], s[3 * 257]); o.z = pk2(s[4 * 257], s[5 * 257]); o.w = pk2(s[6 * 257], s[7 * 257]);
        *(u32x4*)(dst + (size_t)(nd0 + n) * Kd + k0 + kc * 8) = o; }
    __syncthreads();
}
struct CmWin { const float* w; __device__ const float* operator()(int n) const { return n < 384 ? w + 256 + n : (n < 448 ? w + 896 + (n - 384) : (n < 512 ? nullptr : w + 640 + (n - 512))); } };
struct CmPlain { const float* w; int nmax; __device__ const float* operator()(int n) const { return n < nmax ? w + n : nullptr; } };
struct CmGU { const float* g; const float* u; int pn; __device__ const float* operator()(int n) const { const int j = n & 255; return j < 128 ? g + 128 * pn + j : u + 128 * pn + (j - 128); } };
__device__ __forceinline__ void p0_fold_item(const P& p, int g, int kb, int tid, LAS float* scr) {
    LAS float* Mg = scr;
    LAS float* wb = scr + 8192;
    LAS float* cs = scr + 8192 + 4160;
    const float* wf = p.in[15] + g * 4096; const float* win = p.in[10];
    if (tid < 64) { const double a = 6.283185307179586476925 * tid / 64.0; cs[tid] = (float)cos(a); cs[64 + tid] = (float)sin(a); }
    __syncthreads();
    const float sinv = 1.0f / 724.0773439350246f;
    for (int i = 0; i < 16; ++i) { const int e = tid + NTHR * i, c = e >> 7, jj = e & 127, j = jj & 63, isq = jj >> 6; float s = 0.f;
        for (int m = 0; m < 64; ++m) s += cs[isq * 64 + ((m * c) & 63)] * wf[m * 64 + j];
        Mg[c * 128 + jj] = s * sinv; }
    for (int i = 0; i < 8; ++i) { const int e = tid + NTHR * i, k = e >> 6, c = e & 63; wb[k * 65 + c] = win[(size_t)(kb * 64 + k) * 960 + g * 64 + c]; }
    __syncthreads();
    const int jj = tid >> 2, kq = tid & 3; float acc[16];
#pragma unroll
    for (int i = 0; i < 16; ++i) acc[i] = 0.f;
    for (int c = 0; c < 64; ++c) { const float mv = Mg[c * 128 + jj];
#pragma unroll
        for (int i = 0; i < 16; ++i) acc[i] += wb[(kq * 16 + i) * 65 + c] * mv; }
    bf16_t* dst = (bf16_t*)(p.ws + WS_WIN) + (size_t)(768 + g * 128 + jj) * 1024 + kb * 64 + kq * 16;
    u32x4 o0, o1; o0.x = pk2(acc[0], acc[1]); o0.y = pk2(acc[2], acc[3]); o0.z = pk2(acc[4], acc[5]); o0.w = pk2(acc[6], acc[7]);
    o1.x = pk2(acc[8], acc[9]); o1.y = pk2(acc[10], acc[11]); o1.z = pk2(acc[12], acc[13]); o1.w = pk2(acc[14], acc[15]);
    *(u32x4*)dst = o0; *(u32x4*)(dst + 8) = o1;
    __syncthreads();
}
constexpr int I_WGU = 32 * 8 * 2 * 8, I_WD = 32 * 8 * 8, NEI = I_WGU + I_WD;
constexpr int FILL_IN = 182 * 4, FILL_Q = 128 + 12 + 232 + 81, NEI_PREP = NEI - FILL_IN - FILL_Q;
template <bool DYN = false>
__device__ __forceinline__ void p0_expert_items(const P& p, int first, int step, int end, int tid, LAS float* scr, unsigned* ctr = nullptr) {
        constexpr int XS = 129;
        f32x4 v[8];
#define P0_ISSUE(r_) do { const int r = (r_); const float* s0; int k0; \
            if (r < I_WGU) { const int e = r >> 7, t = (r >> 3) & 15, pn = t >> 1, hf = t & 1; k0 = (r & 7) * 128; s0 = (hf ? p.in[21] : p.in[19]) + (size_t)e * 1048576 + 128 * pn; } \
            else { const int q = r - I_WGU, e = q >> 6, nb = (q >> 3) & 7; k0 = (q & 7) * 128; s0 = p.in[23] + (size_t)e * 1048576 + nb * 128; } \
            _Pragma("unroll") for (int i = 0; i < 8; ++i) { const int q = tid + NTHR * i, k = q >> 5, n = (q & 31) * 4; v[i] = __builtin_nontemporal_load((const f32x4*)(s0 + (size_t)(k0 + k) * 1024 + n)); } } while (0)
        int it = first; LAS float* const scr0 = scr; int par = 0;
        LAS int* const nxw = (LAS int*)((LAS unsigned char*)scr0 + LDS_CTL + 128); unsigned pend = 0;
        if constexpr (DYN) { if (tid == 0) { nxw[0] = (int)__hip_atomic_fetch_add(ctr, 1u, __ATOMIC_RELAXED, __HIP_MEMORY_SCOPE_AGENT); pend = __hip_atomic_fetch_add(ctr, 1u, __ATOMIC_RELAXED, __HIP_MEMORY_SCOPE_AGENT); }
            __syncthreads(); it = nxw[0]; __syncthreads(); }
        if (it < end) P0_ISSUE(it);
        for (; it < end; par ^= 1) {
            int nx = it + step;
            scr = scr0 + par * (128 * XS);
#pragma unroll
            for (int i = 0; i < 8; ++i) { const int q = tid + NTHR * i, k = q >> 5, n = (q & 31) * 4; LAS float* d = scr + k * XS + ((n + 8 * (k >> 4)) & 127); d[0] = v[i].x; d[1] = v[i].y; d[2] = v[i].z; d[3] = v[i].w; }
            if constexpr (DYN) { if (tid == 0) { nxw[par] = (int)pend; pend = __hip_atomic_fetch_add(ctr, 1u, __ATOMIC_RELAXED, __HIP_MEMORY_SCOPE_AGENT); } }
            __syncthreads();
            if constexpr (DYN) nx = nxw[par];
            if (nx < end) P0_ISSUE(nx);
            size_t drow; int k0;
            if (it < I_WGU) { const int e = it >> 7, t = (it >> 3) & 15, pn = t >> 1, hf = t & 1; k0 = (it & 7) * 128; drow = (size_t)e * 2048 + pn * 256 + hf * 128; }
            else { const int q = it - I_WGU, e = q >> 6, nb = (q >> 3) & 7; k0 = (q & 7) * 128; drow = (size_t)e * 1024 + nb * 128; }
            if constexpr (MOE_FP8) {
                unsigned char* dst = (unsigned char*)(p.ws + (it < I_WGU ? WS_WGU : WS_WD)) + drow * 1024 + k0;
#pragma unroll
                for (int i = 0; i < 2; ++i) { const int q = tid + NTHR * i, n = q >> 3, kc = q & 7; const LAS float* s = scr + (kc * 16) * XS + ((n + 8 * kc) & 127); u32x4 o;
                    o.x = pg8_pk4_fp8((f32x4){s[0], s[XS], s[2 * XS], s[3 * XS]} * WSCALE); o.y = pg8_pk4_fp8((f32x4){s[4 * XS], s[5 * XS], s[6 * XS], s[7 * XS]} * WSCALE);
                    o.z = pg8_pk4_fp8((f32x4){s[8 * XS], s[9 * XS], s[10 * XS], s[11 * XS]} * WSCALE); o.w = pg8_pk4_fp8((f32x4){s[12 * XS], s[13 * XS], s[14 * XS], s[15 * XS]} * WSCALE);
                    __builtin_nontemporal_store(o, (u32x4*)(dst + (size_t)n * 1024 + kc * 16)); }
            } else {
                bf16_t* dst = (bf16_t*)(p.ws + (it < I_WGU ? WS_WGU : WS_WD)) + drow * 1024 + k0;
#pragma unroll
                for (int i = 0; i < 4; ++i) { const int q = tid + NTHR * i, n = q >> 4, kc = q & 15; const LAS float* s = scr + (kc * 8) * XS + ((n + 8 * (kc >> 1)) & 127);
                    u32x4 o; o.x = pk2(s[0], s[XS]); o.y = pk2(s[2 * XS], s[3 * XS]); o.z = pk2(s[4 * XS], s[5 * XS]); o.w = pk2(s[6 * XS], s[7 * XS]);
                    *(u32x4*)(dst + (size_t)n * 1024 + kc * 8) = o; }
            }
            it = nx;
        }
        __syncthreads();
#undef P0_ISSUE
}
__device__ __forceinline__ void ph_prologue(const P& p, int wg, int nwg, int tid, LAS unsigned char* lds) {
    LAS float* scr = (LAS float*)lds;
    constexpr int I_MOD = 256, I_MISC = 7, I_FOLD = 64, I_WIN = 3 * 16, I_WQ = 5 * 6, I_WKV = 6 * 4, I_WOUT = 4 * 16;
    constexpr int NIT = I_MOD + I_MISC + I_FOLD + I_WIN + I_WQ + I_WKV + I_WOUT;
    for (int it = wg; it < NIT; it += nwg) {
        int r = it;
        if (r < I_MOD) { p0_mod_item(p, r, tid, scr); continue; } r -= I_MOD;
        if (r < I_MISC) { p0_misc_item(p, r, tid); continue; } r -= I_MISC;
        if (r < I_FOLD) { p0_fold_item(p, r >> 4, r & 15, tid, scr); continue; } r -= I_FOLD;
        if (r < I_WIN) { CmWin cm{p.in[10]}; p0_xpose_item(cm, 960, nullptr, (r & 15) * 64, (bf16_t*)(p.ws + WS_WIN), 1024, (r >> 4) * 256, tid, scr); continue; } r -= I_WIN;
        if (r < I_WQ) { CmPlain cm{p.in[13], 1152}; p0_xpose_item(cm, 1152, p.in[11], (r % 6) * 64, (bf16_t*)(p.ws + WS_WQ), 384, (r / 6) * 256, tid, scr); continue; } r -= I_WQ;
        if (r < I_WKV) { CmPlain cm{p.in[14], 1536}; p0_xpose_item(cm, 1536, p.in[12], (r & 3) * 64, (bf16_t*)(p.ws + WS_WKV), 256, (r >> 2) * 256, tid, scr); continue; } r -= I_WKV;
        if (r < I_WOUT) { CmPlain cm{p.in[16], 1024}; p0_xpose_item(cm, 1024, nullptr, (r & 15) * 64, (bf16_t*)(p.ws + WS_WOUT), 1024, (r >> 4) * 256, tid, scr); continue; } r -= I_WOUT;
    }
    p0_expert_items<true>(p, wg, nwg, nwg == NWG ? NEI_PREP : NEI, tid, scr, (unsigned*)(p.ws + WS_CTL) + 64);
}

template <int NR> __device__ __forceinline__ void modul_rows(const float* const (&rows)[NR], bf16_t* const (&outs)[NR], const f32x4 (&a)[4], const f32x4 (&sh)[4], int lane) {
    f32x4 v[NR][4];
#pragma unroll
    for (int r = 0; r < NR; ++r)
#pragma unroll
        for (int j = 0; j < 4; ++j) v[r][j] = __builtin_nontemporal_load((const f32x4*)(rows[r] + 4 * lane + 256 * j));
#pragma unroll
    for (int r = 0; r < NR; ++r) { float ss = 0.f;
#pragma unroll
        for (int j = 0; j < 4; ++j) ss += dot4(v[r][j], v[r][j]);
        const float rinv = rsqrtf(wave_sum(ss) * (1.f / D) + RMS_EPS);
#pragma unroll
        for (int j = 0; j < 4; ++j) { const f32x4 o = v[r][j] * rinv * a[j] + sh[j]; u32x2 w; w.x = pk2(o.x, o.y); w.y = pk2(o.z, o.w); *(u32x2*)(outs[r] + 4 * lane + 256 * j) = w; } }
}
__device__ __forceinline__ void ph_modulate(const P& p, int wg, int nwg, int tid) {
    const int lane = tid & 63, wave = tid >> 6;
    const float* x = p.in[0]; const float* ctx = p.in[2]; const float* gain = p.in[6];
    const float* MOD = (const float*)(p.ws + WS_MOD); bf16_t* HX = (bf16_t*)(p.ws + WS_HX);
    for (int ch = wg; ch < 256; ch += nwg) {
        f32x4 a[4], sh[4];
        { const int r = ch >> 7;
#pragma unroll
          for (int j = 0; j < 4; ++j) { const int c = 4 * lane + 256 * j; sh[j] = *(const f32x4*)(MOD + r * 6144 + c); a[j] = *(const f32x4*)(gain + c) * (*(const f32x4*)(MOD + r * 6144 + 1024 + c) + 1.f); } }
#pragma unroll
        for (int q = 0; q < 2; ++q) { const int m0 = ch * 64 + wave * 8 + q * 4;
            const float* const rows[4] = {x + (size_t)m0 * D, x + (size_t)(m0 + 1) * D, x + (size_t)(m0 + 2) * D, x + (size_t)(m0 + 3) * D};
            bf16_t* const outs[4] = {HX + (size_t)m0 * D, HX + (size_t)(m0 + 1) * D, HX + (size_t)(m0 + 2) * D, HX + (size_t)(m0 + 3) * D};
            modul_rows<4>(rows, outs, a, sh, lane); }
        if (wave == 7) {
#pragma unroll
            for (int j = 0; j < 4; ++j) { const int c = 4 * lane + 256 * j; sh[j] = *(const f32x4*)(MOD + 2 * 6144 + c); a[j] = *(const f32x4*)(gain + c) * (*(const f32x4*)(MOD + 2 * 6144 + 1024 + c) + 1.f); }
            const int c0 = ch * 2;
            const float* const rows[2] = {ctx + (size_t)c0 * D, ctx + (size_t)(c0 + 1) * D};
            bf16_t* const outs[2] = {HX + (size_t)(ML + c0) * D, HX + (size_t)(ML + c0 + 1) * D};
            modul_rows<2>(rows, outs, a, sh, lane); }
    }
}

template <int NR> __device__ __forceinline__ void row1_rows(const P& p, const int (&ms)[NR], int lane) {
    const bf16_t* PX = (const bf16_t*)(p.ws + WS_PX); float* RS = (float*)(p.ws + WS_RSTAT); bf16_t* KR = (bf16_t*)(p.ws + WS_KR);
    const float* ct = (const float*)(p.ws + WS_ROPE); const float* st = ct + 2048;
    u32x4 c0[NR], c1[NR];
#pragma unroll
    for (int r = 0; r < NR; ++r) { const bf16_t* pr = PX + (size_t)ms[r] * PXW; c0[r] = *(const u32x4*)(pr + 8 * lane); c1[r] = *(const u32x4*)(pr + 512 + 8 * (lane & 31)); }
#pragma unroll
    for (int r = 0; r < NR; ++r) { const int m = ms[r];
        float v[8]; v[0] = bflo(c0[r].x); v[1] = bfhi(c0[r].x); v[2] = bflo(c0[r].y); v[3] = bfhi(c0[r].y); v[4] = bflo(c0[r].z); v[5] = bfhi(c0[r].z); v[6] = bflo(c0[r].w); v[7] = bfhi(c0[r].w);
        float sq = 0.f; if (lane < 48) { for (int j = 0; j < 8; ++j) sq += v[j] * v[j]; }
        float skv = 0.f; if (lane < 32) { const float t0 = bflo(c1[r].x), t1 = bfhi(c1[r].x), t2 = bflo(c1[r].y), t3 = bfhi(c1[r].y), t4 = bflo(c1[r].z), t5 = bfhi(c1[r].z), t6 = bflo(c1[r].w), t7 = bfhi(c1[r].w);
            skv = (t0 * t0 + t1 * t1) + (t2 * t2 + t3 * t3) + (t4 * t4 + t5 * t5) + (t6 * t6 + t7 * t7); }
        const float rq = rsqrtf(wave_sum(sq) * (1.f / QL) + RMS_EPS), rkv = rsqrtf(wave_sum(skv) * (1.f / KVL) + RMS_EPS);
        if (lane == 0) { RS[2 * m] = rq; RS[2 * m + 1] = rkv; }
        if (lane >= 48 && lane < 56) {
            const int d0 = (lane - 48) * 8; int b, tt;
            if (m < ML) { b = m >> 13; tt = m & 8191; const int prow = tt >> 6, pcol = tt & 63;
#pragma unroll
                for (int q = 0; q < 4; ++q) { const int pi = (d0 >> 1) + q; const int pos = pi < 16 ? prow : pcol, j = pi & 15; const float c = ct[pos * 16 + j], s = st[pos * 16 + j];
                    const float e = v[2 * q], o = v[2 * q + 1]; v[2 * q] = e * c - o * s; v[2 * q + 1] = e * s + o * c; } }
            else { b = (m - ML) >> 8; tt = SEQ + ((m - ML) & 255); }
            u32x4 o; o.x = pk2(v[0], v[1]); o.y = pk2(v[2], v[3]); o.z = pk2(v[4], v[5]); o.w = pk2(v[6], v[7]);
            if constexpr (ATT_QK8) { u32x2 w8; w8.x = pg8_pk4_fp8((f32x4){v[0], v[1], v[2], v[3]}); w8.y = pg8_pk4_fp8((f32x4){v[4], v[5], v[6], v[7]}); *(u32x2*)((unsigned char*)KR + ((size_t)b * TK + tt) * DROPE + d0) = w8; }
            else *(u32x4*)(KR + ((size_t)b * TK + tt) * DROPE + d0) = o;
        }
    }
}
__device__ __forceinline__ void ph_row1(const P& p, int wg, int nwg, int tid) {
    const int lane = tid & 63, wave = tid >> 6;
    for (int ch = wg; ch < 256; ch += nwg) {
        { const int m0 = ch * 64 + wave * 8; const int ms[8] = {m0, m0 + 1, m0 + 2, m0 + 3, m0 + 4, m0 + 5, m0 + 6, m0 + 7}; row1_rows<8>(p, ms, lane); }
        if (wave == 7) { const int ms[2] = {ML + ch * 2, ML + ch * 2 + 1}; row1_rows<2>(p, ms, lane); }
    }
}

__device__ __forceinline__ float half_max32(float v, int lane) {
    v = fmaxf(v, __builtin_bit_cast(float, __builtin_amdgcn_update_dpp(__builtin_bit_cast(int, v), __builtin_bit_cast(int, v), 0x111, 0xf, 0xf, false)));
    v = fmaxf(v, __builtin_bit_cast(float, __builtin_amdgcn_update_dpp(__builtin_bit_cast(int, v), __builtin_bit_cast(int, v), 0x112, 0xf, 0xf, false)));
    v = fmaxf(v, __builtin_bit_cast(float, __builtin_amdgcn_update_dpp(__builtin_bit_cast(int, v), __builtin_bit_cast(int, v), 0x114, 0xf, 0xf, false)));
    v = fmaxf(v, __builtin_bit_cast(float, __builtin_amdgcn_update_dpp(__builtin_bit_cast(int, v), __builtin_bit_cast(int, v), 0x118, 0xf, 0xf, false)));
    v = fmaxf(v, __builtin_bit_cast(float, __builtin_amdgcn_update_dpp(__builtin_bit_cast(int, v), __builtin_bit_cast(int, v), 0x142, 0xa, 0xf, false)));
    const float m0 = __builtin_bit_cast(float, __builtin_amdgcn_readlane(__builtin_bit_cast(int, v), 31)), m1 = __builtin_bit_cast(float, __builtin_amdgcn_readlane(__builtin_bit_cast(int, v), 63));
    return lane < 32 ? m0 : m1;
}
__device__ __forceinline__ void ph_row2(const P& p, int wg, int nwg, int tid, LAS unsigned char* lds) {
    const int lane = tid & 63, wave = tid >> 6;
    constexpr int HSTR = 2064;
    LAS unsigned char* Hhi = lds; LAS unsigned char* Hlo = lds + 32 * HSTR;
    LAS float* PL = (LAS float*)(lds + LDS_CTL + 4096);
    LAS int* hist = (LAS int*)(lds + LDS_CTL + 1024);
    const bf16_t* WRH = (const bf16_t*)(p.ws + WS_WRT); const bf16_t* WRL = WRH + 32768;
    const float* x = p.in[0]; const float* MOD = (const float*)(p.ws + WS_MOD); const float* npost = p.in[7]; const float* npre = p.in[8]; const float* br = p.in[18];
    const bf16_t* MIX = (const bf16_t*)(p.ws + WS_MIX); bf16_t* HX2 = (bf16_t*)(p.ws + WS_HX);
    int* TOPI = (int*)(p.ws + WS_TOPI); float* GATE = (float*)(p.ws + WS_GATE); int* CHCNT = (int*)(p.ws + WS_CHCNT);
    for (int ch = wg; ch < 256; ch += nwg) {
        if (tid < 32) hist[tid] = 0;
        const int b = (ch * 64) >> 13;
        f32x4 a1[4], a2[4], s2[4];
#pragma unroll
        for (int j = 0; j < 4; ++j) { const int c = 4 * lane + 256 * j;
            a1[j] = *(const f32x4*)(npost + c) * *(const f32x4*)(MOD + b * 6144 + 2048 + c);
            a2[j] = *(const f32x4*)(npre + c) * (*(const f32x4*)(MOD + b * 6144 + 4096 + c) + 1.f);
            s2[j] = *(const f32x4*)(MOD + b * 6144 + 3072 + c); }
        for (int batch = 0; batch < 2; ++batch) {
            u32x2 mw[4][4]; f32x4 xv[4][4];
#pragma unroll
            for (int i = 0; i < 4; ++i) { const int m = ch * 64 + batch * 32 + wave * 4 + i;
#pragma unroll
                for (int j = 0; j < 4; ++j) { mw[i][j] = *(const u32x2*)(MIX + (size_t)m * D + 4 * lane + 256 * j); xv[i][j] = __builtin_nontemporal_load((const f32x4*)(x + (size_t)m * D + 4 * lane + 256 * j)); } }
            const int fr = lane & 15, fq = lane >> 4, rb = (wave & 1) * 16, kq = wave >> 1;
            const bf16_t* bh = WRH + fr * 1024 + kq * 256 + fq * 8; const bf16_t* bl = WRL + fr * 1024 + kq * 256 + fq * 8;
#pragma unroll
            for (int i = 0; i < 4; ++i) {
                const int rl = wave * 4 + i, m = ch * 64 + batch * 32 + rl;
                f32x4 mx[4], h[4]; float ss = 0.f;
#pragma unroll
                for (int j = 0; j < 4; ++j) { const u32x2 w = mw[i][j]; mx[j] = (f32x4){bflo(w.x), bfhi(w.x), bflo(w.y), bfhi(w.y)}; ss += dot4(mx[j], mx[j]); }
                const float r1 = rsqrtf(wave_sum(ss) * (1.f / D) + RMS_EPS); float s2s = 0.f;
#pragma unroll
                for (int j = 0; j < 4; ++j) { h[j] = xv[i][j] + a1[j] * (mx[j] * r1); s2s += dot4(h[j], h[j]); }
                const float r2 = rsqrtf(wave_sum(s2s) * (1.f / D) + RMS_EPS);
#pragma unroll
                for (int j = 0; j < 4; ++j) { h[j] = h[j] * r2 * a2[j] + s2[j];
                    const unsigned h0 = f2bf(h[j].x), h1 = f2bf(h[j].y), h2 = f2bf(h[j].z), h3 = f2bf(h[j].w);
                    u32x2 wh; wh.x = h0 | (h1 << 16); wh.y = h2 | (h3 << 16);
                    u32x2 wl; wl.x = pk2(h[j].x - __uint_as_float(h0 << 16), h[j].y - __uint_as_float(h1 << 16)); wl.y = pk2(h[j].z - __uint_as_float(h2 << 16), h[j].w - __uint_as_float(h3 << 16));
                    if constexpr (MOE_FP8) *(unsigned*)((unsigned char*)HX2 + (size_t)m * D + 4 * lane + 256 * j) = pg8_pk4_fp8(h[j]);
                    else *(u32x2*)(HX2 + (size_t)m * D + 4 * lane + 256 * j) = wh;
                    *(LAS u32x2*)(Hhi + rl * HSTR + (4 * lane + 256 * j) * 2) = wh; *(LAS u32x2*)(Hlo + rl * HSTR + (4 * lane + 256 * j) * 2) = wl; }
            }
            bf16x8 Bh0[8], Bl0[8];
#pragma unroll
            for (int ks = 0; ks < 8; ++ks) { Bh0[ks] = *(const bf16x8*)(bh + ks * 32); Bl0[ks] = *(const bf16x8*)(bl + ks * 32); }
            __syncthreads();
            { f32x4 acc0 = {0.f, 0.f, 0.f, 0.f}, acc1 = {0.f, 0.f, 0.f, 0.f};
              bf16x8 Bh1[8], Bl1[8];
#pragma unroll
              for (int ks = 0; ks < 8; ++ks) { Bh1[ks] = *(const bf16x8*)(bh + 16 * 1024 + ks * 32); Bl1[ks] = *(const bf16x8*)(bl + 16 * 1024 + ks * 32); }
              const LAS unsigned char* ah = Hhi + (rb + fr) * HSTR + kq * 512 + fq * 16; const LAS unsigned char* al = Hlo + (rb + fr) * HSTR + kq * 512 + fq * 16;
#pragma unroll
              for (int ks = 0; ks < 8; ++ks) {
                  const bf16x8 Ah = *(const LAS bf16x8*)(ah + ks * 64), Al = *(const LAS bf16x8*)(al + ks * 64);
                  acc0 = __builtin_amdgcn_mfma_f32_16x16x32_bf16(Ah, Bh0[ks], acc0, 0, 0, 0); acc0 = __builtin_amdgcn_mfma_f32_16x16x32_bf16(Ah, Bl0[ks], acc0, 0, 0, 0); acc0 = __builtin_amdgcn_mfma_f32_16x16x32_bf16(Al, Bh0[ks], acc0, 0, 0, 0); }
#pragma unroll
              for (int ks = 0; ks < 8; ++ks) {
                  const bf16x8 Ah = *(const LAS bf16x8*)(ah + ks * 64), Al = *(const LAS bf16x8*)(al + ks * 64);
                  acc1 = __builtin_amdgcn_mfma_f32_16x16x32_bf16(Ah, Bh1[ks], acc1, 0, 0, 0); acc1 = __builtin_amdgcn_mfma_f32_16x16x32_bf16(Ah, Bl1[ks], acc1, 0, 0, 0); acc1 = __builtin_amdgcn_mfma_f32_16x16x32_bf16(Al, Bh1[ks], acc1, 0, 0, 0); }
#pragma unroll
              for (int r = 0; r < 4; ++r) { PL[(kq * 32 + rb + fq * 4 + r) * 32 + fr] = acc0[r]; PL[(kq * 32 + rb + fq * 4 + r) * 32 + 16 + fr] = acc1[r]; } }
            __syncthreads();
#pragma unroll
            for (int ps = 0; ps < 2; ++ps) {
                const int rl = wave * 4 + ps * 2 + (lane >> 5), e = lane & 31, m = ch * 64 + batch * 32 + rl;
                float v = ((PL[rl * 32 + e] + PL[(32 + rl) * 32 + e]) + (PL[(64 + rl) * 32 + e] + PL[(96 + rl) * 32 + e])) + br[e];
                int ti[4]; float tv[4];
#pragma unroll
                for (int k = 0; k < 4; ++k) { const float mx = half_max32(v, lane); const unsigned long long bal = __ballot(v == mx);
                    const unsigned hm = lane < 32 ? (unsigned)bal : (unsigned)(bal >> 32); const int idx = __ffs((int)hm) - 1;
                    ti[k] = idx; tv[k] = mx; if (e == idx) v = -3.0e38f; }
                const float e1 = __expf(tv[1] - tv[0]), e2 = __expf(tv[2] - tv[0]), e3 = __expf(tv[3] - tv[0]), inv = 1.f / (1.f + e1 + e2 + e3);
                if (e == 0) { *(int4*)(TOPI + 4 * m) = make_int4(ti[0], ti[1], ti[2], ti[3]); *(f32x4*)(GATE + 4 * m) = (f32x4){inv, e1 * inv, e2 * inv, e3 * inv};
                    atomicAdd((int*)&hist[ti[0]], 1); atomicAdd((int*)&hist[ti[1]], 1); atomicAdd((int*)&hist[ti[2]], 1); atomicAdd((int*)&hist[ti[3]], 1); }
            }
            __syncthreads();
        }
        if (tid < 32) CHCNT[ch * 32 + tid] = hist[tid];
        __syncthreads();
    }
}

__device__ __forceinline__ void ph_lists(const P& p, int wg, int nwg, int tid, LAS unsigned char* lds) {
    LAS int* ct = (LAS int*)lds;
    LAS int* part = ct + 8192;
    LAS int* tot = part + 512; LAS int* base = tot + 32; LAS int* off = base + 64; LAS int* tp = off + 32;
    const int* CHCNT = (const int*)(p.ws + WS_CHCNT); const int* TOPI = (const int*)(p.ws + WS_TOPI);
    int* TOKSLOT = (int*)(p.ws + WS_TOKSLOT); int* SLOTTOK = (int*)(p.ws + WS_SLOTTOK); int* TILEE = (int*)(p.ws + WS_TILEE);
    for (int i = tid; i < 8192; i += NTHR) ct[i] = CHCNT[i];
    __syncthreads();
    { const int e = tid & 31, pt = tid >> 5; int s = 0; for (int c = pt * 16; c < pt * 16 + 16; ++c) s += ct[c * 32 + e]; part[pt * 32 + e] = s; }
    __syncthreads();
    if (tid < 32) { int s = 0; for (int k = 0; k < 16; ++k) s += part[k * 32 + tid]; tot[tid] = s; }
    __syncthreads();
    if (tid == 0) { int run = 0; for (int e = 0; e < 32; ++e) { base[e] = run; run += ((tot[e] + 255) >> 8) << 8; } base[32] = run; }
    __syncthreads();
    for (int ch = wg; ch < 256; ch += nwg) {
        { const int e = tid & 31, pt = tid >> 5; int s = 0; for (int c = pt * 16; c < pt * 16 + 16 && c < ch; ++c) s += ct[c * 32 + e]; part[pt * 32 + e] = s; }
        if (tid < 256) tp[tid] = TOPI[ch * 256 + tid];
        __syncthreads();
        if (tid < 32) { int s = base[tid]; for (int k = 0; k < 16; ++k) s += part[k * 32 + tid]; off[tid] = s; }
        __syncthreads();
        if (tid < 256) { const int e = tp[tid]; int rank = 0; for (int q = 0; q < tid; ++q) rank += (tp[q] == e) ? 1 : 0;
            const int s = off[e] + rank; TOKSLOT[ch * 256 + tid] = s; SLOTTOK[s] = ch * 64 + (tid >> 2); }
        __syncthreads();
    }
    if (wg == 0) {
        if (tid < 32) { const int e = tid; for (int s = base[e] + tot[e]; s < base[e] + (((tot[e] + 255) >> 8) << 8); ++s) SLOTTOK[s] = 0;
            for (int t = base[e] >> 8; t < (base[e] >> 8) + ((tot[e] + 255) >> 8); ++t) TILEE[t] = e; }
        const int nt = base[32] >> 8;
        for (int t = nt + tid; t < MAXTILES; t += NTHR) TILEE[t] = -1;
        if (tid == 0) TILEE[400] = nt;
    }
}

__device__ __forceinline__ void ph_final(const P& p, int wg, int nwg, int tid) {
    const int lane = tid & 63, wave = tid >> 6;
    const float* x = p.in[0]; const float* MOD = (const float*)(p.ws + WS_MOD); const float* npost = p.in[7]; const float* nfpost = p.in[9];
    const bf16_t* MIX = (const bf16_t*)(p.ws + WS_MIX); const unsigned char* Y = (const unsigned char*)(p.ws + WS_Y);
    const int* TOKSLOT = (const int*)(p.ws + WS_TOKSLOT); const float* GATE = (const float*)(p.ws + WS_GATE);
    for (int ch = wg; ch < 256; ch += nwg) {
        const int b = (ch * 64) >> 13;
        f32x4 a1[4], a3[4];
#pragma unroll
        for (int j = 0; j < 4; ++j) { const int c = 4 * lane + 256 * j;
            a1[j] = *(const f32x4*)(npost + c) * *(const f32x4*)(MOD + b * 6144 + 2048 + c);
            a3[j] = *(const f32x4*)(nfpost + c) * *(const f32x4*)(MOD + b * 6144 + 5120 + c); }
        int4 sln[2]; f32x4 gtn[2];
#pragma unroll
        for (int q = 0; q < 2; ++q) { const int m = ch * 64 + wave * 8 + q; sln[q] = *(const int4*)(TOKSLOT + 4 * m); gtn[q] = *(const f32x4*)(GATE + 4 * m); }
#pragma unroll 1
        for (int i2 = 0; i2 < 8; i2 += 2) {
            const int4 sl[2] = {sln[0], sln[1]}; const f32x4 gt[2] = {gtn[0], gtn[1]};
            u32x2 mw[2][4]; unsigned yw[2][4][4]; f32x4 xv[2][4];
#pragma unroll
            for (int q = 0; q < 2; ++q) { const int m = ch * 64 + wave * 8 + i2 + q;
#pragma unroll
                for (int j = 0; j < 4; ++j) { const int c = 4 * lane + 256 * j;
                    mw[q][j] = __builtin_nontemporal_load((const u32x2*)(MIX + (size_t)m * D + c)); xv[q][j] = __builtin_nontemporal_load((const f32x4*)(x + (size_t)m * D + c));
                    yw[q][j][0] = __builtin_nontemporal_load((const unsigned*)(Y + (size_t)sl[q].x * D + c)); yw[q][j][1] = __builtin_nontemporal_load((const unsigned*)(Y + (size_t)sl[q].y * D + c));
                    yw[q][j][2] = __builtin_nontemporal_load((const unsigned*)(Y + (size_t)sl[q].z * D + c)); yw[q][j][3] = __builtin_nontemporal_load((const unsigned*)(Y + (size_t)sl[q].w * D + c)); } }
            if (i2 + 2 < 8) {
#pragma unroll
                for (int q = 0; q < 2; ++q) { const int m = ch * 64 + wave * 8 + i2 + 2 + q; sln[q] = *(const int4*)(TOKSLOT + 4 * m); gtn[q] = *(const f32x4*)(GATE + 4 * m); } }
#pragma unroll
            for (int q = 0; q < 2; ++q) { const int m = ch * 64 + wave * 8 + i2 + q; const f32x4 g = gt[q];
                f32x4 mx[4], y[4]; float ss = 0.f, sy = 0.f;
#pragma unroll
                for (int j = 0; j < 4; ++j) { const u32x2 w = mw[q][j]; mx[j] = (f32x4){bflo(w.x), bfhi(w.x), bflo(w.y), bfhi(w.y)}; ss += dot4(mx[j], mx[j]);
                    f32x4 t = fp8x4(yw[q][j][0]) * g.x; t += fp8x4(yw[q][j][1]) * g.y; t += fp8x4(yw[q][j][2]) * g.z; t += fp8x4(yw[q][j][3]) * g.w;
                    y[j] = t; sy += dot4(t, t); }
                const float r1 = rsqrtf(wave_sum(ss) * (1.f / D) + RMS_EPS), r3 = rsqrtf(wave_sum(sy) * (1.f / D) + RMS_EPS);
#pragma unroll
                for (int j = 0; j < 4; ++j) { const int c = 4 * lane + 256 * j;
                    const f32x4 x1 = xv[q][j] + a1[j] * (mx[j] * r1); __builtin_nontemporal_store(x1 + a3[j] * (y[j] * r3), (f32x4*)(p.out + (size_t)m * D + c)); } }
        }
    }
}

typedef float f32x2a __attribute__((ext_vector_type(2)));
__device__ __forceinline__ f32x4 act4p(f32x4 g, f32x4 u1) {
    f32x4 r;
#pragma unroll
    for (int i = 0; i < 4; i += 2) {
        const f32x2a gg = {fminf(g[i], 7.f), fminf(g[i + 1], 7.f)}; f32x2a e = gg * (f32x2a){-2.4554669595930156f, -2.4554669595930156f};
        e[0] = __builtin_amdgcn_exp2f(e[0]); e[1] = __builtin_amdgcn_exp2f(e[1]); e += (f32x2a){1.f, 1.f};
        const f32x2a rc = {__builtin_amdgcn_rcpf(e[0]), __builtin_amdgcn_rcpf(e[1])}, uu = {__builtin_amdgcn_fmed3f(u1[i], -6.f, 8.f), __builtin_amdgcn_fmed3f(u1[i + 1], -6.f, 8.f)};
        const f32x2a o = gg * rc * uu; r[i] = o[0]; r[i + 1] = o[1]; }
    return r;
}
__device__ __forceinline__ f32x4 act4(f32x4 g, f32x4 u) {
    f32x4 r;
#pragma unroll
    for (int i = 0; i < 4; ++i) { const float gg = fminf(g[i], 7.f), uu = fminf(fmaxf(u[i], -7.f), 7.f); r[i] = gg * __builtin_amdgcn_rcpf(1.f + __builtin_amdgcn_exp2f(-2.4554669595930156f * gg)) * (uu + 1.f); }
    return r;
}

namespace pg8 {
constexpr int BM = 256, BK = 64, HALF = 128, HTB = HALF * BK * 2, STAGE_BYTES = 8 * HTB, NXCD = 8, WGM = 8;
__device__ __forceinline__ int lds_byte(int r, int c) { const int st = (r >> 4) * 2 + (c >> 5), rr = r & 15, cc = c & 31, ob = rr * 64 + cc * 2; return st * 1024 + (ob ^ (((ob >> 9) & 1) << 5)); }
__device__ __forceinline__ void stage_rc(int b, int& R, int& C) { const int st = b / 1024, sb = b % 1024, swz = sb ^ (((sb >> 9) & 1) << 5); R = (st >> 1) * 16 + swz / 64; C = (st & 1) * 32 + (swz % 64) / 2; }
__device__ __forceinline__ int perm32(int rho) { const int n = rho >> 4, i = rho & 15; return 8 * (i >> 2) + 4 * n + (i & 3); }
struct GUnit { const char* B; int pm, pn, e, arow, li; };
typedef int i32x4v __attribute__((ext_vector_type(4)));
typedef int i32x8v __attribute__((ext_vector_type(8)));
template <class Epi, class Sched, bool FP8 = false>
__device__ __forceinline__ void gemm_phase(LAS unsigned char* lds, const int tid, const char* Abase, const int K, const Sched& S, const Epi& E) {
    const int wid = __builtin_amdgcn_readfirstlane(tid >> 6), lane = tid & 63, wr = wid >> 2, wc = wid & 3, fr = lane & 15, fq = lane >> 4;
    const int Kb = FP8 ? K : K * 2, nt = Kb / (BK * 2);
    unsigned voffB[2];
#pragma unroll
    for (int i = 0; i < 2; ++i) { int R, C; stage_rc(tid * 16 + i * 8192, R, C); const int Rb = (R & ~31) + perm32(R & 31); voffB[i] = (unsigned)(Rb * Kb + C * 2); }
    const size_t kstep = (size_t)(BK * 2);
    const size_t hstep = (size_t)HALF * Kb;
    const unsigned ldsw = (unsigned)wid * 1024u;
    constexpr int FC = FP8 ? 16 : 8, PSTR = FP8 ? 16 : 1024;
    const int aoff = lds_byte(wr * 64 + fr, fq * FC), boff = lds_byte(wc * 32 + fr, fq * FC);
#define PG8_SA(b, h) (((b) * 2 + (h)) * HTB)
#define PG8_SB(b, h) ((4 + (b) * 2 + (h)) * HTB)
#define PG8_STAGE_B(bufoff, gbase) do { _Pragma("unroll") for (int _i = 0; _i < 2; ++_i) \
        __builtin_amdgcn_global_load_lds((const unsigned*)((const char*)(gbase) + voffB[_i]), (LAS unsigned*)(lds + (bufoff) + ldsw + _i * 8192), 16, 0, 0); } while (0)
#define PG8_STAGE_A(bufoff, vo, koff) do { _Pragma("unroll") for (int _i = 0; _i < 2; ++_i) \
        __builtin_amdgcn_global_load_lds((const unsigned*)(Abase + (size_t)(vo)[_i] + (koff)), (LAS unsigned*)(lds + (bufoff) + ldsw + _i * 8192), 16, 0, 0); } while (0)
#define PG8_LDA(dst, b, h) do { _Pragma("unroll") for (int m = 0; m < 4; ++m) _Pragma("unroll") for (int k = 0; k < 2; ++k) dst[m][k] = *(const LAS bf16x8*)(lds + PG8_SA(b, h) + aoff + m * 2048 + k * PSTR); } while (0)
#define PG8_LDB(dst, b, h) do { _Pragma("unroll") for (int n = 0; n < 2; ++n) _Pragma("unroll") for (int k = 0; k < 2; ++k) dst[n][k] = *(const LAS bf16x8*)(lds + PG8_SB(b, h) + boff + n * 2048 + k * PSTR); } while (0)
#define PG8_CAT(x) __builtin_shufflevector(__builtin_bit_cast(i32x4v, (x)[0]), __builtin_bit_cast(i32x4v, (x)[1]), 0, 1, 2, 3, 4, 5, 6, 7)
#define PG8_MMA(ai, bj, At, Bt) do { __builtin_amdgcn_s_setprio(1); \
        if constexpr (FP8) { _Pragma("unroll") for (int m = 0; m < 4; ++m) _Pragma("unroll") for (int n = 0; n < 2; ++n) \
            acc[ai][bj][m][n] = __builtin_amdgcn_mfma_scale_f32_16x16x128_f8f6f4(PG8_CAT(Bt[n]), PG8_CAT(At[m]), acc[ai][bj][m][n], 0, 0, 0, 0x7F7F7F7F, 0, 0x7F7F7F7F); \
            _Pragma("unroll") for (int m = 0; m < 4; ++m) _Pragma("unroll") for (int n = 0; n < 2; ++n) asm volatile("" : "+v"(acc[ai][bj][m][n])); }   \
        else { _Pragma("unroll") for (int m = 0; m < 4; ++m) _Pragma("unroll") for (int n = 0; n < 2; ++n) _Pragma("unroll") for (int k = 0; k < 2; ++k) \
            acc[ai][bj][m][n] = __builtin_amdgcn_mfma_f32_16x16x32_bf16(Bt[n][k], At[m][k], acc[ai][bj][m][n], 0, 0, 0); } \
        __builtin_amdgcn_s_setprio(0); } while (0)
#define PG8_WAIT_V(n) asm volatile("s_waitcnt vmcnt(" #n ")" ::: "memory")
#define PG8_WAIT_L(n) asm volatile("s_waitcnt lgkmcnt(" #n ")" ::: "memory")
#define PG8_BAR __builtin_amdgcn_s_barrier()
#define PG8_SCHED __builtin_amdgcn_sched_barrier(0)
    GUnit cur, nxt; int ui = 0;
    if (!S.next(0, cur)) return;
    f32x4 acc[2][2][4][2];
#pragma unroll
    for (int a = 0; a < 2; ++a)
#pragma unroll
        for (int b = 0; b < 2; ++b)
#pragma unroll
            for (int m = 0; m < 4; ++m)
#pragma unroll
                for (int n = 0; n < 2; ++n) acc[a][b][m][n] = (f32x4){0.f, 0.f, 0.f, 0.f};
    bf16x8 At[4][2], B0[2][2], B1[2][2];
    unsigned cvo[2][2];
    S.aoffs(cur, tid, cvo);
    const char* cB = cur.B;
    PG8_STAGE_B(PG8_SB(0, 0), cB); PG8_STAGE_B(PG8_SB(0, 1), cB + hstep); PG8_STAGE_A(PG8_SA(0, 0), cvo[0], 0); PG8_STAGE_A(PG8_SA(0, 1), cvo[1], 0);
    if (wr == 1) PG8_BAR;
    PG8_WAIT_V(2); PG8_BAR;
    PG8_STAGE_B(PG8_SB(1, 0), cB + kstep); PG8_STAGE_A(PG8_SA(1, 0), cvo[0], kstep); PG8_STAGE_B(PG8_SB(1, 1), cB + hstep + kstep);
    PG8_WAIT_V(6); PG8_BAR;
    for (;;) {
        const bool has_next = S.next(ui + 1, nxt);
        const char* nB = has_next ? nxt.B : cB;
#pragma nounroll
        for (int t = 0; t < nt; t += 2) {
            const bool last = (t == nt - 2);
            const size_t k1 = (size_t)(t + 1) * kstep, k2 = last ? 0 : (size_t)(t + 2) * kstep, k3 = k2 + kstep;
            const char* b2 = last ? nB : cB + (size_t)(t + 2) * kstep; const char* b3 = b2 + kstep;
            PG8_LDB(B0, 0, 0); PG8_LDB(B1, 0, 1); PG8_SCHED; PG8_LDA(At, 0, 0); PG8_STAGE_A(PG8_SA(1, 1), cvo[1], k1);
            PG8_WAIT_V(8); PG8_WAIT_L(0); PG8_BAR; PG8_MMA(0, 0, At, B0); PG8_MMA(0, 1, At, B1); PG8_BAR; PG8_SCHED;
            if (last && has_next) S.aoffs(nxt, tid, cvo);
            PG8_LDA(At, 0, 1); PG8_STAGE_B(PG8_SB(0, 0), b2); PG8_STAGE_B(PG8_SB(0, 1), b2 + hstep); PG8_STAGE_A(PG8_SA(0, 0), cvo[0], k2);
            PG8_WAIT_V(8); PG8_WAIT_L(0); PG8_BAR; PG8_MMA(1, 0, At, B0); PG8_MMA(1, 1, At, B1); PG8_BAR; PG8_SCHED;
            PG8_LDB(B0, 1, 0); PG8_LDB(B1, 1, 1); PG8_SCHED; PG8_LDA(At, 1, 0); PG8_STAGE_A(PG8_SA(0, 1), cvo[1], k2);
            PG8_WAIT_V(8); PG8_WAIT_L(0); PG8_BAR; PG8_MMA(0, 0, At, B0); PG8_MMA(0, 1, At, B1); PG8_BAR; PG8_SCHED;
            PG8_LDA(At, 1, 1); PG8_STAGE_B(PG8_SB(1, 0), b3); PG8_STAGE_B(PG8_SB(1, 1), b3 + hstep); PG8_STAGE_A(PG8_SA(1, 0), cvo[0], k3);
            PG8_WAIT_V(8); PG8_WAIT_L(0); PG8_BAR; PG8_MMA(1, 0, At, B0); PG8_MMA(1, 1, At, B1); PG8_BAR; PG8_SCHED;
        }
        if (wr == 0) PG8_BAR;
        E(acc, cur, wr, wc, fr, fq);
        if (!has_next) break;
#pragma unroll
        for (int a = 0; a < 2; ++a)
#pragma unroll
            for (int b = 0; b < 2; ++b)
#pragma unroll
                for (int m = 0; m < 4; ++m)
#pragma unroll
                    for (int n = 0; n < 2; ++n) acc[a][b][m][n] = (f32x4){0.f, 0.f, 0.f, 0.f};
        cur = nxt; cB = nB; ++ui;
        if (wr == 1) PG8_BAR;
    }
    PG8_WAIT_V(0);
    PG8_BAR;
#undef PG8_SA
#undef PG8_SB
#undef PG8_STAGE_A
#undef PG8_STAGE_B
#undef PG8_LDA
#undef PG8_LDB
#undef PG8_MMA
#undef PG8_CAT
#undef PG8_WAIT_V
#undef PG8_WAIT_L
#undef PG8_BAR
#undef PG8_SCHED
}
struct DenseSched {
    int nM, nN, G, c, K, lda, acol0; const char* Bt;
    __device__ __forceinline__ bool next(int i, GUnit& u) const {
        const int nwg = nM * nN; const long L = (long)i * G + c; if (L >= nwg) return false;
        int wgid = (int)L; { const int q = nwg / NXCD, r = nwg % NXCD, xcd = wgid % NXCD, off = wgid / NXCD; wgid = (xcd < r ? xcd * (q + 1) : r * (q + 1) + (xcd - r) * q) + off; }
        const int nig = WGM * nN, gid = wgid / nig, fm = gid * WGM, gsz = (nM - fm) < WGM ? (nM - fm) : WGM;
        u.pm = fm + ((wgid % nig) % gsz); u.pn = (wgid % nig) / gsz; u.e = 0; u.arow = u.pm * BM; u.li = i; u.B = Bt + (size_t)u.pn * BM * K * 2; return true;
    }
    __device__ __forceinline__ void aoffs(const GUnit& u, int tid, unsigned (&vo)[2][2]) const {
#pragma unroll
        for (int i = 0; i < 2; ++i) { int R, C; stage_rc(tid * 16 + i * 8192, R, C);
#pragma unroll
            for (int h = 0; h < 2; ++h) vo[h][i] = (unsigned)((u.arow + R + 128 * h) * lda + acol0 + C) * 2u; }
    }
};
template <int NT, bool GATHER, bool FP8 = false> struct MoeSched {
    int G, c; const LAS int* tile; const LAS unsigned* lst; const char* W; int wrows;
    __device__ __forceinline__ bool next(int i, GUnit& u) const {
        constexpr int RPG = 32 / NT; const int L = i * G + c, x = L & 7, j = L >> 3, grp = j >> 5, jj = j & 31;
        const int rt = (grp * 8 + x) * RPG + (jj % RPG), pn = jj / RPG; if (rt >= tile[300]) return false;
        const int e = tile[rt]; u.pm = rt; u.pn = pn; u.e = e; u.arow = rt * BM; u.li = i; u.B = W + ((size_t)e * wrows + pn * BM) * (FP8 ? 1024 : 2048); return true;
    }
    __device__ __forceinline__ void aoffs(const GUnit& u, int tid, unsigned (&vo)[2][2]) const {
#pragma unroll
        for (int i = 0; i < 2; ++i) { int R, C; stage_rc(tid * 16 + i * 8192, R, C);
#pragma unroll
            for (int h = 0; h < 2; ++h) vo[h][i] = GATHER ? lst[u.li * 256 + R + 128 * h] + (unsigned)C * 2u : (unsigned)((u.arow + R + 128 * h) * (FP8 ? 1024 : 2048) + C * 2); }
    }
};
__device__ __forceinline__ u32x4 pack8(f32x4 a, f32x4 b) { u32x4 w; w.x = pk2(a.x, a.y); w.y = pk2(a.z, a.w); w.z = pk2(b.x, b.y); w.w = pk2(b.z, b.w); return w; }
#define PG8_EPI_LOOP _Pragma("unroll") for (int ai = 0; ai < 2; ++ai) _Pragma("unroll") for (int m = 0; m < 4; ++m)
struct EpiRowMajor { bf16_t* O; int ldo;
    __device__ __forceinline__ void operator()(const f32x4 (&acc)[2][2][4][2], const GUnit& u, int wr, int wc, int fr, int fq) const {
        PG8_EPI_LOOP { bf16_t* rp = O + (size_t)(u.arow + 128 * ai + 64 * wr + 16 * m + fr) * ldo + u.pn * BM + 32 * wc + 8 * fq;
#pragma unroll
            for (int bj = 0; bj < 2; ++bj) *(u32x4*)(rp + 128 * bj) = pack8(acc[ai][bj][m][0], acc[ai][bj][m][1]); }
    }
};
constexpr float QPRESCALE = 0.07216878364870322f * 1.4426950408889634f;
struct EpiQ { unsigned char* ws;
    __device__ __forceinline__ void operator()(const f32x4 (&acc)[2][2][4][2], const GUnit& u, int wr, int wc, int fr, int fq) const {
        const float* RS = (const float*)(ws + WS_RSTAT); const float* ct = (const float*)(ws + WS_ROPE); const float* st = ct + 2048; bf16_t* Q = (bf16_t*)(ws + WS_Q);
        PG8_EPI_LOOP { const int row = u.arow + 128 * ai + 64 * wr + 16 * m + fr; const float rinv = RS[2 * row] * (ATT_QK8 ? QPRESCALE * 16.f : QPRESCALE); const int b = row >> 13, t = row & 8191, prow = t >> 6, pcol = t & 63;
#pragma unroll
            for (int bj = 0; bj < 2; ++bj) { const int col = u.pn * BM + 128 * bj + 32 * wc + 8 * fq; if (col >= NH * DQK) continue;
                const int hd = col / DQK, d = col - hd * DQK; f32x4 v0 = acc[ai][bj][m][0] * rinv, v1 = acc[ai][bj][m][1] * rinv;
                if (d >= DNOPE) { const int pi = (d - DNOPE) >> 1, pos = pi < 16 ? prow : pcol, j = pi & 15; const f32x4 cs = *(const f32x4*)(ct + pos * 16 + j), sn = *(const f32x4*)(st + pos * 16 + j);
                    const f32x4 a = v0, c2 = v1; v0.x = a.x * cs.x - a.y * sn.x; v0.y = a.x * sn.x + a.y * cs.x; v0.z = a.z * cs.y - a.w * sn.y; v0.w = a.z * sn.y + a.w * cs.y;
                    v1.x = c2.x * cs.z - c2.y * sn.z; v1.y = c2.x * sn.z + c2.y * cs.z; v1.z = c2.z * cs.w - c2.w * sn.w; v1.w = c2.z * sn.w + c2.w * cs.w; }
                if constexpr (ATT_QK8) { u32x2 w8; w8.x = pg8_pk4_fp8(v0); w8.y = pg8_pk4_fp8(v1); *(u32x2*)((unsigned char*)Q + ((size_t)(b * NH + hd) * SEQ + t) * DQK + d) = w8; }
                else *(u32x4*)(Q + ((size_t)(b * NH + hd) * SEQ + t) * DQK + d) = pack8(v0, v1); }
            asm volatile("" ::: "memory"); }
    }
};
struct EpiKV { unsigned char* ws;
    __device__ __forceinline__ void operator()(const f32x4 (&acc)[2][2][4][2], const GUnit& u, int wr, int wc, int fr, int fq) const {
        const float* RS = (const float*)(ws + WS_RSTAT); bf16_t* KNp = (bf16_t*)(ws + WS_KN); bf16_t* Vp = (bf16_t*)(ws + WS_V);
        PG8_EPI_LOOP { const int row = u.arow + 128 * ai + 64 * wr + 16 * m + fr; const float rinv = RS[2 * row + 1]; int b, tt; if (row < ML) { b = row >> 13; tt = row & 8191; } else { b = (row - ML) >> 8; tt = SEQ + ((row - ML) & 255); }
            const size_t ro = ((size_t)(b * NH + u.pn) * TK + tt) * 128 + 32 * wc + 8 * fq;
            if constexpr (ATT_QK8) { u32x2 w8; w8.x = pg8_pk4_fp8(acc[ai][0][m][0] * rinv); w8.y = pg8_pk4_fp8(acc[ai][0][m][1] * rinv); *(u32x2*)((unsigned char*)KNp + ro) = w8; }
            else *(u32x4*)(KNp + ro) = pack8(acc[ai][0][m][0] * rinv, acc[ai][0][m][1] * rinv);
            if constexpr (ATT_PV8) { u32x2 w8; w8.x = pg8_pk4_fp8(acc[ai][1][m][0] * rinv); w8.y = pg8_pk4_fp8(acc[ai][1][m][1] * rinv); *(u32x2*)((unsigned char*)Vp + ro) = w8; }
            else *(u32x4*)(Vp + ro) = pack8(acc[ai][1][m][0] * rinv, acc[ai][1][m][1] * rinv);
            asm volatile("" ::: "memory"); }
    }
};
struct EpiAct { bf16_t* ACT; const float* bg; const float* bu;
    __device__ __forceinline__ void operator()(const f32x4 (&acc)[2][2][4][2], const GUnit& u, int wr, int wc, int fr, int fq) const {
        const int ac = u.pn * 128 + 32 * wc + 8 * fq; const float* pg = bg + u.e * 1024 + ac; const float* pu = bu + u.e * 1024 + ac;
        const f32x4 g0 = *(const f32x4*)pg, g1 = *(const f32x4*)(pg + 4), u0 = *(const f32x4*)pu, u1 = *(const f32x4*)(pu + 4);
        PG8_EPI_LOOP { const int slot = u.arow + 128 * ai + 64 * wr + 16 * m + fr;
            *(u32x4*)(ACT + (size_t)slot * 1024 + ac) = pack8(act4(acc[ai][0][m][0] + g0, acc[ai][1][m][0] + u0), act4(acc[ai][0][m][1] + g1, acc[ai][1][m][1] + u1)); }
    }
};
__device__ __forceinline__ unsigned pk4_fp8(f32x4 v) { int p = __builtin_amdgcn_cvt_pk_fp8_f32(v.x, v.y, 0, false); p = __builtin_amdgcn_cvt_pk_fp8_f32(v.z, v.w, p, true); return (unsigned)p; }
struct EpiAct8 { unsigned char* ACT; const float* bg; const float* bu; float sc;
    __device__ __forceinline__ void operator()(const f32x4 (&acc)[2][2][4][2], const GUnit& u, int wr, int wc, int fr, int fq) const {
        const int ac = u.pn * 128 + 32 * wc + 8 * fq; const float* pg = bg + u.e * 1024 + ac; const float* pu = bu + u.e * 1024 + ac;
        const f32x4 g0 = *(const f32x4*)pg, g1 = *(const f32x4*)(pg + 4), u0 = *(const f32x4*)pu + 1.f, u1 = *(const f32x4*)(pu + 4) + 1.f;
        PG8_EPI_LOOP { const int slot = u.arow + 128 * ai + 64 * wr + 16 * m + fr; u32x2 w;
            w.x = pk4_fp8(act4p(acc[ai][0][m][0] * sc + g0, acc[ai][1][m][0] * sc + u0)); w.y = pk4_fp8(act4p(acc[ai][0][m][1] * sc + g1, acc[ai][1][m][1] * sc + u1));
            *(u32x2*)(ACT + (size_t)slot * 1024 + ac) = w; }
    }
};
struct EpiY { bf16_t* Y; const float* bd; float sc;
    __device__ __forceinline__ void operator()(const f32x4 (&acc)[2][2][4][2], const GUnit& u, int wr, int wc, int fr, int fq) const {
        const int c0 = u.pn * BM + 32 * wc + 8 * fq; const float* pb = bd + u.e * 1024 + c0;
        const f32x4 b00 = *(const f32x4*)pb, b01 = *(const f32x4*)(pb + 4), b10 = *(const f32x4*)(pb + 128), b11 = *(const f32x4*)(pb + 132);
        PG8_EPI_LOOP { const int slot = u.arow + 128 * ai + 64 * wr + 16 * m + fr; bf16_t* rp = Y + (size_t)slot * 1024 + c0;
            *(u32x4*)rp = pack8(acc[ai][0][m][0] * sc + b00, acc[ai][0][m][1] * sc + b01); *(u32x4*)(rp + 128) = pack8(acc[ai][1][m][0] * sc + b10, acc[ai][1][m][1] * sc + b11); }
    }
};
struct EpiY8 { unsigned char* Y; const float* bd; float sc;
    __device__ __forceinline__ void operator()(const f32x4 (&acc)[2][2][4][2], const GUnit& u, int wr, int wc, int fr, int fq) const {
        const int c0 = u.pn * BM + 32 * wc + 8 * fq; const float* pb = bd + u.e * 1024 + c0;
        const f32x4 b00 = *(const f32x4*)pb, b01 = *(const f32x4*)(pb + 4), b10 = *(const f32x4*)(pb + 128), b11 = *(const f32x4*)(pb + 132);
        PG8_EPI_LOOP { const int slot = u.arow + 128 * ai + 64 * wr + 16 * m + fr; unsigned char* rp = Y + (size_t)slot * 1024 + c0; u32x2 w0, w1;
            w0.x = pk4_fp8(acc[ai][0][m][0] * sc + b00); w0.y = pk4_fp8(acc[ai][0][m][1] * sc + b01); w1.x = pk4_fp8(acc[ai][1][m][0] * sc + b10); w1.y = pk4_fp8(acc[ai][1][m][1] * sc + b11);
            *(u32x2*)rp = w0; *(u32x2*)(rp + 128) = w1; }
    }
};
#undef PG8_EPI_LOOP
}


namespace att {
typedef short s16x4 __attribute__((ext_vector_type(4)));
constexpr int NW = 8, QBLK = 32, KVBLK = 64, NTILE = 66, HALFKEYS = NTILE * KVBLK;
constexpr float SCALE = 0.07216878364870322f, THR = 8.f;
constexpr int SHM_V = KVBLK * 128 * (ATT_PV8 ? 1 : 2), SHM_K = KVBLK * 128 * (ATT_QK8 ? 1 : 2), SHM_R = KVBLK * 64 * (ATT_QK8 ? 1 : 2);
__device__ __forceinline__ int crow(int r, int hi) { return (r & 3) + 8 * (r >> 2) + 4 * hi; }
__device__ __forceinline__ unsigned cvtpk(float lo, float hi) { return pk2(lo, hi); }
__device__ __forceinline__ int v_rd_base(int lane) { return ((lane & 3) << 3) | (((lane >> 2) & 3) << 6) | (((lane >> 4) & 1) << 5) | (((lane >> 5) & 1) << 8); }
constexpr int v_rd_off(int d0, int ks, int half) { return d0 * 512 + ks * 4096 + half * 2048; }
constexpr int SLOT_B = SHM_K + SHM_R + SHM_V, SL_K = 0, SL_R = SHM_K, SL_V = SHM_K + SHM_R, DMA_WS = 3 * SLOT_B, ATT_DMA_LDS = DMA_WS + NW * 64 * 4;
#define RSWZ(row, colB) ((row) * 128 + ((colB) ^ ((((row) >> 1) & 7) << 4)))
#define SBAR() __builtin_amdgcn_sched_barrier(0)
__device__ __forceinline__ float max3(float a, float b, float c) { return __builtin_elementwise_maximum(__builtin_elementwise_maximum(a, b), c); }
__device__ __forceinline__ float sm_max(const f32x16& p0, const f32x16& p1) {
  float a = max3(p0[0], p0[1], p0[2]), b = max3(p0[3], p0[4], p0[5]), c = max3(p1[0], p1[1], p1[2]), d = max3(p1[3], p1[4], p1[5]);
  a = max3(a, p0[6], p0[7]); b = max3(b, p0[8], p0[9]); c = max3(c, p1[6], p1[7]); d = max3(d, p1[8], p1[9]);
  a = max3(a, p0[10], p0[11]); b = max3(b, p0[12], p0[13]); c = max3(c, p1[10], p1[11]); d = max3(d, p1[12], p1[13]);
  a = max3(a, p0[14], p0[15]); c = max3(c, p1[14], p1[15]);
  return max3(a, b, max3(c, d, d));
}
__device__ __forceinline__ float sm_xhalf(float pmax) {
  auto rr = __builtin_amdgcn_permlane32_swap(__float_as_uint(pmax), __float_as_uint(pmax), false, false);
  return max3(__uint_as_float(rr[0]), __uint_as_float(rr[1]), __uint_as_float(rr[1]));
}
#if ATT_PV8
__device__ __forceinline__ int kperm(int i) { return 16 * ((i >> 2) & 1) + 4 * (i >> 3) + (i & 3); }
#else
__device__ __forceinline__ int kperm(int i) { const int a = i >> 3, h = (i >> 2) & 1, b = i & 3; return 16 * (a >> 1) + 8 * h + 4 * (a & 1) + b; }
#endif
__device__ __forceinline__ s16x4 trv(int a) { return __builtin_amdgcn_ds_read_tr16_b64_v4i16((LAS s16x4*)(uintptr_t)(unsigned)a); }
#define QK_LD(s, slot) do { if ((s) < 4) { f0[slot] = *(const LAS bf16x8*)(uintptr_t)(unsigned)(ka[(s)]); f1[slot] = *(const LAS bf16x8*)(uintptr_t)(unsigned)(ka[(s)] + 8192); } \
    else if ((s) < 8) { f0[slot] = *(const LAS bf16x8*)(uintptr_t)(unsigned)(kha[(s) - 4]); f1[slot] = *(const LAS bf16x8*)(uintptr_t)(unsigned)(kha[(s) - 4] + 8192); } \
    else { f0[slot] = *(const LAS bf16x8*)(uintptr_t)(unsigned)(ra[(s) - 8]); f1[slot] = *(const LAS bf16x8*)(uintptr_t)(unsigned)(ra[(s) - 8] + 4096); } } while (0)
#ifndef PP_KD
#define PP_KD 3
#endif
#ifndef PP_VD
#define PP_VD 6
#endif
constexpr int KD = PP_KD, KR_ = KD + 1, VD = PP_VD, VR_ = 16;
__device__ __forceinline__ void pp_qkt_head(bf16x8 (&f0)[KR_], bf16x8 (&f1)[KR_], const int (&kb)[4], const int (&rb)[4], int khd, int soff) {
  int ka[4], kha[4], ra[4];
#pragma unroll
  for (int i = 0; i < 4; ++i) { ka[i] = kb[i] + soff; kha[i] = ka[i] + khd; ra[i] = rb[i] + soff; }
#pragma unroll
  for (int s = 0; s < KD; ++s) QK_LD(s, s);
}
#define PV_LD(n) do { L[(n) & 15] = trv(vb + v_rd_off((n) & 3, (n) >> 2, 0)); H[(n) & 15] = trv(vb + v_rd_off((n) & 3, (n) >> 2, 1)); } while (0)
#define PV_MFMA(n) do { const bf16x8 pa_ = ((n) >> 2) == 0 ? pa0 : ((n) >> 2) == 1 ? pa1 : ((n) >> 2) == 2 ? pa2 : pa3; const s16x4 l_ = L[(n) & 15], h_ = H[(n) & 15]; \
    o[(n) & 3] = __builtin_amdgcn_mfma_f32_32x32x16_bf16(pa_, (bf16x8){l_[0], l_[1], l_[2], l_[3], h_[0], h_[1], h_[2], h_[3]}, o[(n) & 3], 0, 0, 0); } while (0)
template <bool PV>
__device__ __forceinline__ void pp_mphase(f32x16& p0, f32x16& p1, f32x16* o, bf16x8 (&f0)[KR_], bf16x8 (&f1)[KR_], const int (&kb)[4], int khd, const int (&rb)[4], int soff, int vb, const bf16x8* qr,
                                          bf16x8 pa0, bf16x8 pa1, bf16x8 pa2, bf16x8 pa3, const f32x16& minit) {
  int ka[4], kha[4], ra[4]; s16x4 L[VR_], H[VR_];
#pragma unroll
  for (int i = 0; i < 4; ++i) { ka[i] = kb[i] + soff; kha[i] = ka[i] + khd; ra[i] = rb[i] + soff; }
#pragma unroll
  for (int s = 0; s < 12; ++s) {
    if (s + KD < 12) QK_LD(s + KD, (s + KD) % KR_);
    else if (PV) { if (2 * (s + KD - 12) < VD) PV_LD(2 * (s + KD - 12)); if (2 * (s + KD - 12) + 1 < VD) PV_LD(2 * (s + KD - 12) + 1); }
    SBAR();
    p0 = __builtin_amdgcn_mfma_f32_32x32x16_bf16(f0[s % KR_], qr[s], s == 0 ? minit : p0, 0, 0, 0);
    p1 = __builtin_amdgcn_mfma_f32_32x32x16_bf16(f1[s % KR_], qr[s], s == 0 ? minit : p1, 0, 0, 0);
    SBAR(); }
  if (PV) {
#pragma unroll
    for (int n = 2 * KD; n < VD; ++n) PV_LD(n);
#pragma unroll
    for (int n = 0; n < 16; ++n) { if (n + VD < 16) PV_LD(n + VD); SBAR(); PV_MFMA(n); SBAR(); } }
}
__device__ __forceinline__ void pp_pv(f32x16* o, int vb, bf16x8 pa0, bf16x8 pa1, bf16x8 pa2, bf16x8 pa3) {
  s16x4 L[VR_], H[VR_];
#pragma unroll
  for (int n = 0; n < VD; ++n) PV_LD(n);
#pragma unroll
  for (int n = 0; n < 16; ++n) { if (n + VD < 16) PV_LD(n + VD); SBAR(); PV_MFMA(n); SBAR(); }
}
#undef QK_LD
#if ATT_QK8
typedef int i32x4q __attribute__((ext_vector_type(4)));
typedef int i32x8q __attribute__((ext_vector_type(8)));
#define Q8_CAT(a, b) __builtin_shufflevector((a), (b), 0, 1, 2, 3, 4, 5, 6, 7)
#define Q8_LD(s, slot) do { const int a0_ = (s) < 2 ? kq[2 * (s)] : rq[0], a1_ = (s) < 2 ? kq[2 * (s) + 1] : rq[1]; constexpr int b1_ = (s) < 2 ? 32 * 128 : 32 * 64; \
    g0[slot] = Q8_CAT(*(const LAS i32x4q*)(uintptr_t)(unsigned)(a0_ + soff), *(const LAS i32x4q*)(uintptr_t)(unsigned)(a1_ + soff)); \
    g1[slot] = Q8_CAT(*(const LAS i32x4q*)(uintptr_t)(unsigned)(a0_ + soff + b1_), *(const LAS i32x4q*)(uintptr_t)(unsigned)(a1_ + soff + b1_)); } while (0)
typedef int i32x2q __attribute__((ext_vector_type(2)));
__device__ __forceinline__ i32x2q trv8(int a) { return __builtin_amdgcn_ds_read_tr8_b64_v2i32((LAS i32x2q*)(uintptr_t)(unsigned)a); }
#define PV8_LD(db) do { const int a_ = vb8[db] + voff; const i32x2q t0_ = trv8(a_), t1_ = trv8(a_ + 1024), t2_ = trv8(a_ + 4096), t3_ = trv8(a_ + 5120); \
    vf[db] = (i32x8q){t0_[0], t0_[1], t1_[0], t1_[1], t2_[0], t2_[1], t3_[0], t3_[1]}; } while (0)
__device__ __forceinline__ void pp8_head(i32x8q (&g0)[3], i32x8q (&g1)[3], const int (&kq)[4], const int (&rq)[2], int soff) { Q8_LD(0, 0); Q8_LD(1, 1); }
template <bool PV>
#if ATT_PV8
#define PP8_VARG const int (&vb8)[4], int voff
#else
#define PP8_VARG int vb
#endif
__device__ __forceinline__ void pp8_mphase(f32x16& p0, f32x16& p1, f32x16* o, i32x8q (&g0)[3], i32x8q (&g1)[3], const int (&kq)[4], const int (&rq)[2], int soff, PP8_VARG, const i32x8q (&qf)[3],
                                           bf16x8 pa0, bf16x8 pa1, bf16x8 pa2, bf16x8 pa3, const f32x16& minit) {
#if ATT_PV8
  i32x8q vf[4];
#else
  s16x4 L[VR_], H[VR_];
#endif
#pragma unroll
  for (int s = 0; s < 3; ++s) {
    if (s == 0) Q8_LD(2, 2);
#if ATT_PV8
    else if (PV) { PV8_LD(2 * (s - 1)); PV8_LD(2 * (s - 1) + 1); }
#else
    else if (PV) { PV_LD(3 * (s - 1)); PV_LD(3 * (s - 1) + 1); PV_LD(3 * (s - 1) + 2); }
#endif
    SBAR();
    p0 = __builtin_amdgcn_mfma_scale_f32_32x32x64_f8f6f4(g0[s], qf[s], s == 0 ? minit : p0, 0, 0, 0, 0x7F7F7F7F, 0, 0x7B7B7B7B);
    p1 = __builtin_amdgcn_mfma_scale_f32_32x32x64_f8f6f4(g1[s], qf[s], s == 0 ? minit : p1, 0, 0, 0, 0x7F7F7F7F, 0, 0x7B7B7B7B);
    SBAR(); }
  if (PV) {
#if ATT_PV8
    const i32x8q p8 = Q8_CAT(__builtin_bit_cast(i32x4q, pa0), __builtin_bit_cast(i32x4q, pa1));
#pragma unroll
    for (int db = 0; db < 4; ++db) { SBAR(); o[db] = __builtin_amdgcn_mfma_scale_f32_32x32x64_f8f6f4(p8, vf[db], o[db], 0, 0, 0, 0x7F7F7F7F, 0, 0x7F7F7F7F); SBAR(); }
#else
#pragma unroll
    for (int n = 0; n < 16; ++n) { if (n + VD < 16) PV_LD(n + VD); SBAR(); PV_MFMA(n); SBAR(); }
#endif
  }
}
#if ATT_PV8
__device__ __forceinline__ void pp_pv8(f32x16* o, const int (&vb8)[4], int voff, bf16x8 pa0, bf16x8 pa1) {
  i32x8q vf[4];
#pragma unroll
  for (int db = 0; db < 4; ++db) PV8_LD(db);
  const i32x8q p8 = Q8_CAT(__builtin_bit_cast(i32x4q, pa0), __builtin_bit_cast(i32x4q, pa1));
#pragma unroll
  for (int db = 0; db < 4; ++db) o[db] = __builtin_amdgcn_mfma_scale_f32_32x32x64_f8f6f4(p8, vf[db], o[db], 0, 0, 0, 0x7F7F7F7F, 0, 0x7F7F7F7F);
}
#endif
#undef Q8_LD
#undef PV8_LD
#endif
#undef PV_LD
#undef PV_MFMA
typedef float f32x2p __attribute__((ext_vector_type(2)));
__device__ __forceinline__ bf16x8 pp_pack8(const f32x16& p, int b) {
  u32x4 w = {cvtpk(p[b], p[b + 1]), cvtpk(p[b + 2], p[b + 3]), cvtpk(p[b + 4], p[b + 5]), cvtpk(p[b + 6], p[b + 7])}; return *reinterpret_cast<bf16x8*>(&w); }
__device__ __forceinline__ void pp_expsum(f32x16& p0, f32x16& p1, float& l_reg, bf16x8& pa0, bf16x8& pa1, bf16x8& pa2, bf16x8& pa3) {
  f32x2p s0 = {0.f, 0.f}, s1 = {0.f, 0.f};
#pragma unroll
  for (int r = 0; r < 16; r += 2) { f32x2p v = {__builtin_amdgcn_exp2f(p0[r]), __builtin_amdgcn_exp2f(p0[r + 1])}; s0 += v; p0[r] = v[0]; p0[r + 1] = v[1]; }
#pragma unroll
  for (int r = 0; r < 16; r += 2) { f32x2p v = {__builtin_amdgcn_exp2f(p1[r]), __builtin_amdgcn_exp2f(p1[r + 1])}; s1 += v; p1[r] = v[0]; p1[r + 1] = v[1]; }
  s0 += s1; l_reg += s0[0] + s0[1];
#if ATT_PV8
  { u32x4 w0, w1;
    w0.x = pg8_pk4_fp8((f32x4){p0[0], p0[1], p0[2], p0[3]}); w0.y = pg8_pk4_fp8((f32x4){p0[4], p0[5], p0[6], p0[7]}); w0.z = pg8_pk4_fp8((f32x4){p0[8], p0[9], p0[10], p0[11]}); w0.w = pg8_pk4_fp8((f32x4){p0[12], p0[13], p0[14], p0[15]});
    w1.x = pg8_pk4_fp8((f32x4){p1[0], p1[1], p1[2], p1[3]}); w1.y = pg8_pk4_fp8((f32x4){p1[4], p1[5], p1[6], p1[7]}); w1.z = pg8_pk4_fp8((f32x4){p1[8], p1[9], p1[10], p1[11]}); w1.w = pg8_pk4_fp8((f32x4){p1[12], p1[13], p1[14], p1[15]});
    pa0 = *reinterpret_cast<bf16x8*>(&w0); pa1 = *reinterpret_cast<bf16x8*>(&w1); }
#else
  pa0 = pp_pack8(p0, 0); pa1 = pp_pack8(p0, 8); pa2 = pp_pack8(p1, 0); pa3 = pp_pack8(p1, 8);
#endif
}
template <int NTT, bool FULL>
__device__ __forceinline__ void attn_unit_pp(const bf16_t* __restrict__ Qb, const bf16_t* __restrict__ Kh, const bf16_t* __restrict__ Vh, const bf16_t* __restrict__ Rh,
                                             float* __restrict__ Op, float* __restrict__ MLp, LAS unsigned char* lds, const int tid) {
  const int wid = __builtin_amdgcn_readfirstlane(tid >> 6), lane = tid & 63, r32 = lane & 31, hi = lane >> 5;
  const bool grpB = wid >= 4;
  LAS float* wsx = (LAS float*)(lds + DMA_WS) + wid * 64; LAS float* al_l = wsx + 32;
  float l_reg = 0; f32x16 o[4] = {}, minit = {};
#if ATT_QK8
  i32x8q qf[3];
#else
  bf16x8 qr[12];
#endif
  unsigned ko[2], vo[2], ro;
#if ATT_PV8
  { const int row = 8 * wid + (lane >> 3), cp = lane & 7, c = (((cp >> 1) ^ ((row >> 1) & 3)) << 1) | (cp & 1); vo[0] = (unsigned)(row * 128 + c * 16); vo[1] = 0; }
#else
#pragma unroll
  for (int i = 0; i < 2; ++i) { const int pc = 2 * wid + i;
    { const int s = pc * 64 + lane, sub = s >> 5, within = s & 31, kk = (sub >> 2) * 8 + (within >> 2), c = (sub & 3) * 32 + (within & 3) * 8;
      const int k = (kk & ~0xC) | ((kk & 4) << 1) | ((kk & 8) >> 1); vo[i] = (unsigned)(k * 128 + c) * 2u; } }
#endif
#if ATT_QK8
  { const int row = 8 * wid + (lane >> 3), c = (lane & 7) ^ ((row >> 1) & 7); ko[0] = (unsigned)(row * 128 + c * 16); ko[1] = 0; }
  { const int row = 16 * (wid & 3) + (lane >> 2), c = (lane & 3) ^ ((row >> 2) & 3); ro = (unsigned)(row * 64 + c * 16); }
#else
#pragma unroll
  for (int i = 0; i < 2; ++i) { const int pc = 2 * wid + i;
    { const int row = 4 * pc + (lane >> 4), cl = (lane & 15) ^ (row & 15); ko[i] = (unsigned)(row * 128 + cl * 8) * 2u; } }
  { const int row = 8 * wid + (lane >> 3), cl = (lane & 7) ^ ((row >> 1) & 7); ro = (unsigned)(row * 64 + cl * 8) * 2u; }
#endif
#if ATT_QK8
#define GL1(voff, sbase, l) do { unsigned sv_; asm volatile("s_mov_b32 %0, m0\n\ts_mov_b32 m0, %3\n\ts_nop 0\n\tglobal_load_lds_dwordx4 %1, %2\n\ts_mov_b32 m0, %0" : "=&s"(sv_) : "v"(voff), "s"(sbase), "s"(l) : "memory"); } while (0)
#define DMA_KR(t, slot) do { const char* kt_ = (const char*)Kh + (size_t)(t) * (KVBLK * 128); const char* rt_ = (const char*)Rh + (size_t)(t) * (KVBLK * 64); const unsigned sb_ = (unsigned)lb + (unsigned)(slot) * SLOT_B; \
    GL1(ko[0], kt_, sb_ + SL_K + wid * 1024); if (wid < 4) GL1(ro, rt_, sb_ + SL_R + wid * 1024); } while (0)
#define DMA_KR2(t, slot) do { const char* kt_ = (const char*)Kh + (size_t)(t) * (KVBLK * 128); const char* rt_ = (const char*)Rh + (size_t)(t) * (KVBLK * 64); const unsigned sb_ = (unsigned)lb + (unsigned)(slot) * SLOT_B; \
    GL1(ko[0], kt_, sb_ + SL_K + wid * 1024); GL1(ko[0], kt_ + 4096, sb_ + SL_K + (wid + 4) * 1024); GL1(ro, rt_, sb_ + SL_R + wid * 1024); } while (0)
#else
#define DMA_KR(t, slot) do { const char* kt_ = (const char*)Kh + (size_t)(t) * (KVBLK * 256); const char* rt_ = (const char*)Rh + (size_t)(t) * (KVBLK * 128); const unsigned sb_ = (unsigned)lb + (unsigned)(slot) * SLOT_B; unsigned sv_; \
    asm volatile("s_mov_b32 %0, m0\n\ts_mov_b32 m0, %5\n\ts_nop 0\n\tglobal_load_lds_dwordx4 %1, %4\n\ts_mov_b32 m0, %6\n\ts_nop 0\n\tglobal_load_lds_dwordx4 %2, %4\n\ts_mov_b32 m0, %8\n\ts_nop 0\n\tglobal_load_lds_dwordx4 %3, %7\n\ts_mov_b32 m0, %0" \
                 : "=&s"(sv_) : "v"(ko[0]), "v"(ko[1]), "v"(ro), "s"(kt_), "s"(sb_ + SL_K + (2 * wid) * 1024), "s"(sb_ + SL_K + (2 * wid + 1) * 1024), "s"(rt_), "s"(sb_ + SL_R + wid * 1024) : "memory"); } while (0)
#define DMA_KR2(t, slot) do { const char* kt_ = (const char*)Kh + (size_t)(t) * (KVBLK * 256); const char* rt_ = (const char*)Rh + (size_t)(t) * (KVBLK * 128); const unsigned sb_ = (unsigned)lb + (unsigned)(slot) * SLOT_B; unsigned sv_; \
    asm volatile("s_mov_b32 %0, m0\n\ts_mov_b32 m0, %5\n\ts_nop 0\n\tglobal_load_lds_dwordx4 %1, %4\n\ts_mov_b32 m0, %6\n\ts_nop 0\n\tglobal_load_lds_dwordx4 %2, %4\n\ts_mov_b32 m0, %8\n\ts_nop 0\n\tglobal_load_lds_dwordx4 %3, %7\n\t" \
                 "s_mov_b32 m0, %10\n\ts_nop 0\n\tglobal_load_lds_dwordx4 %1, %9\n\ts_mov_b32 m0, %11\n\ts_nop 0\n\tglobal_load_lds_dwordx4 %2, %9\n\ts_mov_b32 m0, %13\n\ts_nop 0\n\tglobal_load_lds_dwordx4 %3, %12\n\ts_mov_b32 m0, %0" \
                 : "=&s"(sv_) : "v"(ko[0]), "v"(ko[1]), "v"(ro), "s"(kt_), "s"(sb_ + SL_K + (2 * wid) * 1024), "s"(sb_ + SL_K + (2 * wid + 1) * 1024), "s"(rt_), "s"(sb_ + SL_R + wid * 1024), \
                   "s"(kt_ + 8192), "s"(sb_ + SL_K + (2 * wid + 8) * 1024), "s"(sb_ + SL_K + (2 * wid + 9) * 1024), "s"(rt_ + 4096), "s"(sb_ + SL_R + (wid + 4) * 1024) : "memory"); } while (0)
#endif
#if ATT_PV8
#define DMA_V(t, slot) do { const char* vt_ = (const char*)Vh + (size_t)(t) * (KVBLK * 128); const unsigned sb_ = (unsigned)lb + (unsigned)(slot) * SLOT_B; GL1(vo[0], vt_, sb_ + SL_V + wid * 1024); } while (0)
#else
#define DMA_V(t, slot) do { const char* vt_ = (const char*)Vh + (size_t)(t) * (KVBLK * 256); const unsigned sb_ = (unsigned)lb + (unsigned)(slot) * SLOT_B; unsigned sv_; \
    asm volatile("s_mov_b32 %0, m0\n\ts_mov_b32 m0, %4\n\ts_nop 0\n\tglobal_load_lds_dwordx4 %1, %3\n\ts_mov_b32 m0, %5\n\ts_nop 0\n\tglobal_load_lds_dwordx4 %2, %3\n\ts_mov_b32 m0, %0" \
                 : "=&s"(sv_) : "v"(vo[0]), "v"(vo[1]), "s"(vt_), "s"(sb_ + SL_V + (2 * wid) * 1024), "s"(sb_ + SL_V + (2 * wid + 1) * 1024) : "memory"); } while (0)
#endif
#define BAR() do { SBAR(); asm volatile("" ::: "memory"); __builtin_amdgcn_s_barrier(); asm volatile("" ::: "memory"); SBAR(); } while (0)
#define MBAR(n) do { SBAR(); asm volatile("s_waitcnt vmcnt(" #n ") lgkmcnt(0)" ::: "memory"); __builtin_amdgcn_s_barrier(); asm volatile("" ::: "memory"); SBAR(); } while (0)
#define RESC(a) do { if (__any((a) < 1.f)) { if (hi == 0) al_l[r32] = (a); asm volatile("s_waitcnt lgkmcnt(0)" ::: "memory"); \
    _Pragma("unroll") for (int d = 0; d < 4; ++d) _Pragma("unroll") for (int r = 0; r < 16; ++r) o[d][r] *= al_l[crow(r, hi)]; } } while (0)
#define VPHASE(FIRST) do { const float relh = sm_max(p0, p1);     \
    if ((FIRST) || __any(relh > (ATT_PV8 ? 8.75f : THR * 1.4426950408889634f))) { const float rel = sm_xhalf(relh), dl = ((FIRST) ? rel : fmaxf(rel, 0.f)) - (ATT_PV8 ? 4.f : 0.f), al = __builtin_amdgcn_exp2f(-dl);     \
      _Pragma("unroll") for (int r = 0; r < 16; ++r) { p0[r] -= dl; p1[r] -= dl; minit[r] -= dl; }     \
      l_reg *= al; RESC(al); } \
    pp_expsum(p0, p1, l_reg, pa0, pa1, pa2, pa3); } while (0)
  constexpr int NT = NTT;
  const int lb = __builtin_amdgcn_readfirstlane((int)(uintptr_t)lds);
  DMA_KR(0, 0); DMA_KR(1, 1); DMA_V(0, 0);
#if ATT_QK8
  { const char* qp = (const char*)Qb + (unsigned)((wid * QBLK + r32) * DQK + hi * 16);
#pragma unroll
    for (int j = 0; j < 3; ++j) qf[j] = Q8_CAT(*reinterpret_cast<const i32x4q*>(qp + 64 * j), *reinterpret_cast<const i32x4q*>(qp + 64 * j + 32)); }
#if ATT_PV8
  int vb8[4];
#pragma unroll
  for (int db = 0; db < 4; ++db) { const int i16 = lane & 15; vb8[db] = lb + SL_V + (16 * hi + (i16 >> 1)) * 128 + ((db ^ ((i16 >> 2) & 3)) * 32) + 16 * ((lane >> 4) & 1) + 8 * (i16 & 1); }
#else
  const int vbase = lb + SL_V + v_rd_base(lane);
#endif
  int kq[4], rq[2];
  { const int kr = kperm(r32);
#pragma unroll
    for (int i = 0; i < 4; ++i) kq[i] = lb + SL_K + kr * 128 + ((((i >> 1) * 4 + (i & 1) * 2 + hi) ^ ((kr >> 1) & 7)) << 4);
#pragma unroll
    for (int i = 0; i < 2; ++i) rq[i] = lb + SL_R + kr * 64 + (((i * 2 + hi) ^ ((kr >> 2) & 3)) << 4); }
  i32x8q g0[3], g1[3];
#else
  { const unsigned qo = (unsigned)((wid * QBLK + r32) * DQK + hi * 8) * 2u;
#pragma unroll
    for (int d0 = 0; d0 < 12; ++d0) qr[d0] = *reinterpret_cast<const bf16x8*>((const char*)Qb + qo + d0 * 32); }
  const int vbase = lb + SL_V + v_rd_base(lane);
  int kb[4], rb[4];
#pragma unroll
  for (int i = 0; i < 4; ++i) { const int cb = (i * 16 + hi * 8) * 2, kr = kperm(r32); kb[i] = lb + SL_K + kr * 256 + ((((2 * i + hi) ^ (kr & 7)) + 8 * ((kr >> 3) & 1)) << 4); rb[i] = lb + SL_R + RSWZ(kr, cb); }
  const int khd = ((kperm(r32) >> 3) & 1) ? -128 : 128;
  bf16x8 f0[KR_], f1[KR_];
#endif
  f32x16 p0, p1; bf16x8 pa0 = {}, pa1 = {}, pa2 = {}, pa3 = {};
  MBAR(0);
  if (grpB) BAR();
#if ATT_QK8
#if ATT_PV8
  pp8_head(g0, g1, kq, rq, 0); pp8_mphase<false>(p0, p1, o, g0, g1, kq, rq, 0, vb8, 0, qf, pa0, pa0, pa0, pa0, minit);
#else
  pp8_head(g0, g1, kq, rq, 0); pp8_mphase<false>(p0, p1, o, g0, g1, kq, rq, 0, 0, qf, pa0, pa0, pa0, pa0, minit);
#endif
#else
  pp_qkt_head(f0, f1, kb, rb, khd, 0); pp_mphase<false>(p0, p1, o, f0, f1, kb, khd, rb, 0, 0, qr, pa0, pa0, pa0, pa0, minit);
#endif
  MBAR(0);
  int sa = 0, sb = 1, sc = 2;
#pragma nounroll
  for (int t = 0; t + 1 < NT; ++t) {
    if (t + 2 < NT && !grpB) DMA_KR2(t + 2, sc);
    DMA_V(t + 1, sb);
    VPHASE(t == 0);
#if ATT_QK8
    pp8_head(g0, g1, kq, rq, sb * SLOT_B);
#else
    pp_qkt_head(f0, f1, kb, rb, khd, sb * SLOT_B);
#endif
    BAR();
#if ATT_QK8
#if ATT_PV8
    pp8_mphase<true>(p0, p1, o, g0, g1, kq, rq, sb * SLOT_B, vb8, sa * SLOT_B, qf, pa0, pa1, pa2, pa3, minit);
#else
    pp8_mphase<true>(p0, p1, o, g0, g1, kq, rq, sb * SLOT_B, vbase + sa * SLOT_B, qf, pa0, pa1, pa2, pa3, minit);
#endif
#else
    pp_mphase<true>(p0, p1, o, f0, f1, kb, khd, rb, sb * SLOT_B, vbase + sa * SLOT_B, qr, pa0, pa1, pa2, pa3, minit);
#endif
    MBAR(0);
    { const int tmp = sa; sa = sb; sb = sc; sc = tmp; }
  }
  VPHASE(NT == 1);
  BAR();
#if ATT_PV8
  pp_pv8(o, vb8, sa * SLOT_B, pa0, pa1);
#else
  pp_pv(o, vbase + sa * SLOT_B, pa0, pa1, pa2, pa3);
#endif
  asm volatile("s_waitcnt vmcnt(0)" ::: "memory");
  if (!grpB) BAR();
  { auto rr = __builtin_amdgcn_permlane32_swap(__float_as_uint(l_reg), __float_as_uint(l_reg), false, false); l_reg = __uint_as_float(rr[0]) + __uint_as_float(rr[1]); }
  if constexpr (FULL) {
    if (hi == 0) wsx[r32] = l_reg; asm volatile("s_waitcnt lgkmcnt(0)" ::: "memory");
    const unsigned oo = (unsigned)((wid * QBLK + 4 * hi) * D + r32) * 2u;
#pragma unroll
    for (int r = 0; r < 16; ++r) { const float rl = __builtin_amdgcn_rcpf(wsx[crow(r, hi)]);
#pragma unroll
      for (int d0 = 0; d0 < 4; ++d0) *(bf16_t*)((char*)Op + oo + (unsigned)(((r & 3) + 8 * (r >> 2)) * D + d0 * 32) * 2u) = (bf16_t)f2bf(o[d0][r] * rl); }
  } else {
    if (hi == 0) { *(float2*)((char*)MLp + (unsigned)(wid * QBLK + r32) * 8u) = make_float2(-minit[0], l_reg); }
    const unsigned oo = (unsigned)((wid * QBLK + 4 * hi) * 128 + r32) * 4u;
#pragma unroll
    for (int r = 0; r < 16; ++r)
#pragma unroll
      for (int d0 = 0; d0 < 4; ++d0) *(float*)((char*)Op + oo + (unsigned)(((r & 3) + 8 * (r >> 2)) * 128 + d0 * 32) * 4u) = o[d0][r]; }
#undef DMA_KR
#undef DMA_KR2
#ifdef GL1
#undef GL1
#endif
#undef DMA_V
#undef BAR
#undef MBAR
#undef RESC
#undef VPHASE
}
#undef RSWZ
#undef SBAR
}
#ifndef ATTN_UNIT
#define ATTN_UNIT attn_unit_pp
#endif
constexpr size_t QKB = ATT_QK8 ? 1 : 2, PVB = ATT_PV8 ? 1 : 2;
__device__ __forceinline__ void ph_attn(const P& p, int wg, int nwg, LAS unsigned char* lds, const int wv) {
    unsigned char* ws = p.ws;
    { for (int L = wg; L < 256; L += nwg) { const int bh = L & 7, qb = (L >> 3) & 31, b = bh / NH, h = bh - b * NH;
        const int tid = fresh_tid(wv);
        __syncthreads();
        att::ATTN_UNIT<2 * att::NTILE, true>((const bf16_t*)(ws + WS_Q + ((size_t)bh * SEQ + qb * 256) * DQK * QKB), (const bf16_t*)(ws + WS_KN + (size_t)bh * TK * 128 * QKB),
                   (const bf16_t*)(ws + WS_V + (size_t)bh * TK * 128 * PVB), (const bf16_t*)(ws + WS_KR + (size_t)b * TK * 64 * QKB),
                   (float*)((bf16_t*)(ws + WS_MIXA) + ((size_t)b * SEQ + qb * 256) * D + h * 128), nullptr, lds, tid); } }
    { for (int L = wg; L < 256; L += nwg) { const int x = L & 7, qb = (L >> 3) & 31, bh = 8 + (x >> 1), half = x & 1, b = bh / NH, key0 = half * att::HALFKEYS, pidx = ((bh - 8) * 32 + qb) * 2 + half;
        const int tid = fresh_tid(wv);
        __syncthreads();
        att::ATTN_UNIT<att::NTILE, false>((const bf16_t*)(ws + WS_Q + ((size_t)bh * SEQ + qb * 256) * DQK * QKB), (const bf16_t*)(ws + WS_KN + ((size_t)bh * TK + key0) * 128 * QKB),
                   (const bf16_t*)(ws + WS_V + ((size_t)bh * TK + key0) * 128 * PVB), (const bf16_t*)(ws + WS_KR + ((size_t)b * TK + key0) * 64 * QKB),
                   (float*)(ws + WS_OPART) + (size_t)pidx * 32768, (float*)(ws + WS_OML) + (size_t)pidx * 512, lds, tid); } }
}
__device__ __forceinline__ void ph_acomb(const P& p, int wg, int nwg, int tid) {
    const int lane = tid & 63, gw = wg * 8 + (tid >> 6), ngw = nwg * 8; unsigned char* ws = p.ws;
    const float* OP = (const float*)(ws + WS_OPART); const float* OML = (const float*)(ws + WS_OML); bf16_t* MIXA = (bf16_t*)(ws + WS_MIXA);
    for (int rw = gw; rw < 4 * 32 * 256; rw += ngw) {
        const int pp = rw >> 8, r = rw & 255, bh = 8 + (pp >> 5), qb = pp & 31, b = bh / NH, h = bh - b * NH;
        const float2 ml1 = *(const float2*)(OML + ((size_t)(pp * 2) * 256 + r) * 2), ml2 = *(const float2*)(OML + ((size_t)(pp * 2 + 1) * 256 + r) * 2);
        typedef float f32x2v __attribute__((ext_vector_type(2)));
        const f32x2v o1 = __builtin_nontemporal_load((const f32x2v*)(OP + ((size_t)(pp * 2) * 256 + r) * 128 + 2 * lane)), o2 = __builtin_nontemporal_load((const f32x2v*)(OP + ((size_t)(pp * 2 + 1) * 256 + r) * 128 + 2 * lane));
        const float M = fmaxf(ml1.x, ml2.x), w1 = __builtin_amdgcn_exp2f(ml1.x - M), w2 = __builtin_amdgcn_exp2f(ml2.x - M), inv = 1.f / (ml1.y * w1 + ml2.y * w2);
        *(unsigned*)(MIXA + ((size_t)b * SEQ + qb * 256 + r) * D + h * 128 + 2 * lane) = pk2((o1.x * w1 + o2.x * w2) * inv, (o1.y * w1 + o2.y * w2) * inv);
    }
}

namespace fou {
typedef short s16x4 __attribute__((ext_vector_type(4)));
template <int OFF> __device__ __forceinline__ s16x4 tr_read(int vb) { s16x4 r; asm volatile("ds_read_b64_tr_b16 %0, %1 offset:%2" : "=&v"(r) : "v"(vb), "i"(OFF) : "memory"); return r; }
__device__ __forceinline__ int rd_base(int lane) { return ((lane & 3) << 3) | (((lane >> 2) & 3) << 6) | (((lane >> 4) & 1) << 5) | (((lane >> 5) & 1) << 8); }
__device__ __forceinline__ int img_off(int k, int c) { const int kk = (k & ~0xC) | ((k & 4) << 1) | ((k & 8) >> 1); return ((kk >> 3) * 2 + (c >> 5)) * 512 + ((kk & 7) * 32 + (c & 31)) * 2; }
#define FOU_PK(L, H) (bf16x8){L[0], L[1], L[2], L[3], H[0], H[1], H[2], H[3]}
template <int KS> __device__ __forceinline__ void a_step(f32x16& yr, f32x16& yi, int vb, const bf16x8 (&ar)[16], const bf16x8 (&ai)[16]) {
    const s16x4 l = tr_read<KS * 2048>(vb), h = tr_read<KS * 2048 + 1024>(vb);
    asm volatile("s_waitcnt lgkmcnt(0)" ::: "memory"); __builtin_amdgcn_sched_barrier(0);
    const bf16x8 bb = FOU_PK(l, h);
    yr = __builtin_amdgcn_mfma_f32_32x32x16_bf16(ar[KS], bb, yr, 0, 0, 0); yi = __builtin_amdgcn_mfma_f32_32x32x16_bf16(ai[KS], bb, yi, 0, 0, 0);
}
__device__ __forceinline__ void stage_a(unsigned char* ws, int bg, int n2, LAS unsigned char* lds, int tid) {
    const int b = bg >> 2, g = bg & 3, lane = tid & 63, w = tid >> 6, r32 = lane & 31, hi = lane >> 5;
    const bf16_t* PXb = (const bf16_t*)(ws + WS_PX) + (size_t)b * SEQ * PXW + 768 + g * 128;
#pragma unroll
    for (int i = 0; i < 4; ++i) { const int q = tid + NTHR * i, kk = q >> 3, jc = (q & 7) * 8, n1 = kk & 127, isq = kk >> 7;
        const bf16x8 v = __builtin_nontemporal_load((const bf16x8*)(PXb + (size_t)(64 * n1 + n2) * PXW + isq * 64 + jc)); *(LAS bf16x8*)(lds + img_off(kk, jc)) = v; }
    const int kb = w & 3, d0 = w >> 2;
    bf16x8 ar[16], ai[16];
    { const bf16_t* gar = (const bf16_t*)(ws + WS_GA) + (size_t)(kb * 32 + r32) * 256 + 8 * hi; const bf16_t* gai = gar + 128 * 256;
#pragma unroll
      for (int k = 0; k < 16; ++k) { ar[k] = *(const bf16x8*)(gar + k * 16); ai[k] = *(const bf16x8*)(gai + k * 16); } }
    __syncthreads();
    const int vb = (int)(uintptr_t)lds + rd_base(lane) + d0 * 512;
    f32x16 yr = {0}, yi = {0};
    a_step<0>(yr, yi, vb, ar, ai); a_step<1>(yr, yi, vb, ar, ai); a_step<2>(yr, yi, vb, ar, ai); a_step<3>(yr, yi, vb, ar, ai);
    a_step<4>(yr, yi, vb, ar, ai); a_step<5>(yr, yi, vb, ar, ai); a_step<6>(yr, yi, vb, ar, ai); a_step<7>(yr, yi, vb, ar, ai);
    a_step<8>(yr, yi, vb, ar, ai); a_step<9>(yr, yi, vb, ar, ai); a_step<10>(yr, yi, vb, ar, ai); a_step<11>(yr, yi, vb, ar, ai);
    a_step<12>(yr, yi, vb, ar, ai); a_step<13>(yr, yi, vb, ar, ai); a_step<14>(yr, yi, vb, ar, ai); a_step<15>(yr, yi, vb, ar, ai);
    const float2* tw = (const float2*)(ws + WS_FTAB); bf16_t* FT = (bf16_t*)(ws + WS_FT);
#pragma unroll
    for (int r = 0; r < 16; ++r) { const int k1 = kb * 32 + (r & 3) + 8 * (r >> 2) + 4 * hi; const float2 t = tw[(n2 * k1) & 8191];
        bf16_t* dst = FT + (((size_t)bg * 128 + k1) * 64 + n2) * 128 + d0 * 32 + r32;
        dst[0] = (bf16_t)f2bf(t.x * yr[r] + t.y * yi[r]); dst[64] = (bf16_t)f2bf(t.x * yi[r] - t.y * yr[r]); }
    __syncthreads();
}
template <int KS> __device__ __forceinline__ void b_step(f32x16 (&acc)[2][2], int vb, const bf16x8 (&g0)[8], const bf16x8 (&g1)[8]) {
    const s16x4 l0 = tr_read<KS * 2048>(vb), h0 = tr_read<KS * 2048 + 1024>(vb), l1 = tr_read<KS * 2048 + 512>(vb), h1 = tr_read<KS * 2048 + 1536>(vb);
    asm volatile("s_waitcnt lgkmcnt(0)" ::: "memory"); __builtin_amdgcn_sched_barrier(0);
    const bf16x8 b0 = FOU_PK(l0, h0), b1 = FOU_PK(l1, h1);
    acc[0][0] = __builtin_amdgcn_mfma_f32_32x32x16_bf16(g0[KS], b0, acc[0][0], 0, 0, 0); acc[0][1] = __builtin_amdgcn_mfma_f32_32x32x16_bf16(g0[KS], b1, acc[0][1], 0, 0, 0);
    acc[1][0] = __builtin_amdgcn_mfma_f32_32x32x16_bf16(g1[KS], b0, acc[1][0], 0, 0, 0); acc[1][1] = __builtin_amdgcn_mfma_f32_32x32x16_bf16(g1[KS], b1, acc[1][1], 0, 0, 0);
}
__device__ __forceinline__ void stage_b(unsigned char* ws, int bg, int k1base, LAS unsigned char* lds, int tid) {
    const int b = bg >> 2, g = bg & 3, lane = tid & 63, w = tid >> 6, r32 = lane & 31, hi = lane >> 5, k1 = k1base + w;
    const bf16_t* src = (const bf16_t*)(ws + WS_FT) + ((size_t)bg * 128 + k1) * 64 * 128;
    LAS unsigned char* my = lds + w * 16384;
#pragma unroll
    for (int i = 0; i < 16; ++i) { const int q = lane + 64 * i, kk = q >> 3, jc = (q & 7) * 8; const bf16x8 v = __builtin_nontemporal_load((const bf16x8*)(src + q * 8)); *(LAS bf16x8*)(my + img_off(kk, jc)) = v; }
    bf16x8 g0[8], g1[8];
    { const bf16_t* gb = (const bf16_t*)(ws + WS_GB) + (size_t)r32 * 128 + 8 * hi;
#pragma unroll
      for (int k = 0; k < 8; ++k) { g0[k] = *(const bf16x8*)(gb + k * 16); g1[k] = *(const bf16x8*)(gb + 32 * 128 + k * 16); } }
    asm volatile("s_waitcnt lgkmcnt(0)" ::: "memory"); __builtin_amdgcn_sched_barrier(0);
    const int vb = (int)(uintptr_t)my + rd_base(lane);
    f32x16 acc[2][2] = {};
    b_step<0>(acc, vb, g0, g1); b_step<1>(acc, vb, g0, g1); b_step<2>(acc, vb, g0, g1); b_step<3>(acc, vb, g0, g1); b_step<4>(acc, vb, g0, g1); b_step<5>(acc, vb, g0, g1); b_step<6>(acc, vb, g0, g1); b_step<7>(acc, vb, g0, g1);
    bf16_t* MIXA = (bf16_t*)(ws + WS_MIXA);
#pragma unroll
    for (int rb = 0; rb < 2; ++rb)
#pragma unroll
        for (int r = 0; r < 16; ++r) { const int k2 = rb * 32 + (r & 3) + 8 * (r >> 2) + 4 * hi; bf16_t* dst = MIXA + ((size_t)b * SEQ + k1 + 128 * k2) * D + 768 + g * 64 + r32;
            dst[0] = (bf16_t)f2bf(acc[rb][0][r]); dst[32] = (bf16_t)f2bf(acc[rb][1][r]); }
}
#undef FOU_PK
}


#define XB_TMO      128
#define XB_XCNT(j)  (256  + 64 * (j))
#define XB_XSUB(j)  (1280 + 64 * (j))
#define XB_XGEN(j)  (2304 + 64 * (j))
#define XB_TOP      3328
#define XB_TOPGEN   3392
#define XCD_BAR_WORDS 3456
#define XB_SPIN_CAP (1u << 18)
__device__ __forceinline__ unsigned xb_ld(unsigned* p)              { return __hip_atomic_load(p, __ATOMIC_RELAXED, __HIP_MEMORY_SCOPE_AGENT); }
__device__ __forceinline__ unsigned xb_add(unsigned* p, unsigned v) { return __hip_atomic_fetch_add(p, v, __ATOMIC_RELAXED, __HIP_MEMORY_SCOPE_AGENT); }
__device__ __forceinline__ unsigned xb_xcc_id() { return (unsigned)__builtin_amdgcn_s_getreg((3 << 11) | 20) & 0xFu; }
#define XB_SPIN(cond, bar) do { unsigned _sp = 0; while (cond) { __builtin_amdgcn_s_sleep(1); \
    if ((++_sp & 255u) == 0u) { if (xb_ld(&(bar)[XB_TMO])) break; if (_sp > XB_SPIN_CAP) { atomicAdd(&(bar)[XB_TMO], 1u); break; } } } } while (0)
struct XcdBarrier { unsigned* bar; unsigned x; volatile LAS unsigned* st; };
__device__ __forceinline__ XcdBarrier xcd_barrier_post(unsigned* bar, volatile LAS unsigned* st) {
    XcdBarrier b; b.bar = bar; b.x = xb_xcc_id(); b.st = st;
    if (threadIdx.x == 0) (void)xb_add(&bar[XB_XCNT(b.x)], 1u);
    return b;
}
__device__ __forceinline__ void xcd_barrier_complete(unsigned* bar, unsigned x, unsigned& nloc, unsigned& nx) {
    const unsigned G = gridDim.x * gridDim.y * gridDim.z;
    unsigned sum, cnt, mine, sp = 0u;
    for (;;) {
        sum = 0u; cnt = 0u; mine = 0u;
#pragma unroll
        for (unsigned j = 0; j < 16; ++j) { const unsigned c = xb_ld(&bar[XB_XCNT(j)]); sum += c; cnt += (c > 0u) ? 1u : 0u; mine = (j == x) ? c : mine; }
        if (sum == G) break;
        __builtin_amdgcn_s_sleep(1);
        if ((++sp & 255u) == 0u) { if (xb_ld(&bar[XB_TMO])) break; if (sp > XB_SPIN_CAP) { atomicAdd(&bar[XB_TMO], 1u); break; } }
    }
    nloc = mine > 0u ? mine : 1u; nx = cnt > 0u ? cnt : 1u;
}
__device__ __forceinline__ void xcd_barrier(const XcdBarrier& b) {
    asm volatile("s_waitcnt vmcnt(0)" ::: "memory");
    __syncthreads();
    if (threadIdx.x == 0) {
        unsigned* bar = b.bar;
        __builtin_amdgcn_s_waitcnt(0);
        unsigned nloc = b.st[0], nx = b.st[1];
        if (nloc == 0u) { xcd_barrier_complete(bar, b.x, nloc, nx); b.st[0] = nloc; b.st[1] = nx; }
        const unsigned old = xb_add(&bar[XB_XSUB(b.x)], 1u);
        const unsigned gen = old / nloc;
        if (old + 1u == (gen + 1u) * nloc) {
            __builtin_amdgcn_fence(__ATOMIC_RELEASE, "agent");
            asm volatile("s_waitcnt vmcnt(0)" ::: "memory");
            const unsigned og = xb_add(&bar[XB_TOP], 1u);
            const unsigned tg = og / nx;
            if (og + 1u == (tg + 1u) * nx) xb_add(&bar[XB_TOPGEN], 1u);
            else XB_SPIN(xb_ld(&bar[XB_TOPGEN]) == tg, bar);
            __builtin_amdgcn_fence(__ATOMIC_ACQUIRE, "agent");
            xb_add(&bar[XB_XGEN(b.x)], 1u);
            asm volatile("s_waitcnt vmcnt(0)" ::: "memory");
        } else {
            XB_SPIN(xb_ld(&bar[XB_XGEN(b.x)]) == gen, bar);
            __builtin_amdgcn_fence(__ATOMIC_ACQUIRE, "agent");
            asm volatile("s_waitcnt vmcnt(0)" ::: "memory");
        }
    }
    __syncthreads();
}

enum { PH_PREP = 0, PH_MODUL = 1, PH_INPROJ = 2, PH_ROW1 = 3, PH_QKV = 4, PH_ATTN = 5, PH_ACOMB = 6, PH_OUTPROJ = 7, PH_ROW2 = 8, PH_LIST = 9, PH_MOE1 = 10, PH_MOE2 = 11, PH_FINAL = 12, NPH = 13 };
__global__ void __launch_bounds__(NTHR, 2) mega(P p) {
    extern __shared__ __attribute__((aligned(16))) unsigned char lds_raw[];
    LAS unsigned char* lds = (LAS unsigned char*)lds_raw;
    const int wg = blockIdx.x, nwg = gridDim.x;
    const int lo = p.ph_lo, hi = p.ph_hi;
    int wv = __builtin_amdgcn_readfirstlane((int)(threadIdx.x >> 6)); asm volatile("" : "+s"(wv));
    if (threadIdx.x == 0) { ((volatile LAS unsigned*)(lds + LDS_CTL))[0] = 0u; ((volatile LAS unsigned*)(lds + LDS_CTL))[1] = 0u; }
    __syncthreads();
    XcdBarrier bar; bar.bar = (unsigned*)(p.ws + WS_CTL) + 4096; bar.x = 0; bar.st = (volatile LAS unsigned*)(lds + LDS_CTL);
    if (hi - lo > 1) bar = xcd_barrier_post((unsigned*)(p.ws + WS_CTL) + 4096, (volatile LAS unsigned*)(lds + LDS_CTL));
#define SEAM(k) do { if (lo <= (k) && (k) + 1 < hi) xcd_barrier(bar); } while (0)
#ifndef PHMASK
#define PHMASK 0xFFFF
#endif
#define IN(k) (((PHMASK >> (k)) & 1) && lo <= (k) && (k) < hi)
    unsigned char* ws = p.ws;
#ifndef REPMASK
#define REPMASK 0
#endif
#define PHASE(k, ...) do { if (IN(k)) { _Pragma("unroll") for (int rep_ = 0; rep_ < 1 + ((REPMASK >> (k)) & 1); ++rep_) { if (rep_) xcd_barrier(bar); __VA_ARGS__ } } SEAM(k); } while (0)
    PHASE(PH_PREP, ph_prologue(p, wg, nwg, fresh_tid(wv), lds););
    PHASE(PH_MODUL, ph_modulate(p, wg, nwg, fresh_tid(wv)););
    PHASE(PH_INPROJ, { const pg8::DenseSched S{MA / 256, PXW / 256, nwg, wg, D, D, 0, (const char*)(ws + WS_WIN)}; const pg8::EpiRowMajor E{(bf16_t*)(ws + WS_PX), PXW};
        pg8::gemm_phase(lds, fresh_tid(wv), (const char*)(ws + WS_HX), D, S, E);
        if (nwg == NWG && wg >= 74) p0_expert_items(p, NEI_PREP + (wg - 74), 182, NEI_PREP + FILL_IN, fresh_tid(wv), (LAS float*)lds); });
    PHASE(PH_ROW1, { ph_row1(p, wg, nwg, fresh_tid(wv));
        { const int tid = fresh_tid(wv); __syncthreads(); for (int u = wg; u < 512; u += nwg) fou::stage_a(ws, u >> 6, u & 63, lds, tid); } });
    PHASE(PH_QKV, {
        { const int tid = fresh_tid(wv); for (int u = (wg + nwg / 2) % nwg; u < 128; u += nwg) fou::stage_b(ws, u >> 4, (u & 15) * 8, lds, tid); __syncthreads(); }
        { const pg8::DenseSched S{ML / 256, 5, nwg, wg, QL, PXW, 0, (const char*)(ws + WS_WQ)}; const pg8::EpiQ E{ws}; pg8::gemm_phase(lds, fresh_tid(wv), (const char*)(ws + WS_PX), QL, S, E); }
        { const pg8::DenseSched S{MA / 256, 6, nwg, wg, KVL, PXW, 512, (const char*)(ws + WS_WKV)}; const pg8::EpiKV E{ws}; pg8::gemm_phase(lds, fresh_tid(wv), (const char*)(ws + WS_PX), KVL, S, E); }
        if (nwg == NWG && wg >= 64) { const int tid = fresh_tid(wv); constexpr int QB = NEI_PREP + FILL_IN;
            if (wg < 128) p0_expert_items(p, QB + (wg - 64), 64, QB + 128, tid, (LAS float*)lds);
            else if (wg < 140) p0_expert_items(p, QB + 128 + (wg - 128), 12, QB + 140, tid, (LAS float*)lds);
            else { p0_expert_items(p, QB + 140 + (wg - 140), 116, QB + 372, tid, (LAS float*)lds);
                   if (wg <= 220) p0_expert_items(p, QB + 372 + (wg - 140), 81, QB + 453, tid, (LAS float*)lds); } } });
    static_assert(NEI_PREP + FILL_IN + 453 == NEI, "filler shares");
    PHASE(PH_ATTN, ph_attn(p, wg, nwg, lds, wv););
    PHASE(PH_ACOMB, ph_acomb(p, wg, nwg, fresh_tid(wv)););
    PHASE(PH_OUTPROJ, { const pg8::DenseSched S{ML / 256, D / 256, nwg, wg, D, D, 0, (const char*)(ws + WS_WOUT)}; const pg8::EpiRowMajor E{(bf16_t*)(ws + WS_MIX), D};
        pg8::gemm_phase(lds, fresh_tid(wv), (const char*)(ws + WS_MIXA), D, S, E); });
    PHASE(PH_ROW2, ph_row2(p, wg, nwg, fresh_tid(wv), lds););
    PHASE(PH_LIST, ph_lists(p, wg, nwg, fresh_tid(wv), lds););
    PHASE(PH_MOE1, { const int tid = fresh_tid(wv);
        LAS int* tileL = (LAS int*)(lds + LDS_CTL + 2048); LAS unsigned* lstL = (LAS unsigned*)(lds + LDS_CTL + 4096);
        const int* TILEE = (const int*)(ws + WS_TILEE); const int* SLOTTOK = (const int*)(ws + WS_SLOTTOK);
        for (int i = tid; i < MAXTILES; i += NTHR) tileL[i] = TILEE[i];
        if (tid == 0) tileL[300] = TILEE[400];
        __syncthreads();
        const pg8::MoeSched<8, true, MOE_FP8> S{nwg, wg, tileL, lstL, (const char*)(ws + WS_WGU), 2048};
        { pg8::GUnit u; for (int i = 0; i < 16 && S.next(i, u); ++i) if (tid < 256) lstL[i * 256 + tid] = (unsigned)SLOTTOK[u.arow + tid] * (MOE_FP8 ? 1024u : 2048u); }
        __syncthreads();
        if constexpr (MOE_FP8) { const pg8::EpiAct8 E{ws + WS_ACT, p.in[20], p.in[22], 1.f / WSCALE}; pg8::gemm_phase<pg8::EpiAct8, pg8::MoeSched<8, true, MOE_FP8>, true>(lds, tid, (const char*)(ws + WS_HX), D, S, E); }
        else { const pg8::EpiAct E{(bf16_t*)(ws + WS_ACT), p.in[20], p.in[22]}; pg8::gemm_phase(lds, fresh_tid(wv), (const char*)(ws + WS_HX), D, S, E); } });
    PHASE(PH_MOE2, { const int tid = fresh_tid(wv);
        LAS int* tileL = (LAS int*)(lds + LDS_CTL + 2048); LAS unsigned* lstL = (LAS unsigned*)(lds + LDS_CTL + 4096);
        const int* TILEE = (const int*)(ws + WS_TILEE);
        for (int i = tid; i < MAXTILES; i += NTHR) tileL[i] = TILEE[i];
        if (tid == 0) tileL[300] = TILEE[400];
        __syncthreads();
        const pg8::MoeSched<4, false, MOE_FP8> S{nwg, wg, tileL, lstL, (const char*)(ws + WS_WD), 1024};
        const pg8::EpiY8 E{ws + WS_Y, p.in[24], MOE_FP8 ? 1.f / WSCALE : 1.f};
        pg8::gemm_phase<pg8::EpiY8, pg8::MoeSched<4, false, MOE_FP8>, MOE_FP8>(lds, tid, (const char*)(ws + WS_ACT), D, S, E); });
    PHASE(PH_FINAL, ph_final(p, wg, nwg, fresh_tid(wv)););
#undef PHASE
#undef IN
#undef SEAM
}

extern "C" void kernel_launch(void* const* d_in, const int* in_sizes, int n_in, void* d_out, int out_size, void* d_ws, size_t ws_size, hipStream_t stream) {
    static int ok = 0;
    if (ok == 0) {
        if (n_in != 25 || in_sizes[0] != ML * D || out_size != ML * D || ws_size < WS_END) { fprintf(stderr, "kernel_launch: unexpected shapes (n_in %d, in0 %d, out %d, ws %zu < %zu)\n", n_in, n_in > 0 ? in_sizes[0] : -1, out_size, ws_size, (size_t)WS_END); ok = -1; return; }
        if (hipFuncSetAttribute((const void*)mega, hipFuncAttributeMaxDynamicSharedMemorySize, LDS_BYTES) != hipSuccess) { fprintf(stderr, "kernel_launch: hipFuncSetAttribute failed\n"); ok = -1; return; }
        int dev = 0, cus = 0, per_cu = 0;
        if (hipGetDevice(&dev) != hipSuccess || hipDeviceGetAttribute(&cus, hipDeviceAttributeMultiprocessorCount, dev) != hipSuccess) { fprintf(stderr, "kernel_launch: device query failed\n"); ok = -1; return; }
        if (hipOccupancyMaxActiveBlocksPerMultiprocessor(&per_cu, (const void*)mega, NTHR, LDS_BYTES) != hipSuccess || per_cu < 1) { fprintf(stderr, "kernel_launch: occupancy query says %d blocks per CU\n", per_cu); (void)hipGetLastError(); }
        if (cus != NWG) fprintf(stderr, "kernel_launch: %d CUs (built for %d)\n", cus, NWG);
        ok = cus < NWG ? cus : NWG;
    }
    if (ok < 0) return;
    const int grid = ok;
    (void)hipMemsetAsync((char*)d_ws + WS_CTL, 0, CTL_BYTES, stream);
    P p{}; for (int i = 0; i < 25; ++i) p.in[i] = (const float*)d_in[i]; p.out = (float*)d_out; p.ws = (unsigned char*)d_ws;
#define MEGA(a, b) do { p.ph_lo = (a); p.ph_hi = (b); hipLaunchKernelGGL(mega, dim3(grid), dim3(NTHR), LDS_BYTES, stream, p); } while (0)
#ifdef MULTI_LAUNCH
    for (int ph = 0; ph < NPH; ++ph) MEGA(ph, ph + 1);
#else
    MEGA(0, NPH);
#endif
#undef MEGA
    const hipError_t le = hipPeekAtLastError();
    if (le != hipSuccess) fprintf(stderr, "kernel_launch: launch failed: %s\n", hipGetErrorName(le));
}
```
